# Optimizing an MI355X kernel written in HIP

```python
import math
import jax
import jax.numpy as jnp
from jax import lax
import numpy as np

D_MODEL = 1024
BATCH = 4
SEQ = 4096
DEPTH = 1

HEAD_DIM = 64
A_GROUPS = ((128, 1), (512, 4), (2048, 16))
A_HEADS = 4
A_QKV_COLS = len(A_GROUPS) * 3 * A_HEADS * HEAD_DIM
A_OUT = A_HEADS * HEAD_DIM
B_Q_HEADS = 8
B_KV_HEADS = 2
B_GROUP = B_Q_HEADS // B_KV_HEADS
B_WINDOW = 128
B_Q_COLS = B_Q_HEADS * HEAD_DIM
B_KV_COLS = B_KV_HEADS * HEAD_DIM
M_HEADS = 4
M_HEAD_DIM = 128
M_Q_COLS = M_HEADS * M_HEAD_DIM
MEM_LEN = 256
IN_SPLITS = (A_QKV_COLS,
             A_QKV_COLS + B_Q_COLS,
             A_QKV_COLS + B_Q_COLS + B_KV_COLS,
             A_QKV_COLS + B_Q_COLS + 2 * B_KV_COLS)
IN_COLS = IN_SPLITS[-1] + M_Q_COLS
N_BRANCH = 3
D_FF = 2816
CONV_WIDTH = 3
ROPE_THETA = 500000.0
ROPE_DIM_FRAC = 4
BLOCK = 128
EPS = 1e-6

kernel_name = 'hybrid_dilated_swa_memory_convffn'


def rmsnorm(t, gain):
    tf = t.astype(jnp.float32)
    y = tf * lax.rsqrt(jnp.mean(tf * tf, axis=-1, keepdims=True) + EPS)
    return (y * gain.astype(jnp.float32)).astype(t.dtype)


def rope_partial(t, positions):
    dh = t.shape[-1]
    rot = dh // ROPE_DIM_FRAC
    half = rot // 2
    freqs = jnp.exp(jnp.arange(half, dtype=jnp.float32) * (-2.0 * math.log(ROPE_THETA) / rot))
    ang = positions.astype(jnp.float32)[:, :, None, None] * freqs
    cos, sin = jnp.cos(ang), jnp.sin(ang)
    t1 = t[..., :half].astype(jnp.float32)
    t2 = t[..., half:rot].astype(jnp.float32)
    rotated = jnp.concatenate([t1 * cos - t2 * sin, t2 * cos + t1 * sin], axis=-1).astype(t.dtype)
    return jnp.concatenate([rotated, t[..., rot:]], axis=-1)


def banded_attn(q, k, v, max_dist, sink=None):
    assert max_dist <= BLOCK
    n, hk, g, L, dh = q.shape
    nb = -(-L // BLOCK)
    pad = nb * BLOCK - L
    q = jnp.pad(q, ((0, 0), (0, 0), (0, 0), (0, pad), (0, 0))).reshape(n, hk, g, nb, BLOCK, dh)
    k = jnp.pad(k, ((0, 0), (0, 0), (0, pad), (0, 0))).reshape(n, hk, nb, BLOCK, dh)
    v = jnp.pad(v, ((0, 0), (0, 0), (0, pad), (0, 0))).reshape(n, hk, nb, BLOCK, dh)

    def with_prev(t):
        prev = jnp.pad(t, ((0, 0), (0, 0), (1, 0), (0, 0), (0, 0)))[:, :, :-1]
        return jnp.concatenate([prev, t], axis=3)

    kw, vw = with_prev(k), with_prev(v)
    s = jnp.einsum('nhgbqd,nhbkd->nhgbqk', q, kw).astype(jnp.float32) * (dh ** -0.5)
    qi = jnp.arange(BLOCK)[:, None]
    kj = jnp.arange(2 * BLOCK)[None, :]
    dist = qi + BLOCK - kj
    band = (dist >= 0) & (dist <= max_dist)
    blk = jnp.arange(nb)[:, None, None]
    mask = band[None] & ((blk > 0) | (kj[None] >= BLOCK))
    s = jnp.where(mask, s, -jnp.inf)
    lse = jax.nn.logsumexp(s, axis=-1)
    if sink is not None:
        lse = jnp.logaddexp(lse, sink.astype(jnp.float32)[None, :, :, None, None])
    p = jnp.exp(s - lse[..., None])
    o = jnp.einsum('nhgbqk,nhbkd->nhgbqd', p.astype(v.dtype), vw)
    o = o.reshape(n, hk, g, nb * BLOCK, dh)[:, :, :, :L]
    lse = lse.reshape(n, hk, g, nb * BLOCK)[:, :, :, :L]
    return o, lse


def to_residue(t, d):
    b, s, h, dh = t.shape
    return t.reshape(b, s // d, d, h, dh).transpose(0, 2, 3, 1, 4).reshape(b * d, h, s // d, dh)


def from_residue(t, d):
    nd, h, L = t.shape[:3]
    rest = t.shape[3:]
    t = t.reshape(nd // d, d, h, L, *rest)
    t = jnp.moveaxis(t, 3, 1)
    return t.reshape(nd // d, L * d, h, *rest)


def dilated_mixture_attn(qkv_a, positions, q_gain, k_gain):
    b, s = qkv_a.shape[:2]
    outs, lses = [], []
    for gi, (window, dil) in enumerate(A_GROUPS):
        q = rope_partial(rmsnorm(qkv_a[:, :, gi, 0], q_gain[gi]), positions)
        k = rope_partial(rmsnorm(qkv_a[:, :, gi, 1], k_gain[gi]), positions)
        v = qkv_a[:, :, gi, 2]
        o, lse = banded_attn(to_residue(q, dil)[:, :, None], to_residue(k, dil),
                             to_residue(v, dil), window // dil)
        outs.append(from_residue(o[:, :, 0], dil))
        lses.append(from_residue(lse[:, :, 0], dil))
    w = jax.nn.softmax(jnp.stack(lses), axis=0)
    o = jnp.einsum('gbshd,gbsh->bshd', jnp.stack(outs), w.astype(qkv_a.dtype))
    return o.reshape(b, s, A_OUT)


def sink_swa_gqa(q, k, v, positions, q_gain, k_gain, sinks):
    b, s = q.shape[:2]
    q = rope_partial(rmsnorm(q, q_gain), positions)
    k = rope_partial(rmsnorm(k, k_gain), positions)
    qg = q.reshape(b, s, B_KV_HEADS, B_GROUP, HEAD_DIM).transpose(0, 2, 3, 1, 4)
    o, _ = banded_attn(qg, k.transpose(0, 2, 1, 3), v.transpose(0, 2, 1, 3),
                       B_WINDOW - 1, sink=sinks.reshape(B_KV_HEADS, B_GROUP))
    return o.transpose(0, 3, 1, 2, 4).reshape(b, s, B_Q_COLS)


def memory_attn(mq, mem, mem_gain, w_kv, q_gain, k_gain):
    b, s = mq.shape[:2]
    m = mem.shape[1]
    kv = (rmsnorm(mem, mem_gain) @ w_kv).reshape(b, m, 2, M_HEADS, M_HEAD_DIM)
    mk = rmsnorm(kv[:, :, 0], k_gain)
    mv = kv[:, :, 1]
    q = rmsnorm(mq.reshape(b, s, M_HEADS, M_HEAD_DIM), q_gain)
    sc = jnp.einsum('bshd,bmhd->bhsm', q, mk).astype(jnp.float32) * (M_HEAD_DIM ** -0.5)
    p = jax.nn.softmax(sc, axis=-1)
    o = jnp.einsum('bhsm,bmhd->bshd', p.astype(mv.dtype), mv)
    return o.reshape(b, s, M_Q_COLS)


def conv_ffn(h, w_up, conv_w, conv_b, w_down):
    s = h.shape[1]
    u = h @ w_up
    up = jnp.pad(u, ((0, 0), (CONV_WIDTH - 1, 0), (0, 0)))
    c = conv_b
    for j in range(CONV_WIDTH):
        c = c + conv_w[j] * up[:, j:j + s]
    a, g = jnp.split(c, 2, axis=-1)
    return (jax.nn.silu(a) * g) @ w_down


def setup_inputs(seed: int = 0) -> dict:
    key = jax.random.key(seed)
    ks = jax.random.split(key, 32)
    f32 = jnp.float32
    L = DEPTH

    def w(k, shape, fan_in):
        return jax.random.normal(k, shape, f32) * (fan_in ** -0.5)

    def gain(k, shape):
        return 1.0 + 0.02 * jax.random.normal(k, shape, f32)

    positions = (jax.random.randint(ks[2], (BATCH, 1), 0, 1024, dtype=jnp.int32)
                 + jnp.arange(SEQ, dtype=jnp.int32)[None, :])
    return {
        'x': jax.random.normal(ks[0], (BATCH, SEQ, D_MODEL), f32),
        'mem': jax.random.normal(ks[1], (BATCH, MEM_LEN, D_MODEL), f32),
        'positions': positions,
        'attn_norm': gain(ks[3], (L, D_MODEL)),
        'w_in': w(ks[4], (L, D_MODEL, IN_COLS), D_MODEL),
        'a_q_norm': gain(ks[5], (L, len(A_GROUPS), HEAD_DIM)),
        'a_k_norm': gain(ks[6], (L, len(A_GROUPS), HEAD_DIM)),
        'b_q_norm': gain(ks[7], (L, HEAD_DIM)),
        'b_k_norm': gain(ks[8], (L, HEAD_DIM)),
        'b_sinks': jax.random.normal(ks[9], (L, B_Q_HEADS), f32),
        'mem_norm': gain(ks[10], (L, D_MODEL)),
        'w_mem_kv': w(ks[11], (L, D_MODEL, 2 * M_Q_COLS), D_MODEL),
        'm_q_norm': gain(ks[12], (L, M_HEAD_DIM)),
        'm_k_norm': gain(ks[13], (L, M_HEAD_DIM)),
        'w_o_a': w(ks[14], (L, A_OUT, D_MODEL), A_OUT),
        'w_o_b': w(ks[15], (L, B_Q_COLS, D_MODEL), B_Q_COLS),
        'w_o_m': w(ks[16], (L, M_Q_COLS, D_MODEL), M_Q_COLS),
        'w_gate': w(ks[17], (L, D_MODEL, N_BRANCH * D_MODEL), D_MODEL),
        'b_gate': 0.01 * jax.random.normal(ks[18], (L, N_BRANCH * D_MODEL), f32),
        'w_out': w(ks[19], (L, D_MODEL, D_MODEL), D_MODEL),
        'ffn_norm': gain(ks[20], (L, D_MODEL)),
        'w_up': w(ks[21], (L, D_MODEL, 2 * D_FF), D_MODEL),
        'conv_w': w(ks[22], (L, CONV_WIDTH, 2 * D_FF), CONV_WIDTH),
        'conv_b': 0.01 * jax.random.normal(ks[23], (L, 2 * D_FF), f32),
        'w_down': w(ks[24], (L, D_FF, D_MODEL), D_FF),
    }


def reference(x, mem, positions, attn_norm, w_in, a_q_norm, a_k_norm, b_q_norm, b_k_norm,
              b_sinks, mem_norm, w_mem_kv, m_q_norm, m_k_norm, w_o_a, w_o_b, w_o_m,
              w_gate, b_gate, w_out, ffn_norm, w_up, conv_w, conv_b, w_down):
    b, s, _ = x.shape
    for l in range(DEPTH):
        h = rmsnorm(x, attn_norm[l])
        proj = h @ w_in[l]
        qkv_a, b_q, b_k, b_v, m_q = jnp.split(proj, IN_SPLITS, axis=-1)
        qkv_a = qkv_a.reshape(b, s, len(A_GROUPS), 3, A_HEADS, HEAD_DIM)
        o_a = dilated_mixture_attn(qkv_a, positions, a_q_norm[l], a_k_norm[l])
        o_b = sink_swa_gqa(b_q.reshape(b, s, B_Q_HEADS, HEAD_DIM),
                           b_k.reshape(b, s, B_KV_HEADS, HEAD_DIM),
                           b_v.reshape(b, s, B_KV_HEADS, HEAD_DIM),
                           positions, b_q_norm[l], b_k_norm[l], b_sinks[l])
        o_m = memory_attn(m_q, mem, mem_norm[l], w_mem_kv[l], m_q_norm[l], m_k_norm[l])
        gates = jax.nn.sigmoid((h @ w_gate[l] + b_gate[l]).astype(jnp.float32))
        gates = gates.astype(x.dtype).reshape(b, s, N_BRANCH, D_MODEL)
        merged = (gates[:, :, 0] * (o_a @ w_o_a[l])
                  + gates[:, :, 1] * (o_b @ w_o_b[l])
                  + gates[:, :, 2] * (o_m @ w_o_m[l]))
        x = x + merged @ w_out[l]
        x = x + conv_ffn(rmsnorm(x, ffn_norm[l]), w_up[l], conv_w[l], conv_b[l], w_down[l])
    return x
```

```cpp
#include <hip/hip_runtime.h>
#include <cstdio>
#include <cstdint>

#ifndef MK_MULTI
#define MK_MULTI 1
#endif

#define LAS __attribute__((address_space(3)))
#define GAS __attribute__((address_space(1)))
typedef unsigned short bf16_t;
typedef short bf16x8 __attribute__((ext_vector_type(8)));
typedef short s16x4 __attribute__((ext_vector_type(4)));
typedef float f32x4 __attribute__((ext_vector_type(4)));
typedef float f32x16 __attribute__((ext_vector_type(16)));
typedef unsigned u32x4 __attribute__((ext_vector_type(4)));
typedef unsigned u32x2 __attribute__((ext_vector_type(2)));

constexpr int T_ = 16384, SEQ_ = 4096, NB_ = 4, DM_ = 1024, MEM_ = 256, DFF_ = 2816;
constexpr int NCAT = 7680;
constexpr int KCAT = 1280;
constexpr float EPS_ = 1e-6f;
constexpr float LOG2E = 1.4426950408889634f;
constexpr float QSCALE64 = 0.125f * LOG2E;
constexpr float QSCALE128 = 0.08838834764831845f * LOG2E;

__device__ __forceinline__ unsigned cvtpk(float lo, float hi) {
    typedef float f2 __attribute__((ext_vector_type(2))); typedef __bf16 b2 __attribute__((ext_vector_type(2)));
    f2 v = {lo, hi}; b2 b = __builtin_convertvector(v, b2); return __builtin_bit_cast(unsigned, b);
}
__device__ __forceinline__ float bflo(unsigned w) { return __uint_as_float(w << 16); }
__device__ __forceinline__ float bfhi(unsigned w) { return __uint_as_float(w & 0xffff0000u); }

namespace pg8 {
constexpr int BM = 256, BK = 64, HALF = 128, HTB = HALF * BK * 2, STAGE_BYTES = 8 * HTB, NXCD = 8, WGM = 8;
__host__ __device__ __forceinline__ int lds_byte(int r, int c) { const int st = (r >> 4) * 2 + (c >> 5), rr = r & 15, cc = c & 31, ob = rr * 64 + cc * 2; return st * 1024 + (ob ^ (((ob >> 9) & 1) << 5)); }
__host__ __device__ __forceinline__ void stage_rc(int b, int& R, int& C) { const int st = b / 1024, sb = b % 1024, swz = sb ^ (((sb >> 9) & 1) << 5); R = (st >> 1) * 16 + swz / 64; C = (st & 1) * 32 + (swz % 64) / 2; }
__host__ __device__ __forceinline__ int perm32(int rho) { const int n = rho >> 4, i = rho & 15; return 8 * (i >> 2) + 4 * n + (i & 3); }

struct Unit { int pm, pn; };
struct Gemm { const bf16_t* A; const bf16_t* Bt; int M, N, K; };

struct StaticOrder {
    int nM, nN, nwg, G, c;
    __host__ __device__ void init(int M, int N, int G_, int c_) { nM = M / BM; nN = N / BM; nwg = nM * nN; G = G_; c = c_; }
    __host__ __device__ bool next(int i, Unit& u) const {
        const long L = (long)i * G + c; if (L >= nwg) return false;
        int wgid = (int)L; { const int q = nwg / NXCD, r = nwg % NXCD, xcd = wgid % NXCD, off = wgid / NXCD; wgid = (xcd < r ? xcd * (q + 1) : r * (q + 1) + (xcd - r) * q) + off; }
        const int nig = WGM * nN, gid = wgid / nig, fm = gid * WGM, gsz = (nM - fm) < WGM ? (nM - fm) : WGM;
        u.pm = fm + ((wgid % nig) % gsz); u.pn = (wgid % nig) / gsz; return true;
    }
    __device__ __forceinline__ void a_ready(const Unit&) const {}
    __device__ __forceinline__ void done(const Unit&) const {}
};

template <class Epi, class Sched, bool ALIGN_EPI, bool PERMA, bool KHOOK>
__device__ __forceinline__ void gemm_phase(LAS unsigned char* lds, const Gemm g, const Sched& S, const Epi& E) {
    const int tid = threadIdx.x, wid = __builtin_amdgcn_readfirstlane(tid >> 6), lane = tid & 63, wr = wid >> 2, wc = wid & 3, fr = lane & 15, fq = lane >> 4;
    const int K = g.K, nt = K / BK;
    unsigned voffA0[2], voffA1[2], voffB[2];
#pragma unroll
    for (int i = 0; i < 2; ++i) { int R, C; stage_rc(tid * 16 + i * 8192, R, C); const int Rb = (R & ~31) + perm32(R & 31);
        if (PERMA) { const int rw = R >> 6, rm = (R >> 4) & 3, rf = R & 15; voffA0[i] = (unsigned)((128 * rw + 8 * rf + rm) * K + C) * 2u; voffA1[i] = (unsigned)((128 * rw + 8 * rf + 4 + rm) * K + C) * 2u; }
        else { voffA0[i] = (unsigned)(R * K + C) * 2u; voffA1[i] = voffA0[i]; }
        voffB[i] = (unsigned)(Rb * K + C) * 2u; }
    const size_t kstep = (size_t)(BK * 2);
    const size_t hstep = (size_t)HALF * K * 2;
    const size_t ahs = PERMA ? (size_t)0 : hstep;
    const size_t tstep = 2 * hstep;
    const unsigned ldsw = (unsigned)wid * 1024u;
    const int aoff = lds_byte(wr * 64 + fr, fq * 8), boff = lds_byte(wc * 32 + fr, fq * 8);
#define PG8_SA(b, h) (((b) * 2 + (h)) * HTB)
#define PG8_SB(b, h) ((4 + (b) * 2 + (h)) * HTB)
#define PG8_STAGE(bufoff, gbase, voff) do { _Pragma("unroll") for (int _i = 0; _i < 2; ++_i) \
        __builtin_amdgcn_global_load_lds((const unsigned*)((const char*)(gbase) + (voff)[_i]), (LAS unsigned*)(lds + (bufoff) + ldsw + _i * 8192), 16, 0, 0); } while (0)
#define PG8_LDA(dst, b, h) do { _Pragma("unroll") for (int m = 0; m < 4; ++m) _Pragma("unroll") for (int k = 0; k < 2; ++k) dst[m][k] = *(const LAS bf16x8*)(lds + PG8_SA(b, h) + aoff + m * 2048 + k * 1024); } while (0)
#define PG8_LDB(dst, b, h) do { _Pragma("unroll") for (int n = 0; n < 2; ++n) _Pragma("unroll") for (int k = 0; k < 2; ++k) dst[n][k] = *(const LAS bf16x8*)(lds + PG8_SB(b, h) + boff + n * 2048 + k * 1024); } while (0)
#define PG8_MMA(ai, bj, At, Bt) do { __builtin_amdgcn_s_setprio(1); _Pragma("unroll") for (int m = 0; m < 4; ++m) _Pragma("unroll") for (int n = 0; n < 2; ++n) _Pragma("unroll") for (int k = 0; k < 2; ++k) \
        acc[ai][bj][m][n] = __builtin_amdgcn_mfma_f32_16x16x32_bf16(Bt[n][k], At[m][k], acc[ai][bj][m][n], 0, 0, 0); __builtin_amdgcn_s_setprio(0); } while (0)
#define PG8_WAIT_V(n) asm volatile("s_waitcnt vmcnt(" #n ")" ::: "memory")
#define PG8_WAIT_L(n) asm volatile("s_waitcnt lgkmcnt(" #n ")" ::: "memory")
#define PG8_BAR __builtin_amdgcn_s_barrier()
#define PG8_SCHED __builtin_amdgcn_sched_barrier(0)
    Unit cur, nxt; int ui = 0;
    if (!S.next(0, cur)) return;
    f32x4 acc[2][2][4][2];
#pragma unroll
    for (int a = 0; a < 2; ++a)
#pragma unroll
        for (int b = 0; b < 2; ++b)
#pragma unroll
            for (int m = 0; m < 4; ++m)
#pragma unroll
                for (int n = 0; n < 2; ++n) acc[a][b][m][n] = (f32x4){0.f, 0.f, 0.f, 0.f};
    bf16x8 At[4][2], B0[2][2], B1[2][2];
    const char* cA = (const char*)g.A + (size_t)cur.pm * tstep; const char* cB = (const char*)g.Bt + (size_t)cur.pn * tstep;
    S.a_ready(cur);
    PG8_STAGE(PG8_SB(0, 0), cB, voffB); PG8_STAGE(PG8_SB(0, 1), cB + hstep, voffB); PG8_STAGE(PG8_SA(0, 0), cA, voffA0); PG8_STAGE(PG8_SA(0, 1), cA + ahs, voffA1);
    if (wr == 1) PG8_BAR;
    PG8_WAIT_V(2); PG8_BAR;
    PG8_STAGE(PG8_SB(1, 0), cB + kstep, voffB); PG8_STAGE(PG8_SA(1, 0), cA + kstep, voffA0); PG8_STAGE(PG8_SB(1, 1), cB + hstep + kstep, voffB);
    PG8_WAIT_V(6); PG8_BAR;
    for (;;) {
        const bool has_next = S.next(ui + 1, nxt);
        const char* nA = has_next ? (const char*)g.A + (size_t)nxt.pm * tstep : cA; const char* nB = has_next ? (const char*)g.Bt + (size_t)nxt.pn * tstep : cB;
        for (int t = 0; t < nt; t += 2) {
            const bool last = (t == nt - 2);
            const char* a1 = cA + (size_t)(t + 1) * kstep;
            const char* a2 = last ? nA : cA + (size_t)(t + 2) * kstep; const char* b2 = last ? nB : cB + (size_t)(t + 2) * kstep;
            const char* a3 = a2 + kstep; const char* b3 = b2 + kstep;
            if (last && has_next) S.a_ready(nxt);
            if constexpr (KHOOK) E.khook(acc, cur, t, wr, wc, fr, fq);
            PG8_LDB(B0, 0, 0); PG8_LDB(B1, 0, 1); PG8_SCHED; PG8_LDA(At, 0, 0); PG8_STAGE(PG8_SA(1, 1), a1 + ahs, voffA1);
            PG8_WAIT_V(8); PG8_WAIT_L(0); PG8_BAR; PG8_MMA(0, 0, At, B0); PG8_MMA(0, 1, At, B1); PG8_BAR; PG8_SCHED;
            PG8_LDA(At, 0, 1); PG8_STAGE(PG8_SB(0, 0), b2, voffB); PG8_STAGE(PG8_SB(0, 1), b2 + hstep, voffB); PG8_STAGE(PG8_SA(0, 0), a2, voffA0);
            PG8_WAIT_V(8); PG8_WAIT_L(0); PG8_BAR; PG8_MMA(1, 0, At, B0); PG8_MMA(1, 1, At, B1); PG8_BAR; PG8_SCHED;
            PG8_LDB(B0, 1, 0); PG8_LDB(B1, 1, 1); PG8_SCHED; PG8_LDA(At, 1, 0); PG8_STAGE(PG8_SA(0, 1), a2 + ahs, voffA1);
            PG8_WAIT_V(8); PG8_WAIT_L(0); PG8_BAR; PG8_MMA(0, 0, At, B0); PG8_MMA(0, 1, At, B1); PG8_BAR; PG8_SCHED;
            PG8_LDA(At, 1, 1); PG8_STAGE(PG8_SB(1, 0), b3, voffB); PG8_STAGE(PG8_SB(1, 1), b3 + hstep, voffB); PG8_STAGE(PG8_SA(1, 0), a3, voffA0);
            PG8_WAIT_V(8); PG8_WAIT_L(0); PG8_BAR; PG8_MMA(1, 0, At, B0); PG8_MMA(1, 1, At, B1); PG8_BAR; PG8_SCHED;
        }
        if constexpr (ALIGN_EPI) { if (wr == 0) PG8_BAR; }
        E(acc, cur, wr, wc, fr, fq); S.done(cur);
        if (!has_next) break;
#pragma unroll
        for (int a = 0; a < 2; ++a)
#pragma unroll
            for (int b = 0; b < 2; ++b)
#pragma unroll
                for (int m = 0; m < 4; ++m)
#pragma unroll
                    for (int n = 0; n < 2; ++n) acc[a][b][m][n] = (f32x4){0.f, 0.f, 0.f, 0.f};
        cur = nxt; cA = nA; cB = nB; ++ui;
        if constexpr (ALIGN_EPI) { if (wr == 1) PG8_BAR; }
    }
    PG8_WAIT_V(0);
    if constexpr (!ALIGN_EPI) { if (wr == 0) PG8_BAR; }
    PG8_BAR;
#undef PG8_SA
#undef PG8_SB
#undef PG8_STAGE
#undef PG8_LDA
#undef PG8_LDB
#undef PG8_MMA
#undef PG8_WAIT_V
#undef PG8_WAIT_L
#undef PG8_BAR
#undef PG8_SCHED
}
}

constexpr size_t MiB = 1u << 20;
constexpr size_t WS_CTL = 0, CTL_ZERO_BYTES = 1 * MiB;
constexpr size_t WS_WO = 1 * MiB;
constexpr size_t WS_WOUT = 4 * MiB;
constexpr size_t WS_WUP = 6 * MiB;
constexpr size_t WS_WDOWN = 17 * MiB;
constexpr size_t WS_SSQ = 23 * MiB;
constexpr size_t WS_UE = 24 * MiB;
constexpr size_t WS_UF = 27 * MiB;
constexpr size_t WS_LSE = 30 * MiB;
constexpr size_t WS_MKV = 31 * MiB;
constexpr size_t WS_G = 34 * MiB;
constexpr size_t WS_ACT = 34 * MiB;
constexpr size_t WS_QA = 130 * MiB;
constexpr size_t WS_KA = 154 * MiB;
constexpr size_t WS_VA = 178 * MiB;
constexpr size_t WS_MERGED = 130 * MiB;
constexpr size_t WS_X1B = 162 * MiB;
constexpr size_t WS_QB = 202 * MiB;
constexpr size_t WS_KVB = 218 * MiB;
constexpr size_t WS_MQ = 226 * MiB;
constexpr size_t WS_END = 242 * MiB;
constexpr size_t DO_A1 = 0;
constexpr size_t DO_WCAT = 34 * MiB;
constexpr size_t DO_ROPE = 49 * MiB;
constexpr size_t DO_OCAT = 0;
constexpr size_t DO_OAG = 40 * MiB;

constexpr int CW_TMO = 0, CW_BAR = 4096;

constexpr int RING_OFF = 0, RING_BYTES = 131072;
constexpr int XCH_OFF = RING_BYTES;
constexpr int LDSCTL_OFF = RING_BYTES + 4096, MISC_OFF = LDSCTL_OFF + 320;
constexpr int LDS_BYTES = 147456;
constexpr int NWAVES = 8;
constexpr int NPHASES = 8;

typedef GAS unsigned gu32;
#define RLX_AGENT __ATOMIC_RELAXED, __HIP_MEMORY_SCOPE_AGENT
#define LDS_WAIT() asm volatile("s_waitcnt lgkmcnt(0)" ::: "memory")
#define VM_WAIT() asm volatile("s_waitcnt vmcnt(0)" ::: "memory")

#define XB_TMO      128
#define XB_XCNT(j)  (256  + 64 * (j))
#define XB_XSUB(j)  (1280 + 64 * (j))
#define XB_XGEN(j)  (2304 + 64 * (j))
#define XB_TOP      3328
#define XB_TOPGEN   3392
#define XCD_BAR_WORDS 3456
#define XB_SPIN_CAP (1u << 18)
__device__ __forceinline__ unsigned xb_ld(unsigned* p)              { return __hip_atomic_load(p, __ATOMIC_RELAXED, __HIP_MEMORY_SCOPE_AGENT); }
__device__ __forceinline__ unsigned xb_add(unsigned* p, unsigned v) { return __hip_atomic_fetch_add(p, v, __ATOMIC_RELAXED, __HIP_MEMORY_SCOPE_AGENT); }
__device__ __forceinline__ unsigned xb_xcc_id() { return (unsigned)__builtin_amdgcn_s_getreg((3 << 11) | 20) & 0xFu; }
#define XB_SPIN(cond, bar) do { unsigned _sp = 0; while (cond) { __builtin_amdgcn_s_sleep(1); \
    if ((++_sp & 255u) == 0u) { if (xb_ld(&(bar)[XB_TMO])) break; if (_sp > XB_SPIN_CAP) { atomicAdd(&(bar)[XB_TMO], 1u); break; } } } } while (0)
struct XcdBarrier { unsigned* bar; unsigned x; volatile LAS unsigned* st; };
__device__ __forceinline__ XcdBarrier xcd_barrier_post(unsigned* bar, volatile LAS unsigned* st) {
    XcdBarrier b; b.bar = bar; b.x = xb_xcc_id(); b.st = st;
    if (threadIdx.x == 0) (void)xb_add(&bar[XB_XCNT(b.x)], 1u);
    return b;
}
__device__ __forceinline__ void xcd_barrier_complete(unsigned* bar, unsigned x, unsigned& nloc, unsigned& nx) {
    const unsigned G = gridDim.x * gridDim.y * gridDim.z;
    unsigned sum, cnt, mine, sp = 0u;
    for (;;) {
        sum = 0u; cnt = 0u; mine = 0u;
#pragma unroll
        for (unsigned j = 0; j < 16; ++j) { const unsigned c = xb_ld(&bar[XB_XCNT(j)]); sum += c; cnt += (c > 0u) ? 1u : 0u; mine = (j == x) ? c : mine; }
        if (sum == G) break;
        __builtin_amdgcn_s_sleep(1);
        if ((++sp & 255u) == 0u) { if (xb_ld(&bar[XB_TMO])) break; if (sp > XB_SPIN_CAP) { atomicAdd(&bar[XB_TMO], 1u); break; } }
    }
    nloc = mine > 0u ? mine : 1u; nx = cnt > 0u ? cnt : 1u;
}
__device__ __forceinline__ void xcd_barrier(const XcdBarrier& b) {
    asm volatile("s_waitcnt vmcnt(0)" ::: "memory");
    __syncthreads();
    if (threadIdx.x == 0) {
        unsigned* bar = b.bar;
        __builtin_amdgcn_s_waitcnt(0);
        unsigned nloc = b.st[0], nx = b.st[1];
        if (nloc == 0u) { xcd_barrier_complete(bar, b.x, nloc, nx); b.st[0] = nloc; b.st[1] = nx; }
        const unsigned old = xb_add(&bar[XB_XSUB(b.x)], 1u);
        const unsigned gen = old / nloc;
        if (old + 1u == (gen + 1u) * nloc) {
            __builtin_amdgcn_fence(__ATOMIC_RELEASE, "agent");
            asm volatile("s_waitcnt vmcnt(0)" ::: "memory");
            const unsigned og = xb_add(&bar[XB_TOP], 1u);
            const unsigned tg = og / nx;
            if (og + 1u == (tg + 1u) * nx) xb_add(&bar[XB_TOPGEN], 1u);
            else XB_SPIN(xb_ld(&bar[XB_TOPGEN]) == tg, bar);
            __builtin_amdgcn_fence(__ATOMIC_ACQUIRE, "agent");
            xb_add(&bar[XB_XGEN(b.x)], 1u);
            asm volatile("s_waitcnt vmcnt(0)" ::: "memory");
        } else {
            XB_SPIN(xb_ld(&bar[XB_XGEN(b.x)]) == gen, bar);
            __builtin_amdgcn_fence(__ATOMIC_ACQUIRE, "agent");
            asm volatile("s_waitcnt vmcnt(0)" ::: "memory");
        }
    }
    __syncthreads();
}

struct Args {
    const float* in[25]; float* out; unsigned char* ws; int ph_lo, ph_hi, li, pad;
};
enum { I_X = 0, I_MEM, I_POS, I_ATTN_NORM, I_W_IN, I_AQ, I_AK, I_BQ, I_BK, I_SINK, I_MEM_NORM, I_W_MKV, I_MQN, I_MKN, I_WOA, I_WOB, I_WOM, I_WGATE, I_BGATE, I_WOUT, I_FFN_NORM, I_WUP, I_CONVW, I_CONVB, I_WDOWN };

__host__ __device__ __forceinline__ int map_uniform(int n) { const int c = n & 255; return (n & ~255) + 128 * ((c >> 5) & 1) + 32 * (c >> 6) + (c & 31); }
__host__ __device__ __forceinline__ int map_up(int n) { return n < DFF_ ? 256 * (n >> 7) + (n & 127) : 256 * ((n - DFF_) >> 7) + 128 + ((n - DFF_) & 127); }

__device__ __forceinline__ float wave_sum(float v) {
#pragma unroll
    for (int o = 1; o < 64; o <<= 1) v += __shfl_xor(v, o);
    return v;
}
template <int MAP>
__device__ __forceinline__ void p0_transpose_item(const float* W, int K, int N, bf16_t* WT, int noff, int pitch, int koff, const float* kscale, LAS float* scr, int item, int lane) {
    const int nblk = N / 32, kb = item / nblk, nb = item % nblk, k0 = 64 * kb, n0 = 32 * nb;
#pragma unroll 8
    for (int i = 0; i < 32; ++i) { const int kk = 2 * i + (lane >> 5); float v = W[(size_t)(k0 + kk) * N + n0 + (lane & 31)]; if (kscale) v *= kscale[k0 + kk]; scr[kk * 33 + (lane & 31)] = v; }
    LDS_WAIT(); asm volatile("" ::: "memory");
    const int c = lane & 7;
    const int r0 = MAP == 0 ? map_uniform(noff + n0) : map_up(noff + n0);
#pragma unroll
    for (int j = 0; j < 4; ++j) { const int n = (lane >> 3) + 8 * j; const LAS float* s = scr + (8 * c) * 33 + n;
        u32x4 o; o.x = cvtpk(s[0 * 33], s[1 * 33]); o.y = cvtpk(s[2 * 33], s[3 * 33]); o.z = cvtpk(s[4 * 33], s[5 * 33]); o.w = cvtpk(s[6 * 33], s[7 * 33]);
        *(GAS u32x4*)(WT + (size_t)(r0 + n) * pitch + koff + k0 + 8 * c) = o; }
    LDS_WAIT(); asm volatile("" ::: "memory");
}
__device__ __forceinline__ void rms_row_to_bf16(const float* xrow, const float* gain, bf16_t* orow, int lane) {
    const GAS f32x4* xr = (const GAS f32x4*)xrow + lane; const GAS f32x4* gr = (const GAS f32x4*)gain + lane;
    f32x4 v[4]; float s = 0.f;
#pragma unroll
    for (int j = 0; j < 4; ++j) { v[j] = xr[64 * j]; s += (v[j].x * v[j].x + v[j].y * v[j].y) + (v[j].z * v[j].z + v[j].w * v[j].w); }
    const float rstd = 1.0f / sqrtf(wave_sum(s) * (1.f / 1024.f) + EPS_);
    GAS u32x2* o8 = (GAS u32x2*)orow + lane;
#pragma unroll
    for (int j = 0; j < 4; ++j) { const f32x4 g = gr[64 * j]; u32x2 w; w.x = cvtpk(v[j].x * rstd * g.x, v[j].y * rstd * g.y); w.y = cvtpk(v[j].z * rstd * g.z, v[j].w * rstd * g.w); o8[64 * j] = w; }
}
__device__ __forceinline__ void sincos_f(float ang, float& co, float& si) {
    const double x = (double)ang; const double n = __builtin_rint(x * 0.63661977236758134308);
    double r = __builtin_fma(-n, 1.5707963267948966192, x); r = __builtin_fma(-n, 6.123233995736766036e-17, r);
    const double r2 = r * r;
    double s = -1.0 / 6227020800.0; s = s * r2 + 1.0 / 39916800.0; s = s * r2 - 1.0 / 362880.0; s = s * r2 + 1.0 / 5040.0; s = s * r2 - 1.0 / 120.0; s = s * r2 + 1.0 / 6.0; s = r - r * r2 * s;
    double c = 1.0 / 479001600.0; c = c * r2 - 1.0 / 3628800.0; c = c * r2 + 1.0 / 40320.0; c = c * r2 - 1.0 / 720.0; c = c * r2 + 1.0 / 24.0; c = c * r2 - 0.5; c = c * r2 + 1.0;
    const int q = (int)((long long)n & 3);
    const double cs = (q == 0) ? c : (q == 1) ? -s : (q == 2) ? -c : s;
    const double sn = (q == 0) ? s : (q == 1) ? c : (q == 2) ? -s : -c;
    co = (float)cs; si = (float)sn;
}

struct Frame {
    LAS unsigned char* lds;
    int tid, lane, wave, vcu, G;
    const Args* a;
};

__device__ __forceinline__ void p0_prologue(const Args& A, LAS unsigned char* lds, int vcu, int G, int wave, int lane) {
    LAS float* scr = (LAS float*)(lds + RING_OFF + wave * 16384);
    const int gw = vcu * NWAVES + wave, NGW = G * NWAVES;
    bf16_t* wcat = (bf16_t*)((unsigned char*)A.out + DO_WCAT);
    bf16_t* a1 = (bf16_t*)((unsigned char*)A.out + DO_A1);
    float* rope = (float*)((unsigned char*)A.out + DO_ROPE);
    bf16_t* wo = (bf16_t*)(A.ws + WS_WO); bf16_t* wout = (bf16_t*)(A.ws + WS_WOUT); bf16_t* wup = (bf16_t*)(A.ws + WS_WUP); bf16_t* wdown = (bf16_t*)(A.ws + WS_WDOWN);
    constexpr int I_IN = (1024 / 64) * (3584 / 32), I_GATE = (1024 / 64) * (3072 / 32), I_MKV = (1024 / 64) * (1024 / 32);
    constexpr int I_OA = (256 / 64) * (1024 / 32), I_OB = (512 / 64) * (1024 / 32), I_OM = I_OB, I_OUT = (1024 / 64) * (1024 / 32);
    constexpr int I_UP = (1024 / 64) * (5632 / 32), I_DOWN = (2816 / 64) * (1024 / 32);
    constexpr int NITEMS = I_IN + I_GATE + I_MKV + I_OA + I_OB + I_OM + I_OUT + I_UP + I_DOWN;
    for (int it = gw; it < NITEMS; it += NGW) {
        int r = it;
        if (r < I_IN) { p0_transpose_item<0>(A.in[I_W_IN], 1024, 3584, wcat, 0, 1024, 0, nullptr, scr, r, lane); continue; } r -= I_IN;
        if (r < I_GATE) { p0_transpose_item<0>(A.in[I_WGATE], 1024, 3072, wcat, 3584, 1024, 0, nullptr, scr, r, lane); continue; } r -= I_GATE;
        if (r < I_MKV) { p0_transpose_item<0>(A.in[I_W_MKV], 1024, 1024, wcat, 6656, 1024, 0, nullptr, scr, r, lane); continue; } r -= I_MKV;
        if (r < I_OA) { p0_transpose_item<0>(A.in[I_WOA], 256, 1024, wo, 0, KCAT, 0, nullptr, scr, r, lane); continue; } r -= I_OA;
        if (r < I_OB) { p0_transpose_item<0>(A.in[I_WOB], 512, 1024, wo, 0, KCAT, 256, nullptr, scr, r, lane); continue; } r -= I_OB;
        if (r < I_OM) { p0_transpose_item<0>(A.in[I_WOM], 512, 1024, wo, 0, KCAT, 768, nullptr, scr, r, lane); continue; } r -= I_OM;
        if (r < I_OUT) { p0_transpose_item<0>(A.in[I_WOUT], 1024, 1024, wout, 0, 1024, 0, nullptr, scr, r, lane); continue; } r -= I_OUT;
        if (r < I_UP) { p0_transpose_item<1>(A.in[I_WUP], 1024, 5632, wup, 0, 1024, 0, A.in[I_FFN_NORM], scr, r, lane); continue; } r -= I_UP;
        p0_transpose_item<0>(A.in[I_WDOWN], 2816, 1024, wdown, 0, 2816, 0, nullptr, scr, r, lane);
    }
    for (int m = gw; m < T_ + NB_ * MEM_; m += NGW) {
        if (m < T_) rms_row_to_bf16(A.in[I_X] + (size_t)m * DM_, A.in[I_ATTN_NORM], a1 + (size_t)m * DM_, lane);
        else rms_row_to_bf16(A.in[I_MEM] + (size_t)(m - T_) * DM_, A.in[I_MEM_NORM], a1 + (size_t)m * DM_, lane);
    }
    const int* pos = (const int*)A.in[I_POS];
    for (int idx = gw * 64 + lane; idx < T_ * 8; idx += NGW * 64) {
        const int t = idx >> 3, i = idx & 7;
        const float fr = (i == 0) ? 1.0f : (i == 1) ? 0.193922758102417f : (i == 2) ? 0.03760603442788124f : (i == 3) ? 0.007292666472494602f : (i == 4) ? 0.0014142136787995696f
                       : (i == 5) ? 0.00027424818836152554f : (i == 6) ? 5.318298644851893e-05f : 1.031338433676865e-05f;
        const float ang = (float)pos[t] * fr; float co, si; sincos_f(ang, co, si);
        rope[t * 16 + i] = co; rope[t * 16 + 8 + i] = si;
    }
}

struct P1Order {
    pg8::StaticOrder so;
    __device__ void init(int G, int c) { so.init(T_, 6656, G, c); }
    __device__ bool next(int i, pg8::Unit& u) const {
        if (so.next(i, u)) return true;
        const long L = (long)i * so.G + so.c - so.nwg; if (L < 0 || L >= 16) return false;
        u.pm = 64 + (int)(L >> 2); u.pn = 26 + (int)(L & 3); return true;
    }
    __device__ __forceinline__ void a_ready(const pg8::Unit&) const {}
    __device__ __forceinline__ void done(const pg8::Unit&) const {}
};

struct Epi1 {
    static constexpr bool PERM = true;
    unsigned char* ws; const float* rope; const float *aq, *ak, *bq, *bk, *bgate;
    __device__ __forceinline__ void plain(const f32x4 (&acc)[2][2][4][2], bf16_t* dst, int ld, int col0, int row0, int wr, int wc, int fr, int fq) const {
#pragma unroll
        for (int ai = 0; ai < 2; ++ai)
#pragma unroll
            for (int m = 0; m < 4; ++m) { bf16_t* rowp = dst + (size_t)(row0 + ai * 128 + wr * 64 + m * 16 + fr) * ld + col0 + wc * 64 + 8 * fq;
#pragma unroll
                for (int bj = 0; bj < 2; ++bj) { const f32x4 v0 = acc[ai][bj][m][0], v1 = acc[ai][bj][m][1]; u32x4 w; w.x = cvtpk(v0[0], v0[1]); w.y = cvtpk(v0[2], v0[3]); w.z = cvtpk(v1[0], v1[1]); w.w = cvtpk(v1[2], v1[3]);
                    *(u32x4*)(rowp + 32 * bj) = w; } }
    }
    __device__ __forceinline__ void normed(const f32x4 (&acc)[2][2][4][2], bf16_t* dst, int ld, int col0, int row0, const float* gain, float scale, int wr, int wc, int fr, int fq) const {
        f32x4 g[2][2];
#pragma unroll
        for (int bj = 0; bj < 2; ++bj)
#pragma unroll
            for (int n = 0; n < 2; ++n) g[bj][n] = *(const f32x4*)(gain + 32 * bj + 8 * fq + 4 * n) * scale;
#pragma unroll
        for (int ai = 0; ai < 2; ++ai)
#pragma unroll
            for (int m = 0; m < 4; ++m) {
                const int row = row0 + ai * 128 + wr * 64 + m * 16 + fr;
                float ss = 0.f;
#pragma unroll
                for (int bj = 0; bj < 2; ++bj)
#pragma unroll
                    for (int n = 0; n < 2; ++n) { const f32x4 x = acc[ai][bj][m][n]; ss += (x[0] * x[0] + x[1] * x[1]) + (x[2] * x[2] + x[3] * x[3]); }
                ss += __shfl_xor(ss, 16); ss += __shfl_xor(ss, 32);
                const float rs = 1.0f / sqrtf(ss * (1.f / 64.f) + EPS_);
                f32x4 v[2][2];
#pragma unroll
                for (int bj = 0; bj < 2; ++bj)
#pragma unroll
                    for (int n = 0; n < 2; ++n) v[bj][n] = acc[ai][bj][m][n] * rs * g[bj][n];
                const float* cs = rope + (size_t)row * 16;
#pragma unroll
                for (int n = 0; n < 2; ++n) {
                    const f32x4 co = *(const f32x4*)(cs + 4 * n), si = *(const f32x4*)(cs + 8 + 4 * n);
                    f32x4 pr;
#pragma unroll
                    for (int e = 0; e < 4; ++e) pr[e] = __shfl_xor(v[0][n][e], 16);
                    const f32x4 r0 = v[0][n] * co - pr * si, r1 = v[0][n] * co + pr * si;
                    v[0][n] = (fq == 0) ? r0 : (fq == 1) ? r1 : v[0][n];
                }
                bf16_t* rowp = dst + (size_t)row * ld + col0 + wc * 64 + 8 * fq;
#pragma unroll
                for (int bj = 0; bj < 2; ++bj) { u32x4 w; w.x = cvtpk(v[bj][0][0], v[bj][0][1]); w.y = cvtpk(v[bj][0][2], v[bj][0][3]); w.z = cvtpk(v[bj][1][0], v[bj][1][1]); w.w = cvtpk(v[bj][1][2], v[bj][1][3]);
                    *(u32x4*)(rowp + 32 * bj) = w; }
            }
    }
    __device__ __forceinline__ void gates(const f32x4 (&acc)[2][2][4][2], bf16_t* dst, int col0, int row0, int wr, int wc, int fr, int fq) const {
        f32x4 bv[2][2];
#pragma unroll
        for (int bj = 0; bj < 2; ++bj)
#pragma unroll
            for (int n = 0; n < 2; ++n) bv[bj][n] = *(const f32x4*)(bgate + col0 + wc * 64 + 32 * bj + 8 * fq + 4 * n);
#pragma unroll
        for (int ai = 0; ai < 2; ++ai)
#pragma unroll
            for (int m = 0; m < 4; ++m) { bf16_t* rowp = dst + (size_t)(row0 + ai * 128 + wr * 64 + m * 16 + fr) * 3072 + col0 + wc * 64 + 8 * fq;
#pragma unroll
                for (int bj = 0; bj < 2; ++bj) { f32x4 v[2];
#pragma unroll
                    for (int n = 0; n < 2; ++n) { const f32x4 z = (acc[ai][bj][m][n] + bv[bj][n]) * (-LOG2E);
#pragma unroll
                        for (int e = 0; e < 4; ++e) v[n][e] = __builtin_amdgcn_rcpf(1.0f + __builtin_amdgcn_exp2f(z[e])); }
                    u32x4 w; w.x = cvtpk(v[0][0], v[0][1]); w.y = cvtpk(v[0][2], v[0][3]); w.z = cvtpk(v[1][0], v[1][1]); w.w = cvtpk(v[1][2], v[1][3]);
                    *(u32x4*)(rowp + 32 * bj) = w; } }
    }
    __device__ __forceinline__ void operator()(const f32x4 (&acc)[2][2][4][2], const pg8::Unit& u, int wr, int wc, int fr, int fq) const {
        const int pn = u.pn, row0 = u.pm * 256;
        if (pn >= 26) { plain(acc, (bf16_t*)(ws + WS_MKV), 1024, (pn - 26) * 256, row0 - T_, wr, wc, fr, fq); return; }
        if (pn >= 14) { gates(acc, (bf16_t*)(ws + WS_G), (pn - 14) * 256, row0, wr, wc, fr, fq); return; }
        if (pn >= 12) { plain(acc, (bf16_t*)(ws + WS_MQ), 512, (pn - 12) * 256, row0, wr, wc, fr, fq); return; }
        if (pn == 11) {
            if (wc >= 2) plain(acc, (bf16_t*)(ws + WS_KVB), 256, 0, row0, wr, wc, fr, fq);
            else normed(acc, (bf16_t*)(ws + WS_KVB), 256, 0, row0, bk, 1.0f, wr, wc, fr, fq);
            return;
        }
        if (pn >= 9) { normed(acc, (bf16_t*)(ws + WS_QB), 512, (pn - 9) * 256, row0, bq, QSCALE64, wr, wc, fr, fq); return; }
        const int gi = pn / 3, ty = pn - 3 * gi;
        if (ty == 2) { plain(acc, (bf16_t*)(ws + WS_VA) + (size_t)gi * T_ * 256, 256, 0, row0, wr, wc, fr, fq); return; }
        if (ty == 0) normed(acc, (bf16_t*)(ws + WS_QA) + (size_t)gi * T_ * 256, 256, 0, row0, aq + 64 * gi, QSCALE64, wr, wc, fr, fq);
        else normed(acc, (bf16_t*)(ws + WS_KA) + (size_t)gi * T_ * 256, 256, 0, row0, ak + 64 * gi, 1.0f, wr, wc, fr, fq);
    }
};

namespace att {
typedef short v4i16_t __attribute__((ext_vector_type(4)));
__device__ __forceinline__ int crow(int r, int h) { return (r & 3) + 8 * (r >> 2) + 4 * h; }
__device__ __forceinline__ s16x4 vtr(LAS const unsigned char* p) { return __builtin_bit_cast(s16x4, __builtin_amdgcn_ds_read_tr16_b64_v4i16((LAS v4i16_t*)p)); }

constexpr int KROW64 = 144, VROW64 = 128, NKEYS_B = 384;
constexpr int LDS_K64 = 0, LDS_V64 = NKEYS_B * KROW64;
constexpr int LDS_K128 = 0, LDS_V128 = 65536;

template <int ND>
__device__ __forceinline__ void softmax_tile(f32x16& s, float& m, float& l, f32x16 (&o)[ND], bf16x8 (&pf)[2]) {
    float mx = s[0];
#pragma unroll
    for (int r = 1; r < 16; ++r) mx = fmaxf(mx, s[r]);
    mx = fmaxf(mx, __shfl_xor(mx, 32));
    const float mn = fmaxf(m, mx), alpha = __builtin_amdgcn_exp2f(m - mn);
    m = mn;
    float ps = 0.f;
#pragma unroll
    for (int r = 0; r < 16; ++r) { s[r] = __builtin_amdgcn_exp2f(s[r] - mn); ps += s[r]; }
    l = l * alpha + ps;
#pragma unroll
    for (int d = 0; d < ND; ++d)
#pragma unroll
        for (int r = 0; r < 16; ++r) o[d][r] *= alpha;
#pragma unroll
    for (int k = 0; k < 2; ++k) { u32x4 w; w.x = cvtpk(s[8 * k + 0], s[8 * k + 1]); w.y = cvtpk(s[8 * k + 2], s[8 * k + 3]); w.z = cvtpk(s[8 * k + 4], s[8 * k + 5]); w.w = cvtpk(s[8 * k + 6], s[8 * k + 7]);
        pf[k] = __builtin_bit_cast(bf16x8, w); }
}

template <int W, bool SINK>
__device__ __forceinline__ void banded_unit(LAS unsigned char* lds, const bf16_t* q0, size_t qstride, const bf16_t* k0, const bf16_t* v0, size_t kvstride, bool first,
                                            bf16_t* o0, size_t ostride, float* lse0, size_t lsestride, float sink2, int tid, int wid, int lane) {
#pragma unroll
    for (int it = 0; it < 6; ++it) {
        const int c = tid + 512 * it, row = c >> 3, ch = c & 7;
        const bool valid = !(first && row < 128);
        u32x4 kv = (u32x4){0u, 0u, 0u, 0u}, vv = kv;
        if (valid) { const long off = ((long)row - 128) * (long)kvstride + ch * 8; kv = *(const u32x4*)(k0 + off); vv = *(const u32x4*)(v0 + off); }
        *(LAS u32x4*)(lds + LDS_K64 + row * KROW64 + ch * 16) = kv;
        *(LAS u32x4*)(lds + LDS_V64 + row * VROW64 + ((ch * 16) ^ (((row >> 1) & 1) << 6))) = vv;
    }
    const int c = lane & 31, h = lane >> 5;
    const int qi = 32 * wid + c;
    bf16x8 qf[4];
#pragma unroll
    for (int d0 = 0; d0 < 4; ++d0) qf[d0] = *(const bf16x8*)(q0 + (size_t)qi * qstride + 16 * d0 + 8 * h);
    __syncthreads();
    float m = -1e30f, l = 0.f; f32x16 o[2];
#pragma unroll
    for (int d = 0; d < 2; ++d)
#pragma unroll
        for (int r = 0; r < 16; ++r) o[d][r] = 0.f;
    int jlo = qi + 128 - W; if (first && jlo < 128) jlo = 128;
    const int jhi = qi + 128;
    const int qq = (lane & 15) >> 2;
    LAS const unsigned char* kbase = lds + LDS_K64 + c * KROW64 + 16 * h;
    LAS const unsigned char* vbase = lds + LDS_V64 + (4 * h + qq) * VROW64 + ((lane >> 4) & 1) * 32 + (lane & 3) * 8;
    const int vsw = (qq >> 1) & 1;
    for (int kt = wid; kt < wid + 5; ++kt) {
        f32x16 s;
#pragma unroll
        for (int r = 0; r < 16; ++r) s[r] = 0.f;
#pragma unroll
        for (int d0 = 0; d0 < 4; ++d0) { const bf16x8 kf = *(LAS const bf16x8*)(kbase + kt * 32 * KROW64 + d0 * 32); s = __builtin_amdgcn_mfma_f32_32x32x16_bf16(kf, qf[d0], s, 0, 0, 0); }
#pragma unroll
        for (int r = 0; r < 16; ++r) { const int j = 32 * kt + crow(r, h); if (j < jlo || j > jhi) s[r] = -INFINITY; }
        bf16x8 pf[2];
        softmax_tile<2>(s, m, l, o, pf);
#pragma unroll
        for (int d = 0; d < 2; ++d)
#pragma unroll
            for (int k = 0; k < 2; ++k) {
                LAS const unsigned char* vp = vbase + (kt * 32 + 16 * k) * VROW64 + 64 * (d ^ vsw);
                const s16x4 lo = vtr(vp), hi = vtr(vp + 8 * VROW64);
                const bf16x8 vf = (bf16x8){lo[0], lo[1], lo[2], lo[3], hi[0], hi[1], hi[2], hi[3]};
                o[d] = __builtin_amdgcn_mfma_f32_32x32x16_bf16(vf, pf[k], o[d], 0, 0, 0);
            }
    }
    float lt = l + __shfl_xor(l, 32);
    if (SINK) lt += __builtin_amdgcn_exp2f(sink2 - m);
    const float inv = 1.0f / lt;
    bf16_t* orow = o0 + (size_t)qi * ostride;
#pragma unroll
    for (int d = 0; d < 2; ++d)
#pragma unroll
        for (int rg = 0; rg < 4; ++rg) { u32x2 w; w.x = cvtpk(o[d][4 * rg] * inv, o[d][4 * rg + 1] * inv); w.y = cvtpk(o[d][4 * rg + 2] * inv, o[d][4 * rg + 3] * inv);
            *(u32x2*)(orow + 32 * d + 8 * rg + 4 * h) = w; }
    if (lse0 && h == 0) lse0[(size_t)qi * lsestride] = m + __builtin_amdgcn_logf(lt);
    __syncthreads();
}

__device__ __forceinline__ void mem_unit(LAS unsigned char* lds, const bf16_t* q0, const bf16_t* kmem, const bf16_t* vmem, const float* qgain, const float* kgain, bf16_t* o0, size_t ostride, int tid, int wid, int lane) {
#pragma unroll
    for (int it = 0; it < 8; ++it) {
        const int cc = tid + 512 * it, row = cc >> 4, ch = cc & 15;
        const u32x4 kv = *(const u32x4*)(kmem + (size_t)row * 1024 + ch * 8), vv = *(const u32x4*)(vmem + (size_t)row * 1024 + ch * 8);
        *(LAS u32x4*)(lds + LDS_K128 + row * 256 + ((ch ^ (row & 15)) * 16)) = kv;
        *(LAS u32x4*)(lds + LDS_V128 + row * 256 + ((ch * 16) ^ ((row & 3) << 6))) = vv;
    }
    const int c = lane & 31, h = lane >> 5;
    const int qi = 32 * wid + c;
    bf16x8 qf[8];
    {
        u32x4 raw[8]; float ss = 0.f;
#pragma unroll
        for (int d0 = 0; d0 < 8; ++d0) { raw[d0] = *(const u32x4*)(q0 + (size_t)qi * 512 + 16 * d0 + 8 * h);
#pragma unroll
            for (int e = 0; e < 4; ++e) { const float a = bflo(raw[d0][e]), b = bfhi(raw[d0][e]); ss += a * a + b * b; } }
        ss += __shfl_xor(ss, 32);
        const float rs = (1.0f / sqrtf(ss * (1.f / 128.f) + EPS_)) * QSCALE128;
#pragma unroll
        for (int d0 = 0; d0 < 8; ++d0) { const f32x4 g0 = *(const f32x4*)(qgain + 16 * d0 + 8 * h), g1 = *(const f32x4*)(qgain + 16 * d0 + 8 * h + 4);
            u32x4 w; w.x = cvtpk(bflo(raw[d0].x) * rs * g0[0], bfhi(raw[d0].x) * rs * g0[1]); w.y = cvtpk(bflo(raw[d0].y) * rs * g0[2], bfhi(raw[d0].y) * rs * g0[3]);
            w.z = cvtpk(bflo(raw[d0].z) * rs * g1[0], bfhi(raw[d0].z) * rs * g1[1]); w.w = cvtpk(bflo(raw[d0].w) * rs * g1[2], bfhi(raw[d0].w) * rs * g1[3]);
            qf[d0] = __builtin_bit_cast(bf16x8, w); }
    }
    __syncthreads();
    {
        const int row = tid >> 1, hf = tid & 1; u32x4 raw[8]; float ss = 0.f;
#pragma unroll
        for (int i = 0; i < 8; ++i) { raw[i] = *(LAS const u32x4*)(lds + LDS_K128 + row * 256 + (((hf * 8 + i) ^ (row & 15)) * 16));
#pragma unroll
            for (int e = 0; e < 4; ++e) { const float a = bflo(raw[i][e]), b = bfhi(raw[i][e]); ss += a * a + b * b; } }
        ss += __shfl_xor(ss, 1);
        const float rs = 1.0f / sqrtf(ss * (1.f / 128.f) + EPS_);
#pragma unroll
        for (int i = 0; i < 8; ++i) { const float* gp = kgain + 64 * hf + 8 * i; const f32x4 g0 = *(const f32x4*)gp, g1 = *(const f32x4*)(gp + 4);
            u32x4 w; w.x = cvtpk(bflo(raw[i].x) * rs * g0[0], bfhi(raw[i].x) * rs * g0[1]); w.y = cvtpk(bflo(raw[i].y) * rs * g0[2], bfhi(raw[i].y) * rs * g0[3]);
            w.z = cvtpk(bflo(raw[i].z) * rs * g1[0], bfhi(raw[i].z) * rs * g1[1]); w.w = cvtpk(bflo(raw[i].w) * rs * g1[2], bfhi(raw[i].w) * rs * g1[3]);
            *(LAS u32x4*)(lds + LDS_K128 + row * 256 + (((hf * 8 + i) ^ (row & 15)) * 16)) = w; }
    }
    __syncthreads();
    float m = -1e30f, l = 0.f; f32x16 o[4];
#pragma unroll
    for (int d = 0; d < 4; ++d)
#pragma unroll
        for (int r = 0; r < 16; ++r) o[d][r] = 0.f;
    const int qq = (lane & 15) >> 2;
    LAS const unsigned char* vbase = lds + LDS_V128 + (4 * h + qq) * 256 + ((lane >> 4) & 1) * 32 + (lane & 3) * 8;
    for (int kt = 0; kt < 8; ++kt) {
        f32x16 s;
#pragma unroll
        for (int r = 0; r < 16; ++r) s[r] = 0.f;
        const int krow = kt * 32 + c;
#pragma unroll
        for (int d0 = 0; d0 < 8; ++d0) { const bf16x8 kf = *(LAS const bf16x8*)(lds + LDS_K128 + krow * 256 + (((2 * d0 + h) ^ (krow & 15)) * 16)); s = __builtin_amdgcn_mfma_f32_32x32x16_bf16(kf, qf[d0], s, 0, 0, 0); }
        bf16x8 pf[2];
        softmax_tile<4>(s, m, l, o, pf);
#pragma unroll
        for (int d = 0; d < 4; ++d)
#pragma unroll
            for (int k = 0; k < 2; ++k) {
                LAS const unsigned char* vp = vbase + (kt * 32 + 16 * k) * 256 + 64 * (d ^ qq);
                const s16x4 lo = vtr(vp), hi = vtr(vp + 8 * 256);
                const bf16x8 vf = (bf16x8){lo[0], lo[1], lo[2], lo[3], hi[0], hi[1], hi[2], hi[3]};
                o[d] = __builtin_amdgcn_mfma_f32_32x32x16_bf16(vf, pf[k], o[d], 0, 0, 0);
            }
    }
    const float inv = 1.0f / (l + __shfl_xor(l, 32));
    bf16_t* orow = o0 + (size_t)qi * ostride;
#pragma unroll
    for (int d = 0; d < 4; ++d)
#pragma unroll
        for (int rg = 0; rg < 4; ++rg) { u32x2 w; w.x = cvtpk(o[d][4 * rg] * inv, o[d][4 * rg + 1] * inv); w.y = cvtpk(o[d][4 * rg + 2] * inv, o[d][4 * rg + 3] * inv);
            *(u32x2*)(orow + 32 * d + 8 * rg + 4 * h) = w; }
    __syncthreads();
}
}

__device__ __forceinline__ void p2_attention(const Args& A, LAS unsigned char* lds, int vcu, int tid, int wid, int lane) {
    unsigned char* ws = A.ws;
    bf16_t* ocat = (bf16_t*)((unsigned char*)A.out + DO_OCAT);
    bf16_t* oag = (bf16_t*)((unsigned char*)A.out + DO_OAG);
    float* lse = (float*)(ws + WS_LSE);
#pragma unroll 1
    for (int gi = 0; gi < 3; ++gi) {
        const int rem = vcu, b = rem >> 6, hd = (rem >> 4) & 3, i16 = rem & 15;
        const int dl = (gi == 0) ? 1 : (gi == 1) ? 4 : 16;
        int r, qb; if (gi == 0) { r = 0; qb = i16; } else if (gi == 1) { r = i16 >> 2; qb = i16 & 3; } else { r = i16; qb = 0; }
        const int i0 = qb * 256;
        const size_t row0 = (size_t)b * SEQ_ + r + (size_t)dl * i0;
        const bf16_t* q = (const bf16_t*)(ws + WS_QA) + (size_t)gi * T_ * 256 + row0 * 256 + hd * 64;
        const bf16_t* k = (const bf16_t*)(ws + WS_KA) + (size_t)gi * T_ * 256 + row0 * 256 + hd * 64;
        const bf16_t* v = (const bf16_t*)(ws + WS_VA) + (size_t)gi * T_ * 256 + row0 * 256 + hd * 64;
        bf16_t* o = oag + (size_t)gi * T_ * 256 + row0 * 256 + hd * 64;
        float* ls = lse + (size_t)gi * T_ * 4 + row0 * 4 + hd;
        att::banded_unit<128, false>(lds, q, (size_t)dl * 256, k, v, (size_t)dl * 256, i0 == 0, o, (size_t)dl * 256, ls, (size_t)dl * 4, 0.f, tid, wid, lane);
    }
#pragma unroll 1
    for (int j = 0; j < 2; ++j) {
        const int u = vcu + 256 * j, b = u >> 7, hq = (u >> 4) & 7, qb = u & 15, kvh = hq >> 2;
        const size_t row0 = (size_t)b * SEQ_ + (size_t)qb * 256;
        const bf16_t* q = (const bf16_t*)(ws + WS_QB) + row0 * 512 + hq * 64;
        const bf16_t* k = (const bf16_t*)(ws + WS_KVB) + row0 * 256 + kvh * 64;
        const bf16_t* v = (const bf16_t*)(ws + WS_KVB) + row0 * 256 + 128 + kvh * 64;
        bf16_t* o = ocat + row0 * KCAT + 256 + hq * 64;
        const float sink2 = A.in[I_SINK][hq] * LOG2E;
        att::banded_unit<127, true>(lds, q, 512, k, v, 256, qb == 0, o, KCAT, nullptr, 0, sink2, tid, wid, lane);
    }
    {
        const int u = vcu, b = u >> 6, hd = (u >> 4) & 3, qb = u & 15;
        const size_t row0 = (size_t)b * SEQ_ + (size_t)qb * 256;
        const bf16_t* q = (const bf16_t*)(ws + WS_MQ) + row0 * 512 + hd * 128;
        const bf16_t* km = (const bf16_t*)(ws + WS_MKV) + (size_t)b * MEM_ * 1024 + hd * 128;
        const bf16_t* vm = km + 512;
        bf16_t* o = ocat + row0 * KCAT + 768 + hd * 128;
        att::mem_unit(lds, q, km, vm, A.in[I_MQN], A.in[I_MKN], o, KCAT, tid, wid, lane);
    }
}

__device__ __forceinline__ void p2b_merge(const Args& A, int vcu, int G, int tid) {
    const bf16_t* oag = (const bf16_t*)((unsigned char*)A.out + DO_OAG);
    bf16_t* ocat = (bf16_t*)((unsigned char*)A.out + DO_OCAT);
    const float* lse = (const float*)(A.ws + WS_LSE);
    for (int idx = vcu * 512 + tid; idx < T_ * 32; idx += G * 512) {
        const int t = idx >> 5, ch = idx & 31, hd = ch >> 3;
        const float l0 = lse[(size_t)t * 4 + hd], l1 = lse[(size_t)T_ * 4 + (size_t)t * 4 + hd], l2 = lse[(size_t)2 * T_ * 4 + (size_t)t * 4 + hd];
        const float mx = fmaxf(l0, fmaxf(l1, l2));
        float w0 = __builtin_amdgcn_exp2f(l0 - mx), w1 = __builtin_amdgcn_exp2f(l1 - mx), w2 = __builtin_amdgcn_exp2f(l2 - mx);
        const float inv = 1.0f / (w0 + w1 + w2); w0 *= inv; w1 *= inv; w2 *= inv;
        const u32x4 a = *(const u32x4*)(oag + (size_t)t * 256 + ch * 8), b = *(const u32x4*)(oag + (size_t)T_ * 256 + (size_t)t * 256 + ch * 8), c = *(const u32x4*)(oag + (size_t)2 * T_ * 256 + (size_t)t * 256 + ch * 8);
        u32x4 w;
#pragma unroll
        for (int e = 0; e < 4; ++e) w[e] = cvtpk(w0 * bflo(a[e]) + w1 * bflo(b[e]) + w2 * bflo(c[e]), w0 * bfhi(a[e]) + w1 * bfhi(b[e]) + w2 * bfhi(c[e]));
        *(u32x4*)(ocat + (size_t)t * KCAT + ch * 8) = w;
    }
}

struct Epi3a {
    static constexpr bool PERM = true;
    const bf16_t* G; bf16_t* MERGED;
    __device__ __forceinline__ void khook(f32x4 (&acc)[2][2][4][2], const pg8::Unit& u, int t, int wr, int wc, int fr, int fq) const {
        if (t != 4 && t != 12) return;
        const int gsel = (t == 4) ? 0 : 1024;
#pragma unroll
        for (int ai = 0; ai < 2; ++ai)
#pragma unroll
            for (int m = 0; m < 4; ++m) { const bf16_t* gp = G + (size_t)(u.pm * 256 + ai * 128 + wr * 64 + m * 16 + fr) * 3072 + gsel + u.pn * 256 + wc * 64 + 8 * fq;
#pragma unroll
                for (int bj = 0; bj < 2; ++bj) { const u32x4 ga = *(const u32x4*)(gp + 32 * bj), gb = *(const u32x4*)(gp + 1024 + 32 * bj);
#pragma unroll
                    for (int e = 0; e < 4; ++e) { const float r0 = bflo(ga[e]) * __builtin_amdgcn_rcpf(fmaxf(bflo(gb[e]), 1e-30f)), r1 = bfhi(ga[e]) * __builtin_amdgcn_rcpf(fmaxf(bfhi(gb[e]), 1e-30f));
                        acc[ai][bj][m][e >> 1][2 * (e & 1)] *= r0; acc[ai][bj][m][e >> 1][2 * (e & 1) + 1] *= r1; } } }
    }
    __device__ __forceinline__ void operator()(const f32x4 (&acc)[2][2][4][2], const pg8::Unit& u, int wr, int wc, int fr, int fq) const {
#pragma unroll
        for (int ai = 0; ai < 2; ++ai)
#pragma unroll
            for (int m = 0; m < 4; ++m) { const size_t row = (size_t)(u.pm * 256 + ai * 128 + wr * 64 + m * 16 + fr); const int col = u.pn * 256 + wc * 64 + 8 * fq;
#pragma unroll
                for (int bj = 0; bj < 2; ++bj) { const u32x4 g2 = *(const u32x4*)(G + row * 3072 + 2048 + col + 32 * bj); const f32x4 v0 = acc[ai][bj][m][0], v1 = acc[ai][bj][m][1];
                    u32x4 w; w.x = cvtpk(v0[0] * bflo(g2.x), v0[1] * bfhi(g2.x)); w.y = cvtpk(v0[2] * bflo(g2.y), v0[3] * bfhi(g2.y)); w.z = cvtpk(v1[0] * bflo(g2.z), v1[1] * bfhi(g2.z)); w.w = cvtpk(v1[2] * bflo(g2.w), v1[3] * bfhi(g2.w));
                    *(u32x4*)(MERGED + row * 1024 + col + 32 * bj) = w; } }
    }
};

struct Epi3b {
    static constexpr bool PERM = true;
    const float* x; float* x1; bf16_t* X1B; float* SSQ;
    __device__ __forceinline__ void operator()(const f32x4 (&acc)[2][2][4][2], const pg8::Unit& u, int wr, int wc, int fr, int fq) const {
#pragma unroll
        for (int ai = 0; ai < 2; ++ai)
#pragma unroll
            for (int m = 0; m < 4; ++m) { const size_t row = (size_t)(u.pm * 256 + ai * 128 + wr * 64 + m * 16 + fr); const int col = u.pn * 256 + wc * 64 + 8 * fq; float ss = 0.f;
#pragma unroll
                for (int bj = 0; bj < 2; ++bj) { const size_t off = row * 1024 + col + 32 * bj;
                    const f32x4 o0 = *(const f32x4*)(x + off) + acc[ai][bj][m][0], o1 = *(const f32x4*)(x + off + 4) + acc[ai][bj][m][1];
                    *(f32x4*)(x1 + off) = o0; *(f32x4*)(x1 + off + 4) = o1;
                    ss += (o0[0] * o0[0] + o0[1] * o0[1]) + (o0[2] * o0[2] + o0[3] * o0[3]) + (o1[0] * o1[0] + o1[1] * o1[1]) + (o1[2] * o1[2] + o1[3] * o1[3]);
                    u32x4 w; w.x = cvtpk(o0[0], o0[1]); w.y = cvtpk(o0[2], o0[3]); w.z = cvtpk(o1[0], o1[1]); w.w = cvtpk(o1[2], o1[3]);
                    *(u32x4*)(X1B + off) = w; }
                ss += __shfl_xor(ss, 16); ss += __shfl_xor(ss, 32);
                if (fq == 0) SSQ[row * 16 + u.pn * 4 + wc] = ss; }
    }
};

struct Epi4 {
    static constexpr bool PERM = true;
    const float* convw; const float* convb; bf16_t* ACT; float* UE; float* UF; LAS float* xch; LAS const float* rtab;
    __device__ __forceinline__ void operator()(f32x4 (&acc)[2][2][4][2], const pg8::Unit& u, int wr, int wc, int fr, int fq) const {
        const int lane = fr + 16 * fq;
        const int rowbase = u.pm * 256 + 128 * wr + 8 * fr;
        const int jj = 32 * wc + 8 * fq;
        const bool bstart = (u.pm & 15) == 0;
        {
            LAS const float* tb = rtab + ((u.pm >> 3) & 1) * 256 + 128 * wr + 8 * fr;
            const f32x4 ra = *(LAS const f32x4*)tb, rb = *(LAS const f32x4*)(tb + 4);
#pragma unroll
            for (int i = 0; i < 8; ++i) { const float rs = (i < 4) ? ra[i & 3] : rb[i & 3];
#pragma unroll
                for (int bj = 0; bj < 2; ++bj)
#pragma unroll
                    for (int n = 0; n < 2; ++n) acc[i >> 2][bj][i & 3][n] *= rs; }
        }
#define U4(bj, n, i) acc[(i) >> 2][bj][(i) & 3][n]
        if (wr == 0 && fr == 0) {
#pragma unroll
            for (int i = 0; i < 2; ++i)
#pragma unroll
                for (int bj = 0; bj < 2; ++bj)
#pragma unroll
                    for (int n = 0; n < 2; ++n) *(f32x4*)(UF + (size_t)(u.pm * 2 + i) * 5632 + u.pn * 256 + 128 * bj + jj + 4 * n) = U4(bj, n, i);
        }
        if (wr == 1 && fr == 15) {
#pragma unroll
            for (int i = 0; i < 2; ++i)
#pragma unroll
                for (int bj = 0; bj < 2; ++bj)
#pragma unroll
                    for (int n = 0; n < 2; ++n) *(f32x4*)(UE + (size_t)(u.pm * 2 + i) * 5632 + u.pn * 256 + 128 * bj + jj + 4 * n) = U4(bj, n, 6 + i);
        }
        if (wr == 0 && fr == 15) {
#pragma unroll
            for (int i = 0; i < 2; ++i)
#pragma unroll
                for (int bj = 0; bj < 2; ++bj)
#pragma unroll
                    for (int n = 0; n < 2; ++n) *(LAS f32x4*)(xch + ((((wc * 2 + i) * 2 + bj) * 2 + n) * 4 + fq) * 4) = U4(bj, n, 6 + i);
        }
        asm volatile("s_waitcnt lgkmcnt(0)" ::: "memory"); __builtin_amdgcn_s_barrier(); asm volatile("" ::: "memory");
        const int src = (lane & 48) | ((fr - 1) & 15);
        const int cha = u.pn * 128 + jj;
#pragma unroll
        for (int n = 0; n < 2; ++n) {
            asm volatile("" ::: "memory"); __builtin_amdgcn_sched_barrier(0);
            f32x4 p6[2], p7[2], w0[2], w1[2], w2[2], cb[2];
#pragma unroll
            for (int bj = 0; bj < 2; ++bj) {
                f32x4 h6 = (f32x4){0.f, 0.f, 0.f, 0.f}, h7 = h6;
                if (wr == 1) { h6 = *(LAS const f32x4*)(xch + ((((wc * 2 + 0) * 2 + bj) * 2 + n) * 4 + fq) * 4); h7 = *(LAS const f32x4*)(xch + ((((wc * 2 + 1) * 2 + bj) * 2 + n) * 4 + fq) * 4); }
#pragma unroll
                for (int e = 0; e < 4; ++e) { const float a6 = __shfl(U4(bj, n, 6)[e], src), a7 = __shfl(U4(bj, n, 7)[e], src); p6[bj][e] = (fr == 0) ? h6[e] : a6; p7[bj][e] = (fr == 0) ? h7[e] : a7; }
                const int ch = bj * DFF_ + cha + 4 * n;
                w0[bj] = *(const f32x4*)(convw + ch); w1[bj] = *(const f32x4*)(convw + 5632 + ch); w2[bj] = *(const f32x4*)(convw + 2 * 5632 + ch); cb[bj] = *(const f32x4*)(convb + ch);
            }
#pragma unroll
            for (int i = 0; i < 8; ++i) {
                f32x4 c[2];
#pragma unroll
                for (int bj = 0; bj < 2; ++bj) {
                    const f32x4 um1 = (i >= 1) ? U4(bj, n, i >= 1 ? i - 1 : 0) : p7[bj];
                    const f32x4 um2 = (i >= 2) ? U4(bj, n, i >= 2 ? i - 2 : 0) : ((i == 1) ? p7[bj] : p6[bj]);
                    c[bj] = cb[bj] + w2[bj] * U4(bj, n, i) + w1[bj] * um1 + w0[bj] * um2;
                }
                f32x4 a;
#pragma unroll
                for (int e = 0; e < 4; ++e) { const float z = c[0][e]; a[e] = z * __builtin_amdgcn_rcpf(1.0f + __builtin_amdgcn_exp2f(-z * LOG2E)) * c[1][e]; }
                u32x2 w; w.x = cvtpk(a[0], a[1]); w.y = cvtpk(a[2], a[3]);
                const bool skip = (wr == 0 && fr == 0 && i < 2 && !bstart);
                if (!skip) *(u32x2*)(ACT + (size_t)(rowbase + i) * DFF_ + cha + 4 * n) = w;
            }
        }
#undef U4
    }
};

struct P4Order : pg8::StaticOrder {
    const float* SSQ; LAS float* rtab;
    __device__ __forceinline__ void a_ready(const pg8::Unit& u) const {
        const int t = threadIdx.x;
        if (t < 256) {
            const float* sp = SSQ + (size_t)(u.pm * 256 + t) * 16;
            const f32x4 s0 = *(const f32x4*)sp, s1 = *(const f32x4*)(sp + 4), s2 = *(const f32x4*)(sp + 8), s3 = *(const f32x4*)(sp + 12);
            const float tot = ((s0[0] + s0[1]) + (s0[2] + s0[3])) + ((s1[0] + s1[1]) + (s1[2] + s1[3])) + ((s2[0] + s2[1]) + (s2[2] + s2[3])) + ((s3[0] + s3[1]) + (s3[2] + s3[3]));
            rtab[((u.pm >> 3) & 1) * 256 + t] = 1.0f / sqrtf(tot * (1.f / 1024.f) + EPS_);
        }
    }
};

struct Epi5 {
    static constexpr bool PERM = true;
    float* out;
    __device__ __forceinline__ void operator()(const f32x4 (&acc)[2][2][4][2], const pg8::Unit& u, int wr, int wc, int fr, int fq) const {
#pragma unroll
        for (int ai = 0; ai < 2; ++ai)
#pragma unroll
            for (int m = 0; m < 4; ++m) { const size_t row = (size_t)(u.pm * 256 + ai * 128 + wr * 64 + m * 16 + fr); const int col = u.pn * 256 + wc * 64 + 8 * fq;
#pragma unroll
                for (int bj = 0; bj < 2; ++bj) { float* p = out + row * 1024 + col + 32 * bj;
                    const f32x4 o0 = *(const f32x4*)p + acc[ai][bj][m][0], o1 = *(const f32x4*)(p + 4) + acc[ai][bj][m][1];
                    *(f32x4*)p = o0; *(f32x4*)(p + 4) = o1; } }
    }
};
struct P5Order : pg8::StaticOrder {
    const float* UE; const float* UF; const float* convw; const float* convb; bf16_t* ACT;
    __device__ __forceinline__ void a_ready(const pg8::Unit& u) const {
        if ((u.pm & 15) != 0) {
            for (int ch = threadIdx.x; ch < DFF_; ch += 512) {
                const int pa = 256 * (ch >> 7) + (ch & 127), pg = pa + 128;
                const float* e = UE + (size_t)((u.pm - 1) * 2) * 5632; const float* f = UF + (size_t)(u.pm * 2) * 5632;
                float r[2];
#pragma unroll
                for (int i = 0; i < 2; ++i) {
                    float cc[2];
#pragma unroll
                    for (int s = 0; s < 2; ++s) { const int p = s ? pg : pa, cch = s * DFF_ + ch;
                        const float um2 = e[p], um1 = e[5632 + p], u0 = f[p], u1 = f[5632 + p];
                        const float w0 = convw[cch], w1 = convw[5632 + cch], w2 = convw[2 * 5632 + cch], b = convb[cch];
                        cc[s] = (i == 0) ? b + w0 * um2 + w1 * um1 + w2 * u0 : b + w0 * um1 + w1 * u0 + w2 * u1; }
                    r[i] = cc[0] * __builtin_amdgcn_rcpf(1.0f + __builtin_amdgcn_exp2f(-cc[0] * LOG2E)) * cc[1];
                }
                const unsigned w = cvtpk(r[0], r[1]);
                ACT[(size_t)(u.pm * 256) * DFF_ + ch] = (bf16_t)(w & 0xffffu); ACT[(size_t)(u.pm * 256 + 1) * DFF_ + ch] = (bf16_t)(w >> 16);
            }
        }
        asm volatile("s_waitcnt vmcnt(0)" ::: "memory"); __builtin_amdgcn_s_barrier(); asm volatile("" ::: "memory");
    }
};

__global__ void __launch_bounds__(NWAVES * 64, 2) fwd_kernel(Args args) {
    extern __shared__ __attribute__((aligned(16))) unsigned char lds_raw[];
    LAS unsigned char* lds = (LAS unsigned char*)lds_raw;
    volatile LAS unsigned* MISC = (volatile LAS unsigned*)(lds + MISC_OFF);
    const int tid = threadIdx.x, lane = tid & 63, wave = __builtin_amdgcn_readfirstlane(tid >> 6);
    const int G = gridDim.x; const int bx = blockIdx.x; const int vcu = (G % 8 == 0) ? (bx % 8) * (G / 8) + bx / 8 : bx;
    unsigned char* ws = args.ws;
    gu32* ctl = (gu32*)(ws + WS_CTL);
    for (int u = tid; u < (LDS_BYTES - LDSCTL_OFF) / 4; u += NWAVES * 64) ((LAS unsigned*)(lds + LDSCTL_OFF))[u] = 0u;
    __syncthreads();
    XcdBarrier bar; bar.bar = (unsigned*)(ctl + CW_BAR); bar.x = 0; bar.st = nullptr;
    if (!MK_MULTI) bar = xcd_barrier_post((unsigned*)(ctl + CW_BAR), MISC + 8);
#define GRID_BAR() do { if (!MK_MULTI) xcd_barrier(bar); } while (0)
    const int lo = args.ph_lo, hi = args.ph_hi;
#ifndef PHASE_MASK
#define PHASE_MASK 0xff
#endif
#define IN(k) (((PHASE_MASK >> (k)) & 1) && lo <= (k) && (k) < hi)
#define BOTH(k) (IN(k) && IN((k) + 1))

    if (IN(0)) { p0_prologue(args, lds, vcu, G, wave, lane); if (BOTH(0)) GRID_BAR(); }

    if (IN(1)) {
        pg8::Gemm g{(const bf16_t*)((unsigned char*)args.out + DO_A1), (const bf16_t*)((unsigned char*)args.out + DO_WCAT), T_ + NB_ * MEM_, NCAT, 1024};
        P1Order S; S.init(G, bx);
        Epi1 E{ws, (const float*)((unsigned char*)args.out + DO_ROPE), args.in[I_AQ], args.in[I_AK], args.in[I_BQ], args.in[I_BK], args.in[I_BGATE]};
        pg8::gemm_phase<Epi1, P1Order, true, false, false>(lds + RING_OFF, g, S, E);
        if (BOTH(1)) GRID_BAR();
    }

    if (IN(2)) { p2_attention(args, lds, vcu, tid, wave, lane); if (BOTH(2)) GRID_BAR(); }

    if (IN(3)) { p2b_merge(args, vcu, G, tid); if (BOTH(3)) GRID_BAR(); }

    if (IN(4)) {
        pg8::Gemm g{(const bf16_t*)((unsigned char*)args.out + DO_OCAT), (const bf16_t*)(ws + WS_WO), T_, 1024, KCAT};
        pg8::StaticOrder S; S.init(T_, 1024, G, bx);
        Epi3a E{(const bf16_t*)(ws + WS_G), (bf16_t*)(ws + WS_MERGED)};
        pg8::gemm_phase<Epi3a, pg8::StaticOrder, false, false, true>(lds + RING_OFF, g, S, E);
        if (BOTH(4)) GRID_BAR();
    }

    if (IN(5)) {
        pg8::Gemm g{(const bf16_t*)(ws + WS_MERGED), (const bf16_t*)(ws + WS_WOUT), T_, 1024, 1024};
        pg8::StaticOrder S; S.init(T_, 1024, G, bx);
        Epi3b E{args.in[I_X], args.out, (bf16_t*)(ws + WS_X1B), (float*)(ws + WS_SSQ)};
        pg8::gemm_phase<Epi3b, pg8::StaticOrder, false, false, false>(lds + RING_OFF, g, S, E);
        if (BOTH(5)) GRID_BAR();
    }

    if (IN(6)) {
        pg8::Gemm g{(const bf16_t*)(ws + WS_X1B), (const bf16_t*)(ws + WS_WUP), T_, 5632, 1024};
        P4Order S; S.init(T_, 5632, G, bx); S.SSQ = (const float*)(ws + WS_SSQ); S.rtab = (LAS float*)(lds + XCH_OFF + 2048);
        Epi4 E{args.in[I_CONVW], args.in[I_CONVB], (bf16_t*)(ws + WS_ACT), (float*)(ws + WS_UE), (float*)(ws + WS_UF), (LAS float*)(lds + XCH_OFF), (LAS const float*)(lds + XCH_OFF + 2048)};
        pg8::gemm_phase<Epi4, P4Order, true, true, false>(lds + RING_OFF, g, S, E);
        if (BOTH(6)) GRID_BAR();
    }

    if (IN(7)) {
        pg8::Gemm g{(const bf16_t*)(ws + WS_ACT), (const bf16_t*)(ws + WS_WDOWN), T_, 1024, DFF_};
        P5Order S; S.init(T_, 1024, G, bx);
        S.UE = (const float*)(ws + WS_UE); S.UF = (const float*)(ws + WS_UF); S.convw = args.in[I_CONVW]; S.convb = args.in[I_CONVB]; S.ACT = (bf16_t*)(ws + WS_ACT);
        Epi5 E{args.out};
        pg8::gemm_phase<Epi5, P5Order, false, false, false>(lds + RING_OFF, g, S, E);
    }
#undef IN
#undef BOTH
#undef GRID_BAR
}

extern "C" void kernel_launch(void* const* d_in, const int* in_sizes, int n_in, void* d_out, int out_size, void* d_ws, size_t ws_size, hipStream_t stream) {
    static int grid = 0;
    if (grid == 0) {
        if (n_in != 25 || out_size != T_ * DM_ || ws_size < WS_END) { fprintf(stderr, "kernel_launch: unexpected shapes (n_in %d, out %d, ws %zu); nothing launched\n", n_in, out_size, ws_size); grid = -1; return; }
        int dev = 0, cus = 0, per_cu = 0;
        if (hipGetDevice(&dev) != hipSuccess || hipDeviceGetAttribute(&cus, hipDeviceAttributeMultiprocessorCount, dev) != hipSuccess) { grid = -1; return; }
        if (hipFuncSetAttribute((const void*)fwd_kernel, hipFuncAttributeMaxDynamicSharedMemorySize, LDS_BYTES) != hipSuccess) { fprintf(stderr, "kernel_launch: hipFuncSetAttribute failed\n"); grid = -1; return; }
        if (hipOccupancyMaxActiveBlocksPerMultiprocessor(&per_cu, (const void*)fwd_kernel, NWAVES * 64, LDS_BYTES) != hipSuccess || per_cu < 1) { fprintf(stderr, "kernel_launch: occupancy query says %d blocks per CU\n", per_cu); }
        (void)hipGetLastError();
        grid = cus;
        if (grid != 256) fprintf(stderr, "kernel_launch: %d CUs (the phase schedules expect 256)\n", grid);
    }
    if (grid < 0) return;
    if (hipMemsetAsync((char*)d_ws + WS_CTL, 0, CTL_ZERO_BYTES, stream) != hipSuccess) return;
    Args a{};
    for (int i = 0; i < 25; ++i) a.in[i] = (const float*)d_in[i];
    a.out = (float*)d_out; a.ws = (unsigned char*)d_ws;
#if MK_MULTI
    for (int p = 0; p < NPHASES; ++p) { a.ph_lo = p; a.ph_hi = p + 1; a.li = p; hipLaunchKernelGGL(fwd_kernel, dim3(grid), dim3(NWAVES * 64), LDS_BYTES, stream, a); }
#else
    a.ph_lo = 0; a.ph_hi = NPHASES; a.li = 0;
    hipLaunchKernelGGL(fwd_kernel, dim3(grid), dim3(NWAVES * 64), LDS_BYTES, stream, a);
#endif
}
```

```cpp
#include <hip/hip_runtime.h>
#include <cstdio>
#include <cstdint>

#ifndef MK_MULTI
#define MK_MULTI 0
#endif

#define LAS __attribute__((address_space(3)))
#define GAS __attribute__((address_space(1)))
typedef unsigned short bf16_t;
typedef short bf16x8 __attribute__((ext_vector_type(8)));
typedef short s16x4 __attribute__((ext_vector_type(4)));
typedef float f32x4 __attribute__((ext_vector_type(4)));
typedef float f32x16 __attribute__((ext_vector_type(16)));
typedef unsigned u32x4 __attribute__((ext_vector_type(4)));
typedef unsigned u32x2 __attribute__((ext_vector_type(2)));

constexpr int T_ = 16384, SEQ_ = 4096, NB_ = 4, DM_ = 1024, MEM_ = 256, DFF_ = 2816;
constexpr int NCAT = 7680;
constexpr int KCAT = 1280;
constexpr float EPS_ = 1e-6f;
constexpr float LOG2E = 1.4426950408889634f;
constexpr float QSCALE64 = 0.125f * LOG2E;
constexpr float QSCALE128 = 0.08838834764831845f * LOG2E;

__device__ __forceinline__ unsigned cvtpk(float lo, float hi) {
    typedef float f2 __attribute__((ext_vector_type(2))); typedef __bf16 b2 __attribute__((ext_vector_type(2)));
    f2 v = {lo, hi}; b2 b = __builtin_convertvector(v, b2); return __builtin_bit_cast(unsigned, b);
}
__device__ __forceinline__ float bflo(unsigned w) { return __uint_as_float(w << 16); }
__device__ __forceinline__ float bfhi(unsigned w) { return __uint_as_float(w & 0xffff0000u); }

namespace pg8 {
constexpr int BM = 256, BK = 64, HALF = 128, HTB = HALF * BK * 2, STAGE_BYTES = 8 * HTB, NXCD = 8, WGM = 8;
__host__ __device__ __forceinline__ int lds_byte(int r, int c) { const int st = (r >> 4) * 2 + (c >> 5), rr = r & 15, cc = c & 31, ob = rr * 64 + cc * 2; return st * 1024 + (ob ^ (((ob >> 9) & 1) << 5)); }
__host__ __device__ __forceinline__ void stage_rc(int b, int& R, int& C) { const int st = b / 1024, sb = b % 1024, swz = sb ^ (((sb >> 9) & 1) << 5); R = (st >> 1) * 16 + swz / 64; C = (st & 1) * 32 + (swz % 64) / 2; }
__host__ __device__ __forceinline__ int perm32(int rho) { const int n = rho >> 4, i = rho & 15; return 8 * (i >> 2) + 4 * n + (i & 3); }

struct Unit { int pm, pn; };
struct Gemm { const bf16_t* A; const bf16_t* Bt; int M, N, K; };

struct StaticOrder {
    int nM, nN, nwg, G, c;
    __host__ __device__ void init(int M, int N, int G_, int c_) { nM = M / BM; nN = N / BM; nwg = nM * nN; G = G_; c = c_; }
    __host__ __device__ bool next(int i, Unit& u) const {
        const long L = (long)i * G + c; if (L >= nwg) return false;
        int wgid = (int)L; { const int q = nwg / NXCD, r = nwg % NXCD, xcd = wgid % NXCD, off = wgid / NXCD; wgid = (xcd < r ? xcd * (q + 1) : r * (q + 1) + (xcd - r) * q) + off; }
        const int nig = WGM * nN, gid = wgid / nig, fm = gid * WGM, gsz = (nM - fm) < WGM ? (nM - fm) : WGM;
        u.pm = fm + ((wgid % nig) % gsz); u.pn = (wgid % nig) / gsz; return true;
    }
    __device__ __forceinline__ void a_ready(const Unit&) const {}
    __device__ __forceinline__ void done(const Unit&) const {}
};

template <class Epi, class Sched, bool ALIGN_EPI, bool PERMA, bool KHOOK>
__device__ __forceinline__ void gemm_phase(LAS unsigned char* lds, const Gemm g, const Sched& S, const Epi& E) {
    const int tid = threadIdx.x, wid = __builtin_amdgcn_readfirstlane(tid >> 6), lane = tid & 63, wr = wid >> 2, wc = wid & 3, fr = lane & 15, fq = lane >> 4;
    const int K = g.K, nt = K / BK;
    unsigned voffA0[2], voffA1[2], voffB[2];
#pragma unroll
    for (int i = 0; i < 2; ++i) { int R, C; stage_rc(tid * 16 + i * 8192, R, C); const int Rb = (R & ~31) + perm32(R & 31);
        if (PERMA) { const int rw = R >> 6, rm = (R >> 4) & 3, rf = R & 15; voffA0[i] = (unsigned)((128 * rw + 8 * rf + rm) * K + C) * 2u; voffA1[i] = (unsigned)((128 * rw + 8 * rf + 4 + rm) * K + C) * 2u; }
        else { voffA0[i] = (unsigned)(R * K + C) * 2u; voffA1[i] = voffA0[i]; }
        voffB[i] = (unsigned)(Rb * K + C) * 2u; }
    const size_t kstep = (size_t)(BK * 2);
    const size_t hstep = (size_t)HALF * K * 2;
    const size_t ahs = PERMA ? (size_t)0 : hstep;
    const size_t tstep = 2 * hstep;
    const unsigned ldsw = (unsigned)wid * 1024u;
    const int aoff = lds_byte(wr * 64 + fr, fq * 8), boff = lds_byte(wc * 32 + fr, fq * 8);
#define PG8_SA(b, h) (((b) * 2 + (h)) * HTB)
#define PG8_SB(b, h) ((4 + (b) * 2 + (h)) * HTB)
#define PG8_STAGE(bufoff, gbase, voff) do { _Pragma("unroll") for (int _i = 0; _i < 2; ++_i) \
        __builtin_amdgcn_global_load_lds((const unsigned*)((const char*)(gbase) + (voff)[_i]), (LAS unsigned*)(lds + (bufoff) + ldsw + _i * 8192), 16, 0, 0); } while (0)
#define PG8_LDA(dst, b, h) do { _Pragma("unroll") for (int m = 0; m < 4; ++m) _Pragma("unroll") for (int k = 0; k < 2; ++k) dst[m][k] = *(const LAS bf16x8*)(lds + PG8_SA(b, h) + aoff + m * 2048 + k * 1024); } while (0)
#define PG8_LDB(dst, b, h) do { _Pragma("unroll") for (int n = 0; n < 2; ++n) _Pragma("unroll") for (int k = 0; k < 2; ++k) dst[n][k] = *(const LAS bf16x8*)(lds + PG8_SB(b, h) + boff + n * 2048 + k * 1024); } while (0)
#define PG8_MMA(ai, bj, At, Bt) do { __builtin_amdgcn_s_setprio(1); _Pragma("unroll") for (int m = 0; m < 4; ++m) _Pragma("unroll") for (int n = 0; n < 2; ++n) _Pragma("unroll") for (int k = 0; k < 2; ++k) \
        acc[ai][bj][m][n] = __builtin_amdgcn_mfma_f32_16x16x32_bf16(Bt[n][k], At[m][k], acc[ai][bj][m][n], 0, 0, 0); __builtin_amdgcn_s_setprio(0); } while (0)
#define PG8_WAIT_V(n) asm volatile("s_waitcnt vmcnt(" #n ")" ::: "memory")
#define PG8_WAIT_L(n) asm volatile("s_waitcnt lgkmcnt(" #n ")" ::: "memory")
#define PG8_BAR __builtin_amdgcn_s_barrier()
#define PG8_SCHED __builtin_amdgcn_sched_barrier(0)
    Unit cur, nxt; int ui = 0;
    if (!S.next(0, cur)) return;
    f32x4 acc[2][2][4][2];
#pragma unroll
    for (int a = 0; a < 2; ++a)
#pragma unroll
        for (int b = 0; b < 2; ++b)
#pragma unroll
            for (int m = 0; m < 4; ++m)
#pragma unroll
                for (int n = 0; n < 2; ++n) acc[a][b][m][n] = (f32x4){0.f, 0.f, 0.f, 0.f};
    bf16x8 At[4][2], B0[2][2], B1[2][2];
    const char* cA = (const char*)g.A + (size_t)cur.pm * tstep; const char* cB = (const char*)g.Bt + (size_t)cur.pn * tstep;
    S.a_ready(cur);
    PG8_STAGE(PG8_SB(0, 0), cB, voffB); PG8_STAGE(PG8_SB(0, 1), cB + hstep, voffB); PG8_STAGE(PG8_SA(0, 0), cA, voffA0); PG8_STAGE(PG8_SA(0, 1), cA + ahs, voffA1);
    if (wr == 1) PG8_BAR;
    PG8_WAIT_V(2); PG8_BAR;
    PG8_STAGE(PG8_SB(1, 0), cB + kstep, voffB); PG8_STAGE(PG8_SA(1, 0), cA + kstep, voffA0); PG8_STAGE(PG8_SB(1, 1), cB + hstep + kstep, voffB);
    PG8_WAIT_V(6); PG8_BAR;
    for (;;) {
        const bool has_next = S.next(ui + 1, nxt);
        const char* nA = has_next ? (const char*)g.A + (size_t)nxt.pm * tstep : cA; const char* nB = has_next ? (const char*)g.Bt + (size_t)nxt.pn * tstep : cB;
        for (int t = 0; t < nt; t += 2) {
            const bool last = (t == nt - 2);
            const char* a1 = cA + (size_t)(t + 1) * kstep;
            const char* a2 = last ? nA : cA + (size_t)(t + 2) * kstep; const char* b2 = last ? nB : cB + (size_t)(t + 2) * kstep;
            const char* a3 = a2 + kstep; const char* b3 = b2 + kstep;
            if (last && has_next) S.a_ready(nxt);
            if constexpr (KHOOK) E.khook(acc, cur, t, wr, wc, fr, fq);
            PG8_LDB(B0, 0, 0); PG8_LDB(B1, 0, 1); PG8_SCHED; PG8_LDA(At, 0, 0); PG8_STAGE(PG8_SA(1, 1), a1 + ahs, voffA1);
            PG8_WAIT_V(8); PG8_WAIT_L(0); PG8_BAR; PG8_MMA(0, 0, At, B0); PG8_MMA(0, 1, At, B1); PG8_BAR; PG8_SCHED;
            PG8_LDA(At, 0, 1); PG8_STAGE(PG8_SB(0, 0), b2, voffB); PG8_STAGE(PG8_SB(0, 1), b2 + hstep, voffB); PG8_STAGE(PG8_SA(0, 0), a2, voffA0);
            PG8_WAIT_V(8); PG8_WAIT_L(0); PG8_BAR; PG8_MMA(1, 0, At, B0); PG8_MMA(1, 1, At, B1); PG8_BAR; PG8_SCHED;
            PG8_LDB(B0, 1, 0); PG8_LDB(B1, 1, 1); PG8_SCHED; PG8_LDA(At, 1, 0); PG8_STAGE(PG8_SA(0, 1), a2 + ahs, voffA1);
            PG8_WAIT_V(8); PG8_WAIT_L(0); PG8_BAR; PG8_MMA(0, 0, At, B0); PG8_MMA(0, 1, At, B1); PG8_BAR; PG8_SCHED;
            PG8_LDA(At, 1, 1); PG8_STAGE(PG8_SB(1, 0), b3, voffB); PG8_STAGE(PG8_SB(1, 1), b3 + hstep, voffB); PG8_STAGE(PG8_SA(1, 0), a3, voffA0);
            PG8_WAIT_V(8); PG8_WAIT_L(0); PG8_BAR; PG8_MMA(1, 0, At, B0); PG8_MMA(1, 1, At, B1); PG8_BAR; PG8_SCHED;
        }
        if constexpr (ALIGN_EPI) { if (wr == 0) PG8_BAR; }
        E(acc, cur, wr, wc, fr, fq); S.done(cur);
        if (!has_next) break;
#pragma unroll
        for (int a = 0; a < 2; ++a)
#pragma unroll
            for (int b = 0; b < 2; ++b)
#pragma unroll
                for (int m = 0; m < 4; ++m)
#pragma unroll
                    for (int n = 0; n < 2; ++n) acc[a][b][m][n] = (f32x4){0.f, 0.f, 0.f, 0.f};
        cur = nxt; cA = nA; cB = nB; ++ui;
        if constexpr (ALIGN_EPI) { if (wr == 1) PG8_BAR; }
    }
    PG8_WAIT_V(0);
    if constexpr (!ALIGN_EPI) { if (wr == 0) PG8_BAR; }
    PG8_BAR;
#undef PG8_SA
#undef PG8_SB
#undef PG8_STAGE
#undef PG8_LDA
#undef PG8_LDB
#undef PG8_MMA
#undef PG8_WAIT_V
#undef PG8_WAIT_L
#undef PG8_BAR
#undef PG8_SCHED
}
}

constexpr size_t MiB = 1u << 20;
constexpr size_t WS_CTL = 0, CTL_ZERO_BYTES = 1 * MiB;
constexpr size_t WS_WO = 1 * MiB;
constexpr size_t WS_WOUT = 4 * MiB;
constexpr size_t WS_WUP = 6 * MiB;
constexpr size_t WS_WDOWN = 17 * MiB;
constexpr size_t WS_SSQ = 23 * MiB;
constexpr size_t WS_UE = 24 * MiB;
constexpr size_t WS_UF = 27 * MiB;
constexpr size_t WS_LSE = 30 * MiB;
constexpr size_t WS_MKV = 31 * MiB;
constexpr size_t WS_G = 34 * MiB;
constexpr size_t WS_ACT = 34 * MiB;
constexpr size_t WS_QA = 130 * MiB;
constexpr size_t WS_KA = 154 * MiB;
constexpr size_t WS_VA = 178 * MiB;
constexpr size_t WS_MERGED = 130 * MiB;
constexpr size_t WS_X1B = 162 * MiB;
constexpr size_t WS_QB = 202 * MiB;
constexpr size_t WS_KVB = 218 * MiB;
constexpr size_t WS_MQ = 226 * MiB;
constexpr size_t WS_END = 242 * MiB;
constexpr size_t DO_A1 = 0;
constexpr size_t DO_WCAT = 34 * MiB;
constexpr size_t DO_ROPE = 49 * MiB;
constexpr size_t DO_OCAT = 0;
constexpr size_t DO_OAG = 40 * MiB;

constexpr int CW_TMO = 0, CW_BAR = 4096;

constexpr int RING_OFF = 0, RING_BYTES = 131072;
constexpr int XCH_OFF = RING_BYTES;
constexpr int LDSCTL_OFF = RING_BYTES + 4096, MISC_OFF = LDSCTL_OFF + 320;
constexpr int LDS_BYTES = 147456;
constexpr int NWAVES = 8;
constexpr int NPHASES = 8;

typedef GAS unsigned gu32;
#define RLX_AGENT __ATOMIC_RELAXED, __HIP_MEMORY_SCOPE_AGENT
#define LDS_WAIT() asm volatile("s_waitcnt lgkmcnt(0)" ::: "memory")
#define VM_WAIT() asm volatile("s_waitcnt vmcnt(0)" ::: "memory")

#define XB_TMO      128
#define XB_XCNT(j)  (256  + 64 * (j))
#define XB_XSUB(j)  (1280 + 64 * (j))
#define XB_XGEN(j)  (2304 + 64 * (j))
#define XB_TOP      3328
#define XB_TOPGEN   3392
#define XCD_BAR_WORDS 3456
#define XB_SPIN_CAP (1u << 18)
__device__ __forceinline__ unsigned xb_ld(unsigned* p)              { return __hip_atomic_load(p, __ATOMIC_RELAXED, __HIP_MEMORY_SCOPE_AGENT); }
__device__ __forceinline__ unsigned xb_add(unsigned* p, unsigned v) { return __hip_atomic_fetch_add(p, v, __ATOMIC_RELAXED, __HIP_MEMORY_SCOPE_AGENT); }
__device__ __forceinline__ unsigned xb_xcc_id() { return (unsigned)__builtin_amdgcn_s_getreg((3 << 11) | 20) & 0xFu; }
#define XB_SPIN(cond, bar) do { unsigned _sp = 0; while (cond) { __builtin_amdgcn_s_sleep(1); \
    if ((++_sp & 255u) == 0u) { if (xb_ld(&(bar)[XB_TMO])) break; if (_sp > XB_SPIN_CAP) { atomicAdd(&(bar)[XB_TMO], 1u); break; } } } } while (0)
struct XcdBarrier { unsigned* bar; unsigned x; volatile LAS unsigned* st; };
__device__ __forceinline__ XcdBarrier xcd_barrier_post(unsigned* bar, volatile LAS unsigned* st) {
    XcdBarrier b; b.bar = bar; b.x = xb_xcc_id(); b.st = st;
    if (threadIdx.x == 0) (void)xb_add(&bar[XB_XCNT(b.x)], 1u);
    return b;
}
__device__ __forceinline__ void xcd_barrier_complete(unsigned* bar, unsigned x, unsigned& nloc, unsigned& nx) {
    const unsigned G = gridDim.x * gridDim.y * gridDim.z;
    unsigned sum, cnt, mine, sp = 0u;
    for (;;) {
        sum = 0u; cnt = 0u; mine = 0u;
#pragma unroll
        for (unsigned j = 0; j < 16; ++j) { const unsigned c = xb_ld(&bar[XB_XCNT(j)]); sum += c; cnt += (c > 0u) ? 1u : 0u; mine = (j == x) ? c : mine; }
        if (sum == G) break;
        __builtin_amdgcn_s_sleep(1);
        if ((++sp & 255u) == 0u) { if (xb_ld(&bar[XB_TMO])) break; if (sp > XB_SPIN_CAP) { atomicAdd(&bar[XB_TMO], 1u); break; } }
    }
    nloc = mine > 0u ? mine : 1u; nx = cnt > 0u ? cnt : 1u;
}
__device__ __forceinline__ void xcd_barrier(const XcdBarrier& b) {
    asm volatile("s_waitcnt vmcnt(0)" ::: "memory");
    __syncthreads();
    if (threadIdx.x == 0) {
        unsigned* bar = b.bar;
        __builtin_amdgcn_s_waitcnt(0);
        unsigned nloc = b.st[0], nx = b.st[1];
        if (nloc == 0u) { xcd_barrier_complete(bar, b.x, nloc, nx); b.st[0] = nloc; b.st[1] = nx; }
        const unsigned old = xb_add(&bar[XB_XSUB(b.x)], 1u);
        const unsigned gen = old / nloc;
        if (old + 1u == (gen + 1u) * nloc) {
            __builtin_amdgcn_fence(__ATOMIC_RELEASE, "agent");
            asm volatile("s_waitcnt vmcnt(0)" ::: "memory");
            const unsigned og = xb_add(&bar[XB_TOP], 1u);
            const unsigned tg = og / nx;
            if (og + 1u == (tg + 1u) * nx) xb_add(&bar[XB_TOPGEN], 1u);
            else XB_SPIN(xb_ld(&bar[XB_TOPGEN]) == tg, bar);
            __builtin_amdgcn_fence(__ATOMIC_ACQUIRE, "agent");
            xb_add(&bar[XB_XGEN(b.x)], 1u);
            asm volatile("s_waitcnt vmcnt(0)" ::: "memory");
        } else {
            XB_SPIN(xb_ld(&bar[XB_XGEN(b.x)]) == gen, bar);
            __builtin_amdgcn_fence(__ATOMIC_ACQUIRE, "agent");
            asm volatile("s_waitcnt vmcnt(0)" ::: "memory");
        }
    }
    __syncthreads();
}

struct Args {
    const float* in[25]; float* out; unsigned char* ws; int ph_lo, ph_hi, li, pad;
};
enum { I_X = 0, I_MEM, I_POS, I_ATTN_NORM, I_W_IN, I_AQ, I_AK, I_BQ, I_BK, I_SINK, I_MEM_NORM, I_W_MKV, I_MQN, I_MKN, I_WOA, I_WOB, I_WOM, I_WGATE, I_BGATE, I_WOUT, I_FFN_NORM, I_WUP, I_CONVW, I_CONVB, I_WDOWN };

__host__ __device__ __forceinline__ int map_uniform(int n) { const int c = n & 255; return (n & ~255) + 128 * ((c >> 5) & 1) + 32 * (c >> 6) + (c & 31); }
__host__ __device__ __forceinline__ int map_up(int n) { return n < DFF_ ? 256 * (n >> 7) + (n & 127) : 256 * ((n - DFF_) >> 7) + 128 + ((n - DFF_) & 127); }

__device__ __forceinline__ float wave_sum(float v) {
#pragma unroll
    for (int o = 1; o < 64; o <<= 1) v += __shfl_xor(v, o);
    return v;
}
template <int MAP>
__device__ __forceinline__ void p0_transpose_item(const float* W, int K, int N, bf16_t* WT, int noff, int pitch, int koff, const float* kscale, LAS float* scr, int item, int lane) {
    const int nblk = N / 32, kb = item / nblk, nb = item % nblk, k0 = 64 * kb, n0 = 32 * nb;
#pragma unroll 8
    for (int i = 0; i < 32; ++i) { const int kk = 2 * i + (lane >> 5); float v = W[(size_t)(k0 + kk) * N + n0 + (lane & 31)]; if (kscale) v *= kscale[k0 + kk]; scr[kk * 33 + (lane & 31)] = v; }
    LDS_WAIT(); asm volatile("" ::: "memory");
    const int c = lane & 7;
    const int r0 = MAP == 0 ? map_uniform(noff + n0) : map_up(noff + n0);
#pragma unroll
    for (int j = 0; j < 4; ++j) { const int n = (lane >> 3) + 8 * j; const LAS float* s = scr + (8 * c) * 33 + n;
        u32x4 o; o.x = cvtpk(s[0 * 33], s[1 * 33]); o.y = cvtpk(s[2 * 33], s[3 * 33]); o.z = cvtpk(s[4 * 33], s[5 * 33]); o.w = cvtpk(s[6 * 33], s[7 * 33]);
        *(GAS u32x4*)(WT + (size_t)(r0 + n) * pitch + koff + k0 + 8 * c) = o; }
    LDS_WAIT(); asm volatile("" ::: "memory");
}
__device__ __forceinline__ void rms_row_to_bf16(const float* xrow, const float* gain, bf16_t* orow, int lane) {
    const GAS f32x4* xr = (const GAS f32x4*)xrow + lane; const GAS f32x4* gr = (const GAS f32x4*)gain + lane;
    f32x4 v[4]; float s = 0.f;
#pragma unroll
    for (int j = 0; j < 4; ++j) { v[j] = xr[64 * j]; s += (v[j].x * v[j].x + v[j].y * v[j].y) + (v[j].z * v[j].z + v[j].w * v[j].w); }
    const float rstd = 1.0f / sqrtf(wave_sum(s) * (1.f / 1024.f) + EPS_);
    GAS u32x2* o8 = (GAS u32x2*)orow + lane;
#pragma unroll
    for (int j = 0; j < 4; ++j) { const f32x4 g = gr[64 * j]; u32x2 w; w.x = cvtpk(v[j].x * rstd * g.x, v[j].y * rstd * g.y); w.y = cvtpk(v[j].z * rstd * g.z, v[j].w * rstd * g.w); o8[64 * j] = w; }
}
__device__ __forceinline__ void sincos_f(float ang, float& co, float& si) {
    const double x = (double)ang; const double n = __builtin_rint(x * 0.63661977236758134308);
    double r = __builtin_fma(-n, 1.5707963267948966192, x); r = __builtin_fma(-n, 6.123233995736766036e-17, r);
    const double r2 = r * r;
    double s = -1.0 / 6227020800.0; s = s * r2 + 1.0 / 39916800.0; s = s * r2 - 1.0 / 362880.0; s = s * r2 + 1.0 / 5040.0; s = s * r2 - 1.0 / 120.0; s = s * r2 + 1.0 / 6.0; s = r - r * r2 * s;
    double c = 1.0 / 479001600.0; c = c * r2 - 1.0 / 3628800.0; c = c * r2 + 1.0 / 40320.0; c = c * r2 - 1.0 / 720.0; c = c * r2 + 1.0 / 24.0; c = c * r2 - 0.5; c = c * r2 + 1.0;
    const int q = (int)((long long)n & 3);
    const double cs = (q == 0) ? c : (q == 1) ? -s : (q == 2) ? -c : s;
    const double sn = (q == 0) ? s : (q == 1) ? c : (q == 2) ? -s : -c;
    co = (float)cs; si = (float)sn;
}

struct Frame {
    LAS unsigned char* lds;
    int tid, lane, wave, vcu, G;
    const Args* a;
};

__device__ __forceinline__ void p0_prologue(const Args& A, LAS unsigned char* lds, int vcu, int G, int wave, int lane) {
    LAS float* scr = (LAS float*)(lds + RING_OFF + wave * 16384);
    const int gw = vcu * NWAVES + wave, NGW = G * NWAVES;
    bf16_t* wcat = (bf16_t*)((unsigned char*)A.out + DO_WCAT);
    bf16_t* a1 = (bf16_t*)((unsigned char*)A.out + DO_A1);
    float* rope = (float*)((unsigned char*)A.out + DO_ROPE);
    bf16_t* wo = (bf16_t*)(A.ws + WS_WO); bf16_t* wout = (bf16_t*)(A.ws + WS_WOUT); bf16_t* wup = (bf16_t*)(A.ws + WS_WUP); bf16_t* wdown = (bf16_t*)(A.ws + WS_WDOWN);
    constexpr int I_IN = (1024 / 64) * (3584 / 32), I_GATE = (1024 / 64) * (3072 / 32), I_MKV = (1024 / 64) * (1024 / 32);
    constexpr int I_OA = (256 / 64) * (1024 / 32), I_OB = (512 / 64) * (1024 / 32), I_OM = I_OB, I_OUT = (1024 / 64) * (1024 / 32);
    constexpr int I_UP = (1024 / 64) * (5632 / 32), I_DOWN = (2816 / 64) * (1024 / 32);
    constexpr int NITEMS = I_IN + I_GATE + I_MKV + I_OA + I_OB + I_OM + I_OUT + I_UP + I_DOWN;
    for (int it = gw; it < NITEMS; it += NGW) {
        int r = it;
        if (r < I_IN) { p0_transpose_item<0>(A.in[I_W_IN], 1024, 3584, wcat, 0, 1024, 0, nullptr, scr, r, lane); continue; } r -= I_IN;
        if (r < I_GATE) { p0_transpose_item<0>(A.in[I_WGATE], 1024, 3072, wcat, 3584, 1024, 0, nullptr, scr, r, lane); continue; } r -= I_GATE;
        if (r < I_MKV) { p0_transpose_item<0>(A.in[I_W_MKV], 1024, 1024, wcat, 6656, 1024, 0, nullptr, scr, r, lane); continue; } r -= I_MKV;
        if (r < I_OA) { p0_transpose_item<0>(A.in[I_WOA], 256, 1024, wo, 0, KCAT, 0, nullptr, scr, r, lane); continue; } r -= I_OA;
        if (r < I_OB) { p0_transpose_item<0>(A.in[I_WOB], 512, 1024, wo, 0, KCAT, 256, nullptr, scr, r, lane); continue; } r -= I_OB;
        if (r < I_OM) { p0_transpose_item<0>(A.in[I_WOM], 512, 1024, wo, 0, KCAT, 768, nullptr, scr, r, lane); continue; } r -= I_OM;
        if (r < I_OUT) { p0_transpose_item<0>(A.in[I_WOUT], 1024, 1024, wout, 0, 1024, 0, nullptr, scr, r, lane); continue; } r -= I_OUT;
        if (r < I_UP) { p0_transpose_item<1>(A.in[I_WUP], 1024, 5632, wup, 0, 1024, 0, A.in[I_FFN_NORM], scr, r, lane); continue; } r -= I_UP;
        p0_transpose_item<0>(A.in[I_WDOWN], 2816, 1024, wdown, 0, 2816, 0, nullptr, scr, r, lane);
    }
    for (int m = gw; m < T_ + NB_ * MEM_; m += NGW) {
        if (m < T_) rms_row_to_bf16(A.in[I_X] + (size_t)m * DM_, A.in[I_ATTN_NORM], a1 + (size_t)m * DM_, lane);
        else rms_row_to_bf16(A.in[I_MEM] + (size_t)(m - T_) * DM_, A.in[I_MEM_NORM], a1 + (size_t)m * DM_, lane);
    }
    const int* pos = (const int*)A.in[I_POS];
    for (int idx = gw * 64 + lane; idx < T_ * 8; idx += NGW * 64) {
        const int t = idx >> 3, i = idx & 7;
        const float fr = (i == 0) ? 1.0f : (i == 1) ? 0.193922758102417f : (i == 2) ? 0.03760603442788124f : (i == 3) ? 0.007292666472494602f : (i == 4) ? 0.0014142136787995696f
                       : (i == 5) ? 0.00027424818836152554f : (i == 6) ? 5.318298644851893e-05f : 1.031338433676865e-05f;
        const float ang = (float)pos[t] * fr; float co, si; sincos_f(ang, co, si);
        rope[t * 16 + i] = co; rope[t * 16 + 8 + i] = si;
    }
}

struct P1Order {
    pg8::StaticOrder so;
    __device__ void init(int G, int c) { so.init(T_, 6656, G, c); }
    __device__ bool next(int i, pg8::Unit& u) const {
        if (so.next(i, u)) return true;
        const long L = (long)i * so.G + so.c - so.nwg; if (L < 0 || L >= 16) return false;
        u.pm = 64 + (int)(L >> 2); u.pn = 26 + (int)(L & 3); return true;
    }
    __device__ __forceinline__ void a_ready(const pg8::Unit&) const {}
    __device__ __forceinline__ void done(const pg8::Unit&) const {}
};

struct Epi1 {
    static constexpr bool PERM = true;
    unsigned char* ws; const float* rope; const float *aq, *ak, *bq, *bk, *bgate;
    __device__ __forceinline__ void plain(const f32x4 (&acc)[2][2][4][2], bf16_t* dst, int ld, int col0, int row0, int wr, int wc, int fr, int fq) const {
#pragma unroll
        for (int ai = 0; ai < 2; ++ai)
#pragma unroll
            for (int m = 0; m < 4; ++m) { bf16_t* rowp = dst + (size_t)(row0 + ai * 128 + wr * 64 + m * 16 + fr) * ld + col0 + wc * 64 + 8 * fq;
#pragma unroll
                for (int bj = 0; bj < 2; ++bj) { const f32x4 v0 = acc[ai][bj][m][0], v1 = acc[ai][bj][m][1]; u32x4 w; w.x = cvtpk(v0[0], v0[1]); w.y = cvtpk(v0[2], v0[3]); w.z = cvtpk(v1[0], v1[1]); w.w = cvtpk(v1[2], v1[3]);
                    *(u32x4*)(rowp + 32 * bj) = w; } }
    }
    __device__ __forceinline__ void normed(const f32x4 (&acc)[2][2][4][2], bf16_t* dst, int ld, int col0, int row0, const float* gain, float scale, int wr, int wc, int fr, int fq) const {
        f32x4 g[2][2];
#pragma unroll
        for (int bj = 0; bj < 2; ++bj)
#pragma unroll
            for (int n = 0; n < 2; ++n) g[bj][n] = *(const f32x4*)(gain + 32 * bj + 8 * fq + 4 * n) * scale;
#pragma unroll
        for (int ai = 0; ai < 2; ++ai)
#pragma unroll
            for (int m = 0; m < 4; ++m) {
                const int row = row0 + ai * 128 + wr * 64 + m * 16 + fr;
                float ss = 0.f;
#pragma unroll
                for (int bj = 0; bj < 2; ++bj)
#pragma unroll
                    for (int n = 0; n < 2; ++n) { const f32x4 x = acc[ai][bj][m][n]; ss += (x[0] * x[0] + x[1] * x[1]) + (x[2] * x[2] + x[3] * x[3]); }
                ss += __shfl_xor(ss, 16); ss += __shfl_xor(ss, 32);
                const float rs = 1.0f / sqrtf(ss * (1.f / 64.f) + EPS_);
                f32x4 v[2][2];
#pragma unroll
                for (int bj = 0; bj < 2; ++bj)
#pragma unroll
                    for (int n = 0; n < 2; ++n) v[bj][n] = acc[ai][bj][m][n] * rs * g[bj][n];
                const float* cs = rope + (size_t)row * 16;
#pragma unroll
                for (int n = 0; n < 2; ++n) {
                    const f32x4 co = *(const f32x4*)(cs + 4 * n), si = *(const f32x4*)(cs + 8 + 4 * n);
                    f32x4 pr;
#pragma unroll
                    for (int e = 0; e < 4; ++e) pr[e] = __shfl_xor(v[0][n][e], 16);
                    const f32x4 r0 = v[0][n] * co - pr * si, r1 = v[0][n] * co + pr * si;
                    v[0][n] = (fq == 0) ? r0 : (fq == 1) ? r1 : v[0][n];
                }
                bf16_t* rowp = dst + (size_t)row * ld + col0 + wc * 64 + 8 * fq;
#pragma unroll
                for (int bj = 0; bj < 2; ++bj) { u32x4 w; w.x = cvtpk(v[bj][0][0], v[bj][0][1]); w.y = cvtpk(v[bj][0][2], v[bj][0][3]); w.z = cvtpk(v[bj][1][0], v[bj][1][1]); w.w = cvtpk(v[bj][1][2], v[bj][1][3]);
                    *(u32x4*)(rowp + 32 * bj) = w; }
            }
    }
    __device__ __forceinline__ void gates(const f32x4 (&acc)[2][2][4][2], bf16_t* dst, int col0, int row0, int wr, int wc, int fr, int fq) const {
        f32x4 bv[2][2];
#pragma unroll
        for (int bj = 0; bj < 2; ++bj)
#pragma unroll
            for (int n = 0; n < 2; ++n) bv[bj][n] = *(const f32x4*)(bgate + col0 + wc * 64 + 32 * bj + 8 * fq + 4 * n);
#pragma unroll
        for (int ai = 0; ai < 2; ++ai)
#pragma unroll
            for (int m = 0; m < 4; ++m) { bf16_t* rowp = dst + (size_t)(row0 + ai * 128 + wr * 64 + m * 16 + fr) * 3072 + col0 + wc * 64 + 8 * fq;
#pragma unroll
                for (int bj = 0; bj < 2; ++bj) { f32x4 v[2];
#pragma unroll
                    for (int n = 0; n < 2; ++n) { const f32x4 z = (acc[ai][bj][m][n] + bv[bj][n]) * (-LOG2E);
#pragma unroll
                        for (int e = 0; e < 4; ++e) v[n][e] = __builtin_amdgcn_rcpf(1.0f + __builtin_amdgcn_exp2f(z[e])); }
                    u32x4 w; w.x = cvtpk(v[0][0], v[0][1]); w.y = cvtpk(v[0][2], v[0][3]); w.z = cvtpk(v[1][0], v[1][1]); w.w = cvtpk(v[1][2], v[1][3]);
                    *(u32x4*)(rowp + 32 * bj) = w; } }
    }
    __device__ __forceinline__ void operator()(const f32x4 (&acc)[2][2][4][2], const pg8::Unit& u, int wr, int wc, int fr, int fq) const {
        const int pn = u.pn, row0 = u.pm * 256;
        if (pn >= 26) { plain(acc, (bf16_t*)(ws + WS_MKV), 1024, (pn - 26) * 256, row0 - T_, wr, wc, fr, fq); return; }
        if (pn >= 14) { gates(acc, (bf16_t*)(ws + WS_G), (pn - 14) * 256, row0, wr, wc, fr, fq); return; }
        if (pn >= 12) { plain(acc, (bf16_t*)(ws + WS_MQ), 512, (pn - 12) * 256, row0, wr, wc, fr, fq); return; }
        if (pn == 11) {
            if (wc >= 2) plain(acc, (bf16_t*)(ws + WS_KVB), 256, 0, row0, wr, wc, fr, fq);
            else normed(acc, (bf16_t*)(ws + WS_KVB), 256, 0, row0, bk, 1.0f, wr, wc, fr, fq);
            return;
        }
        if (pn >= 9) { normed(acc, (bf16_t*)(ws + WS_QB), 512, (pn - 9) * 256, row0, bq, QSCALE64, wr, wc, fr, fq); return; }
        const int gi = pn / 3, ty = pn - 3 * gi;
        if (ty == 2) { plain(acc, (bf16_t*)(ws + WS_VA) + (size_t)gi * T_ * 256, 256, 0, row0, wr, wc, fr, fq); return; }
        if (ty == 0) normed(acc, (bf16_t*)(ws + WS_QA) + (size_t)gi * T_ * 256, 256, 0, row0, aq + 64 * gi, QSCALE64, wr, wc, fr, fq);
        else normed(acc, (bf16_t*)(ws + WS_KA) + (size_t)gi * T_ * 256, 256, 0, row0, ak + 64 * gi, 1.0f, wr, wc, fr, fq);
    }
};

namespace att {
typedef short v4i16_t __attribute__((ext_vector_type(4)));
__device__ __forceinline__ int crow(int r, int h) { return (r & 3) + 8 * (r >> 2) + 4 * h; }
__device__ __forceinline__ s16x4 vtr(LAS const unsigned char* p) { return __builtin_bit_cast(s16x4, __builtin_amdgcn_ds_read_tr16_b64_v4i16((LAS v4i16_t*)p)); }

constexpr int KROW64 = 144, VROW64 = 128, NKEYS_B = 384;
constexpr int LDS_K64 = 0, LDS_V64 = NKEYS_B * KROW64;
constexpr int LDS_K128 = 0, LDS_V128 = 65536;

template <int ND>
__device__ __forceinline__ void softmax_tile(f32x16& s, float& m, float& l, f32x16 (&o)[ND], bf16x8 (&pf)[2]) {
    float mx = s[0];
#pragma unroll
    for (int r = 1; r < 16; ++r) mx = fmaxf(mx, s[r]);
    mx = fmaxf(mx, __shfl_xor(mx, 32));
    const float mn = fmaxf(m, mx), alpha = __builtin_amdgcn_exp2f(m - mn);
    m = mn;
    float ps = 0.f;
#pragma unroll
    for (int r = 0; r < 16; ++r) { s[r] = __builtin_amdgcn_exp2f(s[r] - mn); ps += s[r]; }
    l = l * alpha + ps;
#pragma unroll
    for (int d = 0; d < ND; ++d)
#pragma unroll
        for (int r = 0; r < 16; ++r) o[d][r] *= alpha;
#pragma unroll
    for (int k = 0; k < 2; ++k) { u32x4 w; w.x = cvtpk(s[8 * k + 0], s[8 * k + 1]); w.y = cvtpk(s[8 * k + 2], s[8 * k + 3]); w.z = cvtpk(s[8 * k + 4], s[8 * k + 5]); w.w = cvtpk(s[8 * k + 6], s[8 * k + 7]);
        pf[k] = __builtin_bit_cast(bf16x8, w); }
}

template <int W, bool SINK>
__device__ __forceinline__ void banded_unit(LAS unsigned char* lds, const bf16_t* q0, size_t qstride, const bf16_t* k0, const bf16_t* v0, size_t kvstride, bool first,
                                            bf16_t* o0, size_t ostride, float* lse0, size_t lsestride, float sink2, int tid, int wid, int lane) {
#pragma unroll
    for (int it = 0; it < 6; ++it) {
        const int c = tid + 512 * it, row = c >> 3, ch = c & 7;
        const bool valid = !(first && row < 128);
        u32x4 kv = (u32x4){0u, 0u, 0u, 0u}, vv = kv;
        if (valid) { const long off = ((long)row - 128) * (long)kvstride + ch * 8; kv = *(const u32x4*)(k0 + off); vv = *(const u32x4*)(v0 + off); }
        *(LAS u32x4*)(lds + LDS_K64 + row * KROW64 + ch * 16) = kv;
        *(LAS u32x4*)(lds + LDS_V64 + row * VROW64 + ((ch * 16) ^ (((row >> 1) & 1) << 6))) = vv;
    }
    const int c = lane & 31, h = lane >> 5;
    const int qi = 32 * wid + c;
    bf16x8 qf[4];
#pragma unroll
    for (int d0 = 0; d0 < 4; ++d0) qf[d0] = *(const bf16x8*)(q0 + (size_t)qi * qstride + 16 * d0 + 8 * h);
    __syncthreads();
    float m = -1e30f, l = 0.f; f32x16 o[2];
#pragma unroll
    for (int d = 0; d < 2; ++d)
#pragma unroll
        for (int r = 0; r < 16; ++r) o[d][r] = 0.f;
    int jlo = qi + 128 - W; if (first && jlo < 128) jlo = 128;
    const int jhi = qi + 128;
    const int qq = (lane & 15) >> 2;
    LAS const unsigned char* kbase = lds + LDS_K64 + c * KROW64 + 16 * h;
    LAS const unsigned char* vbase = lds + LDS_V64 + (4 * h + qq) * VROW64 + ((lane >> 4) & 1) * 32 + (lane & 3) * 8;
    const int vsw = (qq >> 1) & 1;
    for (int kt = wid; kt < wid + 5; ++kt) {
        f32x16 s;
#pragma unroll
        for (int r = 0; r < 16; ++r) s[r] = 0.f;
#pragma unroll
        for (int d0 = 0; d0 < 4; ++d0) { const bf16x8 kf = *(LAS const bf16x8*)(kbase + kt * 32 * KROW64 + d0 * 32); s = __builtin_amdgcn_mfma_f32_32x32x16_bf16(kf, qf[d0], s, 0, 0, 0); }
#pragma unroll
        for (int r = 0; r < 16; ++r) { const int j = 32 * kt + crow(r, h); if (j < jlo || j > jhi) s[r] = -INFINITY; }
        bf16x8 pf[2];
        softmax_tile<2>(s, m, l, o, pf);
#pragma unroll
        for (int d = 0; d < 2; ++d)
#pragma unroll
            for (int k = 0; k < 2; ++k) {
                LAS const unsigned char* vp = vbase + (kt * 32 + 16 * k) * VROW64 + 64 * (d ^ vsw);
                const s16x4 lo = vtr(vp), hi = vtr(vp + 8 * VROW64);
                const bf16x8 vf = (bf16x8){lo[0], lo[1], lo[2], lo[3], hi[0], hi[1], hi[2], hi[3]};
                o[d] = __builtin_amdgcn_mfma_f32_32x32x16_bf16(vf, pf[k], o[d], 0, 0, 0);
            }
    }
    float lt = l + __shfl_xor(l, 32);
    if (SINK) lt += __builtin_amdgcn_exp2f(sink2 - m);
    const float inv = 1.0f / lt;
    bf16_t* orow = o0 + (size_t)qi * ostride;
#pragma unroll
    for (int d = 0; d < 2; ++d)
#pragma unroll
        for (int rg = 0; rg < 4; ++rg) { u32x2 w; w.x = cvtpk(o[d][4 * rg] * inv, o[d][4 * rg + 1] * inv); w.y = cvtpk(o[d][4 * rg + 2] * inv, o[d][4 * rg + 3] * inv);
            *(u32x2*)(orow + 32 * d + 8 * rg + 4 * h) = w; }
    if (lse0 && h == 0) lse0[(size_t)qi * lsestride] = m + __builtin_amdgcn_logf(lt);
    __syncthreads();
}

__device__ __forceinline__ void mem_unit(LAS unsigned char* lds, const bf16_t* q0, const bf16_t* kmem, const bf16_t* vmem, const float* qgain, const float* kgain, bf16_t* o0, size_t ostride, int tid, int wid, int lane) {
#pragma unroll
    for (int it = 0; it < 8; ++it) {
        const int cc = tid + 512 * it, row = cc >> 4, ch = cc & 15;
        const u32x4 kv = *(const u32x4*)(kmem + (size_t)row * 1024 + ch * 8), vv = *(const u32x4*)(vmem + (size_t)row * 1024 + ch * 8);
        *(LAS u32x4*)(lds + LDS_K128 + row * 256 + ((ch ^ (row & 15)) * 16)) = kv;
        *(LAS u32x4*)(lds + LDS_V128 + row * 256 + ((ch * 16) ^ ((row & 3) << 6))) = vv;
    }
    const int c = lane & 31, h = lane >> 5;
    const int qi = 32 * wid + c;
    bf16x8 qf[8];
    {
        u32x4 raw[8]; float ss = 0.f;
#pragma unroll
        for (int d0 = 0; d0 < 8; ++d0) { raw[d0] = *(const u32x4*)(q0 + (size_t)qi * 512 + 16 * d0 + 8 * h);
#pragma unroll
            for (int e = 0; e < 4; ++e) { const float a = bflo(raw[d0][e]), b = bfhi(raw[d0][e]); ss += a * a + b * b; } }
        ss += __shfl_xor(ss, 32);
        const float rs = (1.0f / sqrtf(ss * (1.f / 128.f) + EPS_)) * QSCALE128;
#pragma unroll
        for (int d0 = 0; d0 < 8; ++d0) { const f32x4 g0 = *(const f32x4*)(qgain + 16 * d0 + 8 * h), g1 = *(const f32x4*)(qgain + 16 * d0 + 8 * h + 4);
            u32x4 w; w.x = cvtpk(bflo(raw[d0].x) * rs * g0[0], bfhi(raw[d0].x) * rs * g0[1]); w.y = cvtpk(bflo(raw[d0].y) * rs * g0[2], bfhi(raw[d0].y) * rs * g0[3]);
            w.z = cvtpk(bflo(raw[d0].z) * rs * g1[0], bfhi(raw[d0].z) * rs * g1[1]); w.w = cvtpk(bflo(raw[d0].w) * rs * g1[2], bfhi(raw[d0].w) * rs * g1[3]);
            qf[d0] = __builtin_bit_cast(bf16x8, w); }
    }
    __syncthreads();
    {
        const int row = tid >> 1, hf = tid & 1; u32x4 raw[8]; float ss = 0.f;
#pragma unroll
        for (int i = 0; i < 8; ++i) { raw[i] = *(LAS const u32x4*)(lds + LDS_K128 + row * 256 + (((hf * 8 + i) ^ (row & 15)) * 16));
#pragma unroll
            for (int e = 0; e < 4; ++e) { const float a = bflo(raw[i][e]), b = bfhi(raw[i][e]); ss += a * a + b * b; } }
        ss += __shfl_xor(ss, 1);
        const float rs = 1.0f / sqrtf(ss * (1.f / 128.f) + EPS_);
#pragma unroll
        for (int i = 0; i < 8; ++i) { const float* gp = kgain + 64 * hf + 8 * i; const f32x4 g0 = *(const f32x4*)gp, g1 = *(const f32x4*)(gp + 4);
            u32x4 w; w.x = cvtpk(bflo(raw[i].x) * rs * g0[0], bfhi(raw[i].x) * rs * g0[1]); w.y = cvtpk(bflo(raw[i].y) * rs * g0[2], bfhi(raw[i].y) * rs * g0[3]);
            w.z = cvtpk(bflo(raw[i].z) * rs * g1[0], bfhi(raw[i].z) * rs * g1[1]); w.w = cvtpk(bflo(raw[i].w) * rs * g1[2], bfhi(raw[i].w) * rs * g1[3]);
            *(LAS u32x4*)(lds + LDS_K128 + row * 256 + (((hf * 8 + i) ^ (row & 15)) * 16)) = w; }
    }
    __syncthreads();
    float m = -1e30f, l = 0.f; f32x16 o[4];
#pragma unroll
    for (int d = 0; d < 4; ++d)
#pragma unroll
        for (int r = 0; r < 16; ++r) o[d][r] = 0.f;
    const int qq = (lane & 15) >> 2;
    LAS const unsigned char* vbase = lds + LDS_V128 + (4 * h + qq) * 256 + ((lane >> 4) & 1) * 32 + (lane & 3) * 8;
    for (int kt = 0; kt < 8; ++kt) {
        f32x16 s;
#pragma unroll
        for (int r = 0; r < 16; ++r) s[r] = 0.f;
        const int krow = kt * 32 + c;
#pragma unroll
        for (int d0 = 0; d0 < 8; ++d0) { const bf16x8 kf = *(LAS const bf16x8*)(lds + LDS_K128 + krow * 256 + (((2 * d0 + h) ^ (krow & 15)) * 16)); s = __builtin_amdgcn_mfma_f32_32x32x16_bf16(kf, qf[d0], s, 0, 0, 0); }
        bf16x8 pf[2];
        softmax_tile<4>(s, m, l, o, pf);
#pragma unroll
        for (int d = 0; d < 4; ++d)
#pragma unroll
            for (int k = 0; k < 2; ++k) {
                LAS const unsigned char* vp = vbase + (kt * 32 + 16 * k) * 256 + 64 * (d ^ qq);
                const s16x4 lo = vtr(vp), hi = vtr(vp + 8 * 256);
                const bf16x8 vf = (bf16x8){lo[0], lo[1], lo[2], lo[3], hi[0], hi[1], hi[2], hi[3]};
                o[d] = __builtin_amdgcn_mfma_f32_32x32x16_bf16(vf, pf[k], o[d], 0, 0, 0);
            }
    }
    const float inv = 1.0f / (l + __shfl_xor(l, 32));
    bf16_t* orow = o0 + (size_t)qi * ostride;
#pragma unroll
    for (int d = 0; d < 4; ++d)
#pragma unroll
        for (int rg = 0; rg < 4; ++rg) { u32x2 w; w.x = cvtpk(o[d][4 * rg] * inv, o[d][4 * rg + 1] * inv); w.y = cvtpk(o[d][4 * rg + 2] * inv, o[d][4 * rg + 3] * inv);
            *(u32x2*)(orow + 32 * d + 8 * rg + 4 * h) = w; }
    __syncthreads();
}
}

__device__ __forceinline__ void p2_attention(const Args& A, LAS unsigned char* lds, int vcu, int tid, int wid, int lane) {
    unsigned char* ws = A.ws;
    bf16_t* ocat = (bf16_t*)((unsigned char*)A.out + DO_OCAT);
    bf16_t* oag = (bf16_t*)((unsigned char*)A.out + DO_OAG);
    float* lse = (float*)(ws + WS_LSE);
#pragma unroll 1
    for (int gi = 0; gi < 3; ++gi) {
        const int rem = vcu, b = rem >> 6, hd = (rem >> 4) & 3, i16 = rem & 15;
        const int dl = (gi == 0) ? 1 : (gi == 1) ? 4 : 16;
        int r, qb; if (gi == 0) { r = 0; qb = i16; } else if (gi == 1) { r = i16 >> 2; qb = i16 & 3; } else { r = i16; qb = 0; }
        const int i0 = qb * 256;
        const size_t row0 = (size_t)b * SEQ_ + r + (size_t)dl * i0;
        const bf16_t* q = (const bf16_t*)(ws + WS_QA) + (size_t)gi * T_ * 256 + row0 * 256 + hd * 64;
        const bf16_t* k = (const bf16_t*)(ws + WS_KA) + (size_t)gi * T_ * 256 + row0 * 256 + hd * 64;
        const bf16_t* v = (const bf16_t*)(ws + WS_VA) + (size_t)gi * T_ * 256 + row0 * 256 + hd * 64;
        bf16_t* o = oag + (size_t)gi * T_ * 256 + row0 * 256 + hd * 64;
        float* ls = lse + (size_t)gi * T_ * 4 + row0 * 4 + hd;
        att::banded_unit<128, false>(lds, q, (size_t)dl * 256, k, v, (size_t)dl * 256, i0 == 0, o, (size_t)dl * 256, ls, (size_t)dl * 4, 0.f, tid, wid, lane);
    }
#pragma unroll 1
    for (int j = 0; j < 2; ++j) {
        const int u = vcu + 256 * j, b = u >> 7, hq = (u >> 4) & 7, qb = u & 15, kvh = hq >> 2;
        const size_t row0 = (size_t)b * SEQ_ + (size_t)qb * 256;
        const bf16_t* q = (const bf16_t*)(ws + WS_QB) + row0 * 512 + hq * 64;
        const bf16_t* k = (const bf16_t*)(ws + WS_KVB) + row0 * 256 + kvh * 64;
        const bf16_t* v = (const bf16_t*)(ws + WS_KVB) + row0 * 256 + 128 + kvh * 64;
        bf16_t* o = ocat + row0 * KCAT + 256 + hq * 64;
        const float sink2 = A.in[I_SINK][hq] * LOG2E;
        att::banded_unit<127, true>(lds, q, 512, k, v, 256, qb == 0, o, KCAT, nullptr, 0, sink2, tid, wid, lane);
    }
    {
        const int u = vcu, b = u >> 6, hd = (u >> 4) & 3, qb = u & 15;
        const size_t row0 = (size_t)b * SEQ_ + (size_t)qb * 256;
        const bf16_t* q = (const bf16_t*)(ws + WS_MQ) + row0 * 512 + hd * 128;
        const bf16_t* km = (const bf16_t*)(ws + WS_MKV) + (size_t)b * MEM_ * 1024 + hd * 128;
        const bf16_t* vm = km + 512;
        bf16_t* o = ocat + row0 * KCAT + 768 + hd * 128;
        att::mem_unit(lds, q, km, vm, A.in[I_MQN], A.in[I_MKN], o, KCAT, tid, wid, lane);
    }
}

__device__ __forceinline__ void p2b_merge(const Args& A, int vcu, int G, int tid) {
    const bf16_t* oag = (const bf16_t*)((unsigned char*)A.out + DO_OAG);
    bf16_t* ocat = (bf16_t*)((unsigned char*)A.out + DO_OCAT);
    const float* lse = (const float*)(A.ws + WS_LSE);
    for (int idx = vcu * 512 + tid; idx < T_ * 32; idx += G * 512) {
        const int t = idx >> 5, ch = idx & 31, hd = ch >> 3;
        const float l0 = lse[(size_t)t * 4 + hd], l1 = lse[(size_t)T_ * 4 + (size_t)t * 4 + hd], l2 = lse[(size_t)2 * T_ * 4 + (size_t)t * 4 + hd];
        const float mx = fmaxf(l0, fmaxf(l1, l2));
        float w0 = __builtin_amdgcn_exp2f(l0 - mx), w1 = __builtin_amdgcn_exp2f(l1 - mx), w2 = __builtin_amdgcn_exp2f(l2 - mx);
        const float inv = 1.0f / (w0 + w1 + w2); w0 *= inv; w1 *= inv; w2 *= inv;
        const u32x4 a = *(const u32x4*)(oag + (size_t)t * 256 + ch * 8), b = *(const u32x4*)(oag + (size_t)T_ * 256 + (size_t)t * 256 + ch * 8), c = *(const u32x4*)(oag + (size_t)2 * T_ * 256 + (size_t)t * 256 + ch * 8);
        u32x4 w;
#pragma unroll
        for (int e = 0; e < 4; ++e) w[e] = cvtpk(w0 * bflo(a[e]) + w1 * bflo(b[e]) + w2 * bflo(c[e]), w0 * bfhi(a[e]) + w1 * bfhi(b[e]) + w2 * bfhi(c[e]));
        *(u32x4*)(ocat + (size_t)t * KCAT + ch * 8) = w;
    }
}

struct Epi3a {
    static constexpr bool PERM = true;
    const bf16_t* G; bf16_t* MERGED;
    __device__ __forceinline__ void khook(f32x4 (&acc)[2][2][4][2], const pg8::Unit& u, int t, int wr, int wc, int fr, int fq) const {
        if (t != 4 && t != 12) return;
        const int gsel = (t == 4) ? 0 : 1024;
#pragma unroll
        for (int ai = 0; ai < 2; ++ai)
#pragma unroll
            for (int m = 0; m < 4; ++m) { const bf16_t* gp = G + (size_t)(u.pm * 256 + ai * 128 + wr * 64 + m * 16 + fr) * 3072 + gsel + u.pn * 256 + wc * 64 + 8 * fq;
#pragma unroll
                for (int bj = 0; bj < 2; ++bj) { const u32x4 ga = *(const u32x4*)(gp + 32 * bj), gb = *(const u32x4*)(gp + 1024 + 32 * bj);
#pragma unroll
                    for (int e = 0; e < 4; ++e) { const float r0 = bflo(ga[e]) * __builtin_amdgcn_rcpf(fmaxf(bflo(gb[e]), 1e-30f)), r1 = bfhi(ga[e]) * __builtin_amdgcn_rcpf(fmaxf(bfhi(gb[e]), 1e-30f));
                        acc[ai][bj][m][e >> 1][2 * (e & 1)] *= r0; acc[ai][bj][m][e >> 1][2 * (e & 1) + 1] *= r1; } } }
    }
    __device__ __forceinline__ void operator()(const f32x4 (&acc)[2][2][4][2], const pg8::Unit& u, int wr, int wc, int fr, int fq) const {
#pragma unroll
        for (int ai = 0; ai < 2; ++ai)
#pragma unroll
            for (int m = 0; m < 4; ++m) { const size_t row = (size_t)(u.pm * 256 + ai * 128 + wr * 64 + m * 16 + fr); const int col = u.pn * 256 + wc * 64 + 8 * fq;
#pragma unroll
                for (int bj = 0; bj < 2; ++bj) { const u32x4 g2 = *(const u32x4*)(G + row * 3072 + 2048 + col + 32 * bj); const f32x4 v0 = acc[ai][bj][m][0], v1 = acc[ai][bj][m][1];
                    u32x4 w; w.x = cvtpk(v0[0] * bflo(g2.x), v0[1] * bfhi(g2.x)); w.y = cvtpk(v0[2] * bflo(g2.y), v0[3] * bfhi(g2.y)); w.z = cvtpk(v1[0] * bflo(g2.z), v1[1] * bfhi(g2.z)); w.w = cvtpk(v1[2] * bflo(g2.w), v1[3] * bfhi(g2.w));
                    *(u32x4*)(MERGED + row * 1024 + col + 32 * bj) = w; } }
    }
};

struct Epi3b {
    static constexpr bool PERM = true;
    const float* x; float* x1; bf16_t* X1B; float* SSQ;
    __device__ __forceinline__ void operator()(const f32x4 (&acc)[2][2][4][2], const pg8::Unit& u, int wr, int wc, int fr, int fq) const {
#pragma unroll
        for (int ai = 0; ai < 2; ++ai)
#pragma unroll
            for (int m = 0; m < 4; ++m) { const size_t row = (size_t)(u.pm * 256 + ai * 128 + wr * 64 + m * 16 + fr); const int col = u.pn * 256 + wc * 64 + 8 * fq; float ss = 0.f;
#pragma unroll
                for (int bj = 0; bj < 2; ++bj) { const size_t off = row * 1024 + col + 32 * bj;
                    const f32x4 o0 = *(const f32x4*)(x + off) + acc[ai][bj][m][0], o1 = *(const f32x4*)(x + off + 4) + acc[ai][bj][m][1];
                    *(f32x4*)(x1 + off) = o0; *(f32x4*)(x1 + off + 4) = o1;
                    ss += (o0[0] * o0[0] + o0[1] * o0[1]) + (o0[2] * o0[2] + o0[3] * o0[3]) + (o1[0] * o1[0] + o1[1] * o1[1]) + (o1[2] * o1[2] + o1[3] * o1[3]);
                    u32x4 w; w.x = cvtpk(o0[0], o0[1]); w.y = cvtpk(o0[2], o0[3]); w.z = cvtpk(o1[0], o1[1]); w.w = cvtpk(o1[2], o1[3]);
                    *(u32x4*)(X1B + off) = w; }
                ss += __shfl_xor(ss, 16); ss += __shfl_xor(ss, 32);
                if (fq == 0) SSQ[row * 16 + u.pn * 4 + wc] = ss; }
    }
};

struct Epi4 {
    static constexpr bool PERM = true;
    const float* convw; const float* convb; bf16_t* ACT; float* UE; float* UF; LAS float* xch; LAS const float* rtab;
    __device__ __forceinline__ void operator()(f32x4 (&acc)[2][2][4][2], const pg8::Unit& u, int wr, int wc, int fr, int fq) const {
        const int lane = fr + 16 * fq;
        const int rowbase = u.pm * 256 + 128 * wr + 8 * fr;
        const int jj = 32 * wc + 8 * fq;
        const bool bstart = (u.pm & 15) == 0;
        {
            LAS const float* tb = rtab + ((u.pm >> 3) & 1) * 256 + 128 * wr + 8 * fr;
            const f32x4 ra = *(LAS const f32x4*)tb, rb = *(LAS const f32x4*)(tb + 4);
#pragma unroll
            for (int i = 0; i < 8; ++i) { const float rs = (i < 4) ? ra[i & 3] : rb[i & 3];
#pragma unroll
                for (int bj = 0; bj < 2; ++bj)
#pragma unroll
                    for (int n = 0; n < 2; ++n) acc[i >> 2][bj][i & 3][n] *= rs; }
        }
#define U4(bj, n, i) acc[(i) >> 2][bj][(i) & 3][n]
        if (wr == 0 && fr == 0) {
#pragma unroll
            for (int i = 0; i < 2; ++i)
#pragma unroll
                for (int bj = 0; bj < 2; ++bj)
#pragma unroll
                    for (int n = 0; n < 2; ++n) *(f32x4*)(UF + (size_t)(u.pm * 2 + i) * 5632 + u.pn * 256 + 128 * bj + jj + 4 * n) = U4(bj, n, i);
        }
        if (wr == 1 && fr == 15) {
#pragma unroll
            for (int i = 0; i < 2; ++i)
#pragma unroll
                for (int bj = 0; bj < 2; ++bj)
#pragma unroll
                    for (int n = 0; n < 2; ++n) *(f32x4*)(UE + (size_t)(u.pm * 2 + i) * 5632 + u.pn * 256 + 128 * bj + jj + 4 * n) = U4(bj, n, 6 + i);
        }
        if (wr == 0 && fr == 15) {
#pragma unroll
            for (int i = 0; i < 2; ++i)
#pragma unroll
                for (int bj = 0; bj < 2; ++bj)
#pragma unroll
                    for (int n = 0; n < 2; ++n) *(LAS f32x4*)(xch + ((((wc * 2 + i) * 2 + bj) * 2 + n) * 4 + fq) * 4) = U4(bj, n, 6 + i);
        }
        asm volatile("s_waitcnt lgkmcnt(0)" ::: "memory"); __builtin_amdgcn_s_barrier(); asm volatile("" ::: "memory");
        const int src = (lane & 48) | ((fr - 1) & 15);
        const int cha = u.pn * 128 + jj;
#pragma unroll
        for (int n = 0; n < 2; ++n) {
            asm volatile("" ::: "memory"); __builtin_amdgcn_sched_barrier(0);
            f32x4 p6[2], p7[2], w0[2], w1[2], w2[2], cb[2];
#pragma unroll
            for (int bj = 0; bj < 2; ++bj) {
                f32x4 h6 = (f32x4){0.f, 0.f, 0.f, 0.f}, h7 = h6;
                if (wr == 1) { h6 = *(LAS const f32x4*)(xch + ((((wc * 2 + 0) * 2 + bj) * 2 + n) * 4 + fq) * 4); h7 = *(LAS const f32x4*)(xch + ((((wc * 2 + 1) * 2 + bj) * 2 + n) * 4 + fq) * 4); }
#pragma unroll
                for (int e = 0; e < 4; ++e) { const float a6 = __shfl(U4(bj, n, 6)[e], src), a7 = __shfl(U4(bj, n, 7)[e], src); p6[bj][e] = (fr == 0) ? h6[e] : a6; p7[bj][e] = (fr == 0) ? h7[e] : a7; }
                const int ch = bj * DFF_ + cha + 4 * n;
                w0[bj] = *(const f32x4*)(convw + ch); w1[bj] = *(const f32x4*)(convw + 5632 + ch); w2[bj] = *(const f32x4*)(convw + 2 * 5632 + ch); cb[bj] = *(const f32x4*)(convb + ch);
            }
#pragma unroll
            for (int i = 0; i < 8; ++i) {
                f32x4 c[2];
#pragma unroll
                for (int bj = 0; bj < 2; ++bj) {
                    const f32x4 um1 = (i >= 1) ? U4(bj, n, i >= 1 ? i - 1 : 0) : p7[bj];
                    const f32x4 um2 = (i >= 2) ? U4(bj, n, i >= 2 ? i - 2 : 0) : ((i == 1) ? p7[bj] : p6[bj]);
                    c[bj] = cb[bj] + w2[bj] * U4(bj, n, i) + w1[bj] * um1 + w0[bj] * um2;
                }
                f32x4 a;
#pragma unroll
                for (int e = 0; e < 4; ++e) { const float z = c[0][e]; a[e] = z * __builtin_amdgcn_rcpf(1.0f + __builtin_amdgcn_exp2f(-z * LOG2E)) * c[1][e]; }
                u32x2 w; w.x = cvtpk(a[0], a[1]); w.y = cvtpk(a[2], a[3]);
                const bool skip = (wr == 0 && fr == 0 && i < 2 && !bstart);
                if (!skip) *(u32x2*)(ACT + (size_t)(rowbase + i) * DFF_ + cha + 4 * n) = w;
            }
        }
#undef U4
    }
};

struct P4Order : pg8::StaticOrder {
    const float* SSQ; LAS float* rtab;
    __device__ __forceinline__ void a_ready(const pg8::Unit& u) const {
        const int t = threadIdx.x;
        if (t < 256) {
            const float* sp = SSQ + (size_t)(u.pm * 256 + t) * 16;
            const f32x4 s0 = *(const f32x4*)sp, s1 = *(const f32x4*)(sp + 4), s2 = *(const f32x4*)(sp + 8), s3 = *(const f32x4*)(sp + 12);
            const float tot = ((s0[0] + s0[1]) + (s0[2] + s0[3])) + ((s1[0] + s1[1]) + (s1[2] + s1[3])) + ((s2[0] + s2[1]) + (s2[2] + s2[3])) + ((s3[0] + s3[1]) + (s3[2] + s3[3]));
            rtab[((u.pm >> 3) & 1) * 256 + t] = 1.0f / sqrtf(tot * (1.f / 1024.f) + EPS_);
        }
    }
};

struct Epi5 {
    static constexpr bool PERM = true;
    float* out;
    __device__ __forceinline__ void operator()(const f32x4 (&acc)[2][2][4][2], const pg8::Unit& u, int wr, int wc, int fr, int fq) const {
#pragma unroll
        for (int ai = 0; ai < 2; ++ai)
#pragma unroll
            for (int m = 0; m < 4; ++m) { const size_t row = (size_t)(u.pm * 256 + ai * 128 + wr * 64 + m * 16 + fr); const int col = u.pn * 256 + wc * 64 + 8 * fq;
#pragma unroll
                for (int bj = 0; bj < 2; ++bj) { float* p = out + row * 1024 + col + 32 * bj;
                    const f32x4 o0 = *(const f32x4*)p + acc[ai][bj][m][0], o1 = *(const f32x4*)(p + 4) + acc[ai][bj][m][1];
                    *(f32x4*)p = o0; *(f32x4*)(p + 4) = o1; } }
    }
};
struct P5Order : pg8::StaticOrder {
    const float* UE; const float* UF; const float* convw; const float* convb; bf16_t* ACT;
    __device__ __forceinline__ void a_ready(const pg8::Unit& u) const {
        if ((u.pm & 15) != 0) {
            for (int ch = threadIdx.x; ch < DFF_; ch += 512) {
                const int pa = 256 * (ch >> 7) + (ch & 127), pg = pa + 128;
                const float* e = UE + (size_t)((u.pm - 1) * 2) * 5632; const float* f = UF + (size_t)(u.pm * 2) * 5632;
                float r[2];
#pragma unroll
                for (int i = 0; i < 2; ++i) {
                    float cc[2];
#pragma unroll
                    for (int s = 0; s < 2; ++s) { const int p = s ? pg : pa, cch = s * DFF_ + ch;
                        const float um2 = e[p], um1 = e[5632 + p], u0 = f[p], u1 = f[5632 + p];
                        const float w0 = convw[cch], w1 = convw[5632 + cch], w2 = convw[2 * 5632 + cch], b = convb[cch];
                        cc[s] = (i == 0) ? b + w0 * um2 + w1 * um1 + w2 * u0 : b + w0 * um1 + w1 * u0 + w2 * u1; }
                    r[i] = cc[0] * __builtin_amdgcn_rcpf(1.0f + __builtin_amdgcn_exp2f(-cc[0] * LOG2E)) * cc[1];
                }
                const unsigned w = cvtpk(r[0], r[1]);
                ACT[(size_t)(u.pm * 256) * DFF_ + ch] = (bf16_t)(w & 0xffffu); ACT[(size_t)(u.pm * 256 + 1) * DFF_ + ch] = (bf16_t)(w >> 16);
            }
        }
        asm volatile("s_waitcnt vmcnt(0)" ::: "memory"); __builtin_amdgcn_s_barrier(); asm volatile("" ::: "memory");
    }
};

__global__ void __launch_bounds__(NWAVES * 64, 2) fwd_kernel(Args args) {
    extern __shared__ __attribute__((aligned(16))) unsigned char lds_raw[];
    LAS unsigned char* lds = (LAS unsigned char*)lds_raw;
    volatile LAS unsigned* MISC = (volatile LAS unsigned*)(lds + MISC_OFF);
    const int tid = threadIdx.x, lane = tid & 63, wave = __builtin_amdgcn_readfirstlane(tid >> 6);
    const int G = gridDim.x; const int bx = blockIdx.x; const int vcu = (G % 8 == 0) ? (bx % 8) * (G / 8) + bx / 8 : bx;
    unsigned char* ws = args.ws;
    gu32* ctl = (gu32*)(ws + WS_CTL);
    for (int u = tid; u < (LDS_BYTES - LDSCTL_OFF) / 4; u += NWAVES * 64) ((LAS unsigned*)(lds + LDSCTL_OFF))[u] = 0u;
    __syncthreads();
    XcdBarrier bar; bar.bar = (unsigned*)(ctl + CW_BAR); bar.x = 0; bar.st = nullptr;
    if (!MK_MULTI) bar = xcd_barrier_post((unsigned*)(ctl + CW_BAR), MISC + 8);
#define GRID_BAR() do { if (!MK_MULTI) xcd_barrier(bar); } while (0)
    const int lo = args.ph_lo, hi = args.ph_hi;
#ifndef PHASE_MASK
#define PHASE_MASK 0xff
#endif
#define IN(k) (((PHASE_MASK >> (k)) & 1) && lo <= (k) && (k) < hi)
#define BOTH(k) (IN(k) && IN((k) + 1))

    if (IN(0)) { p0_prologue(args, lds, vcu, G, wave, lane); if (BOTH(0)) GRID_BAR(); }

    if (IN(1)) {
        pg8::Gemm g{(const bf16_t*)((unsigned char*)args.out + DO_A1), (const bf16_t*)((unsigned char*)args.out + DO_WCAT), T_ + NB_ * MEM_, NCAT, 1024};
        P1Order S; S.init(G, bx);
        Epi1 E{ws, (const float*)((unsigned char*)args.out + DO_ROPE), args.in[I_AQ], args.in[I_AK], args.in[I_BQ], args.in[I_BK], args.in[I_BGATE]};
        pg8::gemm_phase<Epi1, P1Order, true, false, false>(lds + RING_OFF, g, S, E);
        if (BOTH(1)) GRID_BAR();
    }

    if (IN(2)) { p2_attention(args, lds, vcu, tid, wave, lane); if (BOTH(2)) GRID_BAR(); }

    if (IN(3)) { p2b_merge(args, vcu, G, tid); if (BOTH(3)) GRID_BAR(); }

    if (IN(4)) {
        pg8::Gemm g{(const bf16_t*)((unsigned char*)args.out + DO_OCAT), (const bf16_t*)(ws + WS_WO), T_, 1024, KCAT};
        pg8::StaticOrder S; S.init(T_, 1024, G, bx);
        Epi3a E{(const bf16_t*)(ws + WS_G), (bf16_t*)(ws + WS_MERGED)};
        pg8::gemm_phase<Epi3a, pg8::StaticOrder, false, false, true>(lds + RING_OFF, g, S, E);
        if (BOTH(4)) GRID_BAR();
    }

    if (IN(5)) {
        pg8::Gemm g{(const bf16_t*)(ws + WS_MERGED), (const bf16_t*)(ws + WS_WOUT), T_, 1024, 1024};
        pg8::StaticOrder S; S.init(T_, 1024, G, bx);
        Epi3b E{args.in[I_X], args.out, (bf16_t*)(ws + WS_X1B), (float*)(ws + WS_SSQ)};
        pg8::gemm_phase<Epi3b, pg8::StaticOrder, false, false, false>(lds + RING_OFF, g, S, E);
        if (BOTH(5)) GRID_BAR();
    }

    if (IN(6)) {
        pg8::Gemm g{(const bf16_t*)(ws + WS_X1B), (const bf16_t*)(ws + WS_WUP), T_, 5632, 1024};
        P4Order S; S.init(T_, 5632, G, bx); S.SSQ = (const float*)(ws + WS_SSQ); S.rtab = (LAS float*)(lds + XCH_OFF + 2048);
        Epi4 E{args.in[I_CONVW], args.in[I_CONVB], (bf16_t*)(ws + WS_ACT), (float*)(ws + WS_UE), (float*)(ws + WS_UF), (LAS float*)(lds + XCH_OFF), (LAS const float*)(lds + XCH_OFF + 2048)};
        pg8::gemm_phase<Epi4, P4Order, true, true, false>(lds + RING_OFF, g, S, E);
        if (BOTH(6)) GRID_BAR();
    }

    if (IN(7)) {
        pg8::Gemm g{(const bf16_t*)(ws + WS_ACT), (const bf16_t*)(ws + WS_WDOWN), T_, 1024, DFF_};
        P5Order S; S.init(T_, 1024, G, bx);
        S.UE = (const float*)(ws + WS_UE); S.UF = (const float*)(ws + WS_UF); S.convw = args.in[I_CONVW]; S.convb = args.in[I_CONVB]; S.ACT = (bf16_t*)(ws + WS_ACT);
        Epi5 E{args.out};
        pg8::gemm_phase<Epi5, P5Order, false, false, false>(lds + RING_OFF, g, S, E);
    }
#undef IN
#undef BOTH
#undef GRID_BAR
}

extern "C" void kernel_launch(void* const* d_in, const int* in_sizes, int n_in, void* d_out, int out_size, void* d_ws, size_t ws_size, hipStream_t stream) {
    static int grid = 0;
    if (grid == 0) {
        if (n_in != 25 || out_size != T_ * DM_ || ws_size < WS_END) { fprintf(stderr, "kernel_launch: unexpected shapes (n_in %d, out %d, ws %zu); nothing launched\n", n_in, out_size, ws_size); grid = -1; return; }
        int dev = 0, cus = 0, per_cu = 0;
        if (hipGetDevice(&dev) != hipSuccess || hipDeviceGetAttribute(&cus, hipDeviceAttributeMultiprocessorCount, dev) != hipSuccess) { grid = -1; return; }
        if (hipFuncSetAttribute((const void*)fwd_kernel, hipFuncAttributeMaxDynamicSharedMemorySize, LDS_BYTES) != hipSuccess) { fprintf(stderr, "kernel_launch: hipFuncSetAttribute failed\n"); grid = -1; return; }
        if (hipOccupancyMaxActiveBlocksPerMultiprocessor(&per_cu, (const void*)fwd_kernel, NWAVES * 64, LDS_BYTES) != hipSuccess || per_cu < 1) { fprintf(stderr, "kernel_launch: occupancy query says %d blocks per CU\n", per_cu); }
        (void)hipGetLastError();
        grid = cus;
        if (grid != 256) fprintf(stderr, "kernel_launch: %d CUs (the phase schedules expect 256)\n", grid);
    }
    if (grid < 0) return;
    if (hipMemsetAsync((char*)d_ws + WS_CTL, 0, CTL_ZERO_BYTES, stream) != hipSuccess) return;
    Args a{};
    for (int i = 0; i < 25; ++i) a.in[i] = (const float*)d_in[i];
    a.out = (float*)d_out; a.ws = (unsigned char*)d_ws;
#if MK_MULTI
    for (int p = 0; p < NPHASES; ++p) { a.ph_lo = p; a.ph_hi = p + 1; a.li = p; hipLaunchKernelGGL(fwd_kernel, dim3(grid), dim3(NWAVES * 64), LDS_BYTES, stream, a); }
#else
    a.ph_lo = 0; a.ph_hi = NPHASES; a.li = 0;
    hipLaunchKernelGGL(fwd_kernel, dim3(grid), dim3(NWAVES * 64), LDS_BYTES, stream, a);
#endif
}
```

```cpp
#include <hip/hip_runtime.h>
#include <cstdio>
#include <cstdint>

#ifndef MK_MULTI
#define MK_MULTI 0
#endif

#define LAS __attribute__((address_space(3)))
#define GAS __attribute__((address_space(1)))
typedef unsigned short bf16_t;
typedef short bf16x8 __attribute__((ext_vector_type(8)));
typedef short s16x4 __attribute__((ext_vector_type(4)));
typedef float f32x4 __attribute__((ext_vector_type(4)));
typedef float f32x16 __attribute__((ext_vector_type(16)));
typedef unsigned u32x4 __attribute__((ext_vector_type(4)));
typedef unsigned u32x2 __attribute__((ext_vector_type(2)));

constexpr int T_ = 16384, SEQ_ = 4096, NB_ = 4, DM_ = 1024, MEM_ = 256, DFF_ = 2816;
constexpr int NCAT = 7680;
constexpr int KCAT = 1280;
constexpr float EPS_ = 1e-6f;
constexpr float LOG2E = 1.4426950408889634f;
constexpr float QSCALE64 = 0.125f * LOG2E;
constexpr float QSCALE128 = 0.08838834764831845f * LOG2E;

__device__ __forceinline__ unsigned cvtpk(float lo, float hi) {
    typedef float f2 __attribute__((ext_vector_type(2))); typedef __bf16 b2 __attribute__((ext_vector_type(2)));
    f2 v = {lo, hi}; b2 b = __builtin_convertvector(v, b2); return __builtin_bit_cast(unsigned, b);
}
__device__ __forceinline__ float bflo(unsigned w) { return __uint_as_float(w << 16); }
__device__ __forceinline__ float bfhi(unsigned w) { return __uint_as_float(w & 0xffff0000u); }

namespace pg8 {
constexpr int BM = 256, BK = 64, HALF = 128, HTB = HALF * BK * 2, STAGE_BYTES = 8 * HTB, NXCD = 8, WGM = 8;
__host__ __device__ __forceinline__ int lds_byte(int r, int c) { const int st = (r >> 4) * 2 + (c >> 5), rr = r & 15, cc = c & 31, ob = rr * 64 + cc * 2; return st * 1024 + (ob ^ (((ob >> 9) & 1) << 5)); }
__host__ __device__ __forceinline__ void stage_rc(int b, int& R, int& C) { const int st = b / 1024, sb = b % 1024, swz = sb ^ (((sb >> 9) & 1) << 5); R = (st >> 1) * 16 + swz / 64; C = (st & 1) * 32 + (swz % 64) / 2; }
__host__ __device__ __forceinline__ int perm32(int rho) { const int n = rho >> 4, i = rho & 15; return 8 * (i >> 2) + 4 * n + (i & 3); }

struct Unit { int pm, pn; };
struct Gemm { const bf16_t* A; const bf16_t* Bt; int M, N, K; };

struct StaticOrder {
    int nM, nN, nwg, G, c;
    __host__ __device__ void init(int M, int N, int G_, int c_) { nM = M / BM; nN = N / BM; nwg = nM * nN; G = G_; c = c_; }
    __host__ __device__ bool next(int i, Unit& u) const {
        const long L = (long)i * G + c; if (L >= nwg) return false;
        int wgid = (int)L; { const int q = nwg / NXCD, r = nwg % NXCD, xcd = wgid % NXCD, off = wgid / NXCD; wgid = (xcd < r ? xcd * (q + 1) : r * (q + 1) + (xcd - r) * q) + off; }
        const int nig = WGM * nN, gid = wgid / nig, fm = gid * WGM, gsz = (nM - fm) < WGM ? (nM - fm) : WGM;
        u.pm = fm + ((wgid % nig) % gsz); u.pn = (wgid % nig) / gsz; return true;
    }
    __device__ __forceinline__ void a_ready(const Unit&) const {}
    __device__ __forceinline__ void done(const Unit&) const {}
};

template <class Epi, class Sched, bool ALIGN_EPI, bool PERMA, bool KHOOK>
__device__ __forceinline__ void gemm_phase(LAS unsigned char* lds, const Gemm g, const Sched& S, const Epi& E) {
    const int tid = threadIdx.x, wid = __builtin_amdgcn_readfirstlane(tid >> 6), lane = tid & 63, wr = wid >> 2, wc = wid & 3, fr = lane & 15, fq = lane >> 4;
    const int K = g.K, nt = K / BK;
    unsigned voffA0[2], voffA1[2], voffB[2];
#pragma unroll
    for (int i = 0; i < 2; ++i) { int R, C; stage_rc(tid * 16 + i * 8192, R, C); const int Rb = (R & ~31) + perm32(R & 31);
        if (PERMA) { const int rw = R >> 6, rm = (R >> 4) & 3, rf = R & 15; voffA0[i] = (unsigned)((128 * rw + 8 * rf + rm) * K + C) * 2u; voffA1[i] = (unsigned)((128 * rw + 8 * rf + 4 + rm) * K + C) * 2u; }
        else { voffA0[i] = (unsigned)(R * K + C) * 2u; voffA1[i] = voffA0[i]; }
        voffB[i] = (unsigned)(Rb * K + C) * 2u; }
    const size_t kstep = (size_t)(BK * 2);
    const size_t hstep = (size_t)HALF * K * 2;
    const size_t ahs = PERMA ? (size_t)0 : hstep;
    const size_t tstep = 2 * hstep;
    const unsigned ldsw = (unsigned)wid * 1024u;
    const int aoff = lds_byte(wr * 64 + fr, fq * 8), boff = lds_byte(wc * 32 + fr, fq * 8);
#define PG8_SA(b, h) (((b) * 2 + (h)) * HTB)
#define PG8_SB(b, h) ((4 + (b) * 2 + (h)) * HTB)
#define PG8_STAGE(bufoff, gbase, voff) do { _Pragma("unroll") for (int _i = 0; _i < 2; ++_i) \
        __builtin_amdgcn_global_load_lds((const unsigned*)((const char*)(gbase) + (voff)[_i]), (LAS unsigned*)(lds + (bufoff) + ldsw + _i * 8192), 16, 0, 0); } while (0)
#define PG8_LDA(dst, b, h) do { _Pragma("unroll") for (int m = 0; m < 4; ++m) _Pragma("unroll") for (int k = 0; k < 2; ++k) dst[m][k] = *(const LAS bf16x8*)(lds + PG8_SA(b, h) + aoff + m * 2048 + k * 1024); } while (0)
#define PG8_LDB(dst, b, h) do { _Pragma("unroll") for (int n = 0; n < 2; ++n) _Pragma("unroll") for (int k = 0; k < 2; ++k) dst[n][k] = *(const LAS bf16x8*)(lds + PG8_SB(b, h) + boff + n * 2048 + k * 1024); } while (0)
#define PG8_MMA(ai, bj, At, Bt) do { __builtin_amdgcn_s_setprio(1); _Pragma("unroll") for (int m = 0; m < 4; ++m) _Pragma("unroll") for (int n = 0; n < 2; ++n) _Pragma("unroll") for (int k = 0; k < 2; ++k) \
        acc[ai][bj][m][n] = __builtin_amdgcn_mfma_f32_16x16x32_bf16(Bt[n][k], At[m][k], acc[ai][bj][m][n], 0, 0, 0); __builtin_amdgcn_s_setprio(0); } while (0)
#define PG8_WAIT_V(n) asm volatile("s_waitcnt vmcnt(" #n ")" ::: "memory")
#define PG8_WAIT_L(n) asm volatile("s_waitcnt lgkmcnt(" #n ")" ::: "memory")
#define PG8_BAR __builtin_amdgcn_s_barrier()
#define PG8_SCHED __builtin_amdgcn_sched_barrier(0)
    Unit cur, nxt; int ui = 0;
    if (!S.next(0, cur)) return;
    f32x4 acc[2][2][4][2];
#pragma unroll
    for (int a = 0; a < 2; ++a)
#pragma unroll
        for (int b = 0; b < 2; ++b)
#pragma unroll
            for (int m = 0; m < 4; ++m)
#pragma unroll
                for (int n = 0; n < 2; ++n) acc[a][b][m][n] = (f32x4){0.f, 0.f, 0.f, 0.f};
    bf16x8 At[4][2], B0[2][2], B1[2][2];
    const char* cA = (const char*)g.A + (size_t)cur.pm * tstep; const char* cB = (const char*)g.Bt + (size_t)cur.pn * tstep;
    S.a_ready(cur);
    PG8_STAGE(PG8_SB(0, 0), cB, voffB); PG8_STAGE(PG8_SB(0, 1), cB + hstep, voffB); PG8_STAGE(PG8_SA(0, 0), cA, voffA0); PG8_STAGE(PG8_SA(0, 1), cA + ahs, voffA1);
    if (wr == 1) PG8_BAR;
    PG8_WAIT_V(2); PG8_BAR;
    PG8_STAGE(PG8_SB(1, 0), cB + kstep, voffB); PG8_STAGE(PG8_SA(1, 0), cA + kstep, voffA0); PG8_STAGE(PG8_SB(1, 1), cB + hstep + kstep, voffB);
    PG8_WAIT_V(6); PG8_BAR;
    for (;;) {
        const bool has_next = S.next(ui + 1, nxt);
        const char* nA = has_next ? (const char*)g.A + (size_t)nxt.pm * tstep : cA; const char* nB = has_next ? (const char*)g.Bt + (size_t)nxt.pn * tstep : cB;
        for (int t = 0; t < nt; t += 2) {
            const bool last = (t == nt - 2);
            const char* a1 = cA + (size_t)(t + 1) * kstep;
            const char* a2 = last ? nA : cA + (size_t)(t + 2) * kstep; const char* b2 = last ? nB : cB + (size_t)(t + 2) * kstep;
            const char* a3 = a2 + kstep; const char* b3 = b2 + kstep;
            if (last && has_next) S.a_ready(nxt);
            if constexpr (KHOOK) E.khook(acc, cur, t, wr, wc, fr, fq);
            PG8_LDB(B0, 0, 0); PG8_LDB(B1, 0, 1); PG8_SCHED; PG8_LDA(At, 0, 0); PG8_STAGE(PG8_SA(1, 1), a1 + ahs, voffA1);
            PG8_WAIT_V(8); PG8_WAIT_L(0); PG8_BAR; PG8_MMA(0, 0, At, B0); PG8_MMA(0, 1, At, B1); PG8_BAR; PG8_SCHED;
            PG8_LDA(At, 0, 1); PG8_STAGE(PG8_SB(0, 0), b2, voffB); PG8_STAGE(PG8_SB(0, 1), b2 + hstep, voffB); PG8_STAGE(PG8_SA(0, 0), a2, voffA0);
            PG8_WAIT_V(8); PG8_WAIT_L(0); PG8_BAR; PG8_MMA(1, 0, At, B0); PG8_MMA(1, 1, At, B1); PG8_BAR; PG8_SCHED;
            PG8_LDB(B0, 1, 0); PG8_LDB(B1, 1, 1); PG8_SCHED; PG8_LDA(At, 1, 0); PG8_STAGE(PG8_SA(0, 1), a2 + ahs, voffA1);
            PG8_WAIT_V(8); PG8_WAIT_L(0); PG8_BAR; PG8_MMA(0, 0, At, B0); PG8_MMA(0, 1, At, B1); PG8_BAR; PG8_SCHED;
            PG8_LDA(At, 1, 1); PG8_STAGE(PG8_SB(1, 0), b3, voffB); PG8_STAGE(PG8_SB(1, 1), b3 + hstep, voffB); PG8_STAGE(PG8_SA(1, 0), a3, voffA0);
            PG8_WAIT_V(8); PG8_WAIT_L(0); PG8_BAR; PG8_MMA(1, 0, At, B0); PG8_MMA(1, 1, At, B1); PG8_BAR; PG8_SCHED;
        }
        if constexpr (ALIGN_EPI) { if (wr == 0) PG8_BAR; }
        E(acc, cur, wr, wc, fr, fq); S.done(cur);
        if (!has_next) break;
#pragma unroll
        for (int a = 0; a < 2; ++a)
#pragma unroll
            for (int b = 0; b < 2; ++b)
#pragma unroll
                for (int m = 0; m < 4; ++m)
#pragma unroll
                    for (int n = 0; n < 2; ++n) acc[a][b][m][n] = (f32x4){0.f, 0.f, 0.f, 0.f};
        cur = nxt; cA = nA; cB = nB; ++ui;
        if constexpr (ALIGN_EPI) { if (wr == 1) PG8_BAR; }
    }
    PG8_WAIT_V(0);
    if constexpr (!ALIGN_EPI) { if (wr == 0) PG8_BAR; }
    PG8_BAR;
#undef PG8_SA
#undef PG8_SB
#undef PG8_STAGE
#undef PG8_LDA
#undef PG8_LDB
#undef PG8_MMA
#undef PG8_WAIT_V
#undef PG8_WAIT_L
#undef PG8_BAR
#undef PG8_SCHED
}
}

constexpr size_t MiB = 1u << 20;
constexpr size_t WS_CTL = 0, CTL_ZERO_BYTES = 1 * MiB;
constexpr size_t WS_WO = 1 * MiB;
constexpr size_t WS_WOUT = 4 * MiB;
constexpr size_t WS_WUP = 6 * MiB;
constexpr size_t WS_WDOWN = 17 * MiB;
constexpr size_t WS_SSQ = 23 * MiB;
constexpr size_t WS_UE = 24 * MiB;
constexpr size_t WS_UF = 27 * MiB;
constexpr size_t WS_LSE = 30 * MiB;
constexpr size_t WS_MKV = 31 * MiB;
constexpr size_t WS_G = 34 * MiB;
constexpr size_t WS_ACT = 34 * MiB;
constexpr size_t WS_QA = 130 * MiB;
constexpr size_t WS_KA = 154 * MiB;
constexpr size_t WS_VA = 178 * MiB;
constexpr size_t WS_MERGED = 130 * MiB;
constexpr size_t WS_X1B = 162 * MiB;
constexpr size_t WS_QB = 202 * MiB;
constexpr size_t WS_KVB = 218 * MiB;
constexpr size_t WS_MQ = 226 * MiB;
constexpr size_t WS_END = 242 * MiB;
constexpr size_t DO_A1 = 0;
constexpr size_t DO_WCAT = 34 * MiB;
constexpr size_t DO_ROPE = 49 * MiB;
constexpr size_t DO_OCAT = 0;
constexpr size_t DO_OAG = 40 * MiB;

constexpr int CW_TMO = 0, CW_BAR = 4096;

constexpr int RING_OFF = 0, RING_BYTES = 131072;
constexpr int XCH_OFF = RING_BYTES;
constexpr int LDSCTL_OFF = RING_BYTES + 4096, MISC_OFF = LDSCTL_OFF + 320;
constexpr int LDS_BYTES = 147456;
constexpr int NWAVES = 8;
constexpr int NPHASES = 8;

typedef GAS unsigned gu32;
#define RLX_AGENT __ATOMIC_RELAXED, __HIP_MEMORY_SCOPE_AGENT
#define LDS_WAIT() asm volatile("s_waitcnt lgkmcnt(0)" ::: "memory")
#define VM_WAIT() asm volatile("s_waitcnt vmcnt(0)" ::: "memory")

#define XB_TMO      128
#define XB_XCNT(j)  (256  + 64 * (j))
#define XB_XSUB(j)  (1280 + 64 * (j))
#define XB_XGEN(j)  (2304 + 64 * (j))
#define XB_TOP      3328
#define XB_TOPGEN   3392
#define XCD_BAR_WORDS 3456
#define XB_SPIN_CAP (1u << 18)
__device__ __forceinline__ unsigned xb_ld(unsigned* p)              { return __hip_atomic_load(p, __ATOMIC_RELAXED, __HIP_MEMORY_SCOPE_AGENT); }
__device__ __forceinline__ unsigned xb_add(unsigned* p, unsigned v) { return __hip_atomic_fetch_add(p, v, __ATOMIC_RELAXED, __HIP_MEMORY_SCOPE_AGENT); }
__device__ __forceinline__ unsigned xb_xcc_id() { return (unsigned)__builtin_amdgcn_s_getreg((3 << 11) | 20) & 0xFu; }
#define XB_SPIN(cond, bar) do { unsigned _sp = 0; while (cond) { __builtin_amdgcn_s_sleep(1); \
    if ((++_sp & 255u) == 0u) { if (xb_ld(&(bar)[XB_TMO])) break; if (_sp > XB_SPIN_CAP) { atomicAdd(&(bar)[XB_TMO], 1u); break; } } } } while (0)
struct XcdBarrier { unsigned* bar; unsigned x; volatile LAS unsigned* st; };
__device__ __forceinline__ XcdBarrier xcd_barrier_post(unsigned* bar, volatile LAS unsigned* st) {
    XcdBarrier b; b.bar = bar; b.x = xb_xcc_id(); b.st = st;
    if (threadIdx.x == 0) (void)xb_add(&bar[XB_XCNT(b.x)], 1u);
    return b;
}
__device__ __forceinline__ void xcd_barrier_complete(unsigned* bar, unsigned x, unsigned& nloc, unsigned& nx) {
    const unsigned G = gridDim.x * gridDim.y * gridDim.z;
    unsigned sum, cnt, mine, sp = 0u;
    for (;;) {
        sum = 0u; cnt = 0u; mine = 0u;
#pragma unroll
        for (unsigned j = 0; j < 16; ++j) { const unsigned c = xb_ld(&bar[XB_XCNT(j)]); sum += c; cnt += (c > 0u) ? 1u : 0u; mine = (j == x) ? c : mine; }
        if (sum == G) break;
        __builtin_amdgcn_s_sleep(1);
        if ((++sp & 255u) == 0u) { if (xb_ld(&bar[XB_TMO])) break; if (sp > XB_SPIN_CAP) { atomicAdd(&bar[XB_TMO], 1u); break; } }
    }
    nloc = mine > 0u ? mine : 1u; nx = cnt > 0u ? cnt : 1u;
}
__device__ __forceinline__ void xcd_barrier(const XcdBarrier& b) {
    asm volatile("s_waitcnt vmcnt(0)" ::: "memory");
    __syncthreads();
    if (threadIdx.x == 0) {
        unsigned* bar = b.bar;
        __builtin_amdgcn_s_waitcnt(0);
        unsigned nloc = b.st[0], nx = b.st[1];
        if (nloc == 0u) { xcd_barrier_complete(bar, b.x, nloc, nx); b.st[0] = nloc; b.st[1] = nx; }
        const unsigned old = xb_add(&bar[XB_XSUB(b.x)], 1u);
        const unsigned gen = old / nloc;
        if (old + 1u == (gen + 1u) * nloc) {
            __builtin_amdgcn_fence(__ATOMIC_RELEASE, "agent");
            asm volatile("s_waitcnt vmcnt(0)" ::: "memory");
            const unsigned og = xb_add(&bar[XB_TOP], 1u);
            const unsigned tg = og / nx;
            if (og + 1u == (tg + 1u) * nx) xb_add(&bar[XB_TOPGEN], 1u);
            else XB_SPIN(xb_ld(&bar[XB_TOPGEN]) == tg, bar);
            __builtin_amdgcn_fence(__ATOMIC_ACQUIRE, "agent");
            xb_add(&bar[XB_XGEN(b.x)], 1u);
            asm volatile("s_waitcnt vmcnt(0)" ::: "memory");
        } else {
            XB_SPIN(xb_ld(&bar[XB_XGEN(b.x)]) == gen, bar);
            __builtin_amdgcn_fence(__ATOMIC_ACQUIRE, "agent");
            asm volatile("s_waitcnt vmcnt(0)" ::: "memory");
        }
    }
    __syncthreads();
}

struct Args {
    const float* in[25]; float* out; unsigned char* ws; int ph_lo, ph_hi, li, pad;
};
enum { I_X = 0, I_MEM, I_POS, I_ATTN_NORM, I_W_IN, I_AQ, I_AK, I_BQ, I_BK, I_SINK, I_MEM_NORM, I_W_MKV, I_MQN, I_MKN, I_WOA, I_WOB, I_WOM, I_WGATE, I_BGATE, I_WOUT, I_FFN_NORM, I_WUP, I_CONVW, I_CONVB, I_WDOWN };

__host__ __device__ __forceinline__ int map_uniform(int n) { const int c = n & 255; return (n & ~255) + 128 * ((c >> 5) & 1) + 32 * (c >> 6) + (c & 31); }
__host__ __device__ __forceinline__ int map_up(int n) { return n < DFF_ ? 256 * (n >> 7) + (n & 127) : 256 * ((n - DFF_) >> 7) + 128 + ((n - DFF_) & 127); }

__device__ __forceinline__ float wave_sum(float v) {
#pragma unroll
    for (int o = 1; o < 64; o <<= 1) v += __shfl_xor(v, o);
    return v;
}
template <int MAP>
__device__ __forceinline__ void p0_transpose_item(const float* W, int K, int N, bf16_t* WT, int noff, int pitch, int koff, const float* kscale, LAS float*  , int item, int lane) {
    const int nblk = N / 32, kb = item / nblk, nb = item % nblk, k0 = 64 * kb + 8 * (lane >> 3), n0 = 32 * nb;
    f32x4 v[8];
#pragma unroll
    for (int i = 0; i < 8; ++i) v[i] = *(const f32x4*)(W + (size_t)(k0 + i) * N + n0 + 4 * (lane & 7));
    if (kscale) { const f32x4 s0 = *(const f32x4*)(kscale + k0), s1 = *(const f32x4*)(kscale + k0 + 4);
#pragma unroll
        for (int i = 0; i < 8; ++i) v[i] = v[i] * (i < 4 ? s0[i & 3] : s1[i & 3]); }
    const int r0 = (MAP == 0 ? map_uniform(noff + n0) : map_up(noff + n0)) + 4 * (lane & 7);
#pragma unroll
    for (int e = 0; e < 4; ++e) { u32x4 o; o.x = cvtpk(v[0][e], v[1][e]); o.y = cvtpk(v[2][e], v[3][e]); o.z = cvtpk(v[4][e], v[5][e]); o.w = cvtpk(v[6][e], v[7][e]);
        *(GAS u32x4*)(WT + (size_t)(r0 + e) * pitch + koff + k0 + 0) = o; }
}
template <int NR>
__device__ __forceinline__ void rms_rows_to_bf16(const float* xrow, size_t rstride, const float* gain, bf16_t* orow, int lane) {
    const GAS f32x4* gr = (const GAS f32x4*)gain + lane;
    f32x4 v[NR][4]; float s[NR];
#pragma unroll
    for (int r = 0; r < NR; ++r) { const GAS f32x4* xr = (const GAS f32x4*)(xrow + r * rstride) + lane;
#pragma unroll
        for (int j = 0; j < 4; ++j) v[r][j] = xr[64 * j]; }
    f32x4 g[4];
#pragma unroll
    for (int j = 0; j < 4; ++j) g[j] = gr[64 * j];
#pragma unroll
    for (int r = 0; r < NR; ++r) { s[r] = 0.f;
#pragma unroll
        for (int j = 0; j < 4; ++j) s[r] += (v[r][j].x * v[r][j].x + v[r][j].y * v[r][j].y) + (v[r][j].z * v[r][j].z + v[r][j].w * v[r][j].w); }
#pragma unroll
    for (int r = 0; r < NR; ++r) { const float rstd = 1.0f / sqrtf(wave_sum(s[r]) * (1.f / 1024.f) + EPS_);
        GAS u32x2* o8 = (GAS u32x2*)(orow + r * rstride) + lane;
#pragma unroll
        for (int j = 0; j < 4; ++j) { u32x2 w; w.x = cvtpk(v[r][j].x * rstd * g[j].x, v[r][j].y * rstd * g[j].y); w.y = cvtpk(v[r][j].z * rstd * g[j].z, v[r][j].w * rstd * g[j].w); o8[64 * j] = w; } }
}
__device__ __forceinline__ void sincos_f(float ang, float& co, float& si) {
    const double x = (double)ang; const double n = __builtin_rint(x * 0.63661977236758134308);
    double r = __builtin_fma(-n, 1.5707963267948966192, x); r = __builtin_fma(-n, 6.123233995736766036e-17, r);
    const double r2 = r * r;
    double s = -1.0 / 6227020800.0; s = s * r2 + 1.0 / 39916800.0; s = s * r2 - 1.0 / 362880.0; s = s * r2 + 1.0 / 5040.0; s = s * r2 - 1.0 / 120.0; s = s * r2 + 1.0 / 6.0; s = r - r * r2 * s;
    double c = 1.0 / 479001600.0; c = c * r2 - 1.0 / 3628800.0; c = c * r2 + 1.0 / 40320.0; c = c * r2 - 1.0 / 720.0; c = c * r2 + 1.0 / 24.0; c = c * r2 - 0.5; c = c * r2 + 1.0;
    const int q = (int)((long long)n & 3);
    const double cs = (q == 0) ? c : (q == 1) ? -s : (q == 2) ? -c : s;
    const double sn = (q == 0) ? s : (q == 1) ? c : (q == 2) ? -s : -c;
    co = (float)cs; si = (float)sn;
}

struct Frame {
    LAS unsigned char* lds;
    int tid, lane, wave, vcu, G;
    const Args* a;
};

__device__ __forceinline__ void p0_prologue(const Args& A, LAS unsigned char* lds, int vcu, int G, int wave, int lane) {
    LAS float* scr = (LAS float*)(lds + RING_OFF + wave * 16384);
    const int gw = vcu * NWAVES + wave, NGW = G * NWAVES;
    bf16_t* wcat = (bf16_t*)((unsigned char*)A.out + DO_WCAT);
    bf16_t* a1 = (bf16_t*)((unsigned char*)A.out + DO_A1);
    float* rope = (float*)((unsigned char*)A.out + DO_ROPE);
    constexpr int I_IN = (1024 / 64) * (3584 / 32), I_GATE = (1024 / 64) * (3072 / 32), I_MKV = (1024 / 64) * (1024 / 32);
    constexpr int NEARLY = I_IN + I_GATE + I_MKV;
    for (int it = gw; it < NEARLY; it += NGW) {
        int r = it;
        if (r < I_IN) { p0_transpose_item<0>(A.in[I_W_IN], 1024, 3584, wcat, 0, 1024, 0, nullptr, scr, r, lane); continue; } r -= I_IN;
        if (r < I_GATE) { p0_transpose_item<0>(A.in[I_WGATE], 1024, 3072, wcat, 3584, 1024, 0, nullptr, scr, r, lane); continue; } r -= I_GATE;
        p0_transpose_item<0>(A.in[I_W_MKV], 1024, 1024, wcat, 6656, 1024, 0, nullptr, scr, r, lane);
    }
    for (int m = 4 * gw; m < T_ + NB_ * MEM_; m += 4 * NGW) {
        if (m < T_) rms_rows_to_bf16<4>(A.in[I_X] + (size_t)m * DM_, DM_, A.in[I_ATTN_NORM], a1 + (size_t)m * DM_, lane);
        else rms_rows_to_bf16<4>(A.in[I_MEM] + (size_t)(m - T_) * DM_, DM_, A.in[I_MEM_NORM], a1 + (size_t)m * DM_, lane);
    }
    const int* pos = (const int*)A.in[I_POS];
    for (int idx = gw * 64 + lane; idx < T_ * 8; idx += NGW * 64) {
        const int t = idx >> 3, i = idx & 7;
        const float fr = (i == 0) ? 1.0f : (i == 1) ? 0.193922758102417f : (i == 2) ? 0.03760603442788124f : (i == 3) ? 0.007292666472494602f : (i == 4) ? 0.0014142136787995696f
                       : (i == 5) ? 0.00027424818836152554f : (i == 6) ? 5.318298644851893e-05f : 1.031338433676865e-05f;
        const float ang = (float)pos[t] * fr; float co, si; sincos_f(ang, co, si);
        rope[t * 16 + i] = co; rope[t * 16 + 8 + i] = si;
    }
}

__device__ __forceinline__ void p0_late_weights(const Args& A, LAS unsigned char* lds, int gw, int ngw, int wave, int lane) {
    LAS float* scr = (LAS float*)(lds + RING_OFF + wave * 16384);
    bf16_t* wo = (bf16_t*)(A.ws + WS_WO); bf16_t* wout = (bf16_t*)(A.ws + WS_WOUT); bf16_t* wup = (bf16_t*)(A.ws + WS_WUP); bf16_t* wdown = (bf16_t*)(A.ws + WS_WDOWN);
    constexpr int I_OA = (256 / 64) * (1024 / 32), I_OB = (512 / 64) * (1024 / 32), I_OM = I_OB, I_OUT = (1024 / 64) * (1024 / 32);
    constexpr int I_UP = (1024 / 64) * (5632 / 32), I_DOWN = (2816 / 64) * (1024 / 32);
    constexpr int NLATE = I_OA + I_OB + I_OM + I_OUT + I_UP + I_DOWN;
    for (int it = gw; it < NLATE; it += ngw) {
        int r = it;
        if (r < I_OA) { p0_transpose_item<0>(A.in[I_WOA], 256, 1024, wo, 0, KCAT, 0, nullptr, scr, r, lane); continue; } r -= I_OA;
        if (r < I_OB) { p0_transpose_item<0>(A.in[I_WOB], 512, 1024, wo, 0, KCAT, 256, nullptr, scr, r, lane); continue; } r -= I_OB;
        if (r < I_OM) { p0_transpose_item<0>(A.in[I_WOM], 512, 1024, wo, 0, KCAT, 768, nullptr, scr, r, lane); continue; } r -= I_OM;
        if (r < I_OUT) { p0_transpose_item<0>(A.in[I_WOUT], 1024, 1024, wout, 0, 1024, 0, nullptr, scr, r, lane); continue; } r -= I_OUT;
        if (r < I_UP) { p0_transpose_item<1>(A.in[I_WUP], 1024, 5632, wup, 0, 1024, 0, A.in[I_FFN_NORM], scr, r, lane); continue; } r -= I_UP;
        p0_transpose_item<0>(A.in[I_WDOWN], 2816, 1024, wdown, 0, 2816, 0, nullptr, scr, r, lane);
    }
}

struct P1Order {
    pg8::StaticOrder so;
    __device__ void init(int G, int c) { so.init(T_, 6656, G, c); }
    __device__ bool next(int i, pg8::Unit& u) const {
        if (so.next(i, u)) return true;
        const long L = (long)i * so.G + so.c - so.nwg; if (L < 0 || L >= 16) return false;
        u.pm = 64 + (int)(L >> 2); u.pn = 26 + (int)(L & 3); return true;
    }
    __device__ __forceinline__ void a_ready(const pg8::Unit&) const {}
    __device__ __forceinline__ void done(const pg8::Unit&) const {}
};

struct Epi1 {
    static constexpr bool PERM = true;
    unsigned char* ws; const float* rope; const float *aq, *ak, *bq, *bk, *bgate;
    __device__ __forceinline__ void plain(const f32x4 (&acc)[2][2][4][2], bf16_t* dst, int ld, int col0, int row0, int wr, int wc, int fr, int fq) const {
#pragma unroll
        for (int ai = 0; ai < 2; ++ai)
#pragma unroll
            for (int m = 0; m < 4; ++m) { bf16_t* rowp = dst + (size_t)(row0 + ai * 128 + wr * 64 + m * 16 + fr) * ld + col0 + wc * 64 + 8 * fq;
#pragma unroll
                for (int bj = 0; bj < 2; ++bj) { const f32x4 v0 = acc[ai][bj][m][0], v1 = acc[ai][bj][m][1]; u32x4 w; w.x = cvtpk(v0[0], v0[1]); w.y = cvtpk(v0[2], v0[3]); w.z = cvtpk(v1[0], v1[1]); w.w = cvtpk(v1[2], v1[3]);
                    *(u32x4*)(rowp + 32 * bj) = w; } }
    }
    __device__ __forceinline__ void normed(const f32x4 (&acc)[2][2][4][2], bf16_t* dst, int ld, int col0, int row0, const float* gain, float scale, int wr, int wc, int fr, int fq) const {
        f32x4 g[2][2];
#pragma unroll
        for (int bj = 0; bj < 2; ++bj)
#pragma unroll
            for (int n = 0; n < 2; ++n) g[bj][n] = *(const f32x4*)(gain + 32 * bj + 8 * fq + 4 * n) * scale;
#pragma unroll
        for (int ai = 0; ai < 2; ++ai)
#pragma unroll
            for (int m = 0; m < 4; ++m) {
                const int row = row0 + ai * 128 + wr * 64 + m * 16 + fr;
                float ss = 0.f;
#pragma unroll
                for (int bj = 0; bj < 2; ++bj)
#pragma unroll
                    for (int n = 0; n < 2; ++n) { const f32x4 x = acc[ai][bj][m][n]; ss += (x[0] * x[0] + x[1] * x[1]) + (x[2] * x[2] + x[3] * x[3]); }
                ss += __shfl_xor(ss, 16); ss += __shfl_xor(ss, 32);
                const float rs = 1.0f / sqrtf(ss * (1.f / 64.f) + EPS_);
                f32x4 v[2][2];
#pragma unroll
                for (int bj = 0; bj < 2; ++bj)
#pragma unroll
                    for (int n = 0; n < 2; ++n) v[bj][n] = acc[ai][bj][m][n] * rs * g[bj][n];
                const float* cs = rope + (size_t)row * 16;
#pragma unroll
                for (int n = 0; n < 2; ++n) {
                    const f32x4 co = *(const f32x4*)(cs + 4 * n), si = *(const f32x4*)(cs + 8 + 4 * n);
                    f32x4 pr;
#pragma unroll
                    for (int e = 0; e < 4; ++e) pr[e] = __shfl_xor(v[0][n][e], 16);
                    const f32x4 r0 = v[0][n] * co - pr * si, r1 = v[0][n] * co + pr * si;
                    v[0][n] = (fq == 0) ? r0 : (fq == 1) ? r1 : v[0][n];
                }
                bf16_t* rowp = dst + (size_t)row * ld + col0 + wc * 64 + 8 * fq;
#pragma unroll
                for (int bj = 0; bj < 2; ++bj) { u32x4 w; w.x = cvtpk(v[bj][0][0], v[bj][0][1]); w.y = cvtpk(v[bj][0][2], v[bj][0][3]); w.z = cvtpk(v[bj][1][0], v[bj][1][1]); w.w = cvtpk(v[bj][1][2], v[bj][1][3]);
                    *(u32x4*)(rowp + 32 * bj) = w; }
            }
    }
    __device__ __forceinline__ void gates(const f32x4 (&acc)[2][2][4][2], bf16_t* dst, int col0, int row0, int wr, int wc, int fr, int fq) const {
        f32x4 bv[2][2];
#pragma unroll
        for (int bj = 0; bj < 2; ++bj)
#pragma unroll
            for (int n = 0; n < 2; ++n) bv[bj][n] = *(const f32x4*)(bgate + col0 + wc * 64 + 32 * bj + 8 * fq + 4 * n);
#pragma unroll
        for (int ai = 0; ai < 2; ++ai)
#pragma unroll
            for (int m = 0; m < 4; ++m) { bf16_t* rowp = dst + (size_t)(row0 + ai * 128 + wr * 64 + m * 16 + fr) * 3072 + col0 + wc * 64 + 8 * fq;
#pragma unroll
                for (int bj = 0; bj < 2; ++bj) { f32x4 v[2];
#pragma unroll
                    for (int n = 0; n < 2; ++n) { const f32x4 z = (acc[ai][bj][m][n] + bv[bj][n]) * (-LOG2E);
#pragma unroll
                        for (int e = 0; e < 4; ++e) v[n][e] = __builtin_amdgcn_rcpf(1.0f + __builtin_amdgcn_exp2f(z[e])); }
                    u32x4 w; w.x = cvtpk(v[0][0], v[0][1]); w.y = cvtpk(v[0][2], v[0][3]); w.z = cvtpk(v[1][0], v[1][1]); w.w = cvtpk(v[1][2], v[1][3]);
                    *(u32x4*)(rowp + 32 * bj) = w; } }
    }
    __device__ __forceinline__ void operator()(const f32x4 (&acc)[2][2][4][2], const pg8::Unit& u, int wr, int wc, int fr, int fq) const {
        const int pn = u.pn, row0 = u.pm * 256;
        if (pn >= 26) { plain(acc, (bf16_t*)(ws + WS_MKV), 1024, (pn - 26) * 256, row0 - T_, wr, wc, fr, fq); return; }
        if (pn >= 14) { gates(acc, (bf16_t*)(ws + WS_G), (pn - 14) * 256, row0, wr, wc, fr, fq); return; }
        if (pn >= 12) { plain(acc, (bf16_t*)(ws + WS_MQ), 512, (pn - 12) * 256, row0, wr, wc, fr, fq); return; }
        if (pn == 11) {
            if (wc >= 2) plain(acc, (bf16_t*)(ws + WS_KVB), 256, 0, row0, wr, wc, fr, fq);
            else normed(acc, (bf16_t*)(ws + WS_KVB), 256, 0, row0, bk, 1.0f, wr, wc, fr, fq);
            return;
        }
        if (pn >= 9) { normed(acc, (bf16_t*)(ws + WS_QB), 512, (pn - 9) * 256, row0, bq, QSCALE64, wr, wc, fr, fq); return; }
        const int gi = pn / 3, ty = pn - 3 * gi;
        if (ty == 2) { plain(acc, (bf16_t*)(ws + WS_VA) + (size_t)gi * T_ * 256, 256, 0, row0, wr, wc, fr, fq); return; }
        if (ty == 0) normed(acc, (bf16_t*)(ws + WS_QA) + (size_t)gi * T_ * 256, 256, 0, row0, aq + 64 * gi, QSCALE64, wr, wc, fr, fq);
        else normed(acc, (bf16_t*)(ws + WS_KA) + (size_t)gi * T_ * 256, 256, 0, row0, ak + 64 * gi, 1.0f, wr, wc, fr, fq);
    }
};

namespace att {
typedef short v4i16_t __attribute__((ext_vector_type(4)));
__device__ __forceinline__ int crow(int r, int h) { return (r & 3) + 8 * (r >> 2) + 4 * h; }
__device__ __forceinline__ s16x4 vtr(LAS const unsigned char* p) { return __builtin_bit_cast(s16x4, __builtin_amdgcn_ds_read_tr16_b64_v4i16((LAS v4i16_t*)p)); }

constexpr int KROW64 = 144, VROW64 = 128, NKEYS_B = 384;
constexpr int LDS_K64 = 0, LDS_V64 = NKEYS_B * KROW64;
constexpr int LDS_K128 = 0, LDS_V128 = 65536;

template <int ND>
__device__ __forceinline__ void softmax_tile(f32x16& s, float& m, float& l, f32x16 (&o)[ND], bf16x8 (&pf)[2]) {
    float mx = s[0];
#pragma unroll
    for (int r = 1; r < 16; ++r) mx = fmaxf(mx, s[r]);
    mx = fmaxf(mx, __shfl_xor(mx, 32));
    const float mn = fmaxf(m, mx), alpha = __builtin_amdgcn_exp2f(m - mn);
    m = mn;
    float ps = 0.f;
#pragma unroll
    for (int r = 0; r < 16; ++r) { s[r] = __builtin_amdgcn_exp2f(s[r] - mn); ps += s[r]; }
    l = l * alpha + ps;
    if (__any(alpha != 1.0f)) {
#pragma unroll
        for (int d = 0; d < ND; ++d)
#pragma unroll
            for (int r = 0; r < 16; ++r) o[d][r] *= alpha;
    }
#pragma unroll
    for (int k = 0; k < 2; ++k) { u32x4 w; w.x = cvtpk(s[8 * k + 0], s[8 * k + 1]); w.y = cvtpk(s[8 * k + 2], s[8 * k + 3]); w.z = cvtpk(s[8 * k + 4], s[8 * k + 5]); w.w = cvtpk(s[8 * k + 6], s[8 * k + 7]);
        pf[k] = __builtin_bit_cast(bf16x8, w); }
}

struct BU { const bf16_t* q; const bf16_t* k; const bf16_t* v; bf16_t* o; float* lse; int qstride, kvstride, ostride, lsestride; float sink2; int W; int first; };
__device__ __forceinline__ void bu_load(const BU& u, int tid, u32x4 (&kr)[8], u32x4 (&vr)[8]) {
#pragma unroll
    for (int it = 0; it < 6; ++it) {
        const int c = tid + 512 * it, row = c >> 3, ch = c & 7;
        const bool valid = !(u.first && row < 128);
        const long off = (long)((valid ? row : 128) - 128) * (long)u.kvstride + ch * 8;
        kr[it] = *(const u32x4*)(u.k + off); vr[it] = *(const u32x4*)(u.v + off);
    }
}
__device__ __forceinline__ void bu_store(LAS unsigned char* lds, int tid, const u32x4 (&kr)[8], const u32x4 (&vr)[8], int first) {
#pragma unroll
    for (int it = 0; it < 6; ++it) {
        const int c = tid + 512 * it, row = c >> 3, ch = c & 7;
        const bool valid = !(first && row < 128);
        const u32x4 z = (u32x4){0u, 0u, 0u, 0u};
        *(LAS u32x4*)(lds + LDS_K64 + row * KROW64 + ch * 16) = valid ? kr[it] : z;
        *(LAS u32x4*)(lds + LDS_V64 + row * VROW64 + ((ch * 16) ^ (((row >> 1) & 1) << 6))) = valid ? vr[it] : z;
    }
}
__device__ __forceinline__ void bu_loadq(const BU& u, int wid, int lane, bf16x8 (&qf)[4]) {
    const int qi = 32 * wid + (lane & 31), h = lane >> 5;
#pragma unroll
    for (int d0 = 0; d0 < 4; ++d0) qf[d0] = *(const bf16x8*)(u.q + (size_t)qi * u.qstride + 16 * d0 + 8 * h);
}
__device__ __forceinline__ void bu_compute(LAS unsigned char* lds, const BU& u, const bf16x8 (&qf)[4], int wid, int lane) {
    const int c = lane & 31, h = lane >> 5;
    const int qi = 32 * wid + c;
    float m = -1e30f, l = 0.f; f32x16 o[2];
#pragma unroll
    for (int d = 0; d < 2; ++d)
#pragma unroll
        for (int r = 0; r < 16; ++r) o[d][r] = 0.f;
    int jlo = qi + 128 - u.W; if (u.first && jlo < 128) jlo = 128;
    const int jhi = qi + 128;
    const int qq = (lane & 15) >> 2;
    LAS const unsigned char* kbase = lds + LDS_K64 + c * KROW64 + 16 * h;
    LAS const unsigned char* vbase = lds + LDS_V64 + (4 * h + qq) * VROW64 + ((lane >> 4) & 1) * 32 + (lane & 3) * 8;
    const int vsw = (qq >> 1) & 1;
#pragma unroll 1
    for (int kt = wid; kt < wid + 5; ++kt) {
        f32x16 s;
#pragma unroll
        for (int r = 0; r < 16; ++r) s[r] = 0.f;
#pragma unroll
        for (int d0 = 0; d0 < 4; ++d0) { const bf16x8 kf = *(LAS const bf16x8*)(kbase + kt * 32 * KROW64 + d0 * 32); s = __builtin_amdgcn_mfma_f32_32x32x16_bf16(kf, qf[d0], s, 0, 0, 0); }
        if (u.first || kt == wid || kt == wid + 4) {
#pragma unroll
            for (int r = 0; r < 16; ++r) { const int j = 32 * kt + crow(r, h); if (j < jlo || j > jhi) s[r] = -INFINITY; }
        }
        bf16x8 pf[2];
        softmax_tile<2>(s, m, l, o, pf);
#pragma unroll
        for (int d = 0; d < 2; ++d)
#pragma unroll
            for (int k = 0; k < 2; ++k) {
                LAS const unsigned char* vp = vbase + (kt * 32 + 16 * k) * VROW64 + 64 * (d ^ vsw);
                const s16x4 lo = vtr(vp), hi = vtr(vp + 8 * VROW64);
                const bf16x8 vf = (bf16x8){lo[0], lo[1], lo[2], lo[3], hi[0], hi[1], hi[2], hi[3]};
                o[d] = __builtin_amdgcn_mfma_f32_32x32x16_bf16(vf, pf[k], o[d], 0, 0, 0);
            }
    }
    float lt = l + __shfl_xor(l, 32);
    lt += __builtin_amdgcn_exp2f(u.sink2 - m);
    const float inv = 1.0f / lt;
    bf16_t* orow = u.o + (size_t)qi * u.ostride;
#pragma unroll
    for (int d = 0; d < 2; ++d)
#pragma unroll
        for (int rg = 0; rg < 4; ++rg) { u32x2 w; w.x = cvtpk(o[d][4 * rg] * inv, o[d][4 * rg + 1] * inv); w.y = cvtpk(o[d][4 * rg + 2] * inv, o[d][4 * rg + 3] * inv);
            *(u32x2*)(orow + 32 * d + 8 * rg + 4 * h) = w; }
    if (u.lse && h == 0) u.lse[(size_t)qi * u.lsestride] = m + __builtin_amdgcn_logf(lt);
}

__device__ __forceinline__ void mem_load(const bf16_t* kmem, const bf16_t* vmem, int tid, u32x4 (&kr)[8], u32x4 (&vr)[8]) {
#pragma unroll
    for (int it = 0; it < 8; ++it) { const int cc = tid + 512 * it, row = cc >> 4, ch = cc & 15;
        kr[it] = *(const u32x4*)(kmem + (size_t)row * 1024 + ch * 8); vr[it] = *(const u32x4*)(vmem + (size_t)row * 1024 + ch * 8); }
}
__device__ __forceinline__ void mem_unit(LAS unsigned char* lds, const bf16_t* q0, const u32x4 (&kr)[8], const u32x4 (&vr)[8], const float* qgain, const float* kgain, bf16_t* o0, size_t ostride, int tid, int wid, int lane) {
#pragma unroll
    for (int it = 0; it < 8; ++it) {
        const int cc = tid + 512 * it, row = cc >> 4, ch = cc & 15;
        *(LAS u32x4*)(lds + LDS_K128 + row * 256 + ((ch ^ (row & 15)) * 16)) = kr[it];
        *(LAS u32x4*)(lds + LDS_V128 + row * 256 + ((ch * 16) ^ ((row & 3) << 6))) = vr[it];
    }
    const int c = lane & 31, h = lane >> 5;
    const int qi = 32 * wid + c;
    bf16x8 qf[8];
    {
        u32x4 raw[8]; float ss = 0.f;
#pragma unroll
        for (int d0 = 0; d0 < 8; ++d0) { raw[d0] = *(const u32x4*)(q0 + (size_t)qi * 512 + 16 * d0 + 8 * h);
#pragma unroll
            for (int e = 0; e < 4; ++e) { const float a = bflo(raw[d0][e]), b = bfhi(raw[d0][e]); ss += a * a + b * b; } }
        ss += __shfl_xor(ss, 32);
        const float rs = (1.0f / sqrtf(ss * (1.f / 128.f) + EPS_)) * QSCALE128;
#pragma unroll
        for (int d0 = 0; d0 < 8; ++d0) { const f32x4 g0 = *(const f32x4*)(qgain + 16 * d0 + 8 * h), g1 = *(const f32x4*)(qgain + 16 * d0 + 8 * h + 4);
            u32x4 w; w.x = cvtpk(bflo(raw[d0].x) * rs * g0[0], bfhi(raw[d0].x) * rs * g0[1]); w.y = cvtpk(bflo(raw[d0].y) * rs * g0[2], bfhi(raw[d0].y) * rs * g0[3]);
            w.z = cvtpk(bflo(raw[d0].z) * rs * g1[0], bfhi(raw[d0].z) * rs * g1[1]); w.w = cvtpk(bflo(raw[d0].w) * rs * g1[2], bfhi(raw[d0].w) * rs * g1[3]);
            qf[d0] = __builtin_bit_cast(bf16x8, w); }
    }
    __syncthreads();
    {
        const int row = tid >> 1, hf = tid & 1; u32x4 raw[8]; float ss = 0.f;
#pragma unroll
        for (int i = 0; i < 8; ++i) { raw[i] = *(LAS const u32x4*)(lds + LDS_K128 + row * 256 + (((hf * 8 + i) ^ (row & 15)) * 16));
#pragma unroll
            for (int e = 0; e < 4; ++e) { const float a = bflo(raw[i][e]), b = bfhi(raw[i][e]); ss += a * a + b * b; } }
        ss += __shfl_xor(ss, 1);
        const float rs = 1.0f / sqrtf(ss * (1.f / 128.f) + EPS_);
#pragma unroll
        for (int i = 0; i < 8; ++i) { const float* gp = kgain + 64 * hf + 8 * i; const f32x4 g0 = *(const f32x4*)gp, g1 = *(const f32x4*)(gp + 4);
            u32x4 w; w.x = cvtpk(bflo(raw[i].x) * rs * g0[0], bfhi(raw[i].x) * rs * g0[1]); w.y = cvtpk(bflo(raw[i].y) * rs * g0[2], bfhi(raw[i].y) * rs * g0[3]);
            w.z = cvtpk(bflo(raw[i].z) * rs * g1[0], bfhi(raw[i].z) * rs * g1[1]); w.w = cvtpk(bflo(raw[i].w) * rs * g1[2], bfhi(raw[i].w) * rs * g1[3]);
            *(LAS u32x4*)(lds + LDS_K128 + row * 256 + (((hf * 8 + i) ^ (row & 15)) * 16)) = w; }
    }
    __syncthreads();
    float m = -1e30f, l = 0.f; f32x16 o[4];
#pragma unroll
    for (int d = 0; d < 4; ++d)
#pragma unroll
        for (int r = 0; r < 16; ++r) o[d][r] = 0.f;
    const int qq = (lane & 15) >> 2;
    LAS const unsigned char* vbase = lds + LDS_V128 + (4 * h + qq) * 256 + ((lane >> 4) & 1) * 32 + (lane & 3) * 8;
    for (int kt = 0; kt < 8; ++kt) {
        f32x16 s;
#pragma unroll
        for (int r = 0; r < 16; ++r) s[r] = 0.f;
        const int krow = kt * 32 + c;
#pragma unroll
        for (int d0 = 0; d0 < 8; ++d0) { const bf16x8 kf = *(LAS const bf16x8*)(lds + LDS_K128 + krow * 256 + (((2 * d0 + h) ^ (krow & 15)) * 16)); s = __builtin_amdgcn_mfma_f32_32x32x16_bf16(kf, qf[d0], s, 0, 0, 0); }
        bf16x8 pf[2];
        softmax_tile<4>(s, m, l, o, pf);
#pragma unroll
        for (int d = 0; d < 4; ++d)
#pragma unroll
            for (int k = 0; k < 2; ++k) {
                LAS const unsigned char* vp = vbase + (kt * 32 + 16 * k) * 256 + 64 * (d ^ qq);
                const s16x4 lo = vtr(vp), hi = vtr(vp + 8 * 256);
                const bf16x8 vf = (bf16x8){lo[0], lo[1], lo[2], lo[3], hi[0], hi[1], hi[2], hi[3]};
                o[d] = __builtin_amdgcn_mfma_f32_32x32x16_bf16(vf, pf[k], o[d], 0, 0, 0);
            }
    }
    const float inv = 1.0f / (l + __shfl_xor(l, 32));
    bf16_t* orow = o0 + (size_t)qi * ostride;
#pragma unroll
    for (int d = 0; d < 4; ++d)
#pragma unroll
        for (int rg = 0; rg < 4; ++rg) { u32x2 w; w.x = cvtpk(o[d][4 * rg] * inv, o[d][4 * rg + 1] * inv); w.y = cvtpk(o[d][4 * rg + 2] * inv, o[d][4 * rg + 3] * inv);
            *(u32x2*)(orow + 32 * d + 8 * rg + 4 * h) = w; }
    __syncthreads();
}
}

__device__ __forceinline__ att::BU get_bu(const Args& A, int vcu, int idx) {
    unsigned char* ws = A.ws; att::BU u;
    if (idx < 3) {
        const int gi = idx, b = vcu >> 6, hd = (vcu >> 4) & 3, i16 = vcu & 15;
        const int dl = (gi == 0) ? 1 : (gi == 1) ? 4 : 16;
        int r, qb; if (gi == 0) { r = 0; qb = i16; } else if (gi == 1) { r = i16 >> 2; qb = i16 & 3; } else { r = i16; qb = 0; }
        const int i0 = qb * 256;
        const size_t row0 = (size_t)b * SEQ_ + r + (size_t)dl * i0;
        const size_t base = (size_t)gi * T_ * 256 + row0 * 256 + hd * 64;
        u.q = (const bf16_t*)(ws + WS_QA) + base; u.k = (const bf16_t*)(ws + WS_KA) + base; u.v = (const bf16_t*)(ws + WS_VA) + base;
        u.o = (bf16_t*)((unsigned char*)A.out + DO_OAG) + base;
        u.lse = (float*)(ws + WS_LSE) + (size_t)gi * T_ * 4 + row0 * 4 + hd;
        u.qstride = dl * 256; u.kvstride = dl * 256; u.ostride = dl * 256; u.lsestride = dl * 4; u.sink2 = -INFINITY; u.W = 128; u.first = (i0 == 0);
    } else {
        const int uu = vcu + 256 * (idx - 3), b = uu >> 7, hq = (uu >> 4) & 7, qb = uu & 15, kvh = hq >> 2;
        const size_t row0 = (size_t)b * SEQ_ + (size_t)qb * 256;
        u.q = (const bf16_t*)(ws + WS_QB) + row0 * 512 + hq * 64;
        u.k = (const bf16_t*)(ws + WS_KVB) + row0 * 256 + kvh * 64; u.v = u.k + 128;
        u.o = (bf16_t*)((unsigned char*)A.out + DO_OCAT) + row0 * KCAT + 256 + hq * 64;
        u.lse = nullptr; u.qstride = 512; u.kvstride = 256; u.ostride = KCAT; u.lsestride = 0; u.sink2 = A.in[I_SINK][hq] * LOG2E; u.W = 127; u.first = (qb == 0);
    }
    return u;
}
__device__ __forceinline__ void p2_attention(const Args& A, LAS unsigned char* lds, int vcu, int tid, int wid, int lane) {
    unsigned char* ws = A.ws;
    const int mu = vcu, mb = mu >> 6, mhd = (mu >> 4) & 3, mqb = mu & 15;
    const bf16_t* km = (const bf16_t*)(ws + WS_MKV) + (size_t)mb * MEM_ * 1024 + mhd * 128;
    u32x4 kr[8], vr[8];
    { const att::BU u0 = get_bu(A, vcu, 0); att::bu_load(u0, tid, kr, vr); }
#if defined(PROBE_ATT) && PROBE_ATT == 1
#pragma unroll 1
    for (int idx2 = 0; idx2 < 10; ++idx2) {
        const int idx = idx2 >= 5 ? idx2 - 5 : idx2 == 4 ? 0 : idx2;
        const att::BU u = get_bu(A, vcu, idx);
        att::bu_store(lds, tid, kr, vr, u.first);
        bf16x8 qf[4]; att::bu_loadq(u, wid, lane, qf);
        __syncthreads();
        if (idx2 < 9) { const int nx = idx2 + 1 >= 5 ? idx2 + 1 - 5 : idx2 + 1 == 4 ? 0 : idx2 + 1; const att::BU un = get_bu(A, vcu, nx); att::bu_load(un, tid, kr, vr); }
        else att::mem_load(km, km + 512, tid, kr, vr);
        att::bu_compute(lds, u, qf, wid, lane);
        __syncthreads();
    }
#else
#pragma unroll 1
    for (int idx = 0; idx < 5; ++idx) {
        const att::BU u = get_bu(A, vcu, idx);
        att::bu_store(lds, tid, kr, vr, u.first);
        bf16x8 qf[4]; att::bu_loadq(u, wid, lane, qf);
        __syncthreads();
        if (idx < 4) { const att::BU un = get_bu(A, vcu, idx + 1); att::bu_load(un, tid, kr, vr); }
        else att::mem_load(km, km + 512, tid, kr, vr);
        att::bu_compute(lds, u, qf, wid, lane);
        __syncthreads();
    }
#endif
#if defined(PROBE_ATT) && PROBE_ATT == 2
#pragma unroll 1
    for (int rep = 0; rep < 2; ++rep)
#endif
    {
        const size_t row0 = (size_t)mb * SEQ_ + (size_t)mqb * 256;
        const bf16_t* q = (const bf16_t*)(ws + WS_MQ) + row0 * 512 + mhd * 128;
        bf16_t* o = (bf16_t*)((unsigned char*)A.out + DO_OCAT) + row0 * KCAT + 768 + mhd * 128;
        att::mem_unit(lds, q, kr, vr, A.in[I_MQN], A.in[I_MKN], o, KCAT, tid, wid, lane);
    }
}

__device__ __forceinline__ void p2b_merge(const Args& A, int vcu, int G, int tid) {
    const bf16_t* oag = (const bf16_t*)((unsigned char*)A.out + DO_OAG);
    bf16_t* ocat = (bf16_t*)((unsigned char*)A.out + DO_OCAT);
    const float* lse = (const float*)(A.ws + WS_LSE);
    for (int idx = vcu * 512 + tid; idx < T_ * 32; idx += G * 512) {
        const int t = idx >> 5, ch = idx & 31, hd = ch >> 3;
        const float l0 = lse[(size_t)t * 4 + hd], l1 = lse[(size_t)T_ * 4 + (size_t)t * 4 + hd], l2 = lse[(size_t)2 * T_ * 4 + (size_t)t * 4 + hd];
        const float mx = fmaxf(l0, fmaxf(l1, l2));
        float w0 = __builtin_amdgcn_exp2f(l0 - mx), w1 = __builtin_amdgcn_exp2f(l1 - mx), w2 = __builtin_amdgcn_exp2f(l2 - mx);
        const float inv = 1.0f / (w0 + w1 + w2); w0 *= inv; w1 *= inv; w2 *= inv;
        const u32x4 a = *(const u32x4*)(oag + (size_t)t * 256 + ch * 8), b = *(const u32x4*)(oag + (size_t)T_ * 256 + (size_t)t * 256 + ch * 8), c = *(const u32x4*)(oag + (size_t)2 * T_ * 256 + (size_t)t * 256 + ch * 8);
        u32x4 w;
#pragma unroll
        for (int e = 0; e < 4; ++e) w[e] = cvtpk(w0 * bflo(a[e]) + w1 * bflo(b[e]) + w2 * bflo(c[e]), w0 * bfhi(a[e]) + w1 * bfhi(b[e]) + w2 * bfhi(c[e]));
        *(u32x4*)(ocat + (size_t)t * KCAT + ch * 8) = w;
    }
}

struct P3aOrder : pg8::StaticOrder {
    const bf16_t* oag; bf16_t* ocat; const float* lse;
    __device__ __forceinline__ void a_ready(const pg8::Unit& u) const {
#pragma unroll 1
        for (int i0 = threadIdx.x; i0 < 256 * 32; i0 += 2 * 512) {
            u32x4 a[2], b[2], c[2]; float l0[2], l1[2], l2[2];
#pragma unroll
            for (int j = 0; j < 2; ++j) { const int idx = i0 + 512 * j, t = u.pm * 256 + (idx >> 5), ch = idx & 31, hd = ch >> 3;
                l0[j] = lse[(size_t)t * 4 + hd]; l1[j] = lse[(size_t)T_ * 4 + (size_t)t * 4 + hd]; l2[j] = lse[(size_t)2 * T_ * 4 + (size_t)t * 4 + hd];
                a[j] = *(const u32x4*)(oag + (size_t)t * 256 + ch * 8); b[j] = *(const u32x4*)(oag + (size_t)T_ * 256 + (size_t)t * 256 + ch * 8); c[j] = *(const u32x4*)(oag + (size_t)2 * T_ * 256 + (size_t)t * 256 + ch * 8); }
#pragma unroll
            for (int j = 0; j < 2; ++j) { const int idx = i0 + 512 * j, t = u.pm * 256 + (idx >> 5), ch = idx & 31;
                const float mx = fmaxf(l0[j], fmaxf(l1[j], l2[j]));
                float w0 = __builtin_amdgcn_exp2f(l0[j] - mx), w1 = __builtin_amdgcn_exp2f(l1[j] - mx), w2 = __builtin_amdgcn_exp2f(l2[j] - mx);
                const float inv = 1.0f / (w0 + w1 + w2); w0 *= inv; w1 *= inv; w2 *= inv;
                u32x4 w;
#pragma unroll
                for (int e = 0; e < 4; ++e) w[e] = cvtpk(w0 * bflo(a[j][e]) + w1 * bflo(b[j][e]) + w2 * bflo(c[j][e]), w0 * bfhi(a[j][e]) + w1 * bfhi(b[j][e]) + w2 * bfhi(c[j][e]));
                *(u32x4*)(ocat + (size_t)t * KCAT + ch * 8) = w; }
        }
        asm volatile("s_waitcnt vmcnt(0)" ::: "memory"); __builtin_amdgcn_s_barrier(); asm volatile("" ::: "memory");
    }
};

struct Epi3a {
    static constexpr bool PERM = true;
    const bf16_t* G; bf16_t* MERGED;
    __device__ __forceinline__ void khook(f32x4 (&acc)[2][2][4][2], const pg8::Unit& u, int t, int wr, int wc, int fr, int fq) const {
        if (t != 4 && t != 12) return;
        const int gsel = (t == 4) ? 0 : 1024;
#pragma unroll
        for (int ai = 0; ai < 2; ++ai)
#pragma unroll
            for (int m = 0; m < 4; ++m) { const bf16_t* gp = G + (size_t)(u.pm * 256 + ai * 128 + wr * 64 + m * 16 + fr) * 3072 + gsel + u.pn * 256 + wc * 64 + 8 * fq;
#pragma unroll
                for (int bj = 0; bj < 2; ++bj) { const u32x4 ga = *(const u32x4*)(gp + 32 * bj), gb = *(const u32x4*)(gp + 1024 + 32 * bj);
#pragma unroll
                    for (int e = 0; e < 4; ++e) { const float r0 = bflo(ga[e]) * __builtin_amdgcn_rcpf(fmaxf(bflo(gb[e]), 1e-30f)), r1 = bfhi(ga[e]) * __builtin_amdgcn_rcpf(fmaxf(bfhi(gb[e]), 1e-30f));
                        acc[ai][bj][m][e >> 1][2 * (e & 1)] *= r0; acc[ai][bj][m][e >> 1][2 * (e & 1) + 1] *= r1; } } }
    }
    __device__ __forceinline__ void operator()(const f32x4 (&acc)[2][2][4][2], const pg8::Unit& u, int wr, int wc, int fr, int fq) const {
#pragma unroll
        for (int ai = 0; ai < 2; ++ai)
#pragma unroll
            for (int m = 0; m < 4; ++m) { const size_t row = (size_t)(u.pm * 256 + ai * 128 + wr * 64 + m * 16 + fr); const int col = u.pn * 256 + wc * 64 + 8 * fq;
#pragma unroll
                for (int bj = 0; bj < 2; ++bj) { const u32x4 g2 = *(const u32x4*)(G + row * 3072 + 2048 + col + 32 * bj); const f32x4 v0 = acc[ai][bj][m][0], v1 = acc[ai][bj][m][1];
                    u32x4 w; w.x = cvtpk(v0[0] * bflo(g2.x), v0[1] * bfhi(g2.x)); w.y = cvtpk(v0[2] * bflo(g2.y), v0[3] * bfhi(g2.y)); w.z = cvtpk(v1[0] * bflo(g2.z), v1[1] * bfhi(g2.z)); w.w = cvtpk(v1[2] * bflo(g2.w), v1[3] * bfhi(g2.w));
                    *(u32x4*)(MERGED + row * 1024 + col + 32 * bj) = w; } }
    }
};

struct Epi3b {
    static constexpr bool PERM = true;
    const float* x; float* x1; bf16_t* X1B; float* SSQ;
    __device__ __forceinline__ void operator()(const f32x4 (&acc)[2][2][4][2], const pg8::Unit& u, int wr, int wc, int fr, int fq) const {
#pragma unroll
        for (int ai = 0; ai < 2; ++ai)
#pragma unroll
            for (int m = 0; m < 4; ++m) { const size_t row = (size_t)(u.pm * 256 + ai * 128 + wr * 64 + m * 16 + fr); const int col = u.pn * 256 + wc * 64 + 8 * fq; float ss = 0.f;
#pragma unroll
                for (int bj = 0; bj < 2; ++bj) { const size_t off = row * 1024 + col + 32 * bj;
                    const f32x4 o0 = *(const f32x4*)(x + off) + acc[ai][bj][m][0], o1 = *(const f32x4*)(x + off + 4) + acc[ai][bj][m][1];
                    *(f32x4*)(x1 + off) = o0; *(f32x4*)(x1 + off + 4) = o1;
                    ss += (o0[0] * o0[0] + o0[1] * o0[1]) + (o0[2] * o0[2] + o0[3] * o0[3]) + (o1[0] * o1[0] + o1[1] * o1[1]) + (o1[2] * o1[2] + o1[3] * o1[3]);
                    u32x4 w; w.x = cvtpk(o0[0], o0[1]); w.y = cvtpk(o0[2], o0[3]); w.z = cvtpk(o1[0], o1[1]); w.w = cvtpk(o1[2], o1[3]);
                    *(u32x4*)(X1B + off) = w; }
                ss += __shfl_xor(ss, 16); ss += __shfl_xor(ss, 32);
                if (fq == 0) SSQ[row * 16 + u.pn * 4 + wc] = ss; }
    }
};

struct Epi4 {
    static constexpr bool PERM = true;
    const float* convw; const float* convb; bf16_t* ACT; float* UE; float* UF; LAS float* xch; LAS const float* rtab;
    __device__ __forceinline__ void operator()(f32x4 (&acc)[2][2][4][2], const pg8::Unit& u, int wr, int wc, int fr, int fq) const {
        const int lane = fr + 16 * fq;
        const int rowbase = u.pm * 256 + 128 * wr + 8 * fr;
        const int jj = 32 * wc + 8 * fq;
        const bool bstart = (u.pm & 15) == 0;
        {
            LAS const float* tb = rtab + ((u.pm >> 3) & 1) * 256 + 128 * wr + 8 * fr;
            const f32x4 ra = *(LAS const f32x4*)tb, rb = *(LAS const f32x4*)(tb + 4);
#pragma unroll
            for (int i = 0; i < 8; ++i) { const float rs = (i < 4) ? ra[i & 3] : rb[i & 3];
#pragma unroll
                for (int bj = 0; bj < 2; ++bj)
#pragma unroll
                    for (int n = 0; n < 2; ++n) acc[i >> 2][bj][i & 3][n] *= rs; }
        }
#define U4(bj, n, i) acc[(i) >> 2][bj][(i) & 3][n]
        if (wr == 0 && fr == 0) {
#pragma unroll
            for (int i = 0; i < 2; ++i)
#pragma unroll
                for (int bj = 0; bj < 2; ++bj)
#pragma unroll
                    for (int n = 0; n < 2; ++n) *(f32x4*)(UF + (size_t)(u.pm * 2 + i) * 5632 + u.pn * 256 + 128 * bj + jj + 4 * n) = U4(bj, n, i);
        }
        if (wr == 1 && fr == 15) {
#pragma unroll
            for (int i = 0; i < 2; ++i)
#pragma unroll
                for (int bj = 0; bj < 2; ++bj)
#pragma unroll
                    for (int n = 0; n < 2; ++n) *(f32x4*)(UE + (size_t)(u.pm * 2 + i) * 5632 + u.pn * 256 + 128 * bj + jj + 4 * n) = U4(bj, n, 6 + i);
        }
        if (wr == 0 && fr == 15) {
#pragma unroll
            for (int i = 0; i < 2; ++i)
#pragma unroll
                for (int bj = 0; bj < 2; ++bj)
#pragma unroll
                    for (int n = 0; n < 2; ++n) *(LAS f32x4*)(xch + ((((wc * 2 + i) * 2 + bj) * 2 + n) * 4 + fq) * 4) = U4(bj, n, 6 + i);
        }
        asm volatile("s_waitcnt lgkmcnt(0)" ::: "memory"); __builtin_amdgcn_s_barrier(); asm volatile("" ::: "memory");
        const int src = (lane & 48) | ((fr - 1) & 15);
        const int cha = u.pn * 128 + jj;
#pragma unroll
        for (int n = 0; n < 2; ++n) {
            asm volatile("" ::: "memory"); __builtin_amdgcn_sched_barrier(0);
            f32x4 p6[2], p7[2], w0[2], w1[2], w2[2], cb[2];
#pragma unroll
            for (int bj = 0; bj < 2; ++bj) {
                f32x4 h6 = (f32x4){0.f, 0.f, 0.f, 0.f}, h7 = h6;
                if (wr == 1) { h6 = *(LAS const f32x4*)(xch + ((((wc * 2 + 0) * 2 + bj) * 2 + n) * 4 + fq) * 4); h7 = *(LAS const f32x4*)(xch + ((((wc * 2 + 1) * 2 + bj) * 2 + n) * 4 + fq) * 4); }
#pragma unroll
                for (int e = 0; e < 4; ++e) { const float a6 = __shfl(U4(bj, n, 6)[e], src), a7 = __shfl(U4(bj, n, 7)[e], src); p6[bj][e] = (fr == 0) ? h6[e] : a6; p7[bj][e] = (fr == 0) ? h7[e] : a7; }
                const int ch = bj * DFF_ + cha + 4 * n;
                w0[bj] = *(const f32x4*)(convw + ch); w1[bj] = *(const f32x4*)(convw + 5632 + ch); w2[bj] = *(const f32x4*)(convw + 2 * 5632 + ch); cb[bj] = *(const f32x4*)(convb + ch);
            }
#pragma unroll
            for (int i = 0; i < 8; ++i) {
                f32x4 c[2];
#pragma unroll
                for (int bj = 0; bj < 2; ++bj) {
                    const f32x4 um1 = (i >= 1) ? U4(bj, n, i >= 1 ? i - 1 : 0) : p7[bj];
                    const f32x4 um2 = (i >= 2) ? U4(bj, n, i >= 2 ? i - 2 : 0) : ((i == 1) ? p7[bj] : p6[bj]);
                    c[bj] = cb[bj] + w2[bj] * U4(bj, n, i) + w1[bj] * um1 + w0[bj] * um2;
                }
                f32x4 a;
#pragma unroll
                for (int e = 0; e < 4; ++e) { const float z = c[0][e]; a[e] = z * __builtin_amdgcn_rcpf(1.0f + __builtin_amdgcn_exp2f(-z * LOG2E)) * c[1][e]; }
                u32x2 w; w.x = cvtpk(a[0], a[1]); w.y = cvtpk(a[2], a[3]);
                const bool skip = (wr == 0 && fr == 0 && i < 2 && !bstart);
                if (!skip) *(u32x2*)(ACT + (size_t)(rowbase + i) * DFF_ + cha + 4 * n) = w;
            }
        }
#undef U4
    }
};

struct P4Order : pg8::StaticOrder {
    const float* SSQ; LAS float* rtab;
    __device__ __forceinline__ void a_ready(const pg8::Unit& u) const {
        const int t = threadIdx.x;
        if (t < 256) {
            const float* sp = SSQ + (size_t)(u.pm * 256 + t) * 16;
            const f32x4 s0 = *(const f32x4*)sp, s1 = *(const f32x4*)(sp + 4), s2 = *(const f32x4*)(sp + 8), s3 = *(const f32x4*)(sp + 12);
            const float tot = ((s0[0] + s0[1]) + (s0[2] + s0[3])) + ((s1[0] + s1[1]) + (s1[2] + s1[3])) + ((s2[0] + s2[1]) + (s2[2] + s2[3])) + ((s3[0] + s3[1]) + (s3[2] + s3[3]));
            rtab[((u.pm >> 3) & 1) * 256 + t] = 1.0f / sqrtf(tot * (1.f / 1024.f) + EPS_);
        }
    }
};

struct Epi5 {
    static constexpr bool PERM = true;
    float* out; float* dst;
    __device__ __forceinline__ void operator()(const f32x4 (&acc)[2][2][4][2], const pg8::Unit& u, int wr, int wc, int fr, int fq) const {
#pragma unroll
        for (int ai = 0; ai < 2; ++ai)
#pragma unroll
            for (int m = 0; m < 4; ++m) { const size_t row = (size_t)(u.pm * 256 + ai * 128 + wr * 64 + m * 16 + fr); const int col = u.pn * 256 + wc * 64 + 8 * fq;
#pragma unroll
                for (int bj = 0; bj < 2; ++bj) { const float* p = out + row * 1024 + col + 32 * bj; float* q = dst + row * 1024 + col + 32 * bj;
                    const f32x4 o0 = *(const f32x4*)p + acc[ai][bj][m][0], o1 = *(const f32x4*)(p + 4) + acc[ai][bj][m][1];
                    *(f32x4*)q = o0; *(f32x4*)(q + 4) = o1; } }
    }
};
struct P5Order : pg8::StaticOrder {
    const float* UE; const float* UF; const float* convw; const float* convb; bf16_t* ACT;
    __device__ __forceinline__ void a_ready(const pg8::Unit& u) const {
        if ((u.pm & 15) != 0) {
            for (int ch = threadIdx.x; ch < DFF_; ch += 512) {
                const int pa = 256 * (ch >> 7) + (ch & 127), pg = pa + 128;
                const float* e = UE + (size_t)((u.pm - 1) * 2) * 5632; const float* f = UF + (size_t)(u.pm * 2) * 5632;
                float r[2];
#pragma unroll
                for (int i = 0; i < 2; ++i) {
                    float cc[2];
#pragma unroll
                    for (int s = 0; s < 2; ++s) { const int p = s ? pg : pa, cch = s * DFF_ + ch;
                        const float um2 = e[p], um1 = e[5632 + p], u0 = f[p], u1 = f[5632 + p];
                        const float w0 = convw[cch], w1 = convw[5632 + cch], w2 = convw[2 * 5632 + cch], b = convb[cch];
                        cc[s] = (i == 0) ? b + w0 * um2 + w1 * um1 + w2 * u0 : b + w0 * um1 + w1 * u0 + w2 * u1; }
                    r[i] = cc[0] * __builtin_amdgcn_rcpf(1.0f + __builtin_amdgcn_exp2f(-cc[0] * LOG2E)) * cc[1];
                }
                const unsigned w = cvtpk(r[0], r[1]);
                ACT[(size_t)(u.pm * 256) * DFF_ + ch] = (bf16_t)(w & 0xffffu); ACT[(size_t)(u.pm * 256 + 1) * DFF_ + ch] = (bf16_t)(w >> 16);
            }
        }
        asm volatile("s_waitcnt vmcnt(0)" ::: "memory"); __builtin_amdgcn_s_barrier(); asm volatile("" ::: "memory");
    }
};

__global__ void __launch_bounds__(NWAVES * 64, 2) fwd_kernel(Args args) {
    extern __shared__ __attribute__((aligned(16))) unsigned char lds_raw[];
    LAS unsigned char* lds = (LAS unsigned char*)lds_raw;
    volatile LAS unsigned* MISC = (volatile LAS unsigned*)(lds + MISC_OFF);
    const int tid = threadIdx.x, lane = tid & 63, wave = __builtin_amdgcn_readfirstlane(tid >> 6);
    const int G = gridDim.x; const int bx = blockIdx.x; const int vcu = (G % 8 == 0) ? (bx % 8) * (G / 8) + bx / 8 : bx;
    unsigned char* ws = args.ws;
    gu32* ctl = (gu32*)(ws + WS_CTL);
    for (int u = tid; u < (LDS_BYTES - LDSCTL_OFF) / 4; u += NWAVES * 64) ((LAS unsigned*)(lds + LDSCTL_OFF))[u] = 0u;
    __syncthreads();
    XcdBarrier bar; bar.bar = (unsigned*)(ctl + CW_BAR) + args.li * XCD_BAR_WORDS; bar.x = 0; bar.st = nullptr;
    if (!MK_MULTI) bar = xcd_barrier_post((unsigned*)(ctl + CW_BAR) + args.li * XCD_BAR_WORDS, MISC + 8);
#define GRID_BAR() do { if (!MK_MULTI) xcd_barrier(bar); } while (0)
    const int lo = args.ph_lo, hi = args.ph_hi;
#ifndef PHASE_MASK
#define PHASE_MASK 0xff
#endif
#define IN(k) (((PHASE_MASK >> (k)) & 1) && lo <= (k) && (k) < hi)
#define BOTH(k) (IN(k) && IN((k) + 1))

    if (IN(0)) { p0_prologue(args, lds, vcu, G, wave, lane); if (BOTH(0)) GRID_BAR(); }
#ifdef PROBE_BARS
    for (int xb = 0; xb < PROBE_BARS; ++xb) GRID_BAR();
#endif

    if (IN(1)) {
        pg8::Gemm g{(const bf16_t*)((unsigned char*)args.out + DO_A1), (const bf16_t*)((unsigned char*)args.out + DO_WCAT), T_ + NB_ * MEM_, NCAT, 1024};
        P1Order S; S.init(G, bx);
        Epi1 E{ws, (const float*)((unsigned char*)args.out + DO_ROPE), args.in[I_AQ], args.in[I_AK], args.in[I_BQ], args.in[I_BK], args.in[I_BGATE]};
        pg8::gemm_phase<Epi1, P1Order, true, false, false>(lds + RING_OFF, g, S, E);
        { const int nfull = (1680 / G) * G, nrem = 1680 - nfull;
          if (nrem == 0) p0_late_weights(args, lds, bx * NWAVES + wave, G * NWAVES, wave, lane);
          else if (bx >= nrem) p0_late_weights(args, lds, (bx - nrem) * NWAVES + wave, (G - nrem) * NWAVES, wave, lane); }
        if (BOTH(1)) GRID_BAR();
    }

    if (IN(2)) { p2_attention(args, lds, vcu, tid, wave, lane); if (BOTH(2)) GRID_BAR(); }


    if (IN(4)) {
        pg8::Gemm g{(const bf16_t*)((unsigned char*)args.out + DO_OCAT), (const bf16_t*)(ws + WS_WO), T_, 1024, KCAT};
        P3aOrder S; S.init(T_, 1024, G, bx);
        S.oag = (const bf16_t*)((unsigned char*)args.out + DO_OAG); S.ocat = (bf16_t*)((unsigned char*)args.out + DO_OCAT); S.lse = (const float*)(ws + WS_LSE);
        Epi3a E{(const bf16_t*)(ws + WS_G), (bf16_t*)(ws + WS_MERGED)};
        pg8::gemm_phase<Epi3a, P3aOrder, false, false, true>(lds + RING_OFF, g, S, E);
        if (BOTH(4)) GRID_BAR();
    }

    if (IN(5)) {
        pg8::Gemm g{(const bf16_t*)(ws + WS_MERGED), (const bf16_t*)(ws + WS_WOUT), T_, 1024, 1024};
        pg8::StaticOrder S; S.init(T_, 1024, G, bx);
        Epi3b E{args.in[I_X], args.out, (bf16_t*)(ws + WS_X1B), (float*)(ws + WS_SSQ)};
        pg8::gemm_phase<Epi3b, pg8::StaticOrder, false, false, false>(lds + RING_OFF, g, S, E);
        if (BOTH(5)) GRID_BAR();
    }

    if (IN(6)) {
        pg8::Gemm g{(const bf16_t*)(ws + WS_X1B), (const bf16_t*)(ws + WS_WUP), T_, 5632, 1024};
        P4Order S; S.init(T_, 5632, G, bx); S.SSQ = (const float*)(ws + WS_SSQ); S.rtab = (LAS float*)(lds + XCH_OFF + 2048);
        Epi4 E{args.in[I_CONVW], args.in[I_CONVB], (bf16_t*)(ws + WS_ACT), (float*)(ws + WS_UE), (float*)(ws + WS_UF), (LAS float*)(lds + XCH_OFF), (LAS const float*)(lds + XCH_OFF + 2048)};
        pg8::gemm_phase<Epi4, P4Order, true, true, false>(lds + RING_OFF, g, S, E);
        if (BOTH(6)) GRID_BAR();
    }

    if (IN(7)) {
        pg8::Gemm g{(const bf16_t*)(ws + WS_ACT), (const bf16_t*)(ws + WS_WDOWN), T_, 1024, DFF_};
        P5Order S; S.init(T_, 1024, G, bx);
        S.UE = (const float*)(ws + WS_UE); S.UF = (const float*)(ws + WS_UF); S.convw = args.in[I_CONVW]; S.convb = args.in[I_CONVB]; S.ACT = (bf16_t*)(ws + WS_ACT);
#if defined(PROBE_PHASE) && PROBE_PHASE == 7
        Epi5 E{args.out, args.li == 0 ? (float*)(ws + WS_MERGED) : args.out};
#else
        Epi5 E{args.out, args.out};
#endif
        pg8::gemm_phase<Epi5, P5Order, false, false, false>(lds + RING_OFF, g, S, E);
    }
#undef IN
#undef BOTH
#undef GRID_BAR
}

extern "C" void kernel_launch(void* const* d_in, const int* in_sizes, int n_in, void* d_out, int out_size, void* d_ws, size_t ws_size, hipStream_t stream) {
    static int grid = 0;
    if (grid == 0) {
        if (n_in != 25 || out_size != T_ * DM_ || ws_size < WS_END) { fprintf(stderr, "kernel_launch: unexpected shapes (n_in %d, out %d, ws %zu); nothing launched\n", n_in, out_size, ws_size); grid = -1; return; }
        int dev = 0, cus = 0, per_cu = 0;
        if (hipGetDevice(&dev) != hipSuccess || hipDeviceGetAttribute(&cus, hipDeviceAttributeMultiprocessorCount, dev) != hipSuccess) { grid = -1; return; }
        if (hipFuncSetAttribute((const void*)fwd_kernel, hipFuncAttributeMaxDynamicSharedMemorySize, LDS_BYTES) != hipSuccess) { fprintf(stderr, "kernel_launch: hipFuncSetAttribute failed\n"); grid = -1; return; }
        if (hipOccupancyMaxActiveBlocksPerMultiprocessor(&per_cu, (const void*)fwd_kernel, NWAVES * 64, LDS_BYTES) != hipSuccess || per_cu < 1) { fprintf(stderr, "kernel_launch: occupancy query says %d blocks per CU\n", per_cu); }
        (void)hipGetLastError();
        grid = cus;
        if (grid != 256) fprintf(stderr, "kernel_launch: %d CUs (the phase schedules expect 256)\n", grid);
    }
    if (grid < 0) return;
    if (hipMemsetAsync((char*)d_ws + WS_CTL, 0, CTL_ZERO_BYTES, stream) != hipSuccess) return;
    Args a{};
    for (int i = 0; i < 25; ++i) a.in[i] = (const float*)d_in[i];
    a.out = (float*)d_out; a.ws = (unsigned char*)d_ws;
#if MK_MULTI
    for (int p = 0; p < NPHASES; ++p) { a.ph_lo = p; a.ph_hi = p + 1; a.li = p; hipLaunchKernelGGL(fwd_kernel, dim3(grid), dim3(NWAVES * 64), LDS_BYTES, stream, a); }
#elif defined(PROBE_PHASE)
    a.ph_lo = 0; a.ph_hi = PROBE_PHASE + 1; a.li = 0;
    hipLaunchKernelGGL(fwd_kernel, dim3(grid), dim3(NWAVES * 64), LDS_BYTES, stream, a);
    a.ph_lo = PROBE_PHASE; a.ph_hi = NPHASES; a.li = 1;
    hipLaunchKernelGGL(fwd_kernel, dim3(grid), dim3(NWAVES * 64), LDS_BYTES, stream, a);
#else
    a.ph_lo = 0; a.ph_hi = NPHASES; a.li = 0;
    hipLaunchKernelGGL(fwd_kernel, dim3(grid), dim3(NWAVES * 64), LDS_BYTES, stream, a);
#endif
}
```

```cpp
#include <hip/hip_runtime.h>
#include <cstdio>
#include <cstdint>

#ifndef MK_MULTI
#define MK_MULTI 0
#endif
#define LAS __attribute__((address_space(3)))
#define GAS __attribute__((address_space(1)))
typedef unsigned short bf16_t;
typedef short bf16x8 __attribute__((ext_vector_type(8)));
typedef short s16x4 __attribute__((ext_vector_type(4)));
typedef float f32x4 __attribute__((ext_vector_type(4)));
typedef float f32x16 __attribute__((ext_vector_type(16)));
typedef unsigned u32x4 __attribute__((ext_vector_type(4)));
typedef unsigned u32x2 __attribute__((ext_vector_type(2)));
typedef int v4i32 __attribute__((ext_vector_type(4)));
typedef int v8i32 __attribute__((ext_vector_type(8)));

constexpr int T_ = 16384, SEQ_ = 4096, NB_ = 4, DM_ = 1024, MEM_ = 256, DFF_ = 2816;
constexpr int NCAT = 7680;
constexpr int KCAT = 1280;
constexpr float EPS_ = 1e-6f;
constexpr float LOG2E = 1.4426950408889634f;
constexpr float QSCALE64 = 0.125f * LOG2E;
constexpr float QSCALE128 = 0.08838834764831845f * LOG2E;

__device__ __forceinline__ unsigned cvtpk(float lo, float hi) {
    typedef float f2 __attribute__((ext_vector_type(2))); typedef __bf16 b2 __attribute__((ext_vector_type(2)));
    f2 v = {lo, hi}; b2 b = __builtin_convertvector(v, b2); return __builtin_bit_cast(unsigned, b);
}
__device__ __forceinline__ float xor16(float v) { return __int_as_float(__builtin_amdgcn_ds_swizzle(__float_as_int(v), 0x401F)); }
__device__ __forceinline__ float sum_halves(float v) { const auto rr = __builtin_amdgcn_permlane32_swap(__float_as_uint(v), __float_as_uint(v), false, false); return __uint_as_float(rr[0]) + __uint_as_float(rr[1]); }
__device__ __forceinline__ float bflo(unsigned w) { return __uint_as_float(w << 16); }
__device__ __forceinline__ float bfhi(unsigned w) { return __uint_as_float(w & 0xffff0000u); }

namespace pg8 {
constexpr int BM = 256, BK = 64, HALF = 128, HTB = HALF * BK * 2, STAGE_BYTES = 8 * HTB, NXCD = 8, WGM = 8;
__host__ __device__ __forceinline__ int lds_byte(int r, int c) { const int st = (r >> 4) * 2 + (c >> 5), rr = r & 15, cc = c & 31, ob = rr * 64 + cc * 2; return st * 1024 + (ob ^ (((ob >> 9) & 1) << 5)); }
__host__ __device__ __forceinline__ void stage_rc(int b, int& R, int& C) { const int st = b / 1024, sb = b % 1024, swz = sb ^ (((sb >> 9) & 1) << 5); R = (st >> 1) * 16 + swz / 64; C = (st & 1) * 32 + (swz % 64) / 2; }
__host__ __device__ __forceinline__ int perm32(int rho) { const int n = rho >> 4, i = rho & 15; return 8 * (i >> 2) + 4 * n + (i & 3); }

struct Unit { int pm, pn, par; };
struct Gemm { const bf16_t* A; const bf16_t* Bt; int M, N, K; };

struct StaticOrder {
    int nM, nN, nwg, G, c;
    __host__ __device__ void init(int M, int N, int G_, int c_) { nM = M / BM; nN = N / BM; nwg = nM * nN; G = G_; c = c_; }
    __host__ __device__ bool next(int i, Unit& u) const {
        const long L = (long)i * G + c; if (L >= nwg) return false;
        int wgid = (int)L; { const int q = nwg / NXCD, r = nwg % NXCD, xcd = wgid % NXCD, off = wgid / NXCD; wgid = (xcd < r ? xcd * (q + 1) : r * (q + 1) + (xcd - r) * q) + off; }
        const int nig = WGM * nN, gid = wgid / nig, fm = gid * WGM, gsz = (nM - fm) < WGM ? (nM - fm) : WGM;
        u.pm = fm + ((wgid % nig) % gsz); u.pn = (wgid % nig) / gsz; return true;
    }
    __device__ __forceinline__ void a_ready(const Unit&) const {}
    __device__ __forceinline__ void done(const Unit&) const {}
};

template <class Epi, class Sched, bool ALIGN_EPI, bool PERMA, bool KHOOK, int QM = 0, bool PREF = false>
__device__ __forceinline__ void gemm_phase(LAS unsigned char* lds, const Gemm g, const Sched& S, const Epi& E) {
    constexpr bool FP8 = (QM == 1), I8 = (QM == 2);
    int tid_ = threadIdx.x; asm volatile("" : "+v"(tid_));
    const int tid = tid_, wid = __builtin_amdgcn_readfirstlane(tid >> 6), lane = tid & 63, wr = wid >> 2, wc = wid & 3, fr = lane & 15, fq = lane >> 4;
    const int K = g.K, nt = K / BK;
    unsigned voffA0, voffA1, voffB;
    { int R, C; stage_rc(tid * 16, R, C); const int Rb = (R & ~31) + perm32(R & 31);
        if (PERMA) { const int rw = R >> 6, rm = (R >> 4) & 3, rf = R & 15; voffA0 = (unsigned)((128 * rw + 8 * rf + rm) * K + C) * 2u; voffA1 = (unsigned)((128 * rw + 8 * rf + 4 + rm) * K + C) * 2u; }
        else { voffA0 = (unsigned)(R * K + C) * 2u; voffA1 = voffA0; }
        voffB = (unsigned)(Rb * K + C) * 2u; }
    const size_t pstep_voffA0 = (size_t)(PERMA ? 128 : 64) * K * 2, pstep_voffA1 = pstep_voffA0, pstep_voffB = (size_t)64 * K * 2;
    const size_t kstep = (size_t)(BK * 2);
    const size_t hstep = (size_t)HALF * K * 2;
    const size_t ahs = PERMA ? (size_t)0 : hstep;
    const size_t tstep = 2 * hstep;
    const unsigned ldsw = (unsigned)wid * 1024u;
    const int aoff = lds_byte(wr * 64 + fr, fq * 8), boff = lds_byte(wc * 32 + fr, fq * 8);
#define PG8_SA(b, h) (((b) * 2 + (h)) * HTB)
#define PG8_SB(b, h) ((4 + (b) * 2 + (h)) * HTB)
#define PG8_STAGE(bufoff, gbase, voff) do { _Pragma("unroll") for (int _i = 0; _i < 2; ++_i) { unsigned _v = (voff); asm volatile("" : "+v"(_v));     \
        __builtin_amdgcn_global_load_lds((const unsigned*)((const char*)(gbase) + _i * PG8_PSTEP(voff) + _v), (LAS unsigned*)(lds + (bufoff) + ldsw + _i * 8192), 16, 0, 0); } } while (0)
#define PG8_PSTEP(voff) pstep_##voff
#define PG8_LD8(p) __builtin_shufflevector(*(const LAS v4i32*)(p), *(const LAS v4i32*)((p) + 1024), 0, 1, 2, 3, 4, 5, 6, 7)
#define PG8_LDA(dst, b, h) do { if constexpr (false) { _Pragma("unroll") for (int m = 0; m < 4; ++m) dst##8[m] = PG8_LD8(lds + PG8_SA(b, h) + aoff + m * 2048); } \
        else { _Pragma("unroll") for (int m = 0; m < 4; ++m) _Pragma("unroll") for (int k = 0; k < 2; ++k) dst[m][k] = *(const LAS bf16x8*)(lds + PG8_SA(b, h) + aoff + m * 2048 + k * 1024); } } while (0)
#define PG8_LDB(dst, b, h) do { if constexpr (false) { _Pragma("unroll") for (int n = 0; n < 2; ++n) dst##8[n] = PG8_LD8(lds + PG8_SB(b, h) + boff + n * 2048); } \
        else { _Pragma("unroll") for (int n = 0; n < 2; ++n) _Pragma("unroll") for (int k = 0; k < 2; ++k) dst[n][k] = *(const LAS bf16x8*)(lds + PG8_SB(b, h) + boff + n * 2048 + k * 1024); } } while (0)
#define PG8_CAT(x) __builtin_shufflevector(__builtin_bit_cast(v4i32, (x)[0]), __builtin_bit_cast(v4i32, (x)[1]), 0, 1, 2, 3, 4, 5, 6, 7)
#define PG8_MMA(ai, bj, At, Bt) do { if constexpr (FP8) __builtin_amdgcn_sched_barrier(0); __builtin_amdgcn_s_setprio(1); _Pragma("unroll") for (int m = 0; m < 4; ++m) _Pragma("unroll") for (int n = 0; n < 2; ++n) { \
        if constexpr (FP8) acc[ai][bj][m][n] = __builtin_amdgcn_mfma_scale_f32_16x16x128_f8f6f4(PG8_CAT(Bt[n]), PG8_CAT(At[m]), acc[ai][bj][m][n], 0, 0, 0, 0, 0, 0); \
        else if constexpr (I8) { _Pragma("unroll") for (int k = 0; k < 2; ++k) acc[ai][bj][m][n] = __builtin_bit_cast(f32x4, __builtin_amdgcn_mfma_i32_16x16x64_i8(__builtin_bit_cast(v4i32, Bt[n][k]), __builtin_bit_cast(v4i32, At[m][k]), __builtin_bit_cast(v4i32, acc[ai][bj][m][n]), 0, 0, 0)); } \
        else { _Pragma("unroll") for (int k = 0; k < 2; ++k) acc[ai][bj][m][n] = __builtin_amdgcn_mfma_f32_16x16x32_bf16(Bt[n][k], At[m][k], acc[ai][bj][m][n], 0, 0, 0); } } if constexpr (FP8) __builtin_amdgcn_sched_barrier(0); __builtin_amdgcn_s_setprio(0); if constexpr (FP8) __builtin_amdgcn_sched_barrier(0); } while (0)
#define PG8_WAIT_V(n) asm volatile("s_waitcnt vmcnt(" #n ")" ::: "memory")
#define PG8_WAIT_L(n) asm volatile("s_waitcnt lgkmcnt(" #n ")" ::: "memory")
#define PG8_BAR __builtin_amdgcn_s_barrier()
#define PG8_SCHED __builtin_amdgcn_sched_barrier(0)
    Unit cur, nxt; int ui = 0;
    if (!S.next(0, cur)) return;
    cur.par = 0;
    f32x4 acc[2][2][4][2];
#pragma unroll
    for (int a = 0; a < 2; ++a)
#pragma unroll
        for (int b = 0; b < 2; ++b)
#pragma unroll
            for (int m = 0; m < 4; ++m)
#pragma unroll
                for (int n = 0; n < 2; ++n) acc[a][b][m][n] = (f32x4){0.f, 0.f, 0.f, 0.f};
    bf16x8 At[4][2], B0[2][2], B1[2][2];
    v8i32 At8[4], B08[2], B18[2];
    const char* cA = (const char*)g.A + (size_t)cur.pm * tstep; const char* cB = (const char*)g.Bt + (size_t)cur.pn * tstep;
    S.a_ready(cur);
    PG8_STAGE(PG8_SB(0, 0), cB, voffB); PG8_STAGE(PG8_SB(0, 1), cB + hstep, voffB); PG8_STAGE(PG8_SA(0, 0), cA, voffA0); PG8_STAGE(PG8_SA(0, 1), cA + ahs, voffA1);
    if (wr == 1) PG8_BAR;
    PG8_WAIT_V(2); PG8_BAR;
    PG8_STAGE(PG8_SB(1, 0), cB + kstep, voffB); PG8_STAGE(PG8_SA(1, 0), cA + kstep, voffA0); PG8_STAGE(PG8_SB(1, 1), cB + hstep + kstep, voffB);
    PG8_WAIT_V(6); PG8_BAR;
    for (;;) {
        const bool has_next = S.next(ui + 1, nxt); nxt.par = (ui + 1) & 1;
        const char* nA = has_next ? (const char*)g.A + (size_t)nxt.pm * tstep : cA; const char* nB = has_next ? (const char*)g.Bt + (size_t)nxt.pn * tstep : cB;
        for (int t = 0; t < nt; t += 2) {
            const bool last = (t == nt - 2);
            const char* a1 = cA + (size_t)(t + 1) * kstep;
            const char* a2 = last ? nA : cA + (size_t)(t + 2) * kstep; const char* b2 = last ? nB : cB + (size_t)(t + 2) * kstep;
            const char* a3 = a2 + kstep; const char* b3 = b2 + kstep;
            asm volatile("" : "+s"(a1), "+s"(a2), "+s"(b2), "+s"(a3), "+s"(b3));
            if (last && has_next) S.a_ready(nxt);
            if constexpr (KHOOK) { int l3_ = threadIdx.x; asm volatile("" : "+v"(l3_)); E.khook(acc, cur, t, wr, wc, l3_ & 15, (l3_ >> 4) & 3); }
            PG8_LDB(B0, 0, 0); PG8_LDB(B1, 0, 1); PG8_SCHED; PG8_LDA(At, 0, 0); PG8_STAGE(PG8_SA(1, 1), a1 + ahs, voffA1);
            PG8_WAIT_V(8); PG8_WAIT_L(0); PG8_BAR;
            if constexpr (PREF) { if (t == 0 && wr == 0) E.prefetch(cur, wid); }
            PG8_MMA(0, 0, At, B0); PG8_MMA(0, 1, At, B1); PG8_BAR; PG8_SCHED;
            PG8_LDA(At, 0, 1); PG8_STAGE(PG8_SB(0, 0), b2, voffB); PG8_STAGE(PG8_SB(0, 1), b2 + hstep, voffB); PG8_STAGE(PG8_SA(0, 0), a2, voffA0);
            PG8_WAIT_V(8); PG8_WAIT_L(0); PG8_BAR; PG8_MMA(1, 0, At, B0); PG8_MMA(1, 1, At, B1); PG8_BAR; PG8_SCHED;
            PG8_LDB(B0, 1, 0); PG8_LDB(B1, 1, 1); PG8_SCHED; PG8_LDA(At, 1, 0); PG8_STAGE(PG8_SA(0, 1), a2 + ahs, voffA1);
            PG8_WAIT_V(8); PG8_WAIT_L(0); PG8_BAR; PG8_MMA(0, 0, At, B0); PG8_MMA(0, 1, At, B1); PG8_BAR; PG8_SCHED;
            PG8_LDA(At, 1, 1); PG8_STAGE(PG8_SB(1, 0), b3, voffB); PG8_STAGE(PG8_SB(1, 1), b3 + hstep, voffB); PG8_STAGE(PG8_SA(1, 0), a3, voffA0);
            PG8_WAIT_V(8); PG8_WAIT_L(0); PG8_BAR; PG8_MMA(1, 0, At, B0); PG8_MMA(1, 1, At, B1); PG8_BAR; PG8_SCHED;
        }
        if constexpr (ALIGN_EPI) { if (wr == 0) PG8_BAR; }
        { int l2_ = threadIdx.x; asm volatile("" : "+v"(l2_)); const int fr2 = l2_ & 15, fq2 = (l2_ >> 4) & 3;
          if (!E.skip) E(acc, cur, wr, wc, fr2, fq2); } S.done(cur);
        if (!has_next) break;
#pragma unroll
        for (int a = 0; a < 2; ++a)
#pragma unroll
            for (int b = 0; b < 2; ++b)
#pragma unroll
                for (int m = 0; m < 4; ++m)
#pragma unroll
                    for (int n = 0; n < 2; ++n) acc[a][b][m][n] = (f32x4){0.f, 0.f, 0.f, 0.f};
        cur = nxt; cA = nA; cB = nB; ++ui;
        if constexpr (ALIGN_EPI) { if (wr == 1) PG8_BAR; }
    }
    PG8_WAIT_V(0);
    if constexpr (!ALIGN_EPI) { if (wr == 0) PG8_BAR; }
    PG8_BAR;
#undef PG8_SA
#undef PG8_SB
#undef PG8_STAGE
#undef PG8_PSTEP
#undef PG8_LDA
#undef PG8_LDB
#undef PG8_MMA
#undef PG8_CAT
#undef PG8_LD8
#undef PG8_WAIT_V
#undef PG8_WAIT_L
#undef PG8_BAR
#undef PG8_SCHED
}
}

constexpr size_t MiB = 1u << 20;
constexpr size_t WS_CTL = 0, CTL_ZERO_BYTES = 1 * MiB;
constexpr size_t WS_WO = 1 * MiB;
constexpr size_t WS_WOUT = 4 * MiB;
constexpr size_t WS_WUP = 6 * MiB;
constexpr size_t WS_WDOWN = 17 * MiB;
constexpr size_t WS_SSQ = 23 * MiB;
constexpr size_t WS_UE = 24 * MiB;
constexpr size_t WS_UF = 27 * MiB;
constexpr size_t WS_LSE = 30 * MiB;
constexpr size_t WS_MKV = 31 * MiB;
constexpr size_t WS_G = 34 * MiB;
constexpr size_t WS_A1I8 = 84 * MiB;
constexpr size_t WS_RSC = 23 * MiB;
constexpr size_t WS_CMAX = 23 * MiB + 128 * 1024;
constexpr size_t WS_ACT = 34 * MiB;
constexpr size_t WS_QA = 130 * MiB;
constexpr size_t WS_KA = 154 * MiB;
constexpr size_t WS_VA = 178 * MiB;
constexpr size_t WS_MERGED = 130 * MiB;
constexpr size_t WS_X1B = 162 * MiB;
constexpr size_t WS_X1L = 194 * MiB;
constexpr size_t WS_QB = 202 * MiB;
constexpr size_t WS_KVB = 218 * MiB;
constexpr size_t WS_MQ = 226 * MiB;
constexpr size_t WS_END = 242 * MiB;
constexpr size_t DO_WI8 = 34 * MiB;
constexpr size_t DO_ROPE = 49 * MiB;
constexpr size_t DO_OCAT = 0;
constexpr size_t DO_OAG = 40 * MiB;

constexpr int CW_TMO = 0, CW_BAR = 4096;

constexpr int RING_OFF = 0, RING_BYTES = 131072;
constexpr int XCH_OFF = RING_BYTES;
constexpr int LDSCTL_OFF = RING_BYTES + 4096, MISC_OFF = LDSCTL_OFF + 320;
constexpr int LDS_BYTES = 147456;
constexpr int P1T_ROPE = 131072, P1T_CS = 139264, P1T_BIAS = 140288, P1T_RSC = 141312, P1T_GAIN = 142336;
constexpr int CTAB_OFF = 139264;
constexpr int NWAVES = 8;
constexpr int NPHASES = 8;

typedef GAS unsigned gu32;
#define RLX_AGENT __ATOMIC_RELAXED, __HIP_MEMORY_SCOPE_AGENT
#define LDS_WAIT() asm volatile("s_waitcnt lgkmcnt(0)" ::: "memory")
#define VM_WAIT() asm volatile("s_waitcnt vmcnt(0)" ::: "memory")

#define XB_TMO      128
#define XB_XCNT(j)  (256  + 64 * (j))
#define XB_XSUB(j)  (1280 + 64 * (j))
#define XB_XGEN(j)  (2304 + 64 * (j))
#define XB_TOP      3328
#define XB_TOPGEN   3392
#define XCD_BAR_WORDS 3456
#define XB_SPIN_CAP (1u << 18)
__device__ __forceinline__ unsigned xb_ld(unsigned* p)              { return __hip_atomic_load(p, __ATOMIC_RELAXED, __HIP_MEMORY_SCOPE_AGENT); }
__device__ __forceinline__ unsigned xb_add(unsigned* p, unsigned v) { return __hip_atomic_fetch_add(p, v, __ATOMIC_RELAXED, __HIP_MEMORY_SCOPE_AGENT); }
__device__ __forceinline__ unsigned xb_xcc_id() { return (unsigned)__builtin_amdgcn_s_getreg((3 << 11) | 20) & 0xFu; }
#define XB_SPIN(cond, bar) do { unsigned _sp = 0; while (cond) { __builtin_amdgcn_s_sleep(1); \
    if ((++_sp & 255u) == 0u) { if (xb_ld(&(bar)[XB_TMO])) break; if (_sp > XB_SPIN_CAP) { atomicAdd(&(bar)[XB_TMO], 1u); break; } } } } while (0)
__device__ unsigned g_barrier_words[2 * XCD_BAR_WORDS];
struct XcdBarrier { unsigned* bar; unsigned x, nloc, nx; };
__device__ __forceinline__ void xcd_barrier(const XcdBarrier& b) {
    asm volatile("s_waitcnt vmcnt(0)" ::: "memory");
    __syncthreads();
    if (threadIdx.x == 0) {
        unsigned* bar = b.bar;
        __builtin_amdgcn_s_waitcnt(0);
        const unsigned nloc = b.nloc, nx = b.nx;
        const unsigned old = xb_add(&bar[XB_XSUB(b.x)], 1u);
        const unsigned gen = old / nloc;
        if (old + 1u == (gen + 1u) * nloc) {
            __builtin_amdgcn_fence(__ATOMIC_RELEASE, "agent");
            asm volatile("s_waitcnt vmcnt(0)" ::: "memory");
            const unsigned og = xb_add(&bar[XB_TOP], 1u);
            const unsigned tg = og / nx;
            if (og + 1u == (tg + 1u) * nx) xb_add(&bar[XB_TOPGEN], 1u);
            else XB_SPIN(xb_ld(&bar[XB_TOPGEN]) == tg, bar);
            __builtin_amdgcn_fence(__ATOMIC_ACQUIRE, "agent");
            xb_add(&bar[XB_XGEN(b.x)], 1u);
            asm volatile("s_waitcnt vmcnt(0)" ::: "memory");
        } else {
            XB_SPIN(xb_ld(&bar[XB_XGEN(b.x)]) == gen, bar);
            __builtin_amdgcn_fence(__ATOMIC_ACQUIRE, "agent");
            asm volatile("s_waitcnt vmcnt(0)" ::: "memory");
        }
    }
    __syncthreads();
}

struct Args {
    const float* in[25]; float* out; unsigned char* ws; int ph_lo, ph_hi, li, pad;
};
enum { I_X = 0, I_MEM, I_POS, I_ATTN_NORM, I_W_IN, I_AQ, I_AK, I_BQ, I_BK, I_SINK, I_MEM_NORM, I_W_MKV, I_MQN, I_MKN, I_WOA, I_WOB, I_WOM, I_WGATE, I_BGATE, I_WOUT, I_FFN_NORM, I_WUP, I_CONVW, I_CONVB, I_WDOWN };

__host__ __device__ __forceinline__ int map_uniform(int n) { const int c = n & 255; return (n & ~255) + 128 * ((c >> 5) & 1) + 32 * (c >> 6) + (c & 31); }
__host__ __device__ __forceinline__ int map_up(int n) { return n < DFF_ ? 256 * (n >> 7) + (n & 127) : 256 * ((n - DFF_) >> 7) + 128 + ((n - DFF_) & 127); }

__device__ __forceinline__ float wave_sum(float v) {
#pragma unroll
    for (int o = 1; o < 64; o <<= 1) v += __shfl_xor(v, o);
    return v;
}
template <int MAP>
__device__ __forceinline__ void p0_transpose_item(const float* W, int K, int N, bf16_t* WT, int noff, int pitch, int koff, const float* kscale, LAS float*  , int item, int lane) {
    const int nblk = N / 32, kb = item / nblk, nb = item % nblk, k0 = 64 * kb + 8 * (lane >> 3), n0 = 32 * nb;
    f32x4 v[8];
#pragma unroll
    for (int i = 0; i < 8; ++i) v[i] = *(const f32x4*)(W + (size_t)(k0 + i) * N + n0 + 4 * (lane & 7));
    if (kscale) { const f32x4 s0 = *(const f32x4*)(kscale + k0), s1 = *(const f32x4*)(kscale + k0 + 4);
#pragma unroll
        for (int i = 0; i < 8; ++i) v[i] = v[i] * (i < 4 ? s0[i & 3] : s1[i & 3]); }
    const int r0 = (MAP == 0 ? map_uniform(noff + n0) : map_up(noff + n0)) + 4 * (lane & 7);
#pragma unroll
    for (int e = 0; e < 4; ++e) { u32x4 o; o.x = cvtpk(v[0][e], v[1][e]); o.y = cvtpk(v[2][e], v[3][e]); o.z = cvtpk(v[4][e], v[5][e]); o.w = cvtpk(v[6][e], v[7][e]);
        *(GAS u32x4*)(WT + (size_t)(r0 + e) * pitch + koff + k0 + 0) = o; }
}
constexpr float I8MAGIC = 12582912.0f;
__device__ __forceinline__ unsigned pack_i8(float m0, float m1, float m2, float m3) {
    const unsigned p01 = __builtin_amdgcn_perm(__float_as_uint(m1), __float_as_uint(m0), 0x0c0c0400u);
    const unsigned p23 = __builtin_amdgcn_perm(__float_as_uint(m3), __float_as_uint(m2), 0x0c0c0400u);
    return p01 | (p23 << 16);
}
__device__ __forceinline__ float wave_max(float v) {
#pragma unroll
    for (int o = 1; o < 64; o <<= 1) v = fmaxf(v, __shfl_xor(v, o));
    return v;
}
__device__ __forceinline__ void p0_quant_weight_block(const float* W, int N, int nb, int coff, unsigned char* WT, float* cmax, LAS float* part, int wave, int lane) {
    const int n0 = 32 * nb;
    f32x4 v[2][8];
#pragma unroll
    for (int it = 0; it < 2; ++it) { const int k0 = 128 * wave + 64 * it + 8 * (lane >> 3);
#pragma unroll
        for (int i = 0; i < 8; ++i) v[it][i] = *(const f32x4*)(W + (size_t)(k0 + i) * N + n0 + 4 * (lane & 7)); }
    f32x4 mx = {0.f, 0.f, 0.f, 0.f};
#pragma unroll
    for (int it = 0; it < 2; ++it)
#pragma unroll
        for (int i = 0; i < 8; ++i)
#pragma unroll
            for (int e = 0; e < 4; ++e) mx[e] = fmaxf(mx[e], fabsf(v[it][i][e]));
#pragma unroll
    for (int o = 8; o < 64; o <<= 1)
#pragma unroll
        for (int e = 0; e < 4; ++e) mx[e] = fmaxf(mx[e], __shfl_xor(mx[e], o));
    if (lane < 8) *(LAS f32x4*)(part + wave * 32 + 4 * lane) = mx;
    __syncthreads();
    f32x4 cm = *(const LAS f32x4*)(part + 4 * (lane & 7));
#pragma unroll
    for (int w = 1; w < 8; ++w) { const f32x4 o = *(const LAS f32x4*)(part + w * 32 + 4 * (lane & 7));
#pragma unroll
        for (int e = 0; e < 4; ++e) cm[e] = fmaxf(cm[e], o[e]); }
    if (wave == 0 && lane < 8) *(f32x4*)(cmax + coff + n0 + 4 * lane) = cm;
    f32x4 inv;
#pragma unroll
    for (int e = 0; e < 4; ++e) inv[e] = cm[e] > 0.f ? 127.0f / cm[e] : 0.f;
    const int r0 = map_uniform(coff + n0) + 4 * (lane & 7);
#pragma unroll
    for (int it = 0; it < 2; ++it) { const int k0 = 128 * wave + 64 * it + 8 * (lane >> 3);
#pragma unroll
        for (int e = 0; e < 4; ++e) { u32x2 o;
            o.x = pack_i8(__builtin_fmaf(v[it][0][e], inv[e], I8MAGIC), __builtin_fmaf(v[it][1][e], inv[e], I8MAGIC), __builtin_fmaf(v[it][2][e], inv[e], I8MAGIC), __builtin_fmaf(v[it][3][e], inv[e], I8MAGIC));
            o.y = pack_i8(__builtin_fmaf(v[it][4][e], inv[e], I8MAGIC), __builtin_fmaf(v[it][5][e], inv[e], I8MAGIC), __builtin_fmaf(v[it][6][e], inv[e], I8MAGIC), __builtin_fmaf(v[it][7][e], inv[e], I8MAGIC));
            *(GAS u32x2*)(WT + (size_t)(r0 + e) * 1024 + k0) = o; } }
    __syncthreads();
}
template <int NR>
__device__ __forceinline__ void rms_rows_to_i8(const float* xrow, size_t rstride, const float* gain, unsigned char* orow, float* rsc, int lane) {
    const GAS f32x4* gr = (const GAS f32x4*)gain + lane;
    f32x4 v[NR][4]; float s[NR], mx[NR];
#pragma unroll
    for (int r = 0; r < NR; ++r) { const GAS f32x4* xr = (const GAS f32x4*)(xrow + r * rstride) + lane;
#pragma unroll
        for (int j = 0; j < 4; ++j) v[r][j] = xr[64 * j]; }
    f32x4 g[4];
#pragma unroll
    for (int j = 0; j < 4; ++j) g[j] = gr[64 * j];
#pragma unroll
    for (int r = 0; r < NR; ++r) { s[r] = 0.f;
#pragma unroll
        for (int j = 0; j < 4; ++j) s[r] += (v[r][j].x * v[r][j].x + v[r][j].y * v[r][j].y) + (v[r][j].z * v[r][j].z + v[r][j].w * v[r][j].w); }
#pragma unroll
    for (int r = 0; r < NR; ++r) { const float rstd = 1.0f / sqrtf(wave_sum(s[r]) * (1.f / 1024.f) + EPS_); mx[r] = 0.f;
#pragma unroll
        for (int j = 0; j < 4; ++j) { v[r][j] = v[r][j] * rstd * g[j];
            mx[r] = fmaxf(fmaxf(mx[r], fmaxf(fabsf(v[r][j].x), fabsf(v[r][j].y))), fmaxf(fabsf(v[r][j].z), fabsf(v[r][j].w))); } }
#pragma unroll
    for (int r = 0; r < NR; ++r) mx[r] = wave_max(mx[r]);
#pragma unroll
    for (int r = 0; r < NR; ++r) { const float inv = mx[r] > 0.f ? 127.0f / mx[r] : 0.f;
        GAS unsigned* o4 = (GAS unsigned*)(orow + r * rstride) + lane;
#pragma unroll
        for (int j = 0; j < 4; ++j) o4[64 * j] = pack_i8(__builtin_fmaf(v[r][j].x, inv, I8MAGIC), __builtin_fmaf(v[r][j].y, inv, I8MAGIC), __builtin_fmaf(v[r][j].z, inv, I8MAGIC), __builtin_fmaf(v[r][j].w, inv, I8MAGIC));
        if (lane == 0) rsc[r] = mx[r] * (1.0f / 127.0f); }
}
__device__ __forceinline__ void sincos_f(float ang, float& co, float& si) {
    const double x = (double)ang; const double n = __builtin_rint(x * 0.63661977236758134308);
    double r = __builtin_fma(-n, 1.5707963267948966192, x); r = __builtin_fma(-n, 6.123233995736766036e-17, r);
    const double r2 = r * r;
    double s = -1.0 / 6227020800.0; s = s * r2 + 1.0 / 39916800.0; s = s * r2 - 1.0 / 362880.0; s = s * r2 + 1.0 / 5040.0; s = s * r2 - 1.0 / 120.0; s = s * r2 + 1.0 / 6.0; s = r - r * r2 * s;
    double c = 1.0 / 479001600.0; c = c * r2 - 1.0 / 3628800.0; c = c * r2 + 1.0 / 40320.0; c = c * r2 - 1.0 / 720.0; c = c * r2 + 1.0 / 24.0; c = c * r2 - 0.5; c = c * r2 + 1.0;
    const int q = (int)((long long)n & 3);
    const double cs = (q == 0) ? c : (q == 1) ? -s : (q == 2) ? -c : s;
    const double sn = (q == 0) ? s : (q == 1) ? c : (q == 2) ? -s : -c;
    co = (float)cs; si = (float)sn;
}

struct Frame {
    LAS unsigned char* lds;
    int tid, lane, wave, vcu, G;
    const Args* a;
};

__device__ __forceinline__ void p0_prologue(const Args& A, LAS unsigned char* lds, int vcu, int G, int wave, int lane) {
    const int gw = vcu * NWAVES + wave, NGW = G * NWAVES;
    unsigned char* wi8 = (unsigned char*)A.out + DO_WI8;
    unsigned char* a1 = A.ws + WS_A1I8;
    float* rsc = (float*)(A.ws + WS_RSC); float* cmax = (float*)(A.ws + WS_CMAX);
    unsigned* rope = (unsigned*)((unsigned char*)A.out + DO_ROPE);
    constexpr int B_IN = 3584 / 32, B_GATE = 3072 / 32, B_MKV = 1024 / 32;
    for (int it = vcu; it < B_IN + B_GATE + B_MKV; it += G) {
        LAS float* part = (LAS float*)(lds + RING_OFF);
        if (it < B_IN) p0_quant_weight_block(A.in[I_W_IN], 3584, it, 0, wi8, cmax, part, wave, lane);
        else if (it < B_IN + B_GATE) p0_quant_weight_block(A.in[I_WGATE], 3072, it - B_IN, 3584, wi8, cmax, part, wave, lane);
        else p0_quant_weight_block(A.in[I_W_MKV], 1024, it - B_IN - B_GATE, 6656, wi8, cmax, part, wave, lane);
    }
    for (int m = 4 * gw; m < T_ + NB_ * MEM_; m += 4 * NGW) {
        if (m < T_) rms_rows_to_i8<4>(A.in[I_X] + (size_t)m * DM_, DM_, A.in[I_ATTN_NORM], a1 + (size_t)m * DM_, rsc + m, lane);
        else rms_rows_to_i8<4>(A.in[I_MEM] + (size_t)(m - T_) * DM_, DM_, A.in[I_MEM_NORM], a1 + (size_t)m * DM_, rsc + m, lane);
    }
    const int* pos = (const int*)A.in[I_POS];
    for (int idx = gw * 64 + lane; idx < T_ * 8; idx += NGW * 64) {
        const int t = idx >> 3, i = idx & 7;
        const float fr = (i == 0) ? 1.0f : (i == 1) ? 0.193922758102417f : (i == 2) ? 0.03760603442788124f : (i == 3) ? 0.007292666472494602f : (i == 4) ? 0.0014142136787995696f
                       : (i == 5) ? 0.00027424818836152554f : (i == 6) ? 5.318298644851893e-05f : 1.031338433676865e-05f;
        const float ang = (float)pos[t] * fr; float co, si; sincos_f(ang, co, si);
        rope[idx] = (unsigned)__builtin_bit_cast(unsigned short, (_Float16)co) | ((unsigned)__builtin_bit_cast(unsigned short, (_Float16)si) << 16);
    }
}

struct TItem { const float* W; bf16_t* WT; const float* kscale; int N, noff, pitch, koff, map, item; };
__device__ __forceinline__ void ti_load(const TItem& d, int lane, f32x4 (&v)[8], f32x4 (&sc)[2]) {
    const int nblk = d.N / 32, kb = d.item / nblk, nb = d.item % nblk, k0 = 64 * kb + 8 * (lane >> 3), n0 = 32 * nb;
#pragma unroll
    for (int i = 0; i < 8; ++i) v[i] = *(const f32x4*)(d.W + (size_t)(k0 + i) * d.N + n0 + 4 * (lane & 7));
    if (d.kscale) { sc[0] = *(const f32x4*)(d.kscale + k0); sc[1] = *(const f32x4*)(d.kscale + k0 + 4); }
}
__device__ __forceinline__ void ti_store(const TItem& d, int lane, f32x4 (&v)[8], const f32x4 (&sc)[2]) {
    const int nblk = d.N / 32, kb = d.item / nblk, nb = d.item % nblk, k0 = 64 * kb + 8 * (lane >> 3), n0 = 32 * nb;
    if (d.kscale) {
#pragma unroll
        for (int i = 0; i < 8; ++i) v[i] = v[i] * (i < 4 ? sc[0][i & 3] : sc[1][i & 3]); }
    const int r0 = (d.map == 0 ? map_uniform(d.noff + n0) : map_up(d.noff + n0)) + 4 * (lane & 7);
#pragma unroll
    for (int e = 0; e < 4; ++e) { u32x4 o; o.x = cvtpk(v[0][e], v[1][e]); o.y = cvtpk(v[2][e], v[3][e]); o.z = cvtpk(v[4][e], v[5][e]); o.w = cvtpk(v[6][e], v[7][e]);
        *(GAS u32x4*)(d.WT + (size_t)(r0 + e) * d.pitch + d.koff + k0) = o; }
}
template <int PART>
__device__ __forceinline__ bool late_item(const Args& A, int it, TItem& d) {
    constexpr int I_OA = (256 / 64) * (1024 / 32), I_OB = (512 / 64) * (1024 / 32), I_OM = I_OB, I_OUT = (1024 / 64) * (1024 / 32);
    constexpr int I_UP = (1024 / 64) * (5632 / 32), I_DOWN = (2816 / 64) * (1024 / 32);
    bf16_t* wo = (bf16_t*)(A.ws + WS_WO);
    if (PART == 1) { if (it >= I_DOWN) return false; d = TItem{A.in[I_WDOWN], (bf16_t*)(A.ws + WS_WDOWN), nullptr, 1024, 0, 2816, 0, 0, it}; return true; }
    int r = it;
    if (r < I_OA) { d = TItem{A.in[I_WOA], wo, nullptr, 1024, 0, KCAT, 0, 0, r}; return true; } r -= I_OA;
    if (r < I_OB) { d = TItem{A.in[I_WOB], wo, nullptr, 1024, 0, KCAT, 256, 0, r}; return true; } r -= I_OB;
    if (r < I_OM) { d = TItem{A.in[I_WOM], wo, nullptr, 1024, 0, KCAT, 768, 0, r}; return true; } r -= I_OM;
    if (r < I_OUT) { d = TItem{A.in[I_WOUT], (bf16_t*)(A.ws + WS_WOUT), nullptr, 1024, 0, 1024, 0, 0, r}; return true; } r -= I_OUT;
    if (r < I_UP) { d = TItem{A.in[I_WUP], (bf16_t*)(A.ws + WS_WUP), A.in[I_FFN_NORM], 5632, 0, 1024, 0, 1, r}; return true; }
    return false;
}
template <int PART>
__device__ __forceinline__ void p0_late_weights(const Args& A, int gw, int ngw, int lane) {
    constexpr int NB = 3;
    for (int it = gw; ; it += NB * ngw) {
        TItem d[NB]; bool ok[NB]; f32x4 v[NB][8], sc[NB][2];
#pragma unroll
        for (int b = 0; b < NB; ++b) { ok[b] = late_item<PART>(A, it + b * ngw, d[b]); if (ok[b]) ti_load(d[b], lane, v[b], sc[b]); }
        if (!ok[0]) break;
#pragma unroll
        for (int b = 0; b < NB; ++b) if (ok[b]) ti_store(d[b], lane, v[b], sc[b]);
    }
}

struct TileOrder {
    pg8::StaticOrder so; unsigned mask; int mkv;
    __device__ void init(unsigned mask_, int mkv_, int G, int c) { mask = mask_; mkv = mkv_; so.init(T_, 256 * __builtin_popcount(mask_), G, c); }
    __device__ bool next(int i, pg8::Unit& u) const {
        if (so.next(i, u)) { unsigned m = mask; for (int k = 0; k < u.pn; ++k) m &= m - 1u; u.pn = __builtin_ctz(m); return true; }
        if (!mkv) return false;
        const long L = (long)i * so.G + so.c - so.nwg; if (L < 0 || L >= 16) return false;
        u.pm = 64 + (int)(L >> 2); u.pn = 26 + (int)(L & 3); return true;
    }
    __device__ __forceinline__ void a_ready(const pg8::Unit&) const {}
    __device__ __forceinline__ void done(const pg8::Unit&) const {}
};

__device__ __forceinline__ f32x4 cvt_i32(const f32x4& a) { const v4i32 i = __builtin_bit_cast(v4i32, a); return (f32x4){(float)i[0], (float)i[1], (float)i[2], (float)i[3]}; }

__device__ __forceinline__ float h2f_lo(unsigned w) { return (float)__builtin_bit_cast(_Float16, (unsigned short)(w & 0xffffu)); }
__device__ __forceinline__ float h2f_hi(unsigned w) { return (float)__builtin_bit_cast(_Float16, (unsigned short)(w >> 16)); }

struct EpiG {
    static constexpr bool PERM = true;
    unsigned char* G; LAS const unsigned char* lds;
    bool skip = false;
    __device__ __forceinline__ void operator()(const f32x4 (&acc)[2][2][4][2], const pg8::Unit& u, int wr, int wc, int fr, int fq) const {
        const int col0 = u.pn * 256, row0 = u.pm * 256;
        f32x4 bv[2][2], cs[2][2];
#pragma unroll
        for (int bj = 0; bj < 2; ++bj)
#pragma unroll
            for (int n = 0; n < 2; ++n) { const int j = wc * 64 + 32 * bj + 8 * fq + 4 * n; bv[bj][n] = *(LAS const f32x4*)(lds + P1T_BIAS + 4 * j) * (-LOG2E); cs[bj][n] = *(LAS const f32x4*)(lds + P1T_CS + 4 * j) * (-LOG2E / 127.0f); }
        float rsv[2][4];
#pragma unroll
        for (int ai = 0; ai < 2; ++ai)
#pragma unroll
            for (int m = 0; m < 4; ++m) rsv[ai][m] = *(LAS const float*)(lds + P1T_RSC + 4 * (ai * 128 + wr * 64 + m * 16 + fr));
#pragma unroll
        for (int ai = 0; ai < 2; ++ai)
#pragma unroll
            for (int m = 0; m < 4; ++m) { unsigned char* rowp = G + (size_t)(row0 + ai * 128 + wr * 64 + m * 16 + fr) * 3072 + col0 + wc * 64 + 8 * fq;
#pragma unroll
                for (int bj = 0; bj < 2; ++bj) { u32x2 w;
#pragma unroll
                    for (int n = 0; n < 2; ++n) { const f32x4 z = (cvt_i32(acc[ai][bj][m][n]) * rsv[ai][m]) * cs[bj][n] + bv[bj][n]; unsigned q[4];
#pragma unroll
                        for (int e = 0; e < 4; ++e) { const float g = __builtin_amdgcn_rcpf(1.0f + __builtin_amdgcn_exp2f(z[e])); const unsigned qi = (unsigned)(g * 255.0f + 0.5f); q[e] = qi < 1u ? 1u : qi; }
                        w[n] = q[0] | (q[1] << 8) | (q[2] << 16) | (q[3] << 24); }
                    *(u32x2*)(rowp + 32 * bj) = w; } }
    }
};

struct Epi1 {
    static constexpr bool PERM = true;
    unsigned char* ws; const unsigned* rope; const float *aq, *ak, *bq, *bk, *bgate; const float* rsc; const float* cmax; LAS unsigned char* lds;
    bool skip = false;
    __device__ __forceinline__ void prefetch(const pg8::Unit& u, int w) const {
        int lane = threadIdx.x; asm volatile("" : "+v"(lane)); lane &= 63;
        const int pn = u.pn, pm = u.pm;
        if (pm < 64 && pn < 12) {
#pragma unroll
            for (int j = 0; j < 2; ++j) { const int piece = 2 * w + j;
                __builtin_amdgcn_global_load_lds((const unsigned*)((const char*)rope + (size_t)pm * 8192 + piece * 1024 + lane * 16), (LAS unsigned*)(lds + P1T_ROPE + piece * 1024), 16, 0, 0); }
        }
        if (w == 0) __builtin_amdgcn_global_load_lds((const unsigned*)(cmax + pn * 256 + lane * 4), (LAS unsigned*)(lds + P1T_CS), 16, 0, 0);
        else if (w == 1) { if (pn >= 14 && pn < 26) __builtin_amdgcn_global_load_lds((const unsigned*)(bgate + (pn - 14) * 256 + lane * 4), (LAS unsigned*)(lds + P1T_BIAS), 16, 0, 0); }
        else if (w == 2) __builtin_amdgcn_global_load_lds((const unsigned*)(rsc + pm * 256 + lane * 4), (LAS unsigned*)(lds + P1T_RSC), 16, 0, 0);
        else if (pn < 12) { const int gi = pn / 3, ty = pn - 3 * gi;
            const float* gp = (pn >= 11) ? bk : (pn >= 9) ? bq : (ty == 0) ? aq + 64 * gi : ak + 64 * gi;
            if (lane < 16) __builtin_amdgcn_global_load_lds((const unsigned*)(gp + lane * 4), (LAS unsigned*)(lds + P1T_GAIN), 16, 0, 0); }
    }
    __device__ __forceinline__ void plain(const f32x4 (&acc)[2][2][4][2], bf16_t* dst, int ld, int col0, int row0, int wr, int wc, int fr, int fq) const {
        f32x4 cs[2][2];
#pragma unroll
        for (int bj = 0; bj < 2; ++bj)
#pragma unroll
            for (int n = 0; n < 2; ++n) cs[bj][n] = *(LAS const f32x4*)(lds + P1T_CS + 4 * (wc * 64 + 32 * bj + 8 * fq + 4 * n)) * (1.0f / 127.0f);
        float rsv[2][4];
#pragma unroll
        for (int ai = 0; ai < 2; ++ai)
#pragma unroll
            for (int m = 0; m < 4; ++m) rsv[ai][m] = *(LAS const float*)(lds + P1T_RSC + 4 * (ai * 128 + wr * 64 + m * 16 + fr));
#pragma unroll
        for (int ai = 0; ai < 2; ++ai)
#pragma unroll
            for (int m = 0; m < 4; ++m) { bf16_t* rowp = dst + (size_t)(row0 + ai * 128 + wr * 64 + m * 16 + fr) * ld + col0 + wc * 64 + 8 * fq;
#pragma unroll
                for (int bj = 0; bj < 2; ++bj) { const f32x4 v0 = cvt_i32(acc[ai][bj][m][0]) * rsv[ai][m] * cs[bj][0], v1 = cvt_i32(acc[ai][bj][m][1]) * rsv[ai][m] * cs[bj][1];
                    u32x4 w; w.x = cvtpk(v0[0], v0[1]); w.y = cvtpk(v0[2], v0[3]); w.z = cvtpk(v1[0], v1[1]); w.w = cvtpk(v1[2], v1[3]);
                    *(u32x4*)(rowp + 32 * bj) = w; } }
    }
    __device__ __forceinline__ void normed(const f32x4 (&acc)[2][2][4][2], bf16_t* dst, int ld, int col0, int row0, float scale, int wr, int wc, int fr, int fq) const {
        f32x4 g[2][2], cs[2][2];
#pragma unroll
        for (int bj = 0; bj < 2; ++bj)
#pragma unroll
            for (int n = 0; n < 2; ++n) { g[bj][n] = *(LAS const f32x4*)(lds + P1T_GAIN + 4 * (32 * bj + 8 * fq + 4 * n)) * scale; cs[bj][n] = *(LAS const f32x4*)(lds + P1T_CS + 4 * (wc * 64 + 32 * bj + 8 * fq + 4 * n)) * (1.0f / 127.0f); }
#pragma unroll
        for (int aim = 0; aim < 4; ++aim) {
            const int ai = aim >> 1;
            u32x4 rw[2][2]; float rsv[2];
#pragma unroll
            for (int mm = 0; mm < 2; ++mm) { const int tr = ai * 128 + wr * 64 + (2 * (aim & 1) + mm) * 16 + fr; rsv[mm] = *(LAS const float*)(lds + P1T_RSC + 4 * tr);
#pragma unroll
                for (int n = 0; n < 2; ++n) rw[mm][n] = *(LAS const u32x4*)(lds + P1T_ROPE + 32 * tr + 16 * n); }
#pragma unroll
            for (int mm = 0; mm < 2; ++mm) { const int m = 2 * (aim & 1) + mm;
                const int row = row0 + ai * 128 + wr * 64 + m * 16 + fr;
                f32x4 v[2][2];
                float ss = 0.f;
#pragma unroll
                for (int bj = 0; bj < 2; ++bj)
#pragma unroll
                    for (int n = 0; n < 2; ++n) { const f32x4 x = cvt_i32(acc[ai][bj][m][n]) * cs[bj][n]; v[bj][n] = x; ss += (x[0] * x[0] + x[1] * x[1]) + (x[2] * x[2] + x[3] * x[3]); }
                ss += xor16(ss); ss = sum_halves(ss);
                const float rq = rsv[mm];
                const float rs = rq / sqrtf(ss * (rq * rq * (1.f / 64.f)) + EPS_);
#pragma unroll
                for (int bj = 0; bj < 2; ++bj)
#pragma unroll
                    for (int n = 0; n < 2; ++n) v[bj][n] = v[bj][n] * rs * g[bj][n];
#pragma unroll
                for (int n = 0; n < 2; ++n) {
                    const u32x4 cw = rw[mm][n];
                    const f32x4 co = {h2f_lo(cw[0]), h2f_lo(cw[1]), h2f_lo(cw[2]), h2f_lo(cw[3])}, si = {h2f_hi(cw[0]), h2f_hi(cw[1]), h2f_hi(cw[2]), h2f_hi(cw[3])};
                    f32x4 pr;
#pragma unroll
                    for (int e = 0; e < 4; ++e) pr[e] = xor16(v[0][n][e]);
                    const f32x4 r0 = v[0][n] * co - pr * si, r1 = v[0][n] * co + pr * si;
                    v[0][n] = (fq == 0) ? r0 : (fq == 1) ? r1 : v[0][n];
                }
                bf16_t* rowp = dst + (size_t)row * ld + col0 + wc * 64 + 8 * fq;
#pragma unroll
                for (int bj = 0; bj < 2; ++bj) { u32x4 w; w.x = cvtpk(v[bj][0][0], v[bj][0][1]); w.y = cvtpk(v[bj][0][2], v[bj][0][3]); w.z = cvtpk(v[bj][1][0], v[bj][1][1]); w.w = cvtpk(v[bj][1][2], v[bj][1][3]);
                    *(u32x4*)(rowp + 32 * bj) = w; }
            }
        }
    }
    __device__ __forceinline__ void operator()(const f32x4 (&acc)[2][2][4][2], const pg8::Unit& u, int wr, int wc, int fr, int fq) const {
        const int pn = u.pn, row0 = u.pm * 256;
        if (pn >= 26) { plain(acc, (bf16_t*)(ws + WS_MKV), 1024, (pn - 26) * 256, row0 - T_, wr, wc, fr, fq); return; }
        if (pn >= 14) { EpiG eg{ws + WS_G, lds}; pg8::Unit ug{u.pm, pn - 14}; eg(acc, ug, wr, wc, fr, fq); return; }
        if (pn >= 12) { plain(acc, (bf16_t*)(ws + WS_MQ), 512, (pn - 12) * 256, row0, wr, wc, fr, fq); return; }
        if (pn == 11) {
            if (wc >= 2) plain(acc, (bf16_t*)(ws + WS_KVB), 256, 0, row0, wr, wc, fr, fq);
            else normed(acc, (bf16_t*)(ws + WS_KVB), 256, 0, row0, 1.0f, wr, wc, fr, fq);
            return;
        }
        if (pn >= 9) { normed(acc, (bf16_t*)(ws + WS_QB), 512, (pn - 9) * 256, row0, QSCALE64, wr, wc, fr, fq); return; }
        const int gi = pn / 3, ty = pn - 3 * gi;
        if (ty == 2) { plain(acc, (bf16_t*)(ws + WS_VA) + (size_t)gi * T_ * 256, 256, 0, row0, wr, wc, fr, fq); return; }
        if (ty == 0) normed(acc, (bf16_t*)(ws + WS_QA) + (size_t)gi * T_ * 256, 256, 0, row0, QSCALE64, wr, wc, fr, fq);
        else normed(acc, (bf16_t*)(ws + WS_KA) + (size_t)gi * T_ * 256, 256, 0, row0, 1.0f, wr, wc, fr, fq);
    }
};

namespace att {
typedef short v4i16_t __attribute__((ext_vector_type(4)));
__device__ __forceinline__ int crow(int r, int h) { return (r & 3) + 8 * (r >> 2) + 4 * h; }
__device__ __forceinline__ s16x4 vtr(LAS const unsigned char* p) { return __builtin_bit_cast(s16x4, __builtin_amdgcn_ds_read_tr16_b64_v4i16((LAS v4i16_t*)p)); }

constexpr int KROW64 = 144, VROW64 = 128, NKEYS_B = 384;
constexpr int LDS_K64 = 0, LDS_V64 = NKEYS_B * KROW64;
constexpr int LDS_K128 = 0, LDS_V128 = 65536;

constexpr float SM_THR = 20.0f;
template <int NT, int ND>
__device__ __forceinline__ void softmax_step(f32x16 (&s)[NT], float& mref, float& l, f32x16 (&o)[ND], bf16x8 (&pf)[NT][2]) {
    if (__any(mref != 0.f)) {
#pragma unroll
        for (int t = 0; t < NT; ++t)
#pragma unroll
            for (int r = 0; r < 16; ++r) s[t][r] -= mref;
    }
    float mx = s[0][0];
#pragma unroll
    for (int t = 0; t < NT; ++t)
#pragma unroll
        for (int r = 0; r < 16; ++r) mx = fmaxf(mx, s[t][r]);
    mx = fmaxf(mx, __shfl_xor(mx, 32));
    if (__any(mx > SM_THR)) {
        const float dl = fmaxf(mx, 0.f); mref += dl;
#pragma unroll
        for (int t = 0; t < NT; ++t)
#pragma unroll
            for (int r = 0; r < 16; ++r) s[t][r] -= dl;
        const float f = __builtin_amdgcn_exp2f(-dl); l *= f;
#pragma unroll
        for (int d = 0; d < ND; ++d)
#pragma unroll
            for (int r = 0; r < 16; ++r) o[d][r] *= f;
    }
    float ps0 = 0.f, ps1 = 0.f;
#pragma unroll
    for (int t = 0; t < NT; ++t)
#pragma unroll
        for (int r = 0; r < 16; r += 2) { s[t][r] = __builtin_amdgcn_exp2f(s[t][r]); s[t][r + 1] = __builtin_amdgcn_exp2f(s[t][r + 1]); ps0 += s[t][r]; ps1 += s[t][r + 1]; }
    l += ps0 + ps1;
#pragma unroll
    for (int t = 0; t < NT; ++t)
#pragma unroll
        for (int k = 0; k < 2; ++k) { u32x4 w; w.x = cvtpk(s[t][8 * k + 0], s[t][8 * k + 1]); w.y = cvtpk(s[t][8 * k + 2], s[t][8 * k + 3]); w.z = cvtpk(s[t][8 * k + 4], s[t][8 * k + 5]); w.w = cvtpk(s[t][8 * k + 6], s[t][8 * k + 7]);
            pf[t][k] = __builtin_bit_cast(bf16x8, w); }
}

struct BU { const bf16_t* q; const bf16_t* k; const bf16_t* v; bf16_t* o; float* lse; int qstride, kvstride, ostride, lsestride; float sink2; int W; int first; };
__device__ __forceinline__ void bu_load(const BU& u, int tid, u32x4 (&kr)[6], u32x4 (&vr)[6]) {
#pragma unroll
    for (int it = 0; it < 6; ++it) {
        const int c = tid + 512 * it, row = c >> 3, ch = c & 7;
        const bool valid = !(u.first && row < 128);
        const long off = (long)((valid ? row : 128) - 128) * (long)u.kvstride + ch * 8;
        kr[it] = *(const u32x4*)(u.k + off); vr[it] = *(const u32x4*)(u.v + off);
    }
}
__device__ __forceinline__ void bu_store(LAS unsigned char* lds, int tid, const u32x4 (&kr)[6], const u32x4 (&vr)[6], int first) {
#pragma unroll
    for (int it = 0; it < 6; ++it) {
        const int c = tid + 512 * it, row = c >> 3, ch = c & 7;
        const bool valid = !(first && row < 128);
        const u32x4 z = (u32x4){0u, 0u, 0u, 0u};
        *(LAS u32x4*)(lds + LDS_K64 + row * KROW64 + ch * 16) = valid ? kr[it] : z;
        *(LAS u32x4*)(lds + LDS_V64 + row * VROW64 + ((ch * 16) ^ (((row >> 1) & 1) << 6))) = valid ? vr[it] : z;
    }
}
__device__ __forceinline__ void bu_loadq(const BU& u, int wid, int lane, bf16x8 (&qf)[4]) {
    const int qi = 32 * wid + (lane & 31), h = lane >> 5;
#pragma unroll
    for (int d0 = 0; d0 < 4; ++d0) qf[d0] = *(const bf16x8*)(u.q + (size_t)qi * u.qstride + 16 * d0 + 8 * h);
}
template <int NT>
__device__ __forceinline__ void bu_step(LAS const unsigned char* kbase, LAS const unsigned char* vbase, int vsw, int kt0, int mask, int jlo, int jhi, int h, const bf16x8 (&qf)[4],
                                        float& mref, float& l, f32x16 (&o)[2]) {
    f32x16 s[NT];
#pragma unroll
    for (int d0 = 0; d0 < 4; ++d0)
#pragma unroll
        for (int t = 0; t < NT; ++t) { const bf16x8 kf = *(LAS const bf16x8*)(kbase + (kt0 + t) * 32 * KROW64 + d0 * 32); if (d0 == 0) { for (int r = 0; r < 16; ++r) s[t][r] = 0.f; } s[t] = __builtin_amdgcn_mfma_f32_32x32x16_bf16(kf, qf[d0], s[t], 0, 0, 0); }
    if (mask == 1) {
        const int L = jlo - 32 * kt0 - 4 * h;
#pragma unroll
        for (int r = 0; r < 16; ++r) { if (((r & 3) + 8 * (r >> 2)) < L) s[0][r] = -INFINITY; }
    } else if (mask == 2) {
        const int H = jhi - 32 * kt0 - 4 * h;
#pragma unroll
        for (int r = 0; r < 16; ++r) { if (((r & 3) + 8 * (r >> 2)) > H) s[0][r] = -INFINITY; }
    } else if (mask == 3) {
#pragma unroll
        for (int t = 0; t < NT; ++t) { const int L = jlo - 32 * (kt0 + t) - 4 * h; const unsigned span = (unsigned)(jhi - jlo);
#pragma unroll
            for (int r = 0; r < 16; ++r) { if ((unsigned)(((r & 3) + 8 * (r >> 2)) - L) > span) s[t][r] = -INFINITY; } }
    }
    bf16x8 pf[NT][2];
    softmax_step<NT, 2>(s, mref, l, o, pf);
#pragma unroll
    for (int t = 0; t < NT; ++t)
#pragma unroll
        for (int k = 0; k < 2; ++k)
#pragma unroll
            for (int d = 0; d < 2; ++d) {
                LAS const unsigned char* vp = vbase + ((kt0 + t) * 32 + 16 * k) * VROW64 + 64 * (d ^ vsw);
                const s16x4 lo = vtr(vp), hi = vtr(vp + 8 * VROW64);
                const bf16x8 vf = (bf16x8){lo[0], lo[1], lo[2], lo[3], hi[0], hi[1], hi[2], hi[3]};
                o[d] = __builtin_amdgcn_mfma_f32_32x32x16_bf16(vf, pf[t][k], o[d], 0, 0, 0);
            }
}
__device__ __forceinline__ void bu_compute(LAS unsigned char* lds, const BU& u, const bf16x8 (&qf)[4], int wid, int lane) {
    const int c = lane & 31, h = lane >> 5;
    const int qi = 32 * wid + c;
    float mref = 0.f, l = 0.f; f32x16 o[2];
#pragma unroll
    for (int r = 0; r < 16; ++r) { o[0][r] = 0.f; o[1][r] = 0.f; }
    int jlo = qi + 128 - u.W; if (u.first && jlo < 128) jlo = 128;
    const int jhi = qi + 128;
    const int qq = (lane & 15) >> 2;
    LAS const unsigned char* kbase = lds + LDS_K64 + c * KROW64 + 16 * h;
    LAS const unsigned char* vbase = lds + LDS_V64 + (4 * h + qq) * VROW64 + ((lane >> 4) & 1) * 32 + (lane & 3) * 8;
    const int vsw = (qq >> 1) & 1;
#pragma unroll 1
    for (int st = 0; st < 2; ++st) bu_step<2>(kbase, vbase, vsw, wid + 2 * st, u.first ? 3 : (st == 0 ? 1 : 0), jlo, jhi, h, qf, mref, l, o);
    bu_step<1>(kbase, vbase, vsw, wid + 4, u.first ? 3 : 2, jlo, jhi, h, qf, mref, l, o);
    float lt = l + __shfl_xor(l, 32);
    lt += __builtin_amdgcn_exp2f(u.sink2 - mref);
    const float inv = 1.0f / lt;
    bf16_t* orow = u.o + (size_t)qi * u.ostride;
#pragma unroll
    for (int d = 0; d < 2; ++d)
#pragma unroll
        for (int rg = 0; rg < 4; ++rg) { u32x2 w; w.x = cvtpk(o[d][4 * rg] * inv, o[d][4 * rg + 1] * inv); w.y = cvtpk(o[d][4 * rg + 2] * inv, o[d][4 * rg + 3] * inv);
            *(u32x2*)(orow + 32 * d + 8 * rg + 4 * h) = w; }
    if (u.lse && h == 0) u.lse[(size_t)qi * u.lsestride] = mref + __builtin_amdgcn_logf(lt);
}

__device__ __forceinline__ void mem_load(const bf16_t* kmem, const bf16_t* vmem, int tid, u32x4 (&kr)[8], u32x4 (&vr)[8]) {
#pragma unroll
    for (int it = 0; it < 8; ++it) { const int cc = tid + 512 * it, row = cc >> 4, ch = cc & 15;
        kr[it] = *(const u32x4*)(kmem + (size_t)row * 1024 + ch * 8); vr[it] = *(const u32x4*)(vmem + (size_t)row * 1024 + ch * 8); }
}
__device__ __forceinline__ void mem_unit(LAS unsigned char* lds, const bf16_t* q0, const u32x4 (&kr)[8], const u32x4 (&vr)[8], const float* qgain, const float* kgain, bf16_t* o0, size_t ostride, int tid, int wid, int lane) {
#pragma unroll
    for (int it = 0; it < 8; ++it) {
        const int cc = tid + 512 * it, row = cc >> 4, ch = cc & 15;
        *(LAS u32x4*)(lds + LDS_K128 + row * 256 + ((ch ^ (row & 15)) * 16)) = kr[it];
        *(LAS u32x4*)(lds + LDS_V128 + row * 256 + ((ch * 16) ^ ((row & 3) << 6))) = vr[it];
    }
    const int c = lane & 31, h = lane >> 5;
    const int qi = 32 * wid + c;
    bf16x8 qf[8];
    {
        u32x4 raw[8]; float ss = 0.f;
#pragma unroll
        for (int d0 = 0; d0 < 8; ++d0) { raw[d0] = *(const u32x4*)(q0 + (size_t)qi * 512 + 16 * d0 + 8 * h);
#pragma unroll
            for (int e = 0; e < 4; ++e) { const float a = bflo(raw[d0][e]), b = bfhi(raw[d0][e]); ss += a * a + b * b; } }
        ss += __shfl_xor(ss, 32);
        const float rs = (1.0f / sqrtf(ss * (1.f / 128.f) + EPS_)) * QSCALE128;
#pragma unroll
        for (int d0 = 0; d0 < 8; ++d0) { const f32x4 g0 = *(const f32x4*)(qgain + 16 * d0 + 8 * h), g1 = *(const f32x4*)(qgain + 16 * d0 + 8 * h + 4);
            u32x4 w; w.x = cvtpk(bflo(raw[d0].x) * rs * g0[0], bfhi(raw[d0].x) * rs * g0[1]); w.y = cvtpk(bflo(raw[d0].y) * rs * g0[2], bfhi(raw[d0].y) * rs * g0[3]);
            w.z = cvtpk(bflo(raw[d0].z) * rs * g1[0], bfhi(raw[d0].z) * rs * g1[1]); w.w = cvtpk(bflo(raw[d0].w) * rs * g1[2], bfhi(raw[d0].w) * rs * g1[3]);
            qf[d0] = __builtin_bit_cast(bf16x8, w); }
    }
    __syncthreads();
    {
        const int row = tid >> 1, hf = tid & 1; u32x4 raw[8]; float ss = 0.f;
#pragma unroll
        for (int i = 0; i < 8; ++i) { raw[i] = *(LAS const u32x4*)(lds + LDS_K128 + row * 256 + (((hf * 8 + i) ^ (row & 15)) * 16));
#pragma unroll
            for (int e = 0; e < 4; ++e) { const float a = bflo(raw[i][e]), b = bfhi(raw[i][e]); ss += a * a + b * b; } }
        ss += __shfl_xor(ss, 1);
        const float rs = 1.0f / sqrtf(ss * (1.f / 128.f) + EPS_);
#pragma unroll
        for (int i = 0; i < 8; ++i) { const float* gp = kgain + 64 * hf + 8 * i; const f32x4 g0 = *(const f32x4*)gp, g1 = *(const f32x4*)(gp + 4);
            u32x4 w; w.x = cvtpk(bflo(raw[i].x) * rs * g0[0], bfhi(raw[i].x) * rs * g0[1]); w.y = cvtpk(bflo(raw[i].y) * rs * g0[2], bfhi(raw[i].y) * rs * g0[3]);
            w.z = cvtpk(bflo(raw[i].z) * rs * g1[0], bfhi(raw[i].z) * rs * g1[1]); w.w = cvtpk(bflo(raw[i].w) * rs * g1[2], bfhi(raw[i].w) * rs * g1[3]);
            *(LAS u32x4*)(lds + LDS_K128 + row * 256 + (((hf * 8 + i) ^ (row & 15)) * 16)) = w; }
    }
    __syncthreads();
    float mref = 0.f, l = 0.f; f32x16 o[4];
#pragma unroll
    for (int r = 0; r < 16; ++r) {
#pragma unroll
        for (int d = 0; d < 4; ++d) o[d][r] = 0.f; }
    const int qq = (lane & 15) >> 2;
    LAS const unsigned char* vbase = lds + LDS_V128 + (4 * h + qq) * 256 + ((lane >> 4) & 1) * 32 + (lane & 3) * 8;
#pragma unroll 1
    for (int kt = 0; kt < 8; kt += 2) {
        f32x16 s[2];
#pragma unroll
        for (int d0 = 0; d0 < 8; ++d0)
#pragma unroll
            for (int t = 0; t < 2; ++t) { const int krow = (kt + t) * 32 + c;
                const bf16x8 kf = *(LAS const bf16x8*)(lds + LDS_K128 + krow * 256 + (((2 * d0 + h) ^ (krow & 15)) * 16)); if (d0 == 0) { for (int r = 0; r < 16; ++r) s[t][r] = 0.f; } s[t] = __builtin_amdgcn_mfma_f32_32x32x16_bf16(kf, qf[d0], s[t], 0, 0, 0); }
        bf16x8 pf[2][2];
        softmax_step<2, 4>(s, mref, l, o, pf);
#pragma unroll
        for (int t = 0; t < 2; ++t)
#pragma unroll
            for (int k = 0; k < 2; ++k)
#pragma unroll
                for (int d = 0; d < 4; ++d) {
                    LAS const unsigned char* vp = vbase + ((kt + t) * 32 + 16 * k) * 256 + 64 * (d ^ qq);
                    const s16x4 lo = vtr(vp), hi = vtr(vp + 8 * 256);
                    const bf16x8 vf = (bf16x8){lo[0], lo[1], lo[2], lo[3], hi[0], hi[1], hi[2], hi[3]};
                    o[d] = __builtin_amdgcn_mfma_f32_32x32x16_bf16(vf, pf[t][k], o[d], 0, 0, 0);
                }
    }
    const float inv = 1.0f / (l + __shfl_xor(l, 32));
    bf16_t* orow = o0 + (size_t)qi * ostride;
#pragma unroll
    for (int d = 0; d < 4; ++d)
#pragma unroll
        for (int rg = 0; rg < 4; ++rg) { u32x2 w; w.x = cvtpk(o[d][4 * rg] * inv, o[d][4 * rg + 1] * inv); w.y = cvtpk(o[d][4 * rg + 2] * inv, o[d][4 * rg + 3] * inv);
            *(u32x2*)(orow + 32 * d + 8 * rg + 4 * h) = w; }
    __syncthreads();
}
}

__device__ __forceinline__ att::BU get_bu(const Args& A, int vcu, int idx) {
    unsigned char* ws = A.ws; att::BU u;
    if (idx < 3) {
        const int gi = idx, b = vcu >> 6, hd = (vcu >> 4) & 3, i16 = vcu & 15;
        const int dl = (gi == 0) ? 1 : (gi == 1) ? 4 : 16;
        int r, qb; if (gi == 0) { r = 0; qb = i16; } else if (gi == 1) { r = i16 >> 2; qb = i16 & 3; } else { r = i16; qb = 0; }
        const int i0 = qb * 256;
        const size_t row0 = (size_t)b * SEQ_ + r + (size_t)dl * i0;
        const size_t base = (size_t)gi * T_ * 256 + row0 * 256 + hd * 64;
        u.q = (const bf16_t*)(ws + WS_QA) + base; u.k = (const bf16_t*)(ws + WS_KA) + base; u.v = (const bf16_t*)(ws + WS_VA) + base;
        u.o = (bf16_t*)((unsigned char*)A.out + DO_OAG) + base;
        u.lse = (float*)(ws + WS_LSE) + (size_t)gi * T_ * 4 + row0 * 4 + hd;
        u.qstride = dl * 256; u.kvstride = dl * 256; u.ostride = dl * 256; u.lsestride = dl * 4; u.sink2 = -INFINITY; u.W = 128; u.first = (i0 == 0);
    } else {
        const int uu = vcu + 256 * (idx - 3), b = uu >> 7, hq = (uu >> 4) & 7, qb = uu & 15, kvh = hq >> 2;
        const size_t row0 = (size_t)b * SEQ_ + (size_t)qb * 256;
        u.q = (const bf16_t*)(ws + WS_QB) + row0 * 512 + hq * 64;
        u.k = (const bf16_t*)(ws + WS_KVB) + row0 * 256 + kvh * 64; u.v = u.k + 128;
        u.o = (bf16_t*)((unsigned char*)A.out + DO_OCAT) + row0 * KCAT + 256 + hq * 64;
        u.lse = nullptr; u.qstride = 512; u.kvstride = 256; u.ostride = KCAT; u.lsestride = 0; u.sink2 = A.in[I_SINK][hq] * LOG2E; u.W = 127; u.first = (qb == 0);
    }
    return u;
}
__device__ __forceinline__ void p2_attention(const Args& A, LAS unsigned char* lds, int vcu, int tid, int wid, int lane) {
    unsigned char* ws = A.ws;
    const int mu = vcu, mb = mu >> 6, mhd = (mu >> 4) & 3, mqb = mu & 15;
    const bf16_t* km = (const bf16_t*)(ws + WS_MKV) + (size_t)mb * MEM_ * 1024 + mhd * 128;
    {
        u32x4 kr[6], vr[6];
        { const att::BU u0 = get_bu(A, vcu, 0); att::bu_load(u0, tid, kr, vr); }
#ifdef PROBE_TS
        unsigned long long d1 = 0, d2 = 0, d3 = 0, tA = __builtin_amdgcn_s_memrealtime();
#endif
#pragma unroll 1
        for (int idx = 0; idx < 5; ++idx) {
            const att::BU u = get_bu(A, vcu, idx);
#ifdef PROBE_TS
            const unsigned long long t0 = __builtin_amdgcn_s_memrealtime();
#endif
            att::bu_store(lds, tid, kr, vr, u.first);
            bf16x8 qf[4]; att::bu_loadq(u, wid, lane, qf);
            __syncthreads();
#ifdef PROBE_TS
            const unsigned long long t1 = __builtin_amdgcn_s_memrealtime();
#endif
            if (idx < 4) { const att::BU un = get_bu(A, vcu, idx + 1); att::bu_load(un, tid, kr, vr); }
            att::bu_compute(lds, u, qf, wid, lane);
#ifdef PROBE_TS
            asm volatile("" ::: "memory");
            const unsigned long long t2 = __builtin_amdgcn_s_memrealtime();
#endif
            __syncthreads();
#ifdef PROBE_TS
            const unsigned long long t3 = __builtin_amdgcn_s_memrealtime();
            d1 += t1 - t0; d2 += t2 - t1; d3 += t3 - t2;
#endif
        }
#ifdef PROBE_TS
        if (vcu == 100 && tid == 0) { float* dbg = (float*)(A.ws + WS_SSQ);
            dbg = (float*)(A.ws + WS_CTL + 512 * 1024);
            dbg[0] = (float)d1; dbg[1] = (float)d2; dbg[2] = (float)d3; dbg[3] = (float)(__builtin_amdgcn_s_memrealtime() - tA); }
#endif
    }
    {
        u32x4 mkr[8], mvr[8];
        att::mem_load(km, km + 512, tid, mkr, mvr);
        const size_t row0 = (size_t)mb * SEQ_ + (size_t)mqb * 256;
        const bf16_t* q = (const bf16_t*)(ws + WS_MQ) + row0 * 512 + mhd * 128;
        bf16_t* o = (bf16_t*)((unsigned char*)A.out + DO_OCAT) + row0 * KCAT + 768 + mhd * 128;
        att::mem_unit(lds, q, mkr, mvr, A.in[I_MQN], A.in[I_MKN], o, KCAT, tid, wid, lane);
    }
}

__device__ __forceinline__ void p2b_merge(const Args& A, int vcu, int G, int tid) {
    const bf16_t* oag = (const bf16_t*)((unsigned char*)A.out + DO_OAG);
    bf16_t* ocat = (bf16_t*)((unsigned char*)A.out + DO_OCAT);
    const float* lse = (const float*)(A.ws + WS_LSE);
    for (int idx = vcu * 512 + tid; idx < T_ * 32; idx += G * 512) {
        const int t = idx >> 5, ch = idx & 31, hd = ch >> 3;
        const float l0 = lse[(size_t)t * 4 + hd], l1 = lse[(size_t)T_ * 4 + (size_t)t * 4 + hd], l2 = lse[(size_t)2 * T_ * 4 + (size_t)t * 4 + hd];
        const float mx = fmaxf(l0, fmaxf(l1, l2));
        float w0 = __builtin_amdgcn_exp2f(l0 - mx), w1 = __builtin_amdgcn_exp2f(l1 - mx), w2 = __builtin_amdgcn_exp2f(l2 - mx);
        const float inv = 1.0f / (w0 + w1 + w2); w0 *= inv; w1 *= inv; w2 *= inv;
        const u32x4 a = *(const u32x4*)(oag + (size_t)t * 256 + ch * 8), b = *(const u32x4*)(oag + (size_t)T_ * 256 + (size_t)t * 256 + ch * 8), c = *(const u32x4*)(oag + (size_t)2 * T_ * 256 + (size_t)t * 256 + ch * 8);
        u32x4 w;
#pragma unroll
        for (int e = 0; e < 4; ++e) w[e] = cvtpk(w0 * bflo(a[e]) + w1 * bflo(b[e]) + w2 * bflo(c[e]), w0 * bfhi(a[e]) + w1 * bfhi(b[e]) + w2 * bfhi(c[e]));
        *(u32x4*)(ocat + (size_t)t * KCAT + ch * 8) = w;
    }
}

struct P3aOrder : pg8::StaticOrder {
    const bf16_t* oag; bf16_t* ocat; const float* lse;
    __device__ __forceinline__ void a_ready(const pg8::Unit& u) const {
#pragma unroll 1
        for (int i0 = threadIdx.x; i0 < 256 * 32; i0 += 2 * 512) {
            u32x4 a[2], b[2], c[2]; float l0[2], l1[2], l2[2];
#pragma unroll
            for (int j = 0; j < 2; ++j) { const int idx = i0 + 512 * j, t = u.pm * 256 + (idx >> 5), ch = idx & 31, hd = ch >> 3;
                l0[j] = lse[(size_t)t * 4 + hd]; l1[j] = lse[(size_t)T_ * 4 + (size_t)t * 4 + hd]; l2[j] = lse[(size_t)2 * T_ * 4 + (size_t)t * 4 + hd];
                a[j] = *(const u32x4*)(oag + (size_t)t * 256 + ch * 8); b[j] = *(const u32x4*)(oag + (size_t)T_ * 256 + (size_t)t * 256 + ch * 8); c[j] = *(const u32x4*)(oag + (size_t)2 * T_ * 256 + (size_t)t * 256 + ch * 8); }
#pragma unroll
            for (int j = 0; j < 2; ++j) { const int idx = i0 + 512 * j, t = u.pm * 256 + (idx >> 5), ch = idx & 31;
                const float mx = fmaxf(l0[j], fmaxf(l1[j], l2[j]));
                float w0 = __builtin_amdgcn_exp2f(l0[j] - mx), w1 = __builtin_amdgcn_exp2f(l1[j] - mx), w2 = __builtin_amdgcn_exp2f(l2[j] - mx);
                const float inv = 1.0f / (w0 + w1 + w2); w0 *= inv; w1 *= inv; w2 *= inv;
                u32x4 w;
#pragma unroll
                for (int e = 0; e < 4; ++e) w[e] = cvtpk(w0 * bflo(a[j][e]) + w1 * bflo(b[j][e]) + w2 * bflo(c[j][e]), w0 * bfhi(a[j][e]) + w1 * bfhi(b[j][e]) + w2 * bfhi(c[j][e]));
                *(u32x4*)(ocat + (size_t)t * KCAT + ch * 8) = w; }
        }
        asm volatile("s_waitcnt vmcnt(0)" ::: "memory"); __builtin_amdgcn_s_barrier(); asm volatile("" ::: "memory");
    }
};

__device__ __forceinline__ float ub(unsigned w, int i) { return (float)((w >> (8 * i)) & 0xffu); }
struct Epi3a {
    static constexpr bool PERM = true;
    const unsigned char* G; bf16_t* MERGED;
    bool skip = false;
    __device__ __forceinline__ void khook(f32x4 (&acc)[2][2][4][2], const pg8::Unit& u, int t, int wr, int wc, int fr, int fq) const {
        if (t != 4 && t != 12) return;
        const int gsel = (t == 4) ? 0 : 1024;
#pragma unroll
        for (int ai = 0; ai < 2; ++ai) {
            u32x2 ga[4][2], gb[4][2];
#pragma unroll
            for (int m = 0; m < 4; ++m) { const unsigned char* gp = G + (size_t)(u.pm * 256 + ai * 128 + wr * 64 + m * 16 + fr) * 3072 + gsel + u.pn * 256 + wc * 64 + 8 * fq;
#pragma unroll
                for (int bj = 0; bj < 2; ++bj) { ga[m][bj] = *(const u32x2*)(gp + 32 * bj); gb[m][bj] = *(const u32x2*)(gp + 1024 + 32 * bj); } }
            asm volatile("" ::: "memory");
#pragma unroll
            for (int m = 0; m < 4; ++m)
#pragma unroll
                for (int bj = 0; bj < 2; ++bj)
#pragma unroll
                    for (int n = 0; n < 2; ++n)
#pragma unroll
                        for (int e = 0; e < 4; ++e) acc[ai][bj][m][n][e] *= ub(ga[m][bj][n], e) * __builtin_amdgcn_rcpf(ub(gb[m][bj][n], e));
        }
    }
    __device__ __forceinline__ void operator()(const f32x4 (&acc)[2][2][4][2], const pg8::Unit& u, int wr, int wc, int fr, int fq) const {
        const int col = u.pn * 256 + wc * 64 + 8 * fq;
        u32x2 g2[2][4][2];
#pragma unroll
        for (int ai = 0; ai < 2; ++ai)
#pragma unroll
            for (int m = 0; m < 4; ++m) { const size_t row = (size_t)(u.pm * 256 + ai * 128 + wr * 64 + m * 16 + fr);
#pragma unroll
                for (int bj = 0; bj < 2; ++bj) g2[ai][m][bj] = *(const u32x2*)(G + row * 3072 + 2048 + col + 32 * bj); }
        asm volatile("" ::: "memory");
        const float k = 1.0f / 255.0f;
#pragma unroll
        for (int ai = 0; ai < 2; ++ai)
#pragma unroll
            for (int m = 0; m < 4; ++m) { const size_t row = (size_t)(u.pm * 256 + ai * 128 + wr * 64 + m * 16 + fr);
#pragma unroll
                for (int bj = 0; bj < 2; ++bj) { const u32x2 g = g2[ai][m][bj]; const f32x4 v0 = acc[ai][bj][m][0] * k, v1 = acc[ai][bj][m][1] * k;
                    u32x4 w; w.x = cvtpk(v0[0] * ub(g.x, 0), v0[1] * ub(g.x, 1)); w.y = cvtpk(v0[2] * ub(g.x, 2), v0[3] * ub(g.x, 3)); w.z = cvtpk(v1[0] * ub(g.y, 0), v1[1] * ub(g.y, 1)); w.w = cvtpk(v1[2] * ub(g.y, 2), v1[3] * ub(g.y, 3));
                    *(u32x4*)(MERGED + row * 1024 + col + 32 * bj) = w; } }
    }
};

struct Epi3b {
    static constexpr bool PERM = true;
    const float* x; bf16_t* X1L; bf16_t* X1B; float* SSQ;
    bool skip = false;
    __device__ __forceinline__ void operator()(const f32x4 (&acc)[2][2][4][2], const pg8::Unit& u, int wr, int wc, int fr, int fq) const {
        const int col = u.pn * 256 + wc * 64 + 8 * fq;
#pragma unroll
        for (int ai = 0; ai < 2; ++ai) {
            f32x4 xv[4][2][2];
#pragma unroll
            for (int m = 0; m < 4; ++m) { const size_t row = (size_t)(u.pm * 256 + ai * 128 + wr * 64 + m * 16 + fr);
#pragma unroll
                for (int bj = 0; bj < 2; ++bj) { const size_t off = row * 1024 + col + 32 * bj; xv[m][bj][0] = *(const f32x4*)(x + off); xv[m][bj][1] = *(const f32x4*)(x + off + 4); } }
            asm volatile("" ::: "memory");
#pragma unroll
            for (int m = 0; m < 4; ++m) { const size_t row = (size_t)(u.pm * 256 + ai * 128 + wr * 64 + m * 16 + fr); float ss = 0.f;
#pragma unroll
                for (int bj = 0; bj < 2; ++bj) { const size_t off = row * 1024 + col + 32 * bj;
                    const f32x4 o0 = xv[m][bj][0] + acc[ai][bj][m][0], o1 = xv[m][bj][1] + acc[ai][bj][m][1];
                    ss += (o0[0] * o0[0] + o0[1] * o0[1]) + (o0[2] * o0[2] + o0[3] * o0[3]) + (o1[0] * o1[0] + o1[1] * o1[1]) + (o1[2] * o1[2] + o1[3] * o1[3]);
                    u32x4 w; w.x = cvtpk(o0[0], o0[1]); w.y = cvtpk(o0[2], o0[3]); w.z = cvtpk(o1[0], o1[1]); w.w = cvtpk(o1[2], o1[3]);
                    *(u32x4*)(X1B + off) = w; }
                ss += xor16(ss); ss = sum_halves(ss);
                if (fq == 0) SSQ[row * 16 + u.pn * 4 + wc] = ss; }
            asm volatile("" ::: "memory");
        }
    }
};

struct Epi4 {
    static constexpr bool PERM = true;
    const float* convw; const float* convb; bf16_t* ACT; float* UE; float* UF; LAS float* xch; LAS const float* rtab; LAS const float* ctab;
    bool skip = false;
    __device__ __forceinline__ void operator()(f32x4 (&acc)[2][2][4][2], const pg8::Unit& u, int wr, int wc, int fr, int fq) const {
        const int lane = fr + 16 * fq;
        const int rowbase = u.pm * 256 + 128 * wr + 8 * fr;
        const int jj = 32 * wc + 8 * fq;
        const bool bstart = (u.pm & 15) == 0;
        {
            LAS const float* tb = rtab + ((u.pm >> 3) & 1) * 256 + 128 * wr + 8 * fr;
            const f32x4 ra = *(LAS const f32x4*)tb, rb = *(LAS const f32x4*)(tb + 4);
#pragma unroll
            for (int i = 0; i < 8; ++i) { const float rs = (i < 4) ? ra[i & 3] : rb[i & 3];
#pragma unroll
                for (int bj = 0; bj < 2; ++bj)
#pragma unroll
                    for (int n = 0; n < 2; ++n) acc[i >> 2][bj][i & 3][n] *= rs; }
        }
#define U4(bj, n, i) acc[(i) >> 2][bj][(i) & 3][n]
        if (wr == 0 && fr == 0) {
#pragma unroll
            for (int i = 0; i < 2; ++i)
#pragma unroll
                for (int bj = 0; bj < 2; ++bj)
#pragma unroll
                    for (int n = 0; n < 2; ++n) *(f32x4*)(UF + (size_t)(u.pm * 2 + i) * 5632 + u.pn * 256 + 128 * bj + jj + 4 * n) = U4(bj, n, i);
        }
        if (wr == 1 && fr == 15) {
#pragma unroll
            for (int i = 0; i < 2; ++i)
#pragma unroll
                for (int bj = 0; bj < 2; ++bj)
#pragma unroll
                    for (int n = 0; n < 2; ++n) *(f32x4*)(UE + (size_t)(u.pm * 2 + i) * 5632 + u.pn * 256 + 128 * bj + jj + 4 * n) = U4(bj, n, 6 + i);
        }
        if (wr == 0 && fr == 15) {
#pragma unroll
            for (int i = 0; i < 2; ++i)
#pragma unroll
                for (int bj = 0; bj < 2; ++bj)
#pragma unroll
                    for (int n = 0; n < 2; ++n) *(LAS f32x4*)(xch + ((((wc * 2 + i) * 2 + bj) * 2 + n) * 4 + fq) * 4) = U4(bj, n, 6 + i);
        }
        asm volatile("s_waitcnt lgkmcnt(0)" ::: "memory"); __builtin_amdgcn_s_barrier(); asm volatile("" ::: "memory");
        const int src = (lane & 48) | ((fr - 1) & 15);
        const int cha = u.pn * 128 + jj;
#pragma unroll
        for (int n = 0; n < 2; ++n) {
            asm volatile("" ::: "memory"); __builtin_amdgcn_sched_barrier(0);
            f32x4 p6[2], p7[2], w0[2], w1[2], w2[2], cb[2];
#pragma unroll
            for (int bj = 0; bj < 2; ++bj) {
                f32x4 h6 = (f32x4){0.f, 0.f, 0.f, 0.f}, h7 = h6;
                if (wr == 1) { h6 = *(LAS const f32x4*)(xch + ((((wc * 2 + 0) * 2 + bj) * 2 + n) * 4 + fq) * 4); h7 = *(LAS const f32x4*)(xch + ((((wc * 2 + 1) * 2 + bj) * 2 + n) * 4 + fq) * 4); }
#pragma unroll
                for (int e = 0; e < 4; ++e) { const float a6 = __shfl(U4(bj, n, 6)[e], src), a7 = __shfl(U4(bj, n, 7)[e], src); p6[bj][e] = (fr == 0) ? h6[e] : a6; p7[bj][e] = (fr == 0) ? h7[e] : a7; }
                LAS const float* ct = ctab + u.par * 1024 + bj * 512 + jj + 4 * n;
                w0[bj] = *(LAS const f32x4*)ct; w1[bj] = *(LAS const f32x4*)(ct + 128); w2[bj] = *(LAS const f32x4*)(ct + 256); cb[bj] = *(LAS const f32x4*)(ct + 384);
            }
#pragma unroll
            for (int i = 0; i < 8; ++i) {
                f32x4 c[2];
#pragma unroll
                for (int bj = 0; bj < 2; ++bj) {
                    const f32x4 um1 = (i >= 1) ? U4(bj, n, i >= 1 ? i - 1 : 0) : p7[bj];
                    const f32x4 um2 = (i >= 2) ? U4(bj, n, i >= 2 ? i - 2 : 0) : ((i == 1) ? p7[bj] : p6[bj]);
                    c[bj] = cb[bj] + w2[bj] * U4(bj, n, i) + w1[bj] * um1 + w0[bj] * um2;
                }
                f32x4 a;
#pragma unroll
                for (int e = 0; e < 4; ++e) { const float z = c[0][e]; a[e] = z * __builtin_amdgcn_rcpf(1.0f + __builtin_amdgcn_exp2f(-z * LOG2E)) * c[1][e]; }
                u32x2 w; w.x = cvtpk(a[0], a[1]); w.y = cvtpk(a[2], a[3]);
                const bool skip = (wr == 0 && fr == 0 && i < 2 && !bstart);
                if (!skip) *(u32x2*)(ACT + (size_t)(rowbase + i) * DFF_ + cha + 4 * n) = w;
            }
        }
#undef U4
    }
};

struct P4Order : pg8::StaticOrder {
    const float* SSQ; LAS float* rtab; mutable int lastpm; const float* convw; const float* convb; LAS unsigned char* ctab;
    __device__ __forceinline__ void a_ready(const pg8::Unit& u) const {
        { int t = threadIdx.x; asm volatile("" : "+v"(t)); const int w = __builtin_amdgcn_readfirstlane(t >> 6);
          if (w < 4) { const int bj = t >> 7, tap = (t >> 5) & 3, c4 = t & 31; const float* src = (tap < 3 ? convw + tap * 5632 : convb) + bj * DFF_ + u.pn * 128 + 4 * c4;
              __builtin_amdgcn_global_load_lds((const unsigned*)src, (LAS unsigned*)(ctab + u.par * 4096 + w * 1024), 16, 0, 0); } }
        if (u.pm == lastpm) return;
        lastpm = u.pm;
        const int t = threadIdx.x;
        if (t < 256) {
            const float* sp = SSQ + (size_t)(u.pm * 256 + t) * 16;
            const f32x4 s0 = *(const f32x4*)sp, s1 = *(const f32x4*)(sp + 4), s2 = *(const f32x4*)(sp + 8), s3 = *(const f32x4*)(sp + 12);
            const float tot = ((s0[0] + s0[1]) + (s0[2] + s0[3])) + ((s1[0] + s1[1]) + (s1[2] + s1[3])) + ((s2[0] + s2[1]) + (s2[2] + s2[3])) + ((s3[0] + s3[1]) + (s3[2] + s3[3]));
            rtab[((u.pm >> 3) & 1) * 256 + t] = 1.0f / sqrtf(tot * (1.f / 1024.f) + EPS_);
        }
    }
};

struct Epi5 {
    static constexpr bool PERM = true;
    const bf16_t* X1B; const bf16_t* X1L; float* dst;
    bool skip = false;
    __device__ __forceinline__ void operator()(const f32x4 (&acc)[2][2][4][2], const pg8::Unit& u, int wr, int wc, int fr, int fq) const {
        const int col = u.pn * 256 + wc * 64 + 8 * fq;
#pragma unroll
        for (int ai = 0; ai < 2; ++ai) {
            u32x4 hv[4][2];
#pragma unroll
            for (int m = 0; m < 4; ++m) { const size_t row = (size_t)(u.pm * 256 + ai * 128 + wr * 64 + m * 16 + fr);
#pragma unroll
                for (int bj = 0; bj < 2; ++bj) { const size_t off = row * 1024 + col + 32 * bj; hv[m][bj] = *(const u32x4*)(X1B + off); } }
            asm volatile("" ::: "memory");
#pragma unroll
            for (int m = 0; m < 4; ++m) { const size_t row = (size_t)(u.pm * 256 + ai * 128 + wr * 64 + m * 16 + fr);
#pragma unroll
                for (int bj = 0; bj < 2; ++bj) { float* q = dst + row * 1024 + col + 32 * bj; const u32x4 h = hv[m][bj];
                    const f32x4 x0 = (f32x4){bflo(h.x), bfhi(h.x), bflo(h.y), bfhi(h.y)};
                    const f32x4 x1 = (f32x4){bflo(h.z), bfhi(h.z), bflo(h.w), bfhi(h.w)};
                    *(f32x4*)q = x0 + acc[ai][bj][m][0]; *(f32x4*)(q + 4) = x1 + acc[ai][bj][m][1]; } }
            asm volatile("" ::: "memory");
        }
    }
};
struct P5Order : pg8::StaticOrder {
    const float* UE; const float* UF; const float* convw; const float* convb; bf16_t* ACT;
    __device__ __forceinline__ void a_ready(const pg8::Unit& u) const {
        if ((u.pm & 15) != 0) {
            for (int ch = threadIdx.x; ch < DFF_; ch += 512) {
                const int pa = 256 * (ch >> 7) + (ch & 127), pg = pa + 128;
                const float* e = UE + (size_t)((u.pm - 1) * 2) * 5632; const float* f = UF + (size_t)(u.pm * 2) * 5632;
                float r[2];
#pragma unroll
                for (int i = 0; i < 2; ++i) {
                    float cc[2];
#pragma unroll
                    for (int s = 0; s < 2; ++s) { const int p = s ? pg : pa, cch = s * DFF_ + ch;
                        const float um2 = e[p], um1 = e[5632 + p], u0 = f[p], u1 = f[5632 + p];
                        const float w0 = convw[cch], w1 = convw[5632 + cch], w2 = convw[2 * 5632 + cch], b = convb[cch];
                        cc[s] = (i == 0) ? b + w0 * um2 + w1 * um1 + w2 * u0 : b + w0 * um1 + w1 * u0 + w2 * u1; }
                    r[i] = cc[0] * __builtin_amdgcn_rcpf(1.0f + __builtin_amdgcn_exp2f(-cc[0] * LOG2E)) * cc[1];
                }
                const unsigned w = cvtpk(r[0], r[1]);
                ACT[(size_t)(u.pm * 256) * DFF_ + ch] = (bf16_t)(w & 0xffffu); ACT[(size_t)(u.pm * 256 + 1) * DFF_ + ch] = (bf16_t)(w >> 16);
            }
        }
        asm volatile("s_waitcnt vmcnt(0)" ::: "memory"); __builtin_amdgcn_s_barrier(); asm volatile("" ::: "memory");
    }
};

__device__ __forceinline__ Args opaque_args() {
    Args a{};
#if defined(__HIP_DEVICE_COMPILE__)
    typedef const __attribute__((address_space(4))) Args* KArgsPtr;
    KArgsPtr p = (KArgsPtr)__builtin_amdgcn_kernarg_segment_ptr(); asm volatile("" : "+s"(p));
#pragma unroll
    for (int i = 0; i < 25; ++i) a.in[i] = p->in[i];
    a.out = p->out; a.ws = p->ws; a.ph_lo = p->ph_lo; a.ph_hi = p->ph_hi; a.li = p->li; a.pad = p->pad;
#endif
    return a;
}
__device__ __forceinline__ int opaque_tid() { int t = threadIdx.x; asm volatile("" : "+v"(t)); return t; }
__global__ void __launch_bounds__(NWAVES * 64, 2) fwd_kernel(Args args_by_value) {
    const Args args0 = opaque_args();
    extern __shared__ __attribute__((aligned(16))) unsigned char lds_raw[];
    LAS unsigned char* lds = (LAS unsigned char*)lds_raw;
    volatile LAS unsigned* MISC = (volatile LAS unsigned*)(lds + MISC_OFF);
    const int tid = threadIdx.x, lane = tid & 63, wave = __builtin_amdgcn_readfirstlane(tid >> 6);
    const int G = gridDim.x; const int bx = blockIdx.x; const int vcu = (G % 8 == 0) ? (bx % 8) * (G / 8) + bx / 8 : bx;
    unsigned char* ws = args0.ws;
    gu32* ctl = (gu32*)(ws + WS_CTL);
    for (int u = tid; u < (LDS_BYTES - LDSCTL_OFF) / 4; u += NWAVES * 64) ((LAS unsigned*)(lds + LDSCTL_OFF))[u] = 0u;
    __syncthreads();
    XcdBarrier bar; bar.bar = g_barrier_words + args0.li * XCD_BAR_WORDS; bar.nx = G < 8 ? (unsigned)G : 8u; bar.x = (unsigned)bx % bar.nx; bar.nloc = ((unsigned)G - bar.x + bar.nx - 1u) / bar.nx;
#ifdef PROBE_PH
    const unsigned long long tk0 = __builtin_amdgcn_s_memrealtime(); int nst = 0;
#define GRID_BAR() do { if (!MK_MULTI) xcd_barrier(bar); if (bx == 0 && tid == 0) { ((float*)(ws + WS_CTL + 768 * 1024))[nst] = (float)(__builtin_amdgcn_s_memrealtime() - tk0); } ++nst; } while (0)
#else
#define GRID_BAR() do { if (!MK_MULTI) xcd_barrier(bar); } while (0)
#endif
    const int lo = args0.ph_lo, hi = args0.ph_hi;
#ifndef PHASE_MASK
#define PHASE_MASK 0xff
#endif
#define IN(k) (((PHASE_MASK >> (k)) & 1) && lo <= (k) && (k) < hi)
#define BOTH(k) (IN(k) && IN((k) + 1))

    if (IN(0)) { const Args args = opaque_args(); const int t_ = opaque_tid(); p0_prologue(args, lds, vcu, G, __builtin_amdgcn_readfirstlane(t_ >> 6), t_ & 63); if (BOTH(0)) GRID_BAR(); }
#ifdef PROBE_BARS
    for (int xb = 0; xb < PROBE_BARS; ++xb) GRID_BAR();
#endif

    if (IN(1)) { const Args args = opaque_args();
        constexpr int NUB = 64 * 26 + 16;
        const unsigned* ropep = (const unsigned*)((unsigned char*)args.out + DO_ROPE);
        {
            pg8::Gemm g{(const bf16_t*)(ws + WS_A1I8), (const bf16_t*)((unsigned char*)args.out + DO_WI8), T_ + NB_ * MEM_, NCAT, 512 + args0.pad};
            TileOrder S; S.init(0x3FFFFFFu, 1, G, bx);
            Epi1 E{ws, ropep, args.in[I_AQ], args.in[I_AK], args.in[I_BQ], args.in[I_BK], args.in[I_BGATE], (const float*)(ws + WS_RSC), (const float*)(ws + WS_CMAX), lds};
            pg8::gemm_phase<Epi1, TileOrder, true, false, false, 2, true>(lds + RING_OFF, g, S, E);
            { const int nrem = NUB % G;
              const int t_ = opaque_tid(), w_ = __builtin_amdgcn_readfirstlane(t_ >> 6), l_ = t_ & 63;
              if (nrem == 0) p0_late_weights<0>(args, bx * NWAVES + w_, G * NWAVES, l_);
              else if (bx >= nrem) p0_late_weights<0>(args, (bx - nrem) * NWAVES + w_, (G - nrem) * NWAVES, l_); }
        }
        if (BOTH(1)) GRID_BAR();
    }

    if (IN(2)) { const Args args = opaque_args(); const int t_ = opaque_tid(); p2_attention(args, lds, vcu, t_, __builtin_amdgcn_readfirstlane(t_ >> 6), t_ & 63); if (BOTH(2)) GRID_BAR(); }


    if (IN(4)) { const Args args = opaque_args();
        pg8::Gemm g{(const bf16_t*)((unsigned char*)args.out + DO_OCAT), (const bf16_t*)(ws + WS_WO), T_, 1024, KCAT};
        P3aOrder S; S.init(T_, 1024, G, bx);
        S.oag = (const bf16_t*)((unsigned char*)args.out + DO_OAG); S.ocat = (bf16_t*)((unsigned char*)args.out + DO_OCAT); S.lse = (const float*)(ws + WS_LSE);
        Epi3a E{(const unsigned char*)(ws + WS_G), (bf16_t*)(ws + WS_MERGED)};
        pg8::gemm_phase<Epi3a, P3aOrder, false, false, true>(lds + RING_OFF, g, S, E);
        if (BOTH(4)) GRID_BAR();
    }

    if (IN(5)) { const Args args = opaque_args();
        pg8::Gemm g{(const bf16_t*)(ws + WS_MERGED), (const bf16_t*)(ws + WS_WOUT), T_, 1024, 1024};
        pg8::StaticOrder S; S.init(T_, 1024, G, bx);
        Epi3b E{args.in[I_X], (bf16_t*)(ws + WS_X1L), (bf16_t*)(ws + WS_X1B), (float*)(ws + WS_SSQ)};
        pg8::gemm_phase<Epi3b, pg8::StaticOrder, false, false, false>(lds + RING_OFF, g, S, E);
        if (BOTH(5)) GRID_BAR();
    }

    if (IN(6)) { const Args args = opaque_args();
        pg8::Gemm g{(const bf16_t*)(ws + WS_X1B), (const bf16_t*)(ws + WS_WUP), T_, 5632, 1024};
        P4Order S; S.init(T_, 5632, G, bx); S.SSQ = (const float*)(ws + WS_SSQ); S.rtab = (LAS float*)(lds + XCH_OFF + 2048); S.lastpm = -1; S.convw = args.in[I_CONVW]; S.convb = args.in[I_CONVB]; S.ctab = lds + CTAB_OFF;
        Epi4 E{args.in[I_CONVW], args.in[I_CONVB], (bf16_t*)(ws + WS_ACT), (float*)(ws + WS_UE), (float*)(ws + WS_UF), (LAS float*)(lds + XCH_OFF), (LAS const float*)(lds + XCH_OFF + 2048), (LAS const float*)(lds + CTAB_OFF)};
#ifdef PROBE_NOEPI
        E.skip = (args0.li == 1);
#endif
        pg8::gemm_phase<Epi4, P4Order, true, true, false>(lds + RING_OFF, g, S, E);
        { const int nrem = (64 * 22) % G;
          const int t_ = opaque_tid(), w_ = __builtin_amdgcn_readfirstlane(t_ >> 6), l_ = t_ & 63;
          if (nrem == 0) p0_late_weights<1>(args, bx * NWAVES + w_, G * NWAVES, l_);
          else if (bx >= nrem) p0_late_weights<1>(args, (bx - nrem) * NWAVES + w_, (G - nrem) * NWAVES, l_); }
        if (BOTH(6)) GRID_BAR();
    }

    if (IN(7)) { const Args args = opaque_args();
        pg8::Gemm g{(const bf16_t*)(ws + WS_ACT), (const bf16_t*)(ws + WS_WDOWN), T_, 1024, DFF_};
        P5Order S; S.init(T_, 1024, G, bx);
        S.UE = (const float*)(ws + WS_UE); S.UF = (const float*)(ws + WS_UF); S.convw = args.in[I_CONVW]; S.convb = args.in[I_CONVB]; S.ACT = (bf16_t*)(ws + WS_ACT);
        Epi5 E{(const bf16_t*)(ws + WS_X1B), (const bf16_t*)(ws + WS_X1L), args.out};
        pg8::gemm_phase<Epi5, P5Order, false, false, false>(lds + RING_OFF, g, S, E);
    }
#ifdef PROBE_PH
    if (IN(7) && bx == 0 && tid == 0) { asm volatile("s_waitcnt vmcnt(0)" ::: "memory"); float* st = (float*)(ws + WS_CTL + 768 * 1024); st[nst] = (float)(__builtin_amdgcn_s_memrealtime() - tk0);
        args.out[5] = 1000.0f * (1000.0f * floorf(st[PROBE_PH] / 1000.0f + 0.5f)); }
#endif
#ifdef PROBE_TS
    if (IN(7) && bx == 0 && tid == 0) { asm volatile("s_waitcnt vmcnt(0)" ::: "memory"); const float* dbg = (const float*)(ws + WS_CTL + 512 * 1024); args.out[5] = 1000.0f * (400.0f * floorf(dbg[PROBE_TS - 1] / 400.0f + 0.5f)); }
#endif
#undef IN
#undef BOTH
#undef GRID_BAR
}

extern "C" void kernel_launch(void* const* d_in, const int* in_sizes, int n_in, void* d_out, int out_size, void* d_ws, size_t ws_size, hipStream_t stream) {
    static int grid = 0;
    if (grid == 0) {
        if (n_in != 25 || out_size != T_ * DM_ || ws_size < WS_END) { fprintf(stderr, "kernel_launch: unexpected shapes (n_in %d, out %d, ws %zu); nothing launched\n", n_in, out_size, ws_size); grid = -1; return; }
        int dev = 0, cus = 0, per_cu = 0;
        if (hipGetDevice(&dev) != hipSuccess || hipDeviceGetAttribute(&cus, hipDeviceAttributeMultiprocessorCount, dev) != hipSuccess) { grid = -1; return; }
        if (hipFuncSetAttribute((const void*)fwd_kernel, hipFuncAttributeMaxDynamicSharedMemorySize, LDS_BYTES) != hipSuccess) { fprintf(stderr, "kernel_launch: hipFuncSetAttribute failed\n"); grid = -1; return; }
        if (hipOccupancyMaxActiveBlocksPerMultiprocessor(&per_cu, (const void*)fwd_kernel, NWAVES * 64, LDS_BYTES) != hipSuccess || per_cu < 1) { fprintf(stderr, "kernel_launch: occupancy query says %d blocks per CU\n", per_cu); }
        (void)hipGetLastError();
        grid = cus;
        if (grid != 256) fprintf(stderr, "kernel_launch: %d CUs (the phase schedules expect 256)\n", grid);
    }
    if (grid < 0) return;
    Args a{};
    for (int i = 0; i < 25; ++i) a.in[i] = (const float*)d_in[i];
    a.out = (float*)d_out; a.ws = (unsigned char*)d_ws;
#if MK_MULTI
    for (int p = 0; p < NPHASES; ++p) { a.ph_lo = p; a.ph_hi = p + 1; a.li = p; hipLaunchKernelGGL(fwd_kernel, dim3(grid), dim3(NWAVES * 64), LDS_BYTES, stream, a); }
#elif defined(PROBE_PHASE)
    a.ph_lo = 0; a.ph_hi = PROBE_PHASE + 1; a.li = 0;
    hipLaunchKernelGGL(fwd_kernel, dim3(grid), dim3(NWAVES * 64), LDS_BYTES, stream, a);
    a.ph_lo = PROBE_PHASE; a.ph_hi = NPHASES; a.li = 1;
    hipLaunchKernelGGL(fwd_kernel, dim3(grid), dim3(NWAVES * 64), LDS_BYTES, stream, a);
#else
    a.ph_lo = 0; a.ph_hi = NPHASES; a.li = 0;
    hipLaunchKernelGGL(fwd_kernel, dim3(grid), dim3(NWAVES * 64), LDS_BYTES, stream, a);
#endif
}
```

```cpp
#include <hip/hip_runtime.h>
#include <cstdio>
#include <cstdint>

#ifndef MK_MULTI
#define MK_MULTI 0
#endif
#define LAS __attribute__((address_space(3)))
#define GAS __attribute__((address_space(1)))
typedef unsigned short bf16_t;
typedef short bf16x8 __attribute__((ext_vector_type(8)));
typedef short s16x4 __attribute__((ext_vector_type(4)));
typedef float f32x4 __attribute__((ext_vector_type(4)));
typedef float f32x16 __attribute__((ext_vector_type(16)));
typedef unsigned u32x4 __attribute__((ext_vector_type(4)));
typedef unsigned u32x2 __attribute__((ext_vector_type(2)));
typedef int v4i32 __attribute__((ext_vector_type(4)));
typedef int v8i32 __attribute__((ext_vector_type(8)));

constexpr int T_ = 16384, SEQ_ = 4096, NB_ = 4, DM_ = 1024, MEM_ = 256, DFF_ = 2816;
constexpr int NCAT = 7680;
constexpr int KCAT = 1280;
constexpr float EPS_ = 1e-6f;
constexpr float LOG2E = 1.4426950408889634f;
constexpr float QSCALE64 = 0.125f * LOG2E;
constexpr float QSCALE128 = 0.08838834764831845f * LOG2E;

__device__ __forceinline__ unsigned cvtpk(float lo, float hi) {
    typedef float f2 __attribute__((ext_vector_type(2))); typedef __bf16 b2 __attribute__((ext_vector_type(2)));
    f2 v = {lo, hi}; b2 b = __builtin_convertvector(v, b2); return __builtin_bit_cast(unsigned, b);
}
__device__ __forceinline__ float xor16(float v) { return __int_as_float(__builtin_amdgcn_ds_swizzle(__float_as_int(v), 0x401F)); }
__device__ __forceinline__ float sum_halves(float v) { const auto rr = __builtin_amdgcn_permlane32_swap(__float_as_uint(v), __float_as_uint(v), false, false); return __uint_as_float(rr[0]) + __uint_as_float(rr[1]); }
__device__ __forceinline__ float bflo(unsigned w) { return __uint_as_float(w << 16); }
__device__ __forceinline__ float bfhi(unsigned w) { return __uint_as_float(w & 0xffff0000u); }

namespace pg8 {
constexpr int BM = 256, BK = 64, HALF = 128, HTB = HALF * BK * 2, STAGE_BYTES = 8 * HTB, NXCD = 8, WGM = 8;
__host__ __device__ __forceinline__ int lds_byte(int r, int c) { const int st = (r >> 4) * 2 + (c >> 5), rr = r & 15, cc = c & 31, ob = rr * 64 + cc * 2; return st * 1024 + (ob ^ (((ob >> 9) & 1) << 5)); }
__host__ __device__ __forceinline__ void stage_rc(int b, int& R, int& C) { const int st = b / 1024, sb = b % 1024, swz = sb ^ (((sb >> 9) & 1) << 5); R = (st >> 1) * 16 + swz / 64; C = (st & 1) * 32 + (swz % 64) / 2; }
__host__ __device__ __forceinline__ int perm32(int rho) { const int n = rho >> 4, i = rho & 15; return 8 * (i >> 2) + 4 * n + (i & 3); }

struct Unit { int pm, pn, par; };
struct Gemm { const bf16_t* A; const bf16_t* Bt; int M, N, K; };

struct StaticOrder {
    int nM, nN, nwg, G, c;
    __host__ __device__ void init(int M, int N, int G_, int c_) { nM = M / BM; nN = N / BM; nwg = nM * nN; G = G_; c = c_; }
    __host__ __device__ bool next(int i, Unit& u) const {
        const long L = (long)i * G + c; if (L >= nwg) return false;
        int wgid = (int)L; { const int q = nwg / NXCD, r = nwg % NXCD, xcd = wgid % NXCD, off = wgid / NXCD; wgid = (xcd < r ? xcd * (q + 1) : r * (q + 1) + (xcd - r) * q) + off; }
        const int nig = WGM * nN, gid = wgid / nig, fm = gid * WGM, gsz = (nM - fm) < WGM ? (nM - fm) : WGM;
        u.pm = fm + ((wgid % nig) % gsz); u.pn = (wgid % nig) / gsz; return true;
    }
    __device__ __forceinline__ void a_ready(const Unit&) const {}
    __device__ __forceinline__ void done(const Unit&) const {}
};

template <class Epi, class Sched, bool ALIGN_EPI, bool PERMA, bool KHOOK, int QM = 0, bool PREF = false>
__device__ __forceinline__ void gemm_phase(LAS unsigned char* lds, const Gemm g, const Sched& S, const Epi& E) {
    constexpr bool FP8 = (QM == 1), I8 = (QM == 2);
    int tid_ = threadIdx.x; asm volatile("" : "+v"(tid_));
    const int tid = tid_, wid = __builtin_amdgcn_readfirstlane(tid >> 6), lane = tid & 63, wr = wid >> 2, wc = wid & 3, fr = lane & 15, fq = lane >> 4;
    const int K = g.K, nt = K / BK;
    unsigned voffA0, voffA1, voffB;
    { int R, C; stage_rc(tid * 16, R, C); const int Rb = (R & ~31) + perm32(R & 31);
        if (PERMA) { const int rw = R >> 6, rm = (R >> 4) & 3, rf = R & 15; voffA0 = (unsigned)((128 * rw + 8 * rf + rm) * K + C) * 2u; voffA1 = (unsigned)((128 * rw + 8 * rf + 4 + rm) * K + C) * 2u; }
        else { voffA0 = (unsigned)(R * K + C) * 2u; voffA1 = voffA0; }
        voffB = (unsigned)(Rb * K + C) * 2u; }
    const size_t pstep_voffA0 = (size_t)(PERMA ? 128 : 64) * K * 2, pstep_voffA1 = pstep_voffA0, pstep_voffB = (size_t)64 * K * 2;
    const size_t kstep = (size_t)(BK * 2);
    const size_t hstep = (size_t)HALF * K * 2;
    const size_t ahs = PERMA ? (size_t)0 : hstep;
    const size_t tstep = 2 * hstep;
    const unsigned ldsw = (unsigned)wid * 1024u;
    const int aoff = lds_byte(wr * 64 + fr, fq * 8), boff = lds_byte(wc * 32 + fr, fq * 8);
#define PG8_SA(b, h) (((b) * 2 + (h)) * HTB)
#define PG8_SB(b, h) ((4 + (b) * 2 + (h)) * HTB)
#define PG8_STAGE(bufoff, gbase, voff) do { _Pragma("unroll") for (int _i = 0; _i < 2; ++_i) { unsigned _v = (voff); asm volatile("" : "+v"(_v));     \
        __builtin_amdgcn_global_load_lds((const unsigned*)((const char*)(gbase) + _i * PG8_PSTEP(voff) + _v), (LAS unsigned*)(lds + (bufoff) + ldsw + _i * 8192), 16, 0, 0); } } while (0)
#define PG8_PSTEP(voff) pstep_##voff
#define PG8_LD8(p) __builtin_shufflevector(*(const LAS v4i32*)(p), *(const LAS v4i32*)((p) + 1024), 0, 1, 2, 3, 4, 5, 6, 7)
#define PG8_LDA(dst, b, h) do { if constexpr (false) { _Pragma("unroll") for (int m = 0; m < 4; ++m) dst##8[m] = PG8_LD8(lds + PG8_SA(b, h) + aoff + m * 2048); } \
        else { _Pragma("unroll") for (int m = 0; m < 4; ++m) _Pragma("unroll") for (int k = 0; k < 2; ++k) dst[m][k] = *(const LAS bf16x8*)(lds + PG8_SA(b, h) + aoff + m * 2048 + k * 1024); } } while (0)
#define PG8_LDB(dst, b, h) do { if constexpr (false) { _Pragma("unroll") for (int n = 0; n < 2; ++n) dst##8[n] = PG8_LD8(lds + PG8_SB(b, h) + boff + n * 2048); } \
        else { _Pragma("unroll") for (int n = 0; n < 2; ++n) _Pragma("unroll") for (int k = 0; k < 2; ++k) dst[n][k] = *(const LAS bf16x8*)(lds + PG8_SB(b, h) + boff + n * 2048 + k * 1024); } } while (0)
#define PG8_CAT(x) __builtin_shufflevector(__builtin_bit_cast(v4i32, (x)[0]), __builtin_bit_cast(v4i32, (x)[1]), 0, 1, 2, 3, 4, 5, 6, 7)
#define PG8_MMA(ai, bj, At, Bt) do { if constexpr (FP8) __builtin_amdgcn_sched_barrier(0); __builtin_amdgcn_s_setprio(1); _Pragma("unroll") for (int m = 0; m < 4; ++m) _Pragma("unroll") for (int n = 0; n < 2; ++n) { \
        if constexpr (FP8) acc[ai][bj][m][n] = __builtin_amdgcn_mfma_scale_f32_16x16x128_f8f6f4(PG8_CAT(Bt[n]), PG8_CAT(At[m]), acc[ai][bj][m][n], 0, 0, 0, 0, 0, 0); \
        else if constexpr (I8) { _Pragma("unroll") for (int k = 0; k < 2; ++k) acc[ai][bj][m][n] = __builtin_bit_cast(f32x4, __builtin_amdgcn_mfma_i32_16x16x64_i8(__builtin_bit_cast(v4i32, Bt[n][k]), __builtin_bit_cast(v4i32, At[m][k]), __builtin_bit_cast(v4i32, acc[ai][bj][m][n]), 0, 0, 0)); } \
        else { _Pragma("unroll") for (int k = 0; k < 2; ++k) acc[ai][bj][m][n] = __builtin_amdgcn_mfma_f32_16x16x32_bf16(Bt[n][k], At[m][k], acc[ai][bj][m][n], 0, 0, 0); } } if constexpr (FP8) __builtin_amdgcn_sched_barrier(0); __builtin_amdgcn_s_setprio(0); if constexpr (FP8) __builtin_amdgcn_sched_barrier(0); } while (0)
#define PG8_WAIT_V(n) asm volatile("s_waitcnt vmcnt(" #n ")" ::: "memory")
#define PG8_WAIT_L(n) asm volatile("s_waitcnt lgkmcnt(" #n ")" ::: "memory")
#define PG8_BAR __builtin_amdgcn_s_barrier()
#define PG8_SCHED __builtin_amdgcn_sched_barrier(0)
    Unit cur, nxt; int ui = 0;
    if (!S.next(0, cur)) return;
    cur.par = 0;
    f32x4 acc[2][2][4][2];
#pragma unroll
    for (int a = 0; a < 2; ++a)
#pragma unroll
        for (int b = 0; b < 2; ++b)
#pragma unroll
            for (int m = 0; m < 4; ++m)
#pragma unroll
                for (int n = 0; n < 2; ++n) acc[a][b][m][n] = (f32x4){0.f, 0.f, 0.f, 0.f};
    bf16x8 At[4][2], B0[2][2], B1[2][2];
    v8i32 At8[4], B08[2], B18[2];
    const char* cA = (const char*)g.A + (size_t)cur.pm * tstep; const char* cB = (const char*)g.Bt + (size_t)cur.pn * tstep;
    PG8_STAGE(PG8_SB(0, 0), cB, voffB); PG8_STAGE(PG8_SB(0, 1), cB + hstep, voffB);
    S.a_ready(cur);
    PG8_STAGE(PG8_SA(0, 0), cA, voffA0); PG8_STAGE(PG8_SA(0, 1), cA + ahs, voffA1);
    if (wr == 1) PG8_BAR;
    PG8_WAIT_V(2); PG8_BAR;
    PG8_STAGE(PG8_SB(1, 0), cB + kstep, voffB); PG8_STAGE(PG8_SA(1, 0), cA + kstep, voffA0); PG8_STAGE(PG8_SB(1, 1), cB + hstep + kstep, voffB);
    PG8_WAIT_V(6); PG8_BAR;
    for (;;) {
        const bool has_next = S.next(ui + 1, nxt); nxt.par = (ui + 1) & 1;
        const char* nA = has_next ? (const char*)g.A + (size_t)nxt.pm * tstep : cA; const char* nB = has_next ? (const char*)g.Bt + (size_t)nxt.pn * tstep : cB;
        for (int t = 0; t < nt; t += 2) {
            const bool last = (t == nt - 2);
            const char* a1 = cA + (size_t)(t + 1) * kstep;
            const char* a2 = last ? nA : cA + (size_t)(t + 2) * kstep; const char* b2 = last ? nB : cB + (size_t)(t + 2) * kstep;
            const char* a3 = a2 + kstep; const char* b3 = b2 + kstep;
            asm volatile("" : "+s"(a1), "+s"(a2), "+s"(b2), "+s"(a3), "+s"(b3));
            if (last && has_next) S.a_ready(nxt);
            if constexpr (KHOOK) { int l3_ = threadIdx.x; asm volatile("" : "+v"(l3_)); E.khook(acc, cur, t, wr, wc, l3_ & 15, (l3_ >> 4) & 3); }
            PG8_LDB(B0, 0, 0); PG8_LDB(B1, 0, 1); PG8_SCHED; PG8_LDA(At, 0, 0); PG8_STAGE(PG8_SA(1, 1), a1 + ahs, voffA1);
            PG8_WAIT_V(8); PG8_WAIT_L(0); PG8_BAR;
            if constexpr (PREF) { if (t == 0 && wr == 0) E.prefetch(cur, wid); }
            PG8_MMA(0, 0, At, B0); PG8_MMA(0, 1, At, B1); PG8_BAR; PG8_SCHED;
            PG8_LDA(At, 0, 1); PG8_STAGE(PG8_SB(0, 0), b2, voffB); PG8_STAGE(PG8_SB(0, 1), b2 + hstep, voffB); PG8_STAGE(PG8_SA(0, 0), a2, voffA0);
            PG8_WAIT_V(8); PG8_WAIT_L(0); PG8_BAR; PG8_MMA(1, 0, At, B0); PG8_MMA(1, 1, At, B1); PG8_BAR; PG8_SCHED;
            PG8_LDB(B0, 1, 0); PG8_LDB(B1, 1, 1); PG8_SCHED; PG8_LDA(At, 1, 0); PG8_STAGE(PG8_SA(0, 1), a2 + ahs, voffA1);
            PG8_WAIT_V(8); PG8_WAIT_L(0); PG8_BAR; PG8_MMA(0, 0, At, B0); PG8_MMA(0, 1, At, B1); PG8_BAR; PG8_SCHED;
            PG8_LDA(At, 1, 1); PG8_STAGE(PG8_SB(1, 0), b3, voffB); PG8_STAGE(PG8_SB(1, 1), b3 + hstep, voffB); PG8_STAGE(PG8_SA(1, 0), a3, voffA0);
            PG8_WAIT_V(8); PG8_WAIT_L(0); PG8_BAR; PG8_MMA(1, 0, At, B0); PG8_MMA(1, 1, At, B1); PG8_BAR; PG8_SCHED;
        }
        if constexpr (ALIGN_EPI) { if (wr == 0) PG8_BAR; }
        { int l2_ = threadIdx.x; asm volatile("" : "+v"(l2_)); const int fr2 = l2_ & 15, fq2 = (l2_ >> 4) & 3;
          if (!E.skip) E(acc, cur, wr, wc, fr2, fq2); } S.done(cur);
        if (!has_next) break;
#pragma unroll
        for (int a = 0; a < 2; ++a)
#pragma unroll
            for (int b = 0; b < 2; ++b)
#pragma unroll
                for (int m = 0; m < 4; ++m)
#pragma unroll
                    for (int n = 0; n < 2; ++n) acc[a][b][m][n] = (f32x4){0.f, 0.f, 0.f, 0.f};
        cur = nxt; cA = nA; cB = nB; ++ui;
        if constexpr (ALIGN_EPI) { if (wr == 1) PG8_BAR; }
    }
    PG8_WAIT_V(0);
    if constexpr (!ALIGN_EPI) { if (wr == 0) PG8_BAR; }
    PG8_BAR;
#undef PG8_SA
#undef PG8_SB
#undef PG8_STAGE
#undef PG8_PSTEP
#undef PG8_LDA
#undef PG8_LDB
#undef PG8_MMA
#undef PG8_CAT
#undef PG8_LD8
#undef PG8_WAIT_V
#undef PG8_WAIT_L
#undef PG8_BAR
#undef PG8_SCHED
}
}

constexpr size_t MiB = 1u << 20;
constexpr size_t WS_CTL = 0, CTL_ZERO_BYTES = 1 * MiB;
constexpr size_t WS_WO = 1 * MiB;
constexpr size_t WS_WOUT = 4 * MiB;
constexpr size_t WS_WUP = 6 * MiB;
constexpr size_t WS_WDOWN = 17 * MiB;
constexpr size_t WS_SSQ = 23 * MiB;
constexpr size_t WS_UE = 24 * MiB;
constexpr size_t WS_UF = 27 * MiB;
constexpr size_t WS_LSE = 30 * MiB;
constexpr size_t WS_MKV = 31 * MiB;
constexpr size_t WS_G = 34 * MiB;
constexpr size_t WS_A1I8 = 84 * MiB;
constexpr size_t WS_RSC = 23 * MiB;
constexpr size_t WS_CMAX = 23 * MiB + 128 * 1024;
constexpr size_t WS_ACT = 34 * MiB;
constexpr size_t WS_QA = 130 * MiB;
constexpr size_t WS_KA = 154 * MiB;
constexpr size_t WS_VA = 178 * MiB;
constexpr size_t WS_MERGED = 130 * MiB;
constexpr size_t WS_X1B = 162 * MiB;
constexpr size_t WS_X1L = 194 * MiB;
constexpr size_t WS_QB = 202 * MiB;
constexpr size_t WS_KVB = 218 * MiB;
constexpr size_t WS_MQ = 226 * MiB;
constexpr size_t WS_END = 242 * MiB;
constexpr size_t DO_WI8 = 34 * MiB;
constexpr size_t DO_ROPE = 49 * MiB;
constexpr size_t DO_OCAT = 0;
constexpr size_t DO_OAG = 40 * MiB;

constexpr int CW_TMO = 0, CW_BAR = 4096;

constexpr int RING_OFF = 0, RING_BYTES = 131072;
constexpr int XCH_OFF = RING_BYTES;
constexpr int LDSCTL_OFF = RING_BYTES + 4096, MISC_OFF = LDSCTL_OFF + 320;
constexpr int LDS_BYTES = 147456;
constexpr int P1T_ROPE = 131072, P1T_CS = 139264, P1T_BIAS = 140288, P1T_RSC = 141312, P1T_GAIN = 142336;
constexpr int CTAB_OFF = 139264;
constexpr int NWAVES = 8;
constexpr int NPHASES = 8;

typedef GAS unsigned gu32;
#define RLX_AGENT __ATOMIC_RELAXED, __HIP_MEMORY_SCOPE_AGENT
#define LDS_WAIT() asm volatile("s_waitcnt lgkmcnt(0)" ::: "memory")
#define VM_WAIT() asm volatile("s_waitcnt vmcnt(0)" ::: "memory")

#define XB_TMO      128
#define XB_XCNT(j)  (256  + 64 * (j))
#define XB_XSUB(j)  (1280 + 64 * (j))
#define XB_XGEN(j)  (2304 + 64 * (j))
#define XB_TOP      3328
#define XB_TOPGEN   3392
#define XCD_BAR_WORDS 3456
#define XB_SPIN_CAP (1u << 18)
__device__ __forceinline__ unsigned xb_ld(unsigned* p)              { return __hip_atomic_load(p, __ATOMIC_RELAXED, __HIP_MEMORY_SCOPE_AGENT); }
__device__ __forceinline__ unsigned xb_add(unsigned* p, unsigned v) { return __hip_atomic_fetch_add(p, v, __ATOMIC_RELAXED, __HIP_MEMORY_SCOPE_AGENT); }
__device__ __forceinline__ unsigned xb_xcc_id() { return (unsigned)__builtin_amdgcn_s_getreg((3 << 11) | 20) & 0xFu; }
#define XB_SPIN(cond, bar) do { unsigned _sp = 0; while (cond) { __builtin_amdgcn_s_sleep(1); \
    if ((++_sp & 255u) == 0u) { if (xb_ld(&(bar)[XB_TMO])) break; if (_sp > XB_SPIN_CAP) { atomicAdd(&(bar)[XB_TMO], 1u); break; } } } } while (0)
__device__ unsigned g_barrier_words[2 * XCD_BAR_WORDS];
struct XcdBarrier { unsigned* bar; unsigned x, nloc, nx; };
__device__ __forceinline__ void xcd_barrier(const XcdBarrier& b) {
    asm volatile("s_waitcnt vmcnt(0)" ::: "memory");
    __syncthreads();
    if (threadIdx.x == 0) {
        unsigned* bar = b.bar;
        __builtin_amdgcn_s_waitcnt(0);
        const unsigned nloc = b.nloc, nx = b.nx;
        const unsigned old = xb_add(&bar[XB_XSUB(b.x)], 1u);
        const unsigned gen = old / nloc;
        if (old + 1u == (gen + 1u) * nloc) {
            __builtin_amdgcn_fence(__ATOMIC_RELEASE, "agent");
            asm volatile("s_waitcnt vmcnt(0)" ::: "memory");
            const unsigned og = xb_add(&bar[XB_TOP], 1u);
            const unsigned tg = og / nx;
            if (og + 1u == (tg + 1u) * nx) xb_add(&bar[XB_TOPGEN], 1u);
            else XB_SPIN(xb_ld(&bar[XB_TOPGEN]) == tg, bar);
            __builtin_amdgcn_fence(__ATOMIC_ACQUIRE, "agent");
            xb_add(&bar[XB_XGEN(b.x)], 1u);
            asm volatile("s_waitcnt vmcnt(0)" ::: "memory");
        } else {
            XB_SPIN(xb_ld(&bar[XB_XGEN(b.x)]) == gen, bar);
            __builtin_amdgcn_fence(__ATOMIC_ACQUIRE, "agent");
            asm volatile("s_waitcnt vmcnt(0)" ::: "memory");
        }
    }
    __syncthreads();
}

struct Args {
    const float* in[25]; float* out; unsigned char* ws; int ph_lo, ph_hi, li, pad;
};
enum { I_X = 0, I_MEM, I_POS, I_ATTN_NORM, I_W_IN, I_AQ, I_AK, I_BQ, I_BK, I_SINK, I_MEM_NORM, I_W_MKV, I_MQN, I_MKN, I_WOA, I_WOB, I_WOM, I_WGATE, I_BGATE, I_WOUT, I_FFN_NORM, I_WUP, I_CONVW, I_CONVB, I_WDOWN };

__host__ __device__ __forceinline__ int map_uniform(int n) { const int c = n & 255; return (n & ~255) + 128 * ((c >> 5) & 1) + 32 * (c >> 6) + (c & 31); }
__host__ __device__ __forceinline__ int map_up(int n) { return n < DFF_ ? 256 * (n >> 7) + (n & 127) : 256 * ((n - DFF_) >> 7) + 128 + ((n - DFF_) & 127); }

__device__ __forceinline__ float wave_sum(float v) {
#pragma unroll
    for (int o = 1; o < 64; o <<= 1) v += __shfl_xor(v, o);
    return v;
}
template <int MAP>
__device__ __forceinline__ void p0_transpose_item(const float* W, int K, int N, bf16_t* WT, int noff, int pitch, int koff, const float* kscale, LAS float*  , int item, int lane) {
    const int nblk = N / 32, kb = item / nblk, nb = item % nblk, k0 = 64 * kb + 8 * (lane >> 3), n0 = 32 * nb;
    f32x4 v[8];
#pragma unroll
    for (int i = 0; i < 8; ++i) v[i] = *(const f32x4*)(W + (size_t)(k0 + i) * N + n0 + 4 * (lane & 7));
    if (kscale) { const f32x4 s0 = *(const f32x4*)(kscale + k0), s1 = *(const f32x4*)(kscale + k0 + 4);
#pragma unroll
        for (int i = 0; i < 8; ++i) v[i] = v[i] * (i < 4 ? s0[i & 3] : s1[i & 3]); }
    const int r0 = (MAP == 0 ? map_uniform(noff + n0) : map_up(noff + n0)) + 4 * (lane & 7);
#pragma unroll
    for (int e = 0; e < 4; ++e) { u32x4 o; o.x = cvtpk(v[0][e], v[1][e]); o.y = cvtpk(v[2][e], v[3][e]); o.z = cvtpk(v[4][e], v[5][e]); o.w = cvtpk(v[6][e], v[7][e]);
        *(GAS u32x4*)(WT + (size_t)(r0 + e) * pitch + koff + k0 + 0) = o; }
}
constexpr float I8MAGIC = 12582912.0f;
__device__ __forceinline__ unsigned pack_i8(float m0, float m1, float m2, float m3) {
    const unsigned p01 = __builtin_amdgcn_perm(__float_as_uint(m1), __float_as_uint(m0), 0x0c0c0400u);
    const unsigned p23 = __builtin_amdgcn_perm(__float_as_uint(m3), __float_as_uint(m2), 0x0c0c0400u);
    return p01 | (p23 << 16);
}
__device__ __forceinline__ float wave_max(float v) {
#pragma unroll
    for (int o = 1; o < 64; o <<= 1) v = fmaxf(v, __shfl_xor(v, o));
    return v;
}
__device__ __forceinline__ void p0_quant_weight_block(const float* W, int N, int nb, int coff, unsigned char* WT, float* cmax, LAS float* part, int wave, int lane) {
    const int n0 = 32 * nb;
    f32x4 v[2][8];
#pragma unroll
    for (int it = 0; it < 2; ++it) { const int k0 = 128 * wave + 64 * it + 8 * (lane >> 3);
#pragma unroll
        for (int i = 0; i < 8; ++i) v[it][i] = *(const f32x4*)(W + (size_t)(k0 + i) * N + n0 + 4 * (lane & 7)); }
    f32x4 mx = {0.f, 0.f, 0.f, 0.f};
#pragma unroll
    for (int it = 0; it < 2; ++it)
#pragma unroll
        for (int i = 0; i < 8; ++i)
#pragma unroll
            for (int e = 0; e < 4; ++e) mx[e] = fmaxf(mx[e], fabsf(v[it][i][e]));
#pragma unroll
    for (int o = 8; o < 64; o <<= 1)
#pragma unroll
        for (int e = 0; e < 4; ++e) mx[e] = fmaxf(mx[e], __shfl_xor(mx[e], o));
    if (lane < 8) *(LAS f32x4*)(part + wave * 32 + 4 * lane) = mx;
    __syncthreads();
    f32x4 cm = *(const LAS f32x4*)(part + 4 * (lane & 7));
#pragma unroll
    for (int w = 1; w < 8; ++w) { const f32x4 o = *(const LAS f32x4*)(part + w * 32 + 4 * (lane & 7));
#pragma unroll
        for (int e = 0; e < 4; ++e) cm[e] = fmaxf(cm[e], o[e]); }
    if (wave == 0 && lane < 8) *(f32x4*)(cmax + coff + n0 + 4 * lane) = cm;
    f32x4 inv;
#pragma unroll
    for (int e = 0; e < 4; ++e) inv[e] = cm[e] > 0.f ? 127.0f / cm[e] : 0.f;
    const int r0 = map_uniform(coff + n0) + 4 * (lane & 7);
#pragma unroll
    for (int it = 0; it < 2; ++it) { const int k0 = 128 * wave + 64 * it + 8 * (lane >> 3);
#pragma unroll
        for (int e = 0; e < 4; ++e) { u32x2 o;
            o.x = pack_i8(__builtin_fmaf(v[it][0][e], inv[e], I8MAGIC), __builtin_fmaf(v[it][1][e], inv[e], I8MAGIC), __builtin_fmaf(v[it][2][e], inv[e], I8MAGIC), __builtin_fmaf(v[it][3][e], inv[e], I8MAGIC));
            o.y = pack_i8(__builtin_fmaf(v[it][4][e], inv[e], I8MAGIC), __builtin_fmaf(v[it][5][e], inv[e], I8MAGIC), __builtin_fmaf(v[it][6][e], inv[e], I8MAGIC), __builtin_fmaf(v[it][7][e], inv[e], I8MAGIC));
            *(GAS u32x2*)(WT + (size_t)(r0 + e) * 1024 + k0) = o; } }
    __syncthreads();
}
template <int NR>
__device__ __forceinline__ void rms_rows_to_i8(const float* xrow, size_t rstride, const float* gain, unsigned char* orow, float* rsc, int lane) {
    const GAS f32x4* gr = (const GAS f32x4*)gain + lane;
    f32x4 v[NR][4]; float s[NR], mx[NR];
#pragma unroll
    for (int r = 0; r < NR; ++r) { const GAS f32x4* xr = (const GAS f32x4*)(xrow + r * rstride) + lane;
#pragma unroll
        for (int j = 0; j < 4; ++j) v[r][j] = xr[64 * j]; }
    f32x4 g[4];
#pragma unroll
    for (int j = 0; j < 4; ++j) g[j] = gr[64 * j];
#pragma unroll
    for (int r = 0; r < NR; ++r) { s[r] = 0.f;
#pragma unroll
        for (int j = 0; j < 4; ++j) s[r] += (v[r][j].x * v[r][j].x + v[r][j].y * v[r][j].y) + (v[r][j].z * v[r][j].z + v[r][j].w * v[r][j].w); }
#pragma unroll
    for (int r = 0; r < NR; ++r) { const float rstd = 1.0f / sqrtf(wave_sum(s[r]) * (1.f / 1024.f) + EPS_); mx[r] = 0.f;
#pragma unroll
        for (int j = 0; j < 4; ++j) { v[r][j] = v[r][j] * rstd * g[j];
            mx[r] = fmaxf(fmaxf(mx[r], fmaxf(fabsf(v[r][j].x), fabsf(v[r][j].y))), fmaxf(fabsf(v[r][j].z), fabsf(v[r][j].w))); } }
#pragma unroll
    for (int r = 0; r < NR; ++r) mx[r] = wave_max(mx[r]);
#pragma unroll
    for (int r = 0; r < NR; ++r) { const float inv = mx[r] > 0.f ? 127.0f / mx[r] : 0.f;
        GAS unsigned* o4 = (GAS unsigned*)(orow + r * rstride) + lane;
#pragma unroll
        for (int j = 0; j < 4; ++j) o4[64 * j] = pack_i8(__builtin_fmaf(v[r][j].x, inv, I8MAGIC), __builtin_fmaf(v[r][j].y, inv, I8MAGIC), __builtin_fmaf(v[r][j].z, inv, I8MAGIC), __builtin_fmaf(v[r][j].w, inv, I8MAGIC));
        if (lane == 0) rsc[r] = mx[r] * (1.0f / 127.0f); }
}
__device__ __forceinline__ void sincos_f(float ang, float& co, float& si) {
    const double x = (double)ang; const double n = __builtin_rint(x * 0.63661977236758134308);
    double r = __builtin_fma(-n, 1.5707963267948966192, x); r = __builtin_fma(-n, 6.123233995736766036e-17, r);
    const double r2 = r * r;
    double s = -1.0 / 6227020800.0; s = s * r2 + 1.0 / 39916800.0; s = s * r2 - 1.0 / 362880.0; s = s * r2 + 1.0 / 5040.0; s = s * r2 - 1.0 / 120.0; s = s * r2 + 1.0 / 6.0; s = r - r * r2 * s;
    double c = 1.0 / 479001600.0; c = c * r2 - 1.0 / 3628800.0; c = c * r2 + 1.0 / 40320.0; c = c * r2 - 1.0 / 720.0; c = c * r2 + 1.0 / 24.0; c = c * r2 - 0.5; c = c * r2 + 1.0;
    const int q = (int)((long long)n & 3);
    const double cs = (q == 0) ? c : (q == 1) ? -s : (q == 2) ? -c : s;
    const double sn = (q == 0) ? s : (q == 1) ? c : (q == 2) ? -s : -c;
    co = (float)cs; si = (float)sn;
}

struct Frame {
    LAS unsigned char* lds;
    int tid, lane, wave, vcu, G;
    const Args* a;
};

__device__ __forceinline__ void p0_prologue(const Args& A, LAS unsigned char* lds, int vcu, int G, int wave, int lane) {
    const int gw = vcu * NWAVES + wave, NGW = G * NWAVES;
    unsigned char* wi8 = (unsigned char*)A.out + DO_WI8;
    unsigned char* a1 = A.ws + WS_A1I8;
    float* rsc = (float*)(A.ws + WS_RSC); float* cmax = (float*)(A.ws + WS_CMAX);
    unsigned* rope = (unsigned*)((unsigned char*)A.out + DO_ROPE);
    constexpr int B_IN = 3584 / 32, B_GATE = 3072 / 32, B_MKV = 1024 / 32;
    for (int it = vcu; it < B_IN + B_GATE + B_MKV; it += G) {
        LAS float* part = (LAS float*)(lds + RING_OFF);
        if (it < B_IN) p0_quant_weight_block(A.in[I_W_IN], 3584, it, 0, wi8, cmax, part, wave, lane);
        else if (it < B_IN + B_GATE) p0_quant_weight_block(A.in[I_WGATE], 3072, it - B_IN, 3584, wi8, cmax, part, wave, lane);
        else p0_quant_weight_block(A.in[I_W_MKV], 1024, it - B_IN - B_GATE, 6656, wi8, cmax, part, wave, lane);
    }
    for (int m = 4 * gw; m < T_ + NB_ * MEM_; m += 4 * NGW) {
        if (m < T_) rms_rows_to_i8<4>(A.in[I_X] + (size_t)m * DM_, DM_, A.in[I_ATTN_NORM], a1 + (size_t)m * DM_, rsc + m, lane);
        else rms_rows_to_i8<4>(A.in[I_MEM] + (size_t)(m - T_) * DM_, DM_, A.in[I_MEM_NORM], a1 + (size_t)m * DM_, rsc + m, lane);
    }
    const int* pos = (const int*)A.in[I_POS];
    for (int idx = gw * 64 + lane; idx < T_ * 8; idx += NGW * 64) {
        const int t = idx >> 3, i = idx & 7;
        const float fr = (i == 0) ? 1.0f : (i == 1) ? 0.193922758102417f : (i == 2) ? 0.03760603442788124f : (i == 3) ? 0.007292666472494602f : (i == 4) ? 0.0014142136787995696f
                       : (i == 5) ? 0.00027424818836152554f : (i == 6) ? 5.318298644851893e-05f : 1.031338433676865e-05f;
        const float ang = (float)pos[t] * fr; float co, si; sincos_f(ang, co, si);
        rope[idx] = (unsigned)__builtin_bit_cast(unsigned short, (_Float16)co) | ((unsigned)__builtin_bit_cast(unsigned short, (_Float16)si) << 16);
    }
}

struct TItem { const float* W; bf16_t* WT; const float* kscale; int N, noff, pitch, koff, map, item; };
__device__ __forceinline__ void ti_load(const TItem& d, int lane, f32x4 (&v)[8], f32x4 (&sc)[2]) {
    const int nblk = d.N / 32, kb = d.item / nblk, nb = d.item % nblk, k0 = 64 * kb + 8 * (lane >> 3), n0 = 32 * nb;
#pragma unroll
    for (int i = 0; i < 8; ++i) v[i] = *(const f32x4*)(d.W + (size_t)(k0 + i) * d.N + n0 + 4 * (lane & 7));
    if (d.kscale) { sc[0] = *(const f32x4*)(d.kscale + k0); sc[1] = *(const f32x4*)(d.kscale + k0 + 4); }
}
__device__ __forceinline__ void ti_store(const TItem& d, int lane, f32x4 (&v)[8], const f32x4 (&sc)[2]) {
    const int nblk = d.N / 32, kb = d.item / nblk, nb = d.item % nblk, k0 = 64 * kb + 8 * (lane >> 3), n0 = 32 * nb;
    if (d.kscale) {
#pragma unroll
        for (int i = 0; i < 8; ++i) v[i] = v[i] * (i < 4 ? sc[0][i & 3] : sc[1][i & 3]); }
    const int r0 = (d.map == 0 ? map_uniform(d.noff + n0) : map_up(d.noff + n0)) + 4 * (lane & 7);
#pragma unroll
    for (int e = 0; e < 4; ++e) { u32x4 o; o.x = cvtpk(v[0][e], v[1][e]); o.y = cvtpk(v[2][e], v[3][e]); o.z = cvtpk(v[4][e], v[5][e]); o.w = cvtpk(v[6][e], v[7][e]);
        *(GAS u32x4*)(d.WT + (size_t)(r0 + e) * d.pitch + d.koff + k0) = o; }
}
template <int PART>
__device__ __forceinline__ bool late_item(const Args& A, int it, TItem& d) {
    constexpr int I_OA = (256 / 64) * (1024 / 32), I_OB = (512 / 64) * (1024 / 32), I_OM = I_OB, I_OUT = (1024 / 64) * (1024 / 32);
    constexpr int I_UP = (1024 / 64) * (5632 / 32), I_DOWN = (2816 / 64) * (1024 / 32);
    bf16_t* wo = (bf16_t*)(A.ws + WS_WO);
    if (PART == 1) { if (it >= I_DOWN) return false; d = TItem{A.in[I_WDOWN], (bf16_t*)(A.ws + WS_WDOWN), nullptr, 1024, 0, 2816, 0, 0, it}; return true; }
    int r = it;
    if (r < I_OA) { d = TItem{A.in[I_WOA], wo, nullptr, 1024, 0, KCAT, 0, 0, r}; return true; } r -= I_OA;
    if (r < I_OB) { d = TItem{A.in[I_WOB], wo, nullptr, 1024, 0, KCAT, 256, 0, r}; return true; } r -= I_OB;
    if (r < I_OM) { d = TItem{A.in[I_WOM], wo, nullptr, 1024, 0, KCAT, 768, 0, r}; return true; } r -= I_OM;
    if (r < I_OUT) { d = TItem{A.in[I_WOUT], (bf16_t*)(A.ws + WS_WOUT), nullptr, 1024, 0, 1024, 0, 0, r}; return true; } r -= I_OUT;
    if (r < I_UP) { d = TItem{A.in[I_WUP], (bf16_t*)(A.ws + WS_WUP), A.in[I_FFN_NORM], 5632, 0, 1024, 0, 1, r}; return true; }
    return false;
}
template <int PART>
__device__ __forceinline__ void p0_late_weights(const Args& A, int gw, int ngw, int lane) {
    constexpr int NB = 3;
    for (int it = gw; ; it += NB * ngw) {
        TItem d[NB]; bool ok[NB]; f32x4 v[NB][8], sc[NB][2];
#pragma unroll
        for (int b = 0; b < NB; ++b) { ok[b] = late_item<PART>(A, it + b * ngw, d[b]); if (ok[b]) ti_load(d[b], lane, v[b], sc[b]); }
        if (!ok[0]) break;
#pragma unroll
        for (int b = 0; b < NB; ++b) if (ok[b]) ti_store(d[b], lane, v[b], sc[b]);
    }
}

struct TileOrder {
    pg8::StaticOrder so; unsigned mask; int mkv;
    __device__ void init(unsigned mask_, int mkv_, int G, int c) { mask = mask_; mkv = mkv_; so.init(T_, 256 * __builtin_popcount(mask_), G, c); }
    __device__ bool next(int i, pg8::Unit& u) const {
        if (so.next(i, u)) { unsigned m = mask; for (int k = 0; k < u.pn; ++k) m &= m - 1u; u.pn = __builtin_ctz(m); return true; }
        if (!mkv) return false;
        const long L = (long)i * so.G + so.c - so.nwg; if (L < 0 || L >= 16) return false;
        u.pm = 64 + (int)(L >> 2); u.pn = 26 + (int)(L & 3); return true;
    }
    __device__ __forceinline__ void a_ready(const pg8::Unit&) const {}
    __device__ __forceinline__ void done(const pg8::Unit&) const {}
};

__device__ __forceinline__ f32x4 cvt_i32(const f32x4& a) { const v4i32 i = __builtin_bit_cast(v4i32, a); return (f32x4){(float)i[0], (float)i[1], (float)i[2], (float)i[3]}; }

__device__ __forceinline__ float h2f_lo(unsigned w) { return (float)__builtin_bit_cast(_Float16, (unsigned short)(w & 0xffffu)); }
__device__ __forceinline__ float h2f_hi(unsigned w) { return (float)__builtin_bit_cast(_Float16, (unsigned short)(w >> 16)); }

struct EpiG {
    static constexpr bool PERM = true;
    unsigned char* G; LAS const unsigned char* lds;
    bool skip = false;
    __device__ __forceinline__ void operator()(const f32x4 (&acc)[2][2][4][2], const pg8::Unit& u, int wr, int wc, int fr, int fq) const {
        const int col0 = u.pn * 256, row0 = u.pm * 256;
        f32x4 bv[2][2], cs[2][2];
#pragma unroll
        for (int bj = 0; bj < 2; ++bj)
#pragma unroll
            for (int n = 0; n < 2; ++n) { const int j = wc * 64 + 32 * bj + 8 * fq + 4 * n; bv[bj][n] = *(LAS const f32x4*)(lds + P1T_BIAS + 4 * j) * (-LOG2E); cs[bj][n] = *(LAS const f32x4*)(lds + P1T_CS + 4 * j) * (-LOG2E / 127.0f); }
        float rsv[2][4];
#pragma unroll
        for (int ai = 0; ai < 2; ++ai)
#pragma unroll
            for (int m = 0; m < 4; ++m) rsv[ai][m] = *(LAS const float*)(lds + P1T_RSC + 4 * (ai * 128 + wr * 64 + m * 16 + fr));
#pragma unroll
        for (int ai = 0; ai < 2; ++ai)
#pragma unroll
            for (int m = 0; m < 4; ++m) { unsigned char* rowp = G + (size_t)(row0 + ai * 128 + wr * 64 + m * 16 + fr) * 3072 + col0 + wc * 64 + 8 * fq;
#pragma unroll
                for (int bj = 0; bj < 2; ++bj) { u32x2 w;
#pragma unroll
                    for (int n = 0; n < 2; ++n) { const f32x4 z = (cvt_i32(acc[ai][bj][m][n]) * rsv[ai][m]) * cs[bj][n] + bv[bj][n]; unsigned q[4];
#pragma unroll
                        for (int e = 0; e < 4; ++e) { const float g = __builtin_amdgcn_rcpf(1.0f + __builtin_amdgcn_exp2f(z[e])); const unsigned qi = (unsigned)(g * 255.0f + 0.5f); q[e] = qi < 1u ? 1u : qi; }
                        w[n] = q[0] | (q[1] << 8) | (q[2] << 16) | (q[3] << 24); }
                    *(u32x2*)(rowp + 32 * bj) = w; } }
    }
};

struct Epi1 {
    static constexpr bool PERM = true;
    unsigned char* ws; const unsigned* rope; const float *aq, *ak, *bq, *bk, *bgate; const float* rsc; const float* cmax; LAS unsigned char* lds;
    bool skip = false;
    __device__ __forceinline__ void prefetch(const pg8::Unit& u, int w) const {
        int lane = threadIdx.x; asm volatile("" : "+v"(lane)); lane &= 63;
        const int pn = u.pn, pm = u.pm;
        if (pm < 64 && pn < 12) {
#pragma unroll
            for (int j = 0; j < 2; ++j) { const int piece = 2 * w + j;
                __builtin_amdgcn_global_load_lds((const unsigned*)((const char*)rope + (size_t)pm * 8192 + piece * 1024 + lane * 16), (LAS unsigned*)(lds + P1T_ROPE + piece * 1024), 16, 0, 0); }
        }
        if (w == 0) __builtin_amdgcn_global_load_lds((const unsigned*)(cmax + pn * 256 + lane * 4), (LAS unsigned*)(lds + P1T_CS), 16, 0, 0);
        else if (w == 1) { if (pn >= 14 && pn < 26) __builtin_amdgcn_global_load_lds((const unsigned*)(bgate + (pn - 14) * 256 + lane * 4), (LAS unsigned*)(lds + P1T_BIAS), 16, 0, 0); }
        else if (w == 2) __builtin_amdgcn_global_load_lds((const unsigned*)(rsc + pm * 256 + lane * 4), (LAS unsigned*)(lds + P1T_RSC), 16, 0, 0);
        else if (pn < 12) { const int gi = pn / 3, ty = pn - 3 * gi;
            const float* gp = (pn >= 11) ? bk : (pn >= 9) ? bq : (ty == 0) ? aq + 64 * gi : ak + 64 * gi;
            if (lane < 16) __builtin_amdgcn_global_load_lds((const unsigned*)(gp + lane * 4), (LAS unsigned*)(lds + P1T_GAIN), 16, 0, 0); }
    }
    __device__ __forceinline__ void plain(const f32x4 (&acc)[2][2][4][2], bf16_t* dst, int ld, int col0, int row0, int wr, int wc, int fr, int fq) const {
        f32x4 cs[2][2];
#pragma unroll
        for (int bj = 0; bj < 2; ++bj)
#pragma unroll
            for (int n = 0; n < 2; ++n) cs[bj][n] = *(LAS const f32x4*)(lds + P1T_CS + 4 * (wc * 64 + 32 * bj + 8 * fq + 4 * n)) * (1.0f / 127.0f);
        float rsv[2][4];
#pragma unroll
        for (int ai = 0; ai < 2; ++ai)
#pragma unroll
            for (int m = 0; m < 4; ++m) rsv[ai][m] = *(LAS const float*)(lds + P1T_RSC + 4 * (ai * 128 + wr * 64 + m * 16 + fr));
#pragma unroll
        for (int ai = 0; ai < 2; ++ai)
#pragma unroll
            for (int m = 0; m < 4; ++m) { bf16_t* rowp = dst + (size_t)(row0 + ai * 128 + wr * 64 + m * 16 + fr) * ld + col0 + wc * 64 + 8 * fq;
#pragma unroll
                for (int bj = 0; bj < 2; ++bj) { const f32x4 v0 = cvt_i32(acc[ai][bj][m][0]) * rsv[ai][m] * cs[bj][0], v1 = cvt_i32(acc[ai][bj][m][1]) * rsv[ai][m] * cs[bj][1];
                    u32x4 w; w.x = cvtpk(v0[0], v0[1]); w.y = cvtpk(v0[2], v0[3]); w.z = cvtpk(v1[0], v1[1]); w.w = cvtpk(v1[2], v1[3]);
                    *(u32x4*)(rowp + 32 * bj) = w; } }
    }
    __device__ __forceinline__ void normed(const f32x4 (&acc)[2][2][4][2], bf16_t* dst, int ld, int col0, int row0, float scale, int wr, int wc, int fr, int fq) const {
        f32x4 g[2][2], cs[2][2];
#pragma unroll
        for (int bj = 0; bj < 2; ++bj)
#pragma unroll
            for (int n = 0; n < 2; ++n) { g[bj][n] = *(LAS const f32x4*)(lds + P1T_GAIN + 4 * (32 * bj + 8 * fq + 4 * n)) * scale; cs[bj][n] = *(LAS const f32x4*)(lds + P1T_CS + 4 * (wc * 64 + 32 * bj + 8 * fq + 4 * n)) * (1.0f / 127.0f); }
#pragma unroll
        for (int aim = 0; aim < 4; ++aim) {
            const int ai = aim >> 1;
            u32x4 rw[2][2]; float rsv[2];
#pragma unroll
            for (int mm = 0; mm < 2; ++mm) { const int tr = ai * 128 + wr * 64 + (2 * (aim & 1) + mm) * 16 + fr; rsv[mm] = *(LAS const float*)(lds + P1T_RSC + 4 * tr);
#pragma unroll
                for (int n = 0; n < 2; ++n) rw[mm][n] = *(LAS const u32x4*)(lds + P1T_ROPE + 32 * tr + 16 * n); }
#pragma unroll
            for (int mm = 0; mm < 2; ++mm) { const int m = 2 * (aim & 1) + mm;
                const int row = row0 + ai * 128 + wr * 64 + m * 16 + fr;
                f32x4 v[2][2];
                float ss = 0.f;
#pragma unroll
                for (int bj = 0; bj < 2; ++bj)
#pragma unroll
                    for (int n = 0; n < 2; ++n) { const f32x4 x = cvt_i32(acc[ai][bj][m][n]) * cs[bj][n]; v[bj][n] = x; ss += (x[0] * x[0] + x[1] * x[1]) + (x[2] * x[2] + x[3] * x[3]); }
                ss += xor16(ss); ss = sum_halves(ss);
                const float rq = rsv[mm];
                const float rs = rq / sqrtf(ss * (rq * rq * (1.f / 64.f)) + EPS_);
#pragma unroll
                for (int bj = 0; bj < 2; ++bj)
#pragma unroll
                    for (int n = 0; n < 2; ++n) v[bj][n] = v[bj][n] * rs * g[bj][n];
#pragma unroll
                for (int n = 0; n < 2; ++n) {
                    const u32x4 cw = rw[mm][n];
                    const f32x4 co = {h2f_lo(cw[0]), h2f_lo(cw[1]), h2f_lo(cw[2]), h2f_lo(cw[3])}, si = {h2f_hi(cw[0]), h2f_hi(cw[1]), h2f_hi(cw[2]), h2f_hi(cw[3])};
                    f32x4 pr;
#pragma unroll
                    for (int e = 0; e < 4; ++e) pr[e] = xor16(v[0][n][e]);
                    const f32x4 r0 = v[0][n] * co - pr * si, r1 = v[0][n] * co + pr * si;
                    v[0][n] = (fq == 0) ? r0 : (fq == 1) ? r1 : v[0][n];
                }
                bf16_t* rowp = dst + (size_t)row * ld + col0 + wc * 64 + 8 * fq;
#pragma unroll
                for (int bj = 0; bj < 2; ++bj) { u32x4 w; w.x = cvtpk(v[bj][0][0], v[bj][0][1]); w.y = cvtpk(v[bj][0][2], v[bj][0][3]); w.z = cvtpk(v[bj][1][0], v[bj][1][1]); w.w = cvtpk(v[bj][1][2], v[bj][1][3]);
                    *(u32x4*)(rowp + 32 * bj) = w; }
            }
        }
    }
    __device__ __forceinline__ void operator()(const f32x4 (&acc)[2][2][4][2], const pg8::Unit& u, int wr, int wc, int fr, int fq) const {
        const int pn = u.pn, row0 = u.pm * 256;
        if (pn >= 26) { plain(acc, (bf16_t*)(ws + WS_MKV), 1024, (pn - 26) * 256, row0 - T_, wr, wc, fr, fq); return; }
        if (pn >= 14) { EpiG eg{ws + WS_G, lds}; pg8::Unit ug{u.pm, pn - 14}; eg(acc, ug, wr, wc, fr, fq); return; }
        if (pn >= 12) { plain(acc, (bf16_t*)(ws + WS_MQ), 512, (pn - 12) * 256, row0, wr, wc, fr, fq); return; }
        if (pn == 11) {
            if (wc >= 2) plain(acc, (bf16_t*)(ws + WS_KVB), 256, 0, row0, wr, wc, fr, fq);
            else normed(acc, (bf16_t*)(ws + WS_KVB), 256, 0, row0, 1.0f, wr, wc, fr, fq);
            return;
        }
        if (pn >= 9) { normed(acc, (bf16_t*)(ws + WS_QB), 512, (pn - 9) * 256, row0, QSCALE64, wr, wc, fr, fq); return; }
        const int gi = pn / 3, ty = pn - 3 * gi;
        if (ty == 2) { plain(acc, (bf16_t*)(ws + WS_VA) + (size_t)gi * T_ * 256, 256, 0, row0, wr, wc, fr, fq); return; }
        if (ty == 0) normed(acc, (bf16_t*)(ws + WS_QA) + (size_t)gi * T_ * 256, 256, 0, row0, QSCALE64, wr, wc, fr, fq);
        else normed(acc, (bf16_t*)(ws + WS_KA) + (size_t)gi * T_ * 256, 256, 0, row0, 1.0f, wr, wc, fr, fq);
    }
};

namespace att {
typedef short v4i16_t __attribute__((ext_vector_type(4)));
__device__ __forceinline__ int crow(int r, int h) { return (r & 3) + 8 * (r >> 2) + 4 * h; }
__device__ __forceinline__ s16x4 vtr(LAS const unsigned char* p) { return __builtin_bit_cast(s16x4, __builtin_amdgcn_ds_read_tr16_b64_v4i16((LAS v4i16_t*)p)); }

constexpr int KROW64 = 144, VROW64 = 128, NKEYS_B = 384;
constexpr int LDS_K64 = 0, LDS_V64 = NKEYS_B * KROW64;
constexpr int LDS_K128 = 0, LDS_V128 = 65536;

constexpr float SM_THR = 20.0f;
template <int NT, int ND>
__device__ __forceinline__ void softmax_step(f32x16 (&s)[NT], float& mref, float& l, f32x16 (&o)[ND], bf16x8 (&pf)[NT][2]) {
    if (__any(mref != 0.f)) {
#pragma unroll
        for (int t = 0; t < NT; ++t)
#pragma unroll
            for (int r = 0; r < 16; ++r) s[t][r] -= mref;
    }
    float mx = s[0][0];
#pragma unroll
    for (int t = 0; t < NT; ++t)
#pragma unroll
        for (int r = 0; r < 16; ++r) mx = fmaxf(mx, s[t][r]);
    mx = fmaxf(mx, __shfl_xor(mx, 32));
    if (__any(mx > SM_THR)) {
        const float dl = fmaxf(mx, 0.f); mref += dl;
#pragma unroll
        for (int t = 0; t < NT; ++t)
#pragma unroll
            for (int r = 0; r < 16; ++r) s[t][r] -= dl;
        const float f = __builtin_amdgcn_exp2f(-dl); l *= f;
#pragma unroll
        for (int d = 0; d < ND; ++d)
#pragma unroll
            for (int r = 0; r < 16; ++r) o[d][r] *= f;
    }
    float ps0 = 0.f, ps1 = 0.f;
#pragma unroll
    for (int t = 0; t < NT; ++t)
#pragma unroll
        for (int r = 0; r < 16; r += 2) { s[t][r] = __builtin_amdgcn_exp2f(s[t][r]); s[t][r + 1] = __builtin_amdgcn_exp2f(s[t][r + 1]); ps0 += s[t][r]; ps1 += s[t][r + 1]; }
    l += ps0 + ps1;
#pragma unroll
    for (int t = 0; t < NT; ++t)
#pragma unroll
        for (int k = 0; k < 2; ++k) { u32x4 w; w.x = cvtpk(s[t][8 * k + 0], s[t][8 * k + 1]); w.y = cvtpk(s[t][8 * k + 2], s[t][8 * k + 3]); w.z = cvtpk(s[t][8 * k + 4], s[t][8 * k + 5]); w.w = cvtpk(s[t][8 * k + 6], s[t][8 * k + 7]);
            pf[t][k] = __builtin_bit_cast(bf16x8, w); }
}

struct BU { const bf16_t* q; const bf16_t* k; const bf16_t* v; bf16_t* o; float* lse; int qstride, kvstride, ostride, lsestride; float sink2; int W; int first; };
__device__ __forceinline__ void bu_load(const BU& u, int tid, u32x4 (&kr)[6], u32x4 (&vr)[6]) {
#pragma unroll
    for (int it = 0; it < 6; ++it) {
        const int c = tid + 512 * it, row = c >> 3, ch = c & 7;
        const bool valid = !(u.first && row < 128);
        const long off = (long)((valid ? row : 128) - 128) * (long)u.kvstride + ch * 8;
        kr[it] = *(const u32x4*)(u.k + off); vr[it] = *(const u32x4*)(u.v + off);
    }
}
__device__ __forceinline__ void bu_store(LAS unsigned char* lds, int tid, const u32x4 (&kr)[6], const u32x4 (&vr)[6], int first) {
#pragma unroll
    for (int it = 0; it < 6; ++it) {
        const int c = tid + 512 * it, row = c >> 3, ch = c & 7;
        const bool valid = !(first && row < 128);
        const u32x4 z = (u32x4){0u, 0u, 0u, 0u};
        *(LAS u32x4*)(lds + LDS_K64 + row * KROW64 + ch * 16) = valid ? kr[it] : z;
        *(LAS u32x4*)(lds + LDS_V64 + row * VROW64 + ((ch * 16) ^ (((row >> 1) & 1) << 6))) = valid ? vr[it] : z;
    }
}
__device__ __forceinline__ void bu_loadq(const BU& u, int wid, int lane, bf16x8 (&qf)[4]) {
    const int qi = 32 * wid + (lane & 31), h = lane >> 5;
#pragma unroll
    for (int d0 = 0; d0 < 4; ++d0) qf[d0] = *(const bf16x8*)(u.q + (size_t)qi * u.qstride + 16 * d0 + 8 * h);
}
template <int NT>
__device__ __forceinline__ void bu_step(LAS const unsigned char* kbase, LAS const unsigned char* vbase, int vsw, int kt0, int mask, int jlo, int jhi, int h, const bf16x8 (&qf)[4],
                                        float& mref, float& l, f32x16 (&o)[2]) {
    f32x16 s[NT];
#pragma unroll
    for (int d0 = 0; d0 < 4; ++d0)
#pragma unroll
        for (int t = 0; t < NT; ++t) { const bf16x8 kf = *(LAS const bf16x8*)(kbase + (kt0 + t) * 32 * KROW64 + d0 * 32); if (d0 == 0) { for (int r = 0; r < 16; ++r) s[t][r] = 0.f; } s[t] = __builtin_amdgcn_mfma_f32_32x32x16_bf16(kf, qf[d0], s[t], 0, 0, 0); }
    if (mask == 1) {
        const int L = jlo - 32 * kt0 - 4 * h;
#pragma unroll
        for (int r = 0; r < 16; ++r) { if (((r & 3) + 8 * (r >> 2)) < L) s[0][r] = -INFINITY; }
    } else if (mask == 2) {
        const int H = jhi - 32 * kt0 - 4 * h;
#pragma unroll
        for (int r = 0; r < 16; ++r) { if (((r & 3) + 8 * (r >> 2)) > H) s[0][r] = -INFINITY; }
    } else if (mask == 3) {
#pragma unroll
        for (int t = 0; t < NT; ++t) { const int L = jlo - 32 * (kt0 + t) - 4 * h; const unsigned span = (unsigned)(jhi - jlo);
#pragma unroll
            for (int r = 0; r < 16; ++r) { if ((unsigned)(((r & 3) + 8 * (r >> 2)) - L) > span) s[t][r] = -INFINITY; } }
    }
    bf16x8 pf[NT][2];
    softmax_step<NT, 2>(s, mref, l, o, pf);
#pragma unroll
    for (int t = 0; t < NT; ++t)
#pragma unroll
        for (int k = 0; k < 2; ++k)
#pragma unroll
            for (int d = 0; d < 2; ++d) {
                LAS const unsigned char* vp = vbase + ((kt0 + t) * 32 + 16 * k) * VROW64 + 64 * (d ^ vsw);
                const s16x4 lo = vtr(vp), hi = vtr(vp + 8 * VROW64);
                const bf16x8 vf = (bf16x8){lo[0], lo[1], lo[2], lo[3], hi[0], hi[1], hi[2], hi[3]};
                o[d] = __builtin_amdgcn_mfma_f32_32x32x16_bf16(vf, pf[t][k], o[d], 0, 0, 0);
            }
}
__device__ __forceinline__ void bu_compute(LAS unsigned char* lds, const BU& u, const bf16x8 (&qf)[4], int wid, int lane) {
    const int c = lane & 31, h = lane >> 5;
    const int qi = 32 * wid + c;
    float mref = 0.f, l = 0.f; f32x16 o[2];
#pragma unroll
    for (int r = 0; r < 16; ++r) { o[0][r] = 0.f; o[1][r] = 0.f; }
    int jlo = qi + 128 - u.W; if (u.first && jlo < 128) jlo = 128;
    const int jhi = qi + 128;
    const int qq = (lane & 15) >> 2;
    LAS const unsigned char* kbase = lds + LDS_K64 + c * KROW64 + 16 * h;
    LAS const unsigned char* vbase = lds + LDS_V64 + (4 * h + qq) * VROW64 + ((lane >> 4) & 1) * 32 + (lane & 3) * 8;
    const int vsw = (qq >> 1) & 1;
#pragma unroll 1
    for (int st = 0; st < 2; ++st) bu_step<2>(kbase, vbase, vsw, wid + 2 * st, u.first ? 3 : (st == 0 ? 1 : 0), jlo, jhi, h, qf, mref, l, o);
    bu_step<1>(kbase, vbase, vsw, wid + 4, u.first ? 3 : 2, jlo, jhi, h, qf, mref, l, o);
    float lt = l + __shfl_xor(l, 32);
    lt += __builtin_amdgcn_exp2f(u.sink2 - mref);
    const float inv = 1.0f / lt;
    bf16_t* orow = u.o + (size_t)qi * u.ostride;
#pragma unroll
    for (int d = 0; d < 2; ++d)
#pragma unroll
        for (int rg = 0; rg < 4; ++rg) { u32x2 w; w.x = cvtpk(o[d][4 * rg] * inv, o[d][4 * rg + 1] * inv); w.y = cvtpk(o[d][4 * rg + 2] * inv, o[d][4 * rg + 3] * inv);
            *(u32x2*)(orow + 32 * d + 8 * rg + 4 * h) = w; }
    if (u.lse && h == 0) u.lse[(size_t)qi * u.lsestride] = mref + __builtin_amdgcn_logf(lt);
}

__device__ __forceinline__ void mem_load(const bf16_t* kmem, const bf16_t* vmem, int tid, u32x4 (&kr)[8], u32x4 (&vr)[8]) {
#pragma unroll
    for (int it = 0; it < 8; ++it) { const int cc = tid + 512 * it, row = cc >> 4, ch = cc & 15;
        kr[it] = *(const u32x4*)(kmem + (size_t)row * 1024 + ch * 8); vr[it] = *(const u32x4*)(vmem + (size_t)row * 1024 + ch * 8); }
}
__device__ __forceinline__ void mem_unit(LAS unsigned char* lds, const bf16_t* q0, const u32x4 (&kr)[8], const u32x4 (&vr)[8], const float* qgain, const float* kgain, bf16_t* o0, size_t ostride, int tid, int wid, int lane) {
#pragma unroll
    for (int it = 0; it < 8; ++it) {
        const int cc = tid + 512 * it, row = cc >> 4, ch = cc & 15;
        *(LAS u32x4*)(lds + LDS_K128 + row * 256 + ((ch ^ (row & 15)) * 16)) = kr[it];
        *(LAS u32x4*)(lds + LDS_V128 + row * 256 + ((ch * 16) ^ ((row & 3) << 6))) = vr[it];
    }
    const int c = lane & 31, h = lane >> 5;
    const int qi = 32 * wid + c;
    bf16x8 qf[8];
    {
        u32x4 raw[8]; float ss = 0.f;
#pragma unroll
        for (int d0 = 0; d0 < 8; ++d0) { raw[d0] = *(const u32x4*)(q0 + (size_t)qi * 512 + 16 * d0 + 8 * h);
#pragma unroll
            for (int e = 0; e < 4; ++e) { const float a = bflo(raw[d0][e]), b = bfhi(raw[d0][e]); ss += a * a + b * b; } }
        ss += __shfl_xor(ss, 32);
        const float rs = (1.0f / sqrtf(ss * (1.f / 128.f) + EPS_)) * QSCALE128;
#pragma unroll
        for (int d0 = 0; d0 < 8; ++d0) { const f32x4 g0 = *(const f32x4*)(qgain + 16 * d0 + 8 * h), g1 = *(const f32x4*)(qgain + 16 * d0 + 8 * h + 4);
            u32x4 w; w.x = cvtpk(bflo(raw[d0].x) * rs * g0[0], bfhi(raw[d0].x) * rs * g0[1]); w.y = cvtpk(bflo(raw[d0].y) * rs * g0[2], bfhi(raw[d0].y) * rs * g0[3]);
            w.z = cvtpk(bflo(raw[d0].z) * rs * g1[0], bfhi(raw[d0].z) * rs * g1[1]); w.w = cvtpk(bflo(raw[d0].w) * rs * g1[2], bfhi(raw[d0].w) * rs * g1[3]);
            qf[d0] = __builtin_bit_cast(bf16x8, w); }
    }
    __syncthreads();
    {
        const int row = tid >> 1, hf = tid & 1; u32x4 raw[8]; float ss = 0.f;
#pragma unroll
        for (int i = 0; i < 8; ++i) { raw[i] = *(LAS const u32x4*)(lds + LDS_K128 + row * 256 + (((hf * 8 + i) ^ (row & 15)) * 16));
#pragma unroll
            for (int e = 0; e < 4; ++e) { const float a = bflo(raw[i][e]), b = bfhi(raw[i][e]); ss += a * a + b * b; } }
        ss += __shfl_xor(ss, 1);
        const float rs = 1.0f / sqrtf(ss * (1.f / 128.f) + EPS_);
#pragma unroll
        for (int i = 0; i < 8; ++i) { const float* gp = kgain + 64 * hf + 8 * i; const f32x4 g0 = *(const f32x4*)gp, g1 = *(const f32x4*)(gp + 4);
            u32x4 w; w.x = cvtpk(bflo(raw[i].x) * rs * g0[0], bfhi(raw[i].x) * rs * g0[1]); w.y = cvtpk(bflo(raw[i].y) * rs * g0[2], bfhi(raw[i].y) * rs * g0[3]);
            w.z = cvtpk(bflo(raw[i].z) * rs * g1[0], bfhi(raw[i].z) * rs * g1[1]); w.w = cvtpk(bflo(raw[i].w) * rs * g1[2], bfhi(raw[i].w) * rs * g1[3]);
            *(LAS u32x4*)(lds + LDS_K128 + row * 256 + (((hf * 8 + i) ^ (row & 15)) * 16)) = w; }
    }
    __syncthreads();
    float mref = 0.f, l = 0.f; f32x16 o[4];
#pragma unroll
    for (int r = 0; r < 16; ++r) {
#pragma unroll
        for (int d = 0; d < 4; ++d) o[d][r] = 0.f; }
    const int qq = (lane & 15) >> 2;
    LAS const unsigned char* vbase = lds + LDS_V128 + (4 * h + qq) * 256 + ((lane >> 4) & 1) * 32 + (lane & 3) * 8;
#pragma unroll 1
    for (int kt = 0; kt < 8; kt += 2) {
        f32x16 s[2];
#pragma unroll
        for (int d0 = 0; d0 < 8; ++d0)
#pragma unroll
            for (int t = 0; t < 2; ++t) { const int krow = (kt + t) * 32 + c;
                const bf16x8 kf = *(LAS const bf16x8*)(lds + LDS_K128 + krow * 256 + (((2 * d0 + h) ^ (krow & 15)) * 16)); if (d0 == 0) { for (int r = 0; r < 16; ++r) s[t][r] = 0.f; } s[t] = __builtin_amdgcn_mfma_f32_32x32x16_bf16(kf, qf[d0], s[t], 0, 0, 0); }
        bf16x8 pf[2][2];
        softmax_step<2, 4>(s, mref, l, o, pf);
#pragma unroll
        for (int t = 0; t < 2; ++t)
#pragma unroll
            for (int k = 0; k < 2; ++k)
#pragma unroll
                for (int d = 0; d < 4; ++d) {
                    LAS const unsigned char* vp = vbase + ((kt + t) * 32 + 16 * k) * 256 + 64 * (d ^ qq);
                    const s16x4 lo = vtr(vp), hi = vtr(vp + 8 * 256);
                    const bf16x8 vf = (bf16x8){lo[0], lo[1], lo[2], lo[3], hi[0], hi[1], hi[2], hi[3]};
                    o[d] = __builtin_amdgcn_mfma_f32_32x32x16_bf16(vf, pf[t][k], o[d], 0, 0, 0);
                }
    }
    const float inv = 1.0f / (l + __shfl_xor(l, 32));
    bf16_t* orow = o0 + (size_t)qi * ostride;
#pragma unroll
    for (int d = 0; d < 4; ++d)
#pragma unroll
        for (int rg = 0; rg < 4; ++rg) { u32x2 w; w.x = cvtpk(o[d][4 * rg] * inv, o[d][4 * rg + 1] * inv); w.y = cvtpk(o[d][4 * rg + 2] * inv, o[d][4 * rg + 3] * inv);
            *(u32x2*)(orow + 32 * d + 8 * rg + 4 * h) = w; }
    __syncthreads();
}
}

__device__ __forceinline__ att::BU get_bu(const Args& A, int vcu, int idx) {
    unsigned char* ws = A.ws; att::BU u;
    if (idx < 3) {
        const int gi = idx, b = vcu >> 6, hd = (vcu >> 4) & 3, i16 = vcu & 15;
        const int dl = (gi == 0) ? 1 : (gi == 1) ? 4 : 16;
        int r, qb; if (gi == 0) { r = 0; qb = i16; } else if (gi == 1) { r = i16 >> 2; qb = i16 & 3; } else { r = i16; qb = 0; }
        const int i0 = qb * 256;
        const size_t row0 = (size_t)b * SEQ_ + r + (size_t)dl * i0;
        const size_t base = (size_t)gi * T_ * 256 + row0 * 256 + hd * 64;
        u.q = (const bf16_t*)(ws + WS_QA) + base; u.k = (const bf16_t*)(ws + WS_KA) + base; u.v = (const bf16_t*)(ws + WS_VA) + base;
        u.o = (bf16_t*)((unsigned char*)A.out + DO_OAG) + base;
        u.lse = (float*)(ws + WS_LSE) + (size_t)gi * T_ * 4 + row0 * 4 + hd;
        u.qstride = dl * 256; u.kvstride = dl * 256; u.ostride = dl * 256; u.lsestride = dl * 4; u.sink2 = -INFINITY; u.W = 128; u.first = (i0 == 0);
    } else {
        const int uu = vcu + 256 * (idx - 3), b = uu >> 7, hq = (uu >> 4) & 7, qb = uu & 15, kvh = hq >> 2;
        const size_t row0 = (size_t)b * SEQ_ + (size_t)qb * 256;
        u.q = (const bf16_t*)(ws + WS_QB) + row0 * 512 + hq * 64;
        u.k = (const bf16_t*)(ws + WS_KVB) + row0 * 256 + kvh * 64; u.v = u.k + 128;
        u.o = (bf16_t*)((unsigned char*)A.out + DO_OCAT) + row0 * KCAT + 256 + hq * 64;
        u.lse = nullptr; u.qstride = 512; u.kvstride = 256; u.ostride = KCAT; u.lsestride = 0; u.sink2 = A.in[I_SINK][hq] * LOG2E; u.W = 127; u.first = (qb == 0);
    }
    return u;
}
__device__ __forceinline__ void p2_attention(const Args& A, LAS unsigned char* lds, int vcu, int tid, int wid, int lane) {
    unsigned char* ws = A.ws;
    const int mu = vcu, mb = mu >> 6, mhd = (mu >> 4) & 3, mqb = mu & 15;
    const bf16_t* km = (const bf16_t*)(ws + WS_MKV) + (size_t)mb * MEM_ * 1024 + mhd * 128;
    {
        u32x4 kr[6], vr[6];
        { const att::BU u0 = get_bu(A, vcu, 0); att::bu_load(u0, tid, kr, vr); }
#ifdef PROBE_TS
        unsigned long long d1 = 0, d2 = 0, d3 = 0, tA = __builtin_amdgcn_s_memrealtime();
#endif
#pragma unroll 1
        for (int idx = 0; idx < 5; ++idx) {
            const att::BU u = get_bu(A, vcu, idx);
#ifdef PROBE_TS
            const unsigned long long t0 = __builtin_amdgcn_s_memrealtime();
#endif
            att::bu_store(lds, tid, kr, vr, u.first);
            bf16x8 qf[4]; att::bu_loadq(u, wid, lane, qf);
            __syncthreads();
#ifdef PROBE_TS
            const unsigned long long t1 = __builtin_amdgcn_s_memrealtime();
#endif
            if (idx < 4) { const att::BU un = get_bu(A, vcu, idx + 1); att::bu_load(un, tid, kr, vr); }
            att::bu_compute(lds, u, qf, wid, lane);
#ifdef PROBE_TS
            asm volatile("" ::: "memory");
            const unsigned long long t2 = __builtin_amdgcn_s_memrealtime();
#endif
            __syncthreads();
#ifdef PROBE_TS
            const unsigned long long t3 = __builtin_amdgcn_s_memrealtime();
            d1 += t1 - t0; d2 += t2 - t1; d3 += t3 - t2;
#endif
        }
#ifdef PROBE_TS
        if (vcu == 100 && tid == 0) { float* dbg = (float*)(A.ws + WS_SSQ);
            dbg = (float*)(A.ws + WS_CTL + 512 * 1024);
            dbg[0] = (float)d1; dbg[1] = (float)d2; dbg[2] = (float)d3; dbg[3] = (float)(__builtin_amdgcn_s_memrealtime() - tA); }
#endif
    }
    {
        u32x4 mkr[8], mvr[8];
        att::mem_load(km, km + 512, tid, mkr, mvr);
        const size_t row0 = (size_t)mb * SEQ_ + (size_t)mqb * 256;
        const bf16_t* q = (const bf16_t*)(ws + WS_MQ) + row0 * 512 + mhd * 128;
        bf16_t* o = (bf16_t*)((unsigned char*)A.out + DO_OCAT) + row0 * KCAT + 768 + mhd * 128;
        att::mem_unit(lds, q, mkr, mvr, A.in[I_MQN], A.in[I_MKN], o, KCAT, tid, wid, lane);
    }
}

__device__ __forceinline__ void p2b_merge(const Args& A, int vcu, int G, int tid) {
    const bf16_t* oag = (const bf16_t*)((unsigned char*)A.out + DO_OAG);
    bf16_t* ocat = (bf16_t*)((unsigned char*)A.out + DO_OCAT);
    const float* lse = (const float*)(A.ws + WS_LSE);
    for (int idx = vcu * 512 + tid; idx < T_ * 32; idx += G * 512) {
        const int t = idx >> 5, ch = idx & 31, hd = ch >> 3;
        const float l0 = lse[(size_t)t * 4 + hd], l1 = lse[(size_t)T_ * 4 + (size_t)t * 4 + hd], l2 = lse[(size_t)2 * T_ * 4 + (size_t)t * 4 + hd];
        const float mx = fmaxf(l0, fmaxf(l1, l2));
        float w0 = __builtin_amdgcn_exp2f(l0 - mx), w1 = __builtin_amdgcn_exp2f(l1 - mx), w2 = __builtin_amdgcn_exp2f(l2 - mx);
        const float inv = 1.0f / (w0 + w1 + w2); w0 *= inv; w1 *= inv; w2 *= inv;
        const u32x4 a = *(const u32x4*)(oag + (size_t)t * 256 + ch * 8), b = *(const u32x4*)(oag + (size_t)T_ * 256 + (size_t)t * 256 + ch * 8), c = *(const u32x4*)(oag + (size_t)2 * T_ * 256 + (size_t)t * 256 + ch * 8);
        u32x4 w;
#pragma unroll
        for (int e = 0; e < 4; ++e) w[e] = cvtpk(w0 * bflo(a[e]) + w1 * bflo(b[e]) + w2 * bflo(c[e]), w0 * bfhi(a[e]) + w1 * bfhi(b[e]) + w2 * bfhi(c[e]));
        *(u32x4*)(ocat + (size_t)t * KCAT + ch * 8) = w;
    }
}

struct P3aOrder : pg8::StaticOrder {
    const bf16_t* oag; bf16_t* ocat; const float* lse;
    __device__ __forceinline__ void a_ready(const pg8::Unit& u) const {
#pragma unroll 1
        for (int i0 = threadIdx.x; i0 < 256 * 32; i0 += 2 * 512) {
            u32x4 a[2], b[2], c[2]; float l0[2], l1[2], l2[2];
#pragma unroll
            for (int j = 0; j < 2; ++j) { const int idx = i0 + 512 * j, t = u.pm * 256 + (idx >> 5), ch = idx & 31, hd = ch >> 3;
                l0[j] = lse[(size_t)t * 4 + hd]; l1[j] = lse[(size_t)T_ * 4 + (size_t)t * 4 + hd]; l2[j] = lse[(size_t)2 * T_ * 4 + (size_t)t * 4 + hd];
                a[j] = *(const u32x4*)(oag + (size_t)t * 256 + ch * 8); b[j] = *(const u32x4*)(oag + (size_t)T_ * 256 + (size_t)t * 256 + ch * 8); c[j] = *(const u32x4*)(oag + (size_t)2 * T_ * 256 + (size_t)t * 256 + ch * 8); }
#pragma unroll
            for (int j = 0; j < 2; ++j) { const int idx = i0 + 512 * j, t = u.pm * 256 + (idx >> 5), ch = idx & 31;
                const float mx = fmaxf(l0[j], fmaxf(l1[j], l2[j]));
                float w0 = __builtin_amdgcn_exp2f(l0[j] - mx), w1 = __builtin_amdgcn_exp2f(l1[j] - mx), w2 = __builtin_amdgcn_exp2f(l2[j] - mx);
                const float inv = 1.0f / (w0 + w1 + w2); w0 *= inv; w1 *= inv; w2 *= inv;
                u32x4 w;
#pragma unroll
                for (int e = 0; e < 4; ++e) w[e] = cvtpk(w0 * bflo(a[j][e]) + w1 * bflo(b[j][e]) + w2 * bflo(c[j][e]), w0 * bfhi(a[j][e]) + w1 * bfhi(b[j][e]) + w2 * bfhi(c[j][e]));
                *(u32x4*)(ocat + (size_t)t * KCAT + ch * 8) = w; }
        }
        asm volatile("s_waitcnt vmcnt(0)" ::: "memory"); __builtin_amdgcn_s_barrier(); asm volatile("" ::: "memory");
    }
};

__device__ __forceinline__ float ub(unsigned w, int i) { return (float)((w >> (8 * i)) & 0xffu); }
struct Epi3a {
    static constexpr bool PERM = true;
    const unsigned char* G; bf16_t* MERGED;
    bool skip = false;
    __device__ __forceinline__ void khook(f32x4 (&acc)[2][2][4][2], const pg8::Unit& u, int t, int wr, int wc, int fr, int fq) const {
        if (t != 4 && t != 12) return;
        const int gsel = (t == 4) ? 0 : 1024;
#pragma unroll
        for (int ai = 0; ai < 2; ++ai) {
            u32x2 ga[4][2], gb[4][2];
#pragma unroll
            for (int m = 0; m < 4; ++m) { const unsigned char* gp = G + (size_t)(u.pm * 256 + ai * 128 + wr * 64 + m * 16 + fr) * 3072 + gsel + u.pn * 256 + wc * 64 + 8 * fq;
#pragma unroll
                for (int bj = 0; bj < 2; ++bj) { ga[m][bj] = *(const u32x2*)(gp + 32 * bj); gb[m][bj] = *(const u32x2*)(gp + 1024 + 32 * bj); } }
            asm volatile("" ::: "memory");
#pragma unroll
            for (int m = 0; m < 4; ++m)
#pragma unroll
                for (int bj = 0; bj < 2; ++bj)
#pragma unroll
                    for (int n = 0; n < 2; ++n)
#pragma unroll
                        for (int e = 0; e < 4; ++e) acc[ai][bj][m][n][e] *= ub(ga[m][bj][n], e) * __builtin_amdgcn_rcpf(ub(gb[m][bj][n], e));
        }
    }
    __device__ __forceinline__ void operator()(const f32x4 (&acc)[2][2][4][2], const pg8::Unit& u, int wr, int wc, int fr, int fq) const {
        const int col = u.pn * 256 + wc * 64 + 8 * fq;
        u32x2 g2[2][4][2];
#pragma unroll
        for (int ai = 0; ai < 2; ++ai)
#pragma unroll
            for (int m = 0; m < 4; ++m) { const size_t row = (size_t)(u.pm * 256 + ai * 128 + wr * 64 + m * 16 + fr);
#pragma unroll
                for (int bj = 0; bj < 2; ++bj) g2[ai][m][bj] = *(const u32x2*)(G + row * 3072 + 2048 + col + 32 * bj); }
        asm volatile("" ::: "memory");
        const float k = 1.0f / 255.0f;
#pragma unroll
        for (int ai = 0; ai < 2; ++ai)
#pragma unroll
            for (int m = 0; m < 4; ++m) { const size_t row = (size_t)(u.pm * 256 + ai * 128 + wr * 64 + m * 16 + fr);
#pragma unroll
                for (int bj = 0; bj < 2; ++bj) { const u32x2 g = g2[ai][m][bj]; const f32x4 v0 = acc[ai][bj][m][0] * k, v1 = acc[ai][bj][m][1] * k;
                    u32x4 w; w.x = cvtpk(v0[0] * ub(g.x, 0), v0[1] * ub(g.x, 1)); w.y = cvtpk(v0[2] * ub(g.x, 2), v0[3] * ub(g.x, 3)); w.z = cvtpk(v1[0] * ub(g.y, 0), v1[1] * ub(g.y, 1)); w.w = cvtpk(v1[2] * ub(g.y, 2), v1[3] * ub(g.y, 3));
                    *(u32x4*)(MERGED + row * 1024 + col + 32 * bj) = w; } }
    }
};

struct Epi3b {
    static constexpr bool PERM = true;
    const float* x; bf16_t* X1L; bf16_t* X1B; float* SSQ;
    bool skip = false;
    __device__ __forceinline__ void operator()(const f32x4 (&acc)[2][2][4][2], const pg8::Unit& u, int wr, int wc, int fr, int fq) const {
        const int col = u.pn * 256 + wc * 64 + 8 * fq;
#pragma unroll
        for (int ai = 0; ai < 2; ++ai) {
            f32x4 xv[4][2][2];
#pragma unroll
            for (int m = 0; m < 4; ++m) { const size_t row = (size_t)(u.pm * 256 + ai * 128 + wr * 64 + m * 16 + fr);
#pragma unroll
                for (int bj = 0; bj < 2; ++bj) { const size_t off = row * 1024 + col + 32 * bj; xv[m][bj][0] = *(const f32x4*)(x + off); xv[m][bj][1] = *(const f32x4*)(x + off + 4); } }
            asm volatile("" ::: "memory");
#pragma unroll
            for (int m = 0; m < 4; ++m) { const size_t row = (size_t)(u.pm * 256 + ai * 128 + wr * 64 + m * 16 + fr); float ss = 0.f;
#pragma unroll
                for (int bj = 0; bj < 2; ++bj) { const size_t off = row * 1024 + col + 32 * bj;
                    const f32x4 o0 = xv[m][bj][0] + acc[ai][bj][m][0], o1 = xv[m][bj][1] + acc[ai][bj][m][1];
                    ss += (o0[0] * o0[0] + o0[1] * o0[1]) + (o0[2] * o0[2] + o0[3] * o0[3]) + (o1[0] * o1[0] + o1[1] * o1[1]) + (o1[2] * o1[2] + o1[3] * o1[3]);
                    u32x4 w; w.x = cvtpk(o0[0], o0[1]); w.y = cvtpk(o0[2], o0[3]); w.z = cvtpk(o1[0], o1[1]); w.w = cvtpk(o1[2], o1[3]);
                    *(u32x4*)(X1B + off) = w; }
                ss += xor16(ss); ss = sum_halves(ss);
                if (fq == 0) SSQ[row * 16 + u.pn * 4 + wc] = ss; }
            asm volatile("" ::: "memory");
        }
    }
};

struct Epi4 {
    static constexpr bool PERM = true;
    const float* convw; const float* convb; bf16_t* ACT; float* UE; float* UF; LAS float* xch; LAS const float* rtab; LAS const float* ctab;
    bool skip = false;
    __device__ __forceinline__ void operator()(f32x4 (&acc)[2][2][4][2], const pg8::Unit& u, int wr, int wc, int fr, int fq) const {
        const int lane = fr + 16 * fq;
        const int rowbase = u.pm * 256 + 128 * wr + 8 * fr;
        const int jj = 32 * wc + 8 * fq;
        const bool bstart = (u.pm & 15) == 0;
        {
            LAS const float* tb = rtab + ((u.pm >> 3) & 1) * 256 + 128 * wr + 8 * fr;
            const f32x4 ra = *(LAS const f32x4*)tb, rb = *(LAS const f32x4*)(tb + 4);
#pragma unroll
            for (int i = 0; i < 8; ++i) { const float rs = (i < 4) ? ra[i & 3] : rb[i & 3];
#pragma unroll
                for (int bj = 0; bj < 2; ++bj)
#pragma unroll
                    for (int n = 0; n < 2; ++n) acc[i >> 2][bj][i & 3][n] *= rs; }
        }
#define U4(bj, n, i) acc[(i) >> 2][bj][(i) & 3][n]
        if (wr == 0 && fr == 0) {
#pragma unroll
            for (int i = 0; i < 2; ++i)
#pragma unroll
                for (int bj = 0; bj < 2; ++bj)
#pragma unroll
                    for (int n = 0; n < 2; ++n) *(f32x4*)(UF + (size_t)(u.pm * 2 + i) * 5632 + u.pn * 256 + 128 * bj + jj + 4 * n) = U4(bj, n, i);
        }
        if (wr == 1 && fr == 15) {
#pragma unroll
            for (int i = 0; i < 2; ++i)
#pragma unroll
                for (int bj = 0; bj < 2; ++bj)
#pragma unroll
                    for (int n = 0; n < 2; ++n) *(f32x4*)(UE + (size_t)(u.pm * 2 + i) * 5632 + u.pn * 256 + 128 * bj + jj + 4 * n) = U4(bj, n, 6 + i);
        }
        if (wr == 0 && fr == 15) {
#pragma unroll
            for (int i = 0; i < 2; ++i)
#pragma unroll
                for (int bj = 0; bj < 2; ++bj)
#pragma unroll
                    for (int n = 0; n < 2; ++n) *(LAS f32x4*)(xch + ((((wc * 2 + i) * 2 + bj) * 2 + n) * 4 + fq) * 4) = U4(bj, n, 6 + i);
        }
        asm volatile("s_waitcnt lgkmcnt(0)" ::: "memory"); __builtin_amdgcn_s_barrier(); asm volatile("" ::: "memory");
        const int src = (lane & 48) | ((fr - 1) & 15);
        const int cha = u.pn * 128 + jj;
#pragma unroll
        for (int n = 0; n < 2; ++n) {
            asm volatile("" ::: "memory"); __builtin_amdgcn_sched_barrier(0);
            f32x4 p6[2], p7[2], w0[2], w1[2], w2[2], cb[2];
#pragma unroll
            for (int bj = 0; bj < 2; ++bj) {
                f32x4 h6 = (f32x4){0.f, 0.f, 0.f, 0.f}, h7 = h6;
                if (wr == 1) { h6 = *(LAS const f32x4*)(xch + ((((wc * 2 + 0) * 2 + bj) * 2 + n) * 4 + fq) * 4); h7 = *(LAS const f32x4*)(xch + ((((wc * 2 + 1) * 2 + bj) * 2 + n) * 4 + fq) * 4); }
#pragma unroll
                for (int e = 0; e < 4; ++e) { const float a6 = __shfl(U4(bj, n, 6)[e], src), a7 = __shfl(U4(bj, n, 7)[e], src); p6[bj][e] = (fr == 0) ? h6[e] : a6; p7[bj][e] = (fr == 0) ? h7[e] : a7; }
                LAS const float* ct = ctab + u.par * 1024 + bj * 512 + jj + 4 * n;
                w0[bj] = *(LAS const f32x4*)ct; w1[bj] = *(LAS const f32x4*)(ct + 128); w2[bj] = *(LAS const f32x4*)(ct + 256); cb[bj] = *(LAS const f32x4*)(ct + 384);
            }
#pragma unroll
            for (int i = 0; i < 8; ++i) {
                f32x4 c[2];
#pragma unroll
                for (int bj = 0; bj < 2; ++bj) {
                    const f32x4 um1 = (i >= 1) ? U4(bj, n, i >= 1 ? i - 1 : 0) : p7[bj];
                    const f32x4 um2 = (i >= 2) ? U4(bj, n, i >= 2 ? i - 2 : 0) : ((i == 1) ? p7[bj] : p6[bj]);
                    c[bj] = cb[bj] + w2[bj] * U4(bj, n, i) + w1[bj] * um1 + w0[bj] * um2;
                }
                f32x4 a;
#pragma unroll
                for (int e = 0; e < 4; ++e) { const float z = c[0][e]; a[e] = z * __builtin_amdgcn_rcpf(1.0f + __builtin_amdgcn_exp2f(-z * LOG2E)) * c[1][e]; }
                u32x2 w; w.x = cvtpk(a[0], a[1]); w.y = cvtpk(a[2], a[3]);
                const bool skip = (wr == 0 && fr == 0 && i < 2 && !bstart);
                if (!skip) *(u32x2*)(ACT + (size_t)(rowbase + i) * DFF_ + cha + 4 * n) = w;
            }
        }
#undef U4
    }
};

struct P4Order : pg8::StaticOrder {
    const float* SSQ; LAS float* rtab; mutable int lastpm; const float* convw; const float* convb; LAS unsigned char* ctab;
    __device__ __forceinline__ void a_ready(const pg8::Unit& u) const {
        { int t = threadIdx.x; asm volatile("" : "+v"(t)); const int w = __builtin_amdgcn_readfirstlane(t >> 6);
          if (w < 4) { const int bj = t >> 7, tap = (t >> 5) & 3, c4 = t & 31; const float* src = (tap < 3 ? convw + tap * 5632 : convb) + bj * DFF_ + u.pn * 128 + 4 * c4;
              __builtin_amdgcn_global_load_lds((const unsigned*)src, (LAS unsigned*)(ctab + u.par * 4096 + w * 1024), 16, 0, 0); } }
        if (u.pm == lastpm) return;
        lastpm = u.pm;
        const int t = threadIdx.x;
        if (t < 256) {
            const float* sp = SSQ + (size_t)(u.pm * 256 + t) * 16;
            const f32x4 s0 = *(const f32x4*)sp, s1 = *(const f32x4*)(sp + 4), s2 = *(const f32x4*)(sp + 8), s3 = *(const f32x4*)(sp + 12);
            const float tot = ((s0[0] + s0[1]) + (s0[2] + s0[3])) + ((s1[0] + s1[1]) + (s1[2] + s1[3])) + ((s2[0] + s2[1]) + (s2[2] + s2[3])) + ((s3[0] + s3[1]) + (s3[2] + s3[3]));
            rtab[((u.pm >> 3) & 1) * 256 + t] = 1.0f / sqrtf(tot * (1.f / 1024.f) + EPS_);
        }
    }
};

struct Epi5 {
    static constexpr bool PERM = true;
    const bf16_t* X1B; const bf16_t* X1L; float* dst;
    bool skip = false;
    __device__ __forceinline__ void operator()(const f32x4 (&acc)[2][2][4][2], const pg8::Unit& u, int wr, int wc, int fr, int fq) const {
        const int col = u.pn * 256 + wc * 64 + 8 * fq;
#pragma unroll
        for (int ai = 0; ai < 2; ++ai) {
            u32x4 hv[4][2];
#pragma unroll
            for (int m = 0; m < 4; ++m) { const size_t row = (size_t)(u.pm * 256 + ai * 128 + wr * 64 + m * 16 + fr);
#pragma unroll
                for (int bj = 0; bj < 2; ++bj) { const size_t off = row * 1024 + col + 32 * bj; hv[m][bj] = *(const u32x4*)(X1B + off); } }
            asm volatile("" ::: "memory");
#pragma unroll
            for (int m = 0; m < 4; ++m) { const size_t row = (size_t)(u.pm * 256 + ai * 128 + wr * 64 + m * 16 + fr);
#pragma unroll
                for (int bj = 0; bj < 2; ++bj) { float* q = dst + row * 1024 + col + 32 * bj; const u32x4 h = hv[m][bj];
                    const f32x4 x0 = (f32x4){bflo(h.x), bfhi(h.x), bflo(h.y), bfhi(h.y)};
                    const f32x4 x1 = (f32x4){bflo(h.z), bfhi(h.z), bflo(h.w), bfhi(h.w)};
                    *(f32x4*)q = x0 + acc[ai][bj][m][0]; *(f32x4*)(q + 4) = x1 + acc[ai][bj][m][1]; } }
            asm volatile("" ::: "memory");
        }
    }
};
struct P5Order : pg8::StaticOrder {
    const float* UE; const float* UF; const float* convw; const float* convb; bf16_t* ACT;
    __device__ __forceinline__ void a_ready(const pg8::Unit& u) const {
        if ((u.pm & 15) != 0) {
            for (int ch = threadIdx.x; ch < DFF_; ch += 512) {
                const int pa = 256 * (ch >> 7) + (ch & 127), pg = pa + 128;
                const float* e = UE + (size_t)((u.pm - 1) * 2) * 5632; const float* f = UF + (size_t)(u.pm * 2) * 5632;
                float r[2];
#pragma unroll
                for (int i = 0; i < 2; ++i) {
                    float cc[2];
#pragma unroll
                    for (int s = 0; s < 2; ++s) { const int p = s ? pg : pa, cch = s * DFF_ + ch;
                        const float um2 = e[p], um1 = e[5632 + p], u0 = f[p], u1 = f[5632 + p];
                        const float w0 = convw[cch], w1 = convw[5632 + cch], w2 = convw[2 * 5632 + cch], b = convb[cch];
                        cc[s] = (i == 0) ? b + w0 * um2 + w1 * um1 + w2 * u0 : b + w0 * um1 + w1 * u0 + w2 * u1; }
                    r[i] = cc[0] * __builtin_amdgcn_rcpf(1.0f + __builtin_amdgcn_exp2f(-cc[0] * LOG2E)) * cc[1];
                }
                const unsigned w = cvtpk(r[0], r[1]);
                ACT[(size_t)(u.pm * 256) * DFF_ + ch] = (bf16_t)(w & 0xffffu); ACT[(size_t)(u.pm * 256 + 1) * DFF_ + ch] = (bf16_t)(w >> 16);
            }
        }
        asm volatile("s_waitcnt vmcnt(0)" ::: "memory"); __builtin_amdgcn_s_barrier(); asm volatile("" ::: "memory");
    }
};

__device__ __forceinline__ Args opaque_args() {
    Args a{};
#if defined(__HIP_DEVICE_COMPILE__)
    typedef const __attribute__((address_space(4))) Args* KArgsPtr;
    KArgsPtr p = (KArgsPtr)__builtin_amdgcn_kernarg_segment_ptr(); asm volatile("" : "+s"(p));
#pragma unroll
    for (int i = 0; i < 25; ++i) a.in[i] = p->in[i];
    a.out = p->out; a.ws = p->ws; a.ph_lo = p->ph_lo; a.ph_hi = p->ph_hi; a.li = p->li; a.pad = p->pad;
#endif
    return a;
}
__device__ __forceinline__ int opaque_tid() { int t = threadIdx.x; asm volatile("" : "+v"(t)); return t; }
__global__ void __launch_bounds__(NWAVES * 64, 2) fwd_kernel(Args args_by_value) {
    const Args args0 = opaque_args();
    extern __shared__ __attribute__((aligned(16))) unsigned char lds_raw[];
    LAS unsigned char* lds = (LAS unsigned char*)lds_raw;
    volatile LAS unsigned* MISC = (volatile LAS unsigned*)(lds + MISC_OFF);
    const int tid = threadIdx.x, lane = tid & 63, wave = __builtin_amdgcn_readfirstlane(tid >> 6);
    const int G = gridDim.x; const int bx = blockIdx.x; const int vcu = (G % 8 == 0) ? (bx % 8) * (G / 8) + bx / 8 : bx;
    unsigned char* ws = args0.ws;
    gu32* ctl = (gu32*)(ws + WS_CTL);
    for (int u = tid; u < (LDS_BYTES - LDSCTL_OFF) / 4; u += NWAVES * 64) ((LAS unsigned*)(lds + LDSCTL_OFF))[u] = 0u;
    __syncthreads();
    XcdBarrier bar; bar.bar = g_barrier_words + args0.li * XCD_BAR_WORDS; bar.nx = G < 8 ? (unsigned)G : 8u; bar.x = (unsigned)bx % bar.nx; bar.nloc = ((unsigned)G - bar.x + bar.nx - 1u) / bar.nx;
#ifdef PROBE_PH
    const unsigned long long tk0 = __builtin_amdgcn_s_memrealtime(); int nst = 0;
#define GRID_BAR() do { if (!MK_MULTI) xcd_barrier(bar); if (bx == 0 && tid == 0) { ((float*)(ws + WS_CTL + 768 * 1024))[nst] = (float)(__builtin_amdgcn_s_memrealtime() - tk0); } ++nst; } while (0)
#else
#define GRID_BAR() do { if (!MK_MULTI) xcd_barrier(bar); } while (0)
#endif
    const int lo = args0.ph_lo, hi = args0.ph_hi;
#ifndef PHASE_MASK
#define PHASE_MASK 0xff
#endif
#define IN(k) (((PHASE_MASK >> (k)) & 1) && lo <= (k) && (k) < hi)
#define BOTH(k) (IN(k) && IN((k) + 1))

    if (IN(0)) { const Args args = opaque_args(); const int t_ = opaque_tid(); p0_prologue(args, lds, vcu, G, __builtin_amdgcn_readfirstlane(t_ >> 6), t_ & 63); if (BOTH(0)) GRID_BAR(); }
#ifdef PROBE_BARS
    for (int xb = 0; xb < PROBE_BARS; ++xb) GRID_BAR();
#endif

    if (IN(1)) { const Args args = opaque_args();
        constexpr int NUB = 64 * 26 + 16;
        const unsigned* ropep = (const unsigned*)((unsigned char*)args.out + DO_ROPE);
        {
            pg8::Gemm g{(const bf16_t*)(ws + WS_A1I8), (const bf16_t*)((unsigned char*)args.out + DO_WI8), T_ + NB_ * MEM_, NCAT, 512 + args0.pad};
            TileOrder S; S.init(0x3FFFFFFu, 1, G, bx);
            Epi1 E{ws, ropep, args.in[I_AQ], args.in[I_AK], args.in[I_BQ], args.in[I_BK], args.in[I_BGATE], (const float*)(ws + WS_RSC), (const float*)(ws + WS_CMAX), lds};
            pg8::gemm_phase<Epi1, TileOrder, true, false, false, 2, true>(lds + RING_OFF, g, S, E);
            { const int nrem = NUB % G;
              const int t_ = opaque_tid(), w_ = __builtin_amdgcn_readfirstlane(t_ >> 6), l_ = t_ & 63;
              if (nrem == 0) p0_late_weights<0>(args, bx * NWAVES + w_, G * NWAVES, l_);
              else if (bx >= nrem) p0_late_weights<0>(args, (bx - nrem) * NWAVES + w_, (G - nrem) * NWAVES, l_); }
        }
        if (BOTH(1)) GRID_BAR();
    }

    if (IN(2)) { const Args args = opaque_args(); const int t_ = opaque_tid(); p2_attention(args, lds, vcu, t_, __builtin_amdgcn_readfirstlane(t_ >> 6), t_ & 63); if (BOTH(2)) GRID_BAR(); }


    if (IN(4)) { const Args args = opaque_args();
        pg8::Gemm g{(const bf16_t*)((unsigned char*)args.out + DO_OCAT), (const bf16_t*)(ws + WS_WO), T_, 1024, KCAT};
        P3aOrder S; S.init(T_, 1024, G, bx);
        S.oag = (const bf16_t*)((unsigned char*)args.out + DO_OAG); S.ocat = (bf16_t*)((unsigned char*)args.out + DO_OCAT); S.lse = (const float*)(ws + WS_LSE);
        Epi3a E{(const unsigned char*)(ws + WS_G), (bf16_t*)(ws + WS_MERGED)};
        pg8::gemm_phase<Epi3a, P3aOrder, false, false, true>(lds + RING_OFF, g, S, E);
        if (BOTH(4)) GRID_BAR();
    }

    if (IN(5)) { const Args args = opaque_args();
        pg8::Gemm g{(const bf16_t*)(ws + WS_MERGED), (const bf16_t*)(ws + WS_WOUT), T_, 1024, 1024};
        pg8::StaticOrder S; S.init(T_, 1024, G, bx);
        Epi3b E{args.in[I_X], (bf16_t*)(ws + WS_X1L), (bf16_t*)(ws + WS_X1B), (float*)(ws + WS_SSQ)};
        pg8::gemm_phase<Epi3b, pg8::StaticOrder, false, false, false>(lds + RING_OFF, g, S, E);
        if (BOTH(5)) GRID_BAR();
    }

    if (IN(6)) { const Args args = opaque_args();
        pg8::Gemm g{(const bf16_t*)(ws + WS_X1B), (const bf16_t*)(ws + WS_WUP), T_, 5632, 1024};
        P4Order S; S.init(T_, 5632, G, bx); S.SSQ = (const float*)(ws + WS_SSQ); S.rtab = (LAS float*)(lds + XCH_OFF + 2048); S.lastpm = -1; S.convw = args.in[I_CONVW]; S.convb = args.in[I_CONVB]; S.ctab = lds + CTAB_OFF;
        Epi4 E{args.in[I_CONVW], args.in[I_CONVB], (bf16_t*)(ws + WS_ACT), (float*)(ws + WS_UE), (float*)(ws + WS_UF), (LAS float*)(lds + XCH_OFF), (LAS const float*)(lds + XCH_OFF + 2048), (LAS const float*)(lds + CTAB_OFF)};
#ifdef PROBE_NOEPI
        E.skip = (args0.li == 1);
#endif
        pg8::gemm_phase<Epi4, P4Order, true, true, false>(lds + RING_OFF, g, S, E);
        { const int nrem = (64 * 22) % G;
          const int t_ = opaque_tid(), w_ = __builtin_amdgcn_readfirstlane(t_ >> 6), l_ = t_ & 63;
          if (nrem == 0) p0_late_weights<1>(args, bx * NWAVES + w_, G * NWAVES, l_);
          else if (bx >= nrem) p0_late_weights<1>(args, (bx - nrem) * NWAVES + w_, (G - nrem) * NWAVES, l_); }
        if (BOTH(6)) GRID_BAR();
    }

    if (IN(7)) { const Args args = opaque_args();
        pg8::Gemm g{(const bf16_t*)(ws + WS_ACT), (const bf16_t*)(ws + WS_WDOWN), T_, 1024, DFF_};
        P5Order S; S.init(T_, 1024, G, bx);
        S.UE = (const float*)(ws + WS_UE); S.UF = (const float*)(ws + WS_UF); S.convw = args.in[I_CONVW]; S.convb = args.in[I_CONVB]; S.ACT = (bf16_t*)(ws + WS_ACT);
        Epi5 E{(const bf16_t*)(ws + WS_X1B), (const bf16_t*)(ws + WS_X1L), args.out};
        pg8::gemm_phase<Epi5, P5Order, false, false, false>(lds + RING_OFF, g, S, E);
    }
#ifdef PROBE_PH
    if (IN(7) && bx == 0 && tid == 0) { asm volatile("s_waitcnt vmcnt(0)" ::: "memory"); float* st = (float*)(ws + WS_CTL + 768 * 1024); st[nst] = (float)(__builtin_amdgcn_s_memrealtime() - tk0);
        args.out[5] = 1000.0f * (1000.0f * floorf(st[PROBE_PH] / 1000.0f + 0.5f)); }
#endif
#ifdef PROBE_TS
    if (IN(7) && bx == 0 && tid == 0) { asm volatile("s_waitcnt vmcnt(0)" ::: "memory"); const float* dbg = (const float*)(ws + WS_CTL + 512 * 1024); args.out[5] = 1000.0f * (400.0f * floorf(dbg[PROBE_TS - 1] / 400.0f + 0.5f)); }
#endif
#undef IN
#undef BOTH
#undef GRID_BAR
}

extern "C" void kernel_launch(void* const* d_in, const int* in_sizes, int n_in, void* d_out, int out_size, void* d_ws, size_t ws_size, hipStream_t stream) {
    static int grid = 0;
    if (grid == 0) {
        if (n_in != 25 || out_size != T_ * DM_ || ws_size < WS_END) { fprintf(stderr, "kernel_launch: unexpected shapes (n_in %d, out %d, ws %zu); nothing launched\n", n_in, out_size, ws_size); grid = -1; return; }
        int dev = 0, cus = 0, per_cu = 0;
        if (hipGetDevice(&dev) != hipSuccess || hipDeviceGetAttribute(&cus, hipDeviceAttributeMultiprocessorCount, dev) != hipSuccess) { grid = -1; return; }
        if (hipFuncSetAttribute((const void*)fwd_kernel, hipFuncAttributeMaxDynamicSharedMemorySize, LDS_BYTES) != hipSuccess) { fprintf(stderr, "kernel_launch: hipFuncSetAttribute failed\n"); grid = -1; return; }
        if (hipOccupancyMaxActiveBlocksPerMultiprocessor(&per_cu, (const void*)fwd_kernel, NWAVES * 64, LDS_BYTES) != hipSuccess || per_cu < 1) { fprintf(stderr, "kernel_launch: occupancy query says %d blocks per CU\n", per_cu); }
        (void)hipGetLastError();
        grid = cus;
        if (grid != 256) fprintf(stderr, "kernel_launch: %d CUs (the phase schedules expect 256)\n", grid);
    }
    if (grid < 0) return;
    Args a{};
    for (int i = 0; i < 25; ++i) a.in[i] = (const float*)d_in[i];
    a.out = (float*)d_out; a.ws = (unsigned char*)d_ws;
#if MK_MULTI
    for (int p = 0; p < NPHASES; ++p) { a.ph_lo = p; a.ph_hi = p + 1; a.li = p; hipLaunchKernelGGL(fwd_kernel, dim3(grid), dim3(NWAVES * 64), LDS_BYTES, stream, a); }
#elif defined(PROBE_PHASE)
    a.ph_lo = 0; a.ph_hi = PROBE_PHASE + 1; a.li = 0;
    hipLaunchKernelGGL(fwd_kernel, dim3(grid), dim3(NWAVES * 64), LDS_BYTES, stream, a);
    a.ph_lo = PROBE_PHASE; a.ph_hi = NPHASES; a.li = 1;
    hipLaunchKernelGGL(fwd_kernel, dim3(grid), dim3(NWAVES * 64), LDS_BYTES, stream, a);
#else
    a.ph_lo = 0; a.ph_hi = NPHASES; a.li = 0;
    hipLaunchKernelGGL(fwd_kernel, dim3(grid), dim3(NWAVES * 64), LDS_BYTES, stream, a);
#endif
}
```

```cpp
#include <hip/hip_runtime.h>
#include <cstdio>
#include <cstdint>

#ifndef MK_MULTI
#define MK_MULTI 0
#endif
#define LAS __attribute__((address_space(3)))
#define GAS __attribute__((address_space(1)))
typedef unsigned short bf16_t;
typedef short bf16x8 __attribute__((ext_vector_type(8)));
typedef short s16x4 __attribute__((ext_vector_type(4)));
typedef float f32x4 __attribute__((ext_vector_type(4)));
typedef float f32x16 __attribute__((ext_vector_type(16)));
typedef unsigned u32x4 __attribute__((ext_vector_type(4)));
typedef unsigned u32x2 __attribute__((ext_vector_type(2)));
typedef int v4i32 __attribute__((ext_vector_type(4)));
typedef int v8i32 __attribute__((ext_vector_type(8)));

constexpr int T_ = 16384, SEQ_ = 4096, NB_ = 4, DM_ = 1024, MEM_ = 256, DFF_ = 2816;
constexpr int NCAT = 7680;
constexpr int KCAT = 1280;
constexpr float EPS_ = 1e-6f;
constexpr float LOG2E = 1.4426950408889634f;
constexpr float QSCALE64 = 0.125f * LOG2E;
constexpr float QSCALE128 = 0.08838834764831845f * LOG2E;

__device__ __forceinline__ unsigned cvtpk(float lo, float hi) {
    typedef float f2 __attribute__((ext_vector_type(2))); typedef __bf16 b2 __attribute__((ext_vector_type(2)));
    f2 v = {lo, hi}; b2 b = __builtin_convertvector(v, b2); return __builtin_bit_cast(unsigned, b);
}
__device__ __forceinline__ float xor16(float v) { return __int_as_float(__builtin_amdgcn_ds_swizzle(__float_as_int(v), 0x401F)); }
__device__ __forceinline__ float sum_halves(float v) { const auto rr = __builtin_amdgcn_permlane32_swap(__float_as_uint(v), __float_as_uint(v), false, false); return __uint_as_float(rr[0]) + __uint_as_float(rr[1]); }
__device__ __forceinline__ float bflo(unsigned w) { return __uint_as_float(w << 16); }
__device__ __forceinline__ float bfhi(unsigned w) { return __uint_as_float(w & 0xffff0000u); }

namespace pg8 {
constexpr int BM = 256, BK = 64, HALF = 128, HTB = HALF * BK * 2, STAGE_BYTES = 8 * HTB, NXCD = 8, WGM = 8;
__host__ __device__ __forceinline__ int lds_byte(int r, int c) { const int st = (r >> 4) * 2 + (c >> 5), rr = r & 15, cc = c & 31, ob = rr * 64 + cc * 2; return st * 1024 + (ob ^ (((ob >> 9) & 1) << 5)); }
__host__ __device__ __forceinline__ void stage_rc(int b, int& R, int& C) { const int st = b / 1024, sb = b % 1024, swz = sb ^ (((sb >> 9) & 1) << 5); R = (st >> 1) * 16 + swz / 64; C = (st & 1) * 32 + (swz % 64) / 2; }
__host__ __device__ __forceinline__ int perm32(int rho) { const int n = rho >> 4, i = rho & 15; return 8 * (i >> 2) + 4 * n + (i & 3); }

struct Unit { int pm, pn, par; };
struct Gemm { const bf16_t* A; const bf16_t* Bt; int M, N, K; };

struct StaticOrder {
    int nM, nN, nwg, G, c;
    __host__ __device__ void init(int M, int N, int G_, int c_) { nM = M / BM; nN = N / BM; nwg = nM * nN; G = G_; c = c_; }
    __host__ __device__ bool next(int i, Unit& u) const {
        const long L = (long)i * G + c; if (L >= nwg) return false;
        int wgid = (int)L; { const int q = nwg / NXCD, r = nwg % NXCD, xcd = wgid % NXCD, off = wgid / NXCD; wgid = (xcd < r ? xcd * (q + 1) : r * (q + 1) + (xcd - r) * q) + off; }
        const int nig = WGM * nN, gid = wgid / nig, fm = gid * WGM, gsz = (nM - fm) < WGM ? (nM - fm) : WGM;
        u.pm = fm + ((wgid % nig) % gsz); u.pn = (wgid % nig) / gsz; return true;
    }
    __device__ __forceinline__ void a_ready(const Unit&) const {}
    __device__ __forceinline__ void done(const Unit&) const {}
};

template <class Epi, class Sched, bool ALIGN_EPI, bool PERMA, bool KHOOK, int QM = 0, bool PREF = false>
__device__ __forceinline__ void gemm_phase(LAS unsigned char* lds, const Gemm g, const Sched& S, const Epi& E) {
    constexpr bool FP8 = (QM == 1), I8 = (QM == 2);
    int tid_ = threadIdx.x; asm volatile("" : "+v"(tid_));
    const int tid = tid_, wid = __builtin_amdgcn_readfirstlane(tid >> 6), lane = tid & 63, wr = wid >> 2, wc = wid & 3, fr = lane & 15, fq = lane >> 4;
    const int K = g.K, nt = K / BK;
    unsigned voffA0, voffA1, voffB;
    { int R, C; stage_rc(tid * 16, R, C); const int Rb = (R & ~31) + perm32(R & 31);
        if (PERMA) { const int rw = R >> 6, rm = (R >> 4) & 3, rf = R & 15; voffA0 = (unsigned)((128 * rw + 8 * rf + rm) * K + C) * 2u; voffA1 = (unsigned)((128 * rw + 8 * rf + 4 + rm) * K + C) * 2u; }
        else { voffA0 = (unsigned)(R * K + C) * 2u; voffA1 = voffA0; }
        voffB = (unsigned)(Rb * K + C) * 2u; }
    const size_t pstep_voffA0 = (size_t)(PERMA ? 128 : 64) * K * 2, pstep_voffA1 = pstep_voffA0, pstep_voffB = (size_t)64 * K * 2;
    const size_t kstep = (size_t)(BK * 2);
    const size_t hstep = (size_t)HALF * K * 2;
    const size_t ahs = PERMA ? (size_t)0 : hstep;
    const size_t tstep = 2 * hstep;
    const unsigned ldsw = (unsigned)wid * 1024u;
    const int aoff = lds_byte(wr * 64 + fr, fq * 8), boff = lds_byte(wc * 32 + fr, fq * 8);
#define PG8_SA(b, h) (((b) * 2 + (h)) * HTB)
#define PG8_SB(b, h) ((4 + (b) * 2 + (h)) * HTB)
#define PG8_STAGE(bufoff, gbase, voff) do { _Pragma("unroll") for (int _i = 0; _i < 2; ++_i) { unsigned _v = (voff); asm volatile("" : "+v"(_v));     \
        __builtin_amdgcn_global_load_lds((const unsigned*)((const char*)(gbase) + _i * PG8_PSTEP(voff) + _v), (LAS unsigned*)(lds + (bufoff) + ldsw + _i * 8192), 16, 0, 0); } } while (0)
#define PG8_PSTEP(voff) pstep_##voff
#define PG8_LD8(p) __builtin_shufflevector(*(const LAS v4i32*)(p), *(const LAS v4i32*)((p) + 1024), 0, 1, 2, 3, 4, 5, 6, 7)
#define PG8_LDA(dst, b, h) do { if constexpr (false) { _Pragma("unroll") for (int m = 0; m < 4; ++m) dst##8[m] = PG8_LD8(lds + PG8_SA(b, h) + aoff + m * 2048); } \
        else { _Pragma("unroll") for (int m = 0; m < 4; ++m) _Pragma("unroll") for (int k = 0; k < 2; ++k) dst[m][k] = *(const LAS bf16x8*)(lds + PG8_SA(b, h) + aoff + m * 2048 + k * 1024); } } while (0)
#define PG8_LDB(dst, b, h) do { if constexpr (false) { _Pragma("unroll") for (int n = 0; n < 2; ++n) dst##8[n] = PG8_LD8(lds + PG8_SB(b, h) + boff + n * 2048); } \
        else { _Pragma("unroll") for (int n = 0; n < 2; ++n) _Pragma("unroll") for (int k = 0; k < 2; ++k) dst[n][k] = *(const LAS bf16x8*)(lds + PG8_SB(b, h) + boff + n * 2048 + k * 1024); } } while (0)
#define PG8_CAT(x) __builtin_shufflevector(__builtin_bit_cast(v4i32, (x)[0]), __builtin_bit_cast(v4i32, (x)[1]), 0, 1, 2, 3, 4, 5, 6, 7)
#define PG8_MMA(ai, bj, At, Bt) do { if constexpr (FP8) __builtin_amdgcn_sched_barrier(0); __builtin_amdgcn_s_setprio(1); _Pragma("unroll") for (int m = 0; m < 4; ++m) _Pragma("unroll") for (int n = 0; n < 2; ++n) { \
        if constexpr (FP8) acc[ai][bj][m][n] = __builtin_amdgcn_mfma_scale_f32_16x16x128_f8f6f4(PG8_CAT(Bt[n]), PG8_CAT(At[m]), acc[ai][bj][m][n], 0, 0, 0, 0, 0, 0); \
        else if constexpr (I8) { _Pragma("unroll") for (int k = 0; k < 2; ++k) acc[ai][bj][m][n] = __builtin_bit_cast(f32x4, __builtin_amdgcn_mfma_i32_16x16x64_i8(__builtin_bit_cast(v4i32, Bt[n][k]), __builtin_bit_cast(v4i32, At[m][k]), __builtin_bit_cast(v4i32, acc[ai][bj][m][n]), 0, 0, 0)); } \
        else { _Pragma("unroll") for (int k = 0; k < 2; ++k) acc[ai][bj][m][n] = __builtin_amdgcn_mfma_f32_16x16x32_bf16(Bt[n][k], At[m][k], acc[ai][bj][m][n], 0, 0, 0); } } if constexpr (FP8) __builtin_amdgcn_sched_barrier(0); __builtin_amdgcn_s_setprio(0); if constexpr (FP8) __builtin_amdgcn_sched_barrier(0); } while (0)
#define PG8_WAIT_V(n) asm volatile("s_waitcnt vmcnt(" #n ")" ::: "memory")
#define PG8_WAIT_L(n) asm volatile("s_waitcnt lgkmcnt(" #n ")" ::: "memory")
#define PG8_BAR __builtin_amdgcn_s_barrier()
#define PG8_SCHED __builtin_amdgcn_sched_barrier(0)
    Unit cur, nxt; int ui = 0;
    if (!S.next(0, cur)) return;
    cur.par = 0;
    f32x4 acc[2][2][4][2];
#pragma unroll
    for (int a = 0; a < 2; ++a)
#pragma unroll
        for (int b = 0; b < 2; ++b)
#pragma unroll
            for (int m = 0; m < 4; ++m)
#pragma unroll
                for (int n = 0; n < 2; ++n) acc[a][b][m][n] = (f32x4){0.f, 0.f, 0.f, 0.f};
    bf16x8 At[4][2], B0[2][2], B1[2][2];
    v8i32 At8[4], B08[2], B18[2];
    const char* cA = (const char*)g.A + (size_t)cur.pm * tstep; const char* cB = (const char*)g.Bt + (size_t)cur.pn * tstep;
    S.a_ready(cur);
    PG8_STAGE(PG8_SB(0, 0), cB, voffB); PG8_STAGE(PG8_SB(0, 1), cB + hstep, voffB); PG8_STAGE(PG8_SA(0, 0), cA, voffA0); PG8_STAGE(PG8_SA(0, 1), cA + ahs, voffA1);
    if (wr == 1) PG8_BAR;
    PG8_WAIT_V(2); PG8_BAR;
    PG8_STAGE(PG8_SB(1, 0), cB + kstep, voffB); PG8_STAGE(PG8_SA(1, 0), cA + kstep, voffA0); PG8_STAGE(PG8_SB(1, 1), cB + hstep + kstep, voffB);
    PG8_WAIT_V(6); PG8_BAR;
    for (;;) {
        const bool has_next = S.next(ui + 1, nxt); nxt.par = (ui + 1) & 1;
        const char* nA = has_next ? (const char*)g.A + (size_t)nxt.pm * tstep : cA; const char* nB = has_next ? (const char*)g.Bt + (size_t)nxt.pn * tstep : cB;
        for (int t = 0; t < nt; t += 2) {
            const bool last = (t == nt - 2);
            const char* a1 = cA + (size_t)(t + 1) * kstep;
            const char* a2 = last ? nA : cA + (size_t)(t + 2) * kstep; const char* b2 = last ? nB : cB + (size_t)(t + 2) * kstep;
            const char* a3 = a2 + kstep; const char* b3 = b2 + kstep;
            asm volatile("" : "+s"(a1), "+s"(a2), "+s"(b2), "+s"(a3), "+s"(b3));
            if (last && has_next) S.a_ready(nxt);
            if constexpr (KHOOK) { int l3_ = threadIdx.x; asm volatile("" : "+v"(l3_)); E.khook(acc, cur, t, wr, wc, l3_ & 15, (l3_ >> 4) & 3); }
            PG8_LDB(B0, 0, 0); PG8_LDB(B1, 0, 1); PG8_SCHED; PG8_LDA(At, 0, 0); PG8_STAGE(PG8_SA(1, 1), a1 + ahs, voffA1);
            PG8_WAIT_V(8); PG8_WAIT_L(0); PG8_BAR;
            if constexpr (PREF) { if (t == 0 && wr == 0) E.prefetch(cur, wid); }
            PG8_MMA(0, 0, At, B0); PG8_MMA(0, 1, At, B1); PG8_BAR; PG8_SCHED;
            PG8_LDA(At, 0, 1); PG8_STAGE(PG8_SB(0, 0), b2, voffB); PG8_STAGE(PG8_SB(0, 1), b2 + hstep, voffB); PG8_STAGE(PG8_SA(0, 0), a2, voffA0);
            PG8_WAIT_V(8); PG8_WAIT_L(0); PG8_BAR; PG8_MMA(1, 0, At, B0); PG8_MMA(1, 1, At, B1); PG8_BAR; PG8_SCHED;
            PG8_LDB(B0, 1, 0); PG8_LDB(B1, 1, 1); PG8_SCHED; PG8_LDA(At, 1, 0); PG8_STAGE(PG8_SA(0, 1), a2 + ahs, voffA1);
            PG8_WAIT_V(8); PG8_WAIT_L(0); PG8_BAR; PG8_MMA(0, 0, At, B0); PG8_MMA(0, 1, At, B1); PG8_BAR; PG8_SCHED;
            PG8_LDA(At, 1, 1); PG8_STAGE(PG8_SB(1, 0), b3, voffB); PG8_STAGE(PG8_SB(1, 1), b3 + hstep, voffB); PG8_STAGE(PG8_SA(1, 0), a3, voffA0);
            PG8_WAIT_V(8); PG8_WAIT_L(0); PG8_BAR; PG8_MMA(1, 0, At, B0); PG8_MMA(1, 1, At, B1); PG8_BAR; PG8_SCHED;
        }
        if constexpr (ALIGN_EPI) { if (wr == 0) PG8_BAR; }
        { int l2_ = threadIdx.x; asm volatile("" : "+v"(l2_)); const int fr2 = l2_ & 15, fq2 = (l2_ >> 4) & 3;
          if (!E.skip) E(acc, cur, wr, wc, fr2, fq2); } S.done(cur);
        if (!has_next) break;
#pragma unroll
        for (int a = 0; a < 2; ++a)
#pragma unroll
            for (int b = 0; b < 2; ++b)
#pragma unroll
                for (int m = 0; m < 4; ++m)
#pragma unroll
                    for (int n = 0; n < 2; ++n) acc[a][b][m][n] = (f32x4){0.f, 0.f, 0.f, 0.f};
        cur = nxt; cA = nA; cB = nB; ++ui;
        if constexpr (ALIGN_EPI) { if (wr == 1) PG8_BAR; }
    }
    PG8_WAIT_V(0);
    if constexpr (!ALIGN_EPI) { if (wr == 0) PG8_BAR; }
    PG8_BAR;
#undef PG8_SA
#undef PG8_SB
#undef PG8_STAGE
#undef PG8_PSTEP
#undef PG8_LDA
#undef PG8_LDB
#undef PG8_MMA
#undef PG8_CAT
#undef PG8_LD8
#undef PG8_WAIT_V
#undef PG8_WAIT_L
#undef PG8_BAR
#undef PG8_SCHED
}
}

constexpr size_t MiB = 1u << 20;
constexpr size_t WS_CTL = 0, CTL_ZERO_BYTES = 1 * MiB;
constexpr size_t WS_WO = 1 * MiB;
constexpr size_t WS_WOUT = 4 * MiB;
constexpr size_t WS_WUP = 6 * MiB;
constexpr size_t WS_WDOWN = 17 * MiB;
constexpr size_t WS_SSQ = 23 * MiB;
constexpr size_t WS_UE = 24 * MiB;
constexpr size_t WS_UF = 27 * MiB;
constexpr size_t WS_LSE = 30 * MiB;
constexpr size_t WS_MKV = 31 * MiB;
constexpr size_t WS_G = 34 * MiB;
constexpr size_t WS_A1I8 = 84 * MiB;
constexpr size_t WS_RSC = 23 * MiB;
constexpr size_t WS_CMAX = 23 * MiB + 128 * 1024;
constexpr size_t WS_ACT = 34 * MiB;
constexpr size_t WS_QA = 130 * MiB;
constexpr size_t WS_KA = 154 * MiB;
constexpr size_t WS_VA = 178 * MiB;
constexpr size_t WS_MERGED = 130 * MiB;
constexpr size_t WS_X1B = 162 * MiB;
constexpr size_t WS_X1L = 194 * MiB;
constexpr size_t WS_QB = 202 * MiB;
constexpr size_t WS_KVB = 218 * MiB;
constexpr size_t WS_MQ = 226 * MiB;
constexpr size_t WS_END = 242 * MiB;
constexpr size_t DO_WI8 = 34 * MiB;
constexpr size_t DO_ROPE = 49 * MiB;
constexpr size_t DO_OCAT = 0;
constexpr size_t DO_OAG = 40 * MiB;

constexpr int CW_TMO = 0, CW_BAR = 4096;

constexpr int RING_OFF = 0, RING_BYTES = 131072;
constexpr int XCH_OFF = RING_BYTES;
constexpr int LDSCTL_OFF = RING_BYTES + 4096, MISC_OFF = LDSCTL_OFF + 320;
constexpr int LDS_BYTES = 147456;
constexpr int P1T_ROPE = 131072, P1T_CS = 139264, P1T_BIAS = 140288, P1T_RSC = 141312, P1T_GAIN = 142336;
constexpr int CTAB_OFF = 139264;
constexpr int NWAVES = 8;
constexpr int NPHASES = 8;

typedef GAS unsigned gu32;
#define RLX_AGENT __ATOMIC_RELAXED, __HIP_MEMORY_SCOPE_AGENT
#define LDS_WAIT() asm volatile("s_waitcnt lgkmcnt(0)" ::: "memory")
#define VM_WAIT() asm volatile("s_waitcnt vmcnt(0)" ::: "memory")

#define XB_TMO      128
#define XB_XCNT(j)  (256  + 64 * (j))
#define XB_XSUB(j)  (1280 + 64 * (j))
#define XB_XGEN(j)  (2304 + 64 * (j))
#define XB_TOP      3328
#define XB_TOPGEN   3392
#define XCD_BAR_WORDS 3456
#define XB_SPIN_CAP (1u << 18)
__device__ __forceinline__ unsigned xb_ld(unsigned* p)              { return __hip_atomic_load(p, __ATOMIC_RELAXED, __HIP_MEMORY_SCOPE_AGENT); }
__device__ __forceinline__ unsigned xb_add(unsigned* p, unsigned v) { return __hip_atomic_fetch_add(p, v, __ATOMIC_RELAXED, __HIP_MEMORY_SCOPE_AGENT); }
__device__ __forceinline__ unsigned xb_xcc_id() { return (unsigned)__builtin_amdgcn_s_getreg((3 << 11) | 20) & 0xFu; }
#define XB_SPIN(cond, bar) do { unsigned _sp = 0; while (cond) { __builtin_amdgcn_s_sleep(1); \
    if ((++_sp & 255u) == 0u) { if (xb_ld(&(bar)[XB_TMO])) break; if (_sp > XB_SPIN_CAP) { atomicAdd(&(bar)[XB_TMO], 1u); break; } } } } while (0)
__device__ unsigned g_barrier_words[2 * XCD_BAR_WORDS];
struct XcdBarrier { unsigned* bar; unsigned x, nloc, nx; };
__device__ __forceinline__ void xcd_barrier(const XcdBarrier& b) {
    asm volatile("s_waitcnt vmcnt(0)" ::: "memory");
    __syncthreads();
    if (threadIdx.x == 0) {
        unsigned* bar = b.bar;
        __builtin_amdgcn_s_waitcnt(0);
        const unsigned nloc = b.nloc, nx = b.nx;
        const unsigned old = xb_add(&bar[XB_XSUB(b.x)], 1u);
        const unsigned gen = old / nloc;
        if (old + 1u == (gen + 1u) * nloc) {
            __builtin_amdgcn_fence(__ATOMIC_RELEASE, "agent");
            asm volatile("s_waitcnt vmcnt(0)" ::: "memory");
            const unsigned og = xb_add(&bar[XB_TOP], 1u);
            const unsigned tg = og / nx;
            if (og + 1u == (tg + 1u) * nx) xb_add(&bar[XB_TOPGEN], 1u);
            else XB_SPIN(xb_ld(&bar[XB_TOPGEN]) == tg, bar);
            __builtin_amdgcn_fence(__ATOMIC_ACQUIRE, "agent");
            xb_add(&bar[XB_XGEN(b.x)], 1u);
            asm volatile("s_waitcnt vmcnt(0)" ::: "memory");
        } else {
            XB_SPIN(xb_ld(&bar[XB_XGEN(b.x)]) == gen, bar);
            __builtin_amdgcn_fence(__ATOMIC_ACQUIRE, "agent");
            asm volatile("s_waitcnt vmcnt(0)" ::: "memory");
        }
    }
    __syncthreads();
}

struct Args {
    const float* in[25]; float* out; unsigned char* ws; int ph_lo, ph_hi, li, pad;
};
enum { I_X = 0, I_MEM, I_POS, I_ATTN_NORM, I_W_IN, I_AQ, I_AK, I_BQ, I_BK, I_SINK, I_MEM_NORM, I_W_MKV, I_MQN, I_MKN, I_WOA, I_WOB, I_WOM, I_WGATE, I_BGATE, I_WOUT, I_FFN_NORM, I_WUP, I_CONVW, I_CONVB, I_WDOWN };

__host__ __device__ __forceinline__ int map_uniform(int n) { const int c = n & 255; return (n & ~255) + 128 * ((c >> 5) & 1) + 32 * (c >> 6) + (c & 31); }
__host__ __device__ __forceinline__ int map_up(int n) { return n < DFF_ ? 256 * (n >> 7) + (n & 127) : 256 * ((n - DFF_) >> 7) + 128 + ((n - DFF_) & 127); }

__device__ __forceinline__ float wave_sum(float v) {
#pragma unroll
    for (int o = 1; o < 64; o <<= 1) v += __shfl_xor(v, o);
    return v;
}
template <int MAP>
__device__ __forceinline__ void p0_transpose_item(const float* W, int K, int N, bf16_t* WT, int noff, int pitch, int koff, const float* kscale, LAS float*  , int item, int lane) {
    const int nblk = N / 32, kb = item / nblk, nb = item % nblk, k0 = 64 * kb + 8 * (lane >> 3), n0 = 32 * nb;
    f32x4 v[8];
#pragma unroll
    for (int i = 0; i < 8; ++i) v[i] = *(const f32x4*)(W + (size_t)(k0 + i) * N + n0 + 4 * (lane & 7));
    if (kscale) { const f32x4 s0 = *(const f32x4*)(kscale + k0), s1 = *(const f32x4*)(kscale + k0 + 4);
#pragma unroll
        for (int i = 0; i < 8; ++i) v[i] = v[i] * (i < 4 ? s0[i & 3] : s1[i & 3]); }
    const int r0 = (MAP == 0 ? map_uniform(noff + n0) : map_up(noff + n0)) + 4 * (lane & 7);
#pragma unroll
    for (int e = 0; e < 4; ++e) { u32x4 o; o.x = cvtpk(v[0][e], v[1][e]); o.y = cvtpk(v[2][e], v[3][e]); o.z = cvtpk(v[4][e], v[5][e]); o.w = cvtpk(v[6][e], v[7][e]);
        *(GAS u32x4*)(WT + (size_t)(r0 + e) * pitch + koff + k0 + 0) = o; }
}
constexpr float I8MAGIC = 12582912.0f;
__device__ __forceinline__ unsigned pack_i8(float m0, float m1, float m2, float m3) {
    const unsigned p01 = __builtin_amdgcn_perm(__float_as_uint(m1), __float_as_uint(m0), 0x0c0c0400u);
    const unsigned p23 = __builtin_amdgcn_perm(__float_as_uint(m3), __float_as_uint(m2), 0x0c0c0400u);
    return p01 | (p23 << 16);
}
__device__ __forceinline__ float wave_max(float v) {
#pragma unroll
    for (int o = 1; o < 64; o <<= 1) v = fmaxf(v, __shfl_xor(v, o));
    return v;
}
__device__ __forceinline__ void p0_quant_weight_block(const float* W, int N, int nb, int coff, unsigned char* WT, float* cmax, LAS float* part, int wave, int lane) {
    const int n0 = 32 * nb;
    f32x4 v[2][8];
#pragma unroll
    for (int it = 0; it < 2; ++it) { const int k0 = 128 * wave + 64 * it + 8 * (lane >> 3);
#pragma unroll
        for (int i = 0; i < 8; ++i) v[it][i] = *(const f32x4*)(W + (size_t)(k0 + i) * N + n0 + 4 * (lane & 7)); }
    f32x4 mx = {0.f, 0.f, 0.f, 0.f};
#pragma unroll
    for (int it = 0; it < 2; ++it)
#pragma unroll
        for (int i = 0; i < 8; ++i)
#pragma unroll
            for (int e = 0; e < 4; ++e) mx[e] = fmaxf(mx[e], fabsf(v[it][i][e]));
#pragma unroll
    for (int o = 8; o < 64; o <<= 1)
#pragma unroll
        for (int e = 0; e < 4; ++e) mx[e] = fmaxf(mx[e], __shfl_xor(mx[e], o));
    if (lane < 8) *(LAS f32x4*)(part + wave * 32 + 4 * lane) = mx;
    __syncthreads();
    f32x4 cm = *(const LAS f32x4*)(part + 4 * (lane & 7));
#pragma unroll
    for (int w = 1; w < 8; ++w) { const f32x4 o = *(const LAS f32x4*)(part + w * 32 + 4 * (lane & 7));
#pragma unroll
        for (int e = 0; e < 4; ++e) cm[e] = fmaxf(cm[e], o[e]); }
    if (wave == 0 && lane < 8) *(f32x4*)(cmax + coff + n0 + 4 * lane) = cm;
    f32x4 inv;
#pragma unroll
    for (int e = 0; e < 4; ++e) inv[e] = cm[e] > 0.f ? 127.0f / cm[e] : 0.f;
    const int r0 = map_uniform(coff + n0) + 4 * (lane & 7);
#pragma unroll
    for (int it = 0; it < 2; ++it) { const int k0 = 128 * wave + 64 * it + 8 * (lane >> 3);
#pragma unroll
        for (int e = 0; e < 4; ++e) { u32x2 o;
            o.x = pack_i8(__builtin_fmaf(v[it][0][e], inv[e], I8MAGIC), __builtin_fmaf(v[it][1][e], inv[e], I8MAGIC), __builtin_fmaf(v[it][2][e], inv[e], I8MAGIC), __builtin_fmaf(v[it][3][e], inv[e], I8MAGIC));
            o.y = pack_i8(__builtin_fmaf(v[it][4][e], inv[e], I8MAGIC), __builtin_fmaf(v[it][5][e], inv[e], I8MAGIC), __builtin_fmaf(v[it][6][e], inv[e], I8MAGIC), __builtin_fmaf(v[it][7][e], inv[e], I8MAGIC));
            *(GAS u32x2*)(WT + (size_t)(r0 + e) * 1024 + k0) = o; } }
    __syncthreads();
}
template <int NR>
__device__ __forceinline__ void rms_rows_to_i8(const float* xrow, size_t rstride, const float* gain, unsigned char* orow, float* rsc, int lane) {
    const GAS f32x4* gr = (const GAS f32x4*)gain + lane;
    f32x4 v[NR][4]; float s[NR], mx[NR];
#pragma unroll
    for (int r = 0; r < NR; ++r) { const GAS f32x4* xr = (const GAS f32x4*)(xrow + r * rstride) + lane;
#pragma unroll
        for (int j = 0; j < 4; ++j) v[r][j] = xr[64 * j]; }
    f32x4 g[4];
#pragma unroll
    for (int j = 0; j < 4; ++j) g[j] = gr[64 * j];
#pragma unroll
    for (int r = 0; r < NR; ++r) { s[r] = 0.f;
#pragma unroll
        for (int j = 0; j < 4; ++j) s[r] += (v[r][j].x * v[r][j].x + v[r][j].y * v[r][j].y) + (v[r][j].z * v[r][j].z + v[r][j].w * v[r][j].w); }
#pragma unroll
    for (int r = 0; r < NR; ++r) { const float rstd = 1.0f / sqrtf(wave_sum(s[r]) * (1.f / 1024.f) + EPS_); mx[r] = 0.f;
#pragma unroll
        for (int j = 0; j < 4; ++j) { v[r][j] = v[r][j] * rstd * g[j];
            mx[r] = fmaxf(fmaxf(mx[r], fmaxf(fabsf(v[r][j].x), fabsf(v[r][j].y))), fmaxf(fabsf(v[r][j].z), fabsf(v[r][j].w))); } }
#pragma unroll
    for (int r = 0; r < NR; ++r) mx[r] = wave_max(mx[r]);
#pragma unroll
    for (int r = 0; r < NR; ++r) { const float inv = mx[r] > 0.f ? 127.0f / mx[r] : 0.f;
        GAS unsigned* o4 = (GAS unsigned*)(orow + r * rstride) + lane;
#pragma unroll
        for (int j = 0; j < 4; ++j) o4[64 * j] = pack_i8(__builtin_fmaf(v[r][j].x, inv, I8MAGIC), __builtin_fmaf(v[r][j].y, inv, I8MAGIC), __builtin_fmaf(v[r][j].z, inv, I8MAGIC), __builtin_fmaf(v[r][j].w, inv, I8MAGIC));
        if (lane == 0) rsc[r] = mx[r] * (1.0f / 127.0f); }
}
__device__ __forceinline__ void sincos_f(float ang, float& co, float& si) {
    const double x = (double)ang; const double n = __builtin_rint(x * 0.63661977236758134308);
    double r = __builtin_fma(-n, 1.5707963267948966192, x); r = __builtin_fma(-n, 6.123233995736766036e-17, r);
    const double r2 = r * r;
    double s = -1.0 / 6227020800.0; s = s * r2 + 1.0 / 39916800.0; s = s * r2 - 1.0 / 362880.0; s = s * r2 + 1.0 / 5040.0; s = s * r2 - 1.0 / 120.0; s = s * r2 + 1.0 / 6.0; s = r - r * r2 * s;
    double c = 1.0 / 479001600.0; c = c * r2 - 1.0 / 3628800.0; c = c * r2 + 1.0 / 40320.0; c = c * r2 - 1.0 / 720.0; c = c * r2 + 1.0 / 24.0; c = c * r2 - 0.5; c = c * r2 + 1.0;
    const int q = (int)((long long)n & 3);
    const double cs = (q == 0) ? c : (q == 1) ? -s : (q == 2) ? -c : s;
    const double sn = (q == 0) ? s : (q == 1) ? c : (q == 2) ? -s : -c;
    co = (float)cs; si = (float)sn;
}

struct Frame {
    LAS unsigned char* lds;
    int tid, lane, wave, vcu, G;
    const Args* a;
};

__device__ __forceinline__ void p0_prologue(const Args& A, LAS unsigned char* lds, int vcu, int G, int wave, int lane) {
    const int gw = vcu * NWAVES + wave, NGW = G * NWAVES;
    unsigned char* wi8 = (unsigned char*)A.out + DO_WI8;
    unsigned char* a1 = A.ws + WS_A1I8;
    float* rsc = (float*)(A.ws + WS_RSC); float* cmax = (float*)(A.ws + WS_CMAX);
    unsigned* rope = (unsigned*)((unsigned char*)A.out + DO_ROPE);
    constexpr int B_IN = 3584 / 32, B_GATE = 3072 / 32, B_MKV = 1024 / 32;
    for (int it = vcu; it < B_IN + B_GATE + B_MKV; it += G) {
        LAS float* part = (LAS float*)(lds + RING_OFF);
        if (it < B_IN) p0_quant_weight_block(A.in[I_W_IN], 3584, it, 0, wi8, cmax, part, wave, lane);
        else if (it < B_IN + B_GATE) p0_quant_weight_block(A.in[I_WGATE], 3072, it - B_IN, 3584, wi8, cmax, part, wave, lane);
        else p0_quant_weight_block(A.in[I_W_MKV], 1024, it - B_IN - B_GATE, 6656, wi8, cmax, part, wave, lane);
    }
    for (int m = 4 * gw; m < T_ + NB_ * MEM_; m += 4 * NGW) {
        if (m < T_) rms_rows_to_i8<4>(A.in[I_X] + (size_t)m * DM_, DM_, A.in[I_ATTN_NORM], a1 + (size_t)m * DM_, rsc + m, lane);
        else rms_rows_to_i8<4>(A.in[I_MEM] + (size_t)(m - T_) * DM_, DM_, A.in[I_MEM_NORM], a1 + (size_t)m * DM_, rsc + m, lane);
    }
    const int* pos = (const int*)A.in[I_POS];
    for (int idx = gw * 64 + lane; idx < T_ * 8; idx += NGW * 64) {
        const int t = idx >> 3, i = idx & 7;
        const float fr = (i == 0) ? 1.0f : (i == 1) ? 0.193922758102417f : (i == 2) ? 0.03760603442788124f : (i == 3) ? 0.007292666472494602f : (i == 4) ? 0.0014142136787995696f
                       : (i == 5) ? 0.00027424818836152554f : (i == 6) ? 5.318298644851893e-05f : 1.031338433676865e-05f;
        const float ang = (float)pos[t] * fr; float co, si; sincos_f(ang, co, si);
        rope[idx] = (unsigned)__builtin_bit_cast(unsigned short, (_Float16)co) | ((unsigned)__builtin_bit_cast(unsigned short, (_Float16)si) << 16);
    }
}

struct TItem { const float* W; bf16_t* WT; const float* kscale; int N, noff, pitch, koff, map, item; };
__device__ __forceinline__ void ti_load(const TItem& d, int lane, f32x4 (&v)[8], f32x4 (&sc)[2]) {
    const int nblk = d.N / 32, kb = d.item / nblk, nb = d.item % nblk, k0 = 64 * kb + 8 * (lane >> 3), n0 = 32 * nb;
#pragma unroll
    for (int i = 0; i < 8; ++i) v[i] = *(const f32x4*)(d.W + (size_t)(k0 + i) * d.N + n0 + 4 * (lane & 7));
    if (d.kscale) { sc[0] = *(const f32x4*)(d.kscale + k0); sc[1] = *(const f32x4*)(d.kscale + k0 + 4); }
}
__device__ __forceinline__ void ti_store(const TItem& d, int lane, f32x4 (&v)[8], const f32x4 (&sc)[2]) {
    const int nblk = d.N / 32, kb = d.item / nblk, nb = d.item % nblk, k0 = 64 * kb + 8 * (lane >> 3), n0 = 32 * nb;
    if (d.kscale) {
#pragma unroll
        for (int i = 0; i < 8; ++i) v[i] = v[i] * (i < 4 ? sc[0][i & 3] : sc[1][i & 3]); }
    const int r0 = (d.map == 0 ? map_uniform(d.noff + n0) : map_up(d.noff + n0)) + 4 * (lane & 7);
#pragma unroll
    for (int e = 0; e < 4; ++e) { u32x4 o; o.x = cvtpk(v[0][e], v[1][e]); o.y = cvtpk(v[2][e], v[3][e]); o.z = cvtpk(v[4][e], v[5][e]); o.w = cvtpk(v[6][e], v[7][e]);
        *(GAS u32x4*)(d.WT + (size_t)(r0 + e) * d.pitch + d.koff + k0) = o; }
}
template <int PART>
__device__ __forceinline__ bool late_item(const Args& A, int it, TItem& d) {
    constexpr int I_OA = (256 / 64) * (1024 / 32), I_OB = (512 / 64) * (1024 / 32), I_OM = I_OB, I_OUT = (1024 / 64) * (1024 / 32);
    constexpr int I_UP = (1024 / 64) * (5632 / 32), I_DOWN = (2816 / 64) * (1024 / 32);
    bf16_t* wo = (bf16_t*)(A.ws + WS_WO);
    if (PART == 1) { if (it >= I_DOWN) return false; d = TItem{A.in[I_WDOWN], (bf16_t*)(A.ws + WS_WDOWN), nullptr, 1024, 0, 2816, 0, 0, it}; return true; }
    int r = it;
    if (r < I_OA) { d = TItem{A.in[I_WOA], wo, nullptr, 1024, 0, KCAT, 0, 0, r}; return true; } r -= I_OA;
    if (r < I_OB) { d = TItem{A.in[I_WOB], wo, nullptr, 1024, 0, KCAT, 256, 0, r}; return true; } r -= I_OB;
    if (r < I_OM) { d = TItem{A.in[I_WOM], wo, nullptr, 1024, 0, KCAT, 768, 0, r}; return true; } r -= I_OM;
    if (r < I_OUT) { d = TItem{A.in[I_WOUT], (bf16_t*)(A.ws + WS_WOUT), nullptr, 1024, 0, 1024, 0, 0, r}; return true; } r -= I_OUT;
    if (r < I_UP) { d = TItem{A.in[I_WUP], (bf16_t*)(A.ws + WS_WUP), A.in[I_FFN_NORM], 5632, 0, 1024, 0, 1, r}; return true; }
    return false;
}
template <int PART>
__device__ __forceinline__ void p0_late_weights(const Args& A, int gw, int ngw, int lane) {
    constexpr int NB = 3;
    for (int it = gw; ; it += NB * ngw) {
        TItem d[NB]; bool ok[NB]; f32x4 v[NB][8], sc[NB][2];
#pragma unroll
        for (int b = 0; b < NB; ++b) { ok[b] = late_item<PART>(A, it + b * ngw, d[b]); if (ok[b]) ti_load(d[b], lane, v[b], sc[b]); }
        if (!ok[0]) break;
#pragma unroll
        for (int b = 0; b < NB; ++b) if (ok[b]) ti_store(d[b], lane, v[b], sc[b]);
    }
}

struct TileOrder {
    pg8::StaticOrder so; unsigned mask; int mkv;
    __device__ void init(unsigned mask_, int mkv_, int G, int c) { mask = mask_; mkv = mkv_; so.init(T_, 256 * __builtin_popcount(mask_), G, c); }
    __device__ bool next(int i, pg8::Unit& u) const {
        if (so.next(i, u)) { unsigned m = mask; for (int k = 0; k < u.pn; ++k) m &= m - 1u; u.pn = __builtin_ctz(m); return true; }
        if (!mkv) return false;
        const long L = (long)i * so.G + so.c - so.nwg; if (L < 0 || L >= 16) return false;
        u.pm = 64 + (int)(L >> 2); u.pn = 26 + (int)(L & 3); return true;
    }
    __device__ __forceinline__ void a_ready(const pg8::Unit&) const {}
    __device__ __forceinline__ void done(const pg8::Unit&) const {}
};

__device__ __forceinline__ f32x4 cvt_i32(const f32x4& a) { const v4i32 i = __builtin_bit_cast(v4i32, a); return (f32x4){(float)i[0], (float)i[1], (float)i[2], (float)i[3]}; }

__device__ __forceinline__ float h2f_lo(unsigned w) { return (float)__builtin_bit_cast(_Float16, (unsigned short)(w & 0xffffu)); }
__device__ __forceinline__ float h2f_hi(unsigned w) { return (float)__builtin_bit_cast(_Float16, (unsigned short)(w >> 16)); }

struct EpiG {
    static constexpr bool PERM = true;
    unsigned char* G; LAS const unsigned char* lds;
    bool skip = false;
    __device__ __forceinline__ void operator()(const f32x4 (&acc)[2][2][4][2], const pg8::Unit& u, int wr, int wc, int fr, int fq) const {
        const int col0 = u.pn * 256, row0 = u.pm * 256;
        f32x4 bv[2][2], cs[2][2];
#pragma unroll
        for (int bj = 0; bj < 2; ++bj)
#pragma unroll
            for (int n = 0; n < 2; ++n) { const int j = wc * 64 + 32 * bj + 8 * fq + 4 * n; bv[bj][n] = *(LAS const f32x4*)(lds + P1T_BIAS + 4 * j) * (-LOG2E); cs[bj][n] = *(LAS const f32x4*)(lds + P1T_CS + 4 * j) * (-LOG2E / 127.0f); }
        float rsv[2][4];
#pragma unroll
        for (int ai = 0; ai < 2; ++ai)
#pragma unroll
            for (int m = 0; m < 4; ++m) rsv[ai][m] = *(LAS const float*)(lds + P1T_RSC + 4 * (ai * 128 + wr * 64 + m * 16 + fr));
#pragma unroll
        for (int ai = 0; ai < 2; ++ai)
#pragma unroll
            for (int m = 0; m < 4; ++m) { unsigned char* rowp = G + (size_t)(row0 + ai * 128 + wr * 64 + m * 16 + fr) * 3072 + col0 + wc * 64 + 8 * fq;
#pragma unroll
                for (int bj = 0; bj < 2; ++bj) { u32x2 w;
#pragma unroll
                    for (int n = 0; n < 2; ++n) { const f32x4 z = (cvt_i32(acc[ai][bj][m][n]) * rsv[ai][m]) * cs[bj][n] + bv[bj][n]; unsigned q[4];
#pragma unroll
                        for (int e = 0; e < 4; ++e) { const float g = __builtin_amdgcn_rcpf(1.0f + __builtin_amdgcn_exp2f(z[e])); const unsigned qi = (unsigned)(g * 255.0f + 0.5f); q[e] = qi < 1u ? 1u : qi; }
                        w[n] = q[0] | (q[1] << 8) | (q[2] << 16) | (q[3] << 24); }
                    *(u32x2*)(rowp + 32 * bj) = w; } }
    }
};

struct Epi1 {
    static constexpr bool PERM = true;
    unsigned char* ws; const unsigned* rope; const float *aq, *ak, *bq, *bk, *bgate; const float* rsc; const float* cmax; LAS unsigned char* lds;
    bool skip = false;
    __device__ __forceinline__ void prefetch(const pg8::Unit& u, int w) const {
        int lane = threadIdx.x; asm volatile("" : "+v"(lane)); lane &= 63;
        const int pn = u.pn, pm = u.pm;
        if (pm < 64 && pn < 12) {
#pragma unroll
            for (int j = 0; j < 2; ++j) { const int piece = 2 * w + j;
                __builtin_amdgcn_global_load_lds((const unsigned*)((const char*)rope + (size_t)pm * 8192 + piece * 1024 + lane * 16), (LAS unsigned*)(lds + P1T_ROPE + piece * 1024), 16, 0, 0); }
        }
        if (w == 0) __builtin_amdgcn_global_load_lds((const unsigned*)(cmax + pn * 256 + lane * 4), (LAS unsigned*)(lds + P1T_CS), 16, 0, 0);
        else if (w == 1) { if (pn >= 14 && pn < 26) __builtin_amdgcn_global_load_lds((const unsigned*)(bgate + (pn - 14) * 256 + lane * 4), (LAS unsigned*)(lds + P1T_BIAS), 16, 0, 0); }
        else if (w == 2) __builtin_amdgcn_global_load_lds((const unsigned*)(rsc + pm * 256 + lane * 4), (LAS unsigned*)(lds + P1T_RSC), 16, 0, 0);
        else if (pn < 12) { const int gi = pn / 3, ty = pn - 3 * gi;
            const float* gp = (pn >= 11) ? bk : (pn >= 9) ? bq : (ty == 0) ? aq + 64 * gi : ak + 64 * gi;
            if (lane < 16) __builtin_amdgcn_global_load_lds((const unsigned*)(gp + lane * 4), (LAS unsigned*)(lds + P1T_GAIN), 16, 0, 0); }
    }
    __device__ __forceinline__ void plain(const f32x4 (&acc)[2][2][4][2], bf16_t* dst, int ld, int col0, int row0, int wr, int wc, int fr, int fq) const {
        f32x4 cs[2][2];
#pragma unroll
        for (int bj = 0; bj < 2; ++bj)
#pragma unroll
            for (int n = 0; n < 2; ++n) cs[bj][n] = *(LAS const f32x4*)(lds + P1T_CS + 4 * (wc * 64 + 32 * bj + 8 * fq + 4 * n)) * (1.0f / 127.0f);
        float rsv[2][4];
#pragma unroll
        for (int ai = 0; ai < 2; ++ai)
#pragma unroll
            for (int m = 0; m < 4; ++m) rsv[ai][m] = *(LAS const float*)(lds + P1T_RSC + 4 * (ai * 128 + wr * 64 + m * 16 + fr));
#pragma unroll
        for (int ai = 0; ai < 2; ++ai)
#pragma unroll
            for (int m = 0; m < 4; ++m) { bf16_t* rowp = dst + (size_t)(row0 + ai * 128 + wr * 64 + m * 16 + fr) * ld + col0 + wc * 64 + 8 * fq;
#pragma unroll
                for (int bj = 0; bj < 2; ++bj) { const f32x4 v0 = cvt_i32(acc[ai][bj][m][0]) * rsv[ai][m] * cs[bj][0], v1 = cvt_i32(acc[ai][bj][m][1]) * rsv[ai][m] * cs[bj][1];
                    u32x4 w; w.x = cvtpk(v0[0], v0[1]); w.y = cvtpk(v0[2], v0[3]); w.z = cvtpk(v1[0], v1[1]); w.w = cvtpk(v1[2], v1[3]);
                    *(u32x4*)(rowp + 32 * bj) = w; } }
    }
    __device__ __forceinline__ void normed(const f32x4 (&acc)[2][2][4][2], bf16_t* dst, int ld, int col0, int row0, float scale, int wr, int wc, int fr, int fq) const {
        f32x4 g[2][2], cs[2][2];
#pragma unroll
        for (int bj = 0; bj < 2; ++bj)
#pragma unroll
            for (int n = 0; n < 2; ++n) { g[bj][n] = *(LAS const f32x4*)(lds + P1T_GAIN + 4 * (32 * bj + 8 * fq + 4 * n)) * scale; cs[bj][n] = *(LAS const f32x4*)(lds + P1T_CS + 4 * (wc * 64 + 32 * bj + 8 * fq + 4 * n)) * (1.0f / 127.0f); }
#pragma unroll
        for (int aim = 0; aim < 4; ++aim) {
            const int ai = aim >> 1;
            u32x4 rw[2][2]; float rsv[2];
#pragma unroll
            for (int mm = 0; mm < 2; ++mm) { const int tr = ai * 128 + wr * 64 + (2 * (aim & 1) + mm) * 16 + fr; rsv[mm] = *(LAS const float*)(lds + P1T_RSC + 4 * tr);
#pragma unroll
                for (int n = 0; n < 2; ++n) rw[mm][n] = *(LAS const u32x4*)(lds + P1T_ROPE + 32 * tr + 16 * n); }
#pragma unroll
            for (int mm = 0; mm < 2; ++mm) { const int m = 2 * (aim & 1) + mm;
                const int row = row0 + ai * 128 + wr * 64 + m * 16 + fr;
                f32x4 v[2][2];
                float ss = 0.f;
#pragma unroll
                for (int bj = 0; bj < 2; ++bj)
#pragma unroll
                    for (int n = 0; n < 2; ++n) { const f32x4 x = cvt_i32(acc[ai][bj][m][n]) * cs[bj][n]; v[bj][n] = x; ss += (x[0] * x[0] + x[1] * x[1]) + (x[2] * x[2] + x[3] * x[3]); }
                ss += xor16(ss); ss = sum_halves(ss);
                const float rq = rsv[mm];
                const float rs = rq / sqrtf(ss * (rq * rq * (1.f / 64.f)) + EPS_);
#pragma unroll
                for (int bj = 0; bj < 2; ++bj)
#pragma unroll
                    for (int n = 0; n < 2; ++n) v[bj][n] = v[bj][n] * rs * g[bj][n];
#pragma unroll
                for (int n = 0; n < 2; ++n) {
                    const u32x4 cw = rw[mm][n];
                    const f32x4 co = {h2f_lo(cw[0]), h2f_lo(cw[1]), h2f_lo(cw[2]), h2f_lo(cw[3])}, si = {h2f_hi(cw[0]), h2f_hi(cw[1]), h2f_hi(cw[2]), h2f_hi(cw[3])};
                    f32x4 pr;
#pragma unroll
                    for (int e = 0; e < 4; ++e) pr[e] = xor16(v[0][n][e]);
                    const f32x4 r0 = v[0][n] * co - pr * si, r1 = v[0][n] * co + pr * si;
                    v[0][n] = (fq == 0) ? r0 : (fq == 1) ? r1 : v[0][n];
                }
                bf16_t* rowp = dst + (size_t)row * ld + col0 + wc * 64 + 8 * fq;
#pragma unroll
                for (int bj = 0; bj < 2; ++bj) { u32x4 w; w.x = cvtpk(v[bj][0][0], v[bj][0][1]); w.y = cvtpk(v[bj][0][2], v[bj][0][3]); w.z = cvtpk(v[bj][1][0], v[bj][1][1]); w.w = cvtpk(v[bj][1][2], v[bj][1][3]);
                    *(u32x4*)(rowp + 32 * bj) = w; }
            }
        }
    }
    __device__ __forceinline__ void operator()(const f32x4 (&acc)[2][2][4][2], const pg8::Unit& u, int wr, int wc, int fr, int fq) const {
        const int pn = u.pn, row0 = u.pm * 256;
        if (pn >= 26) { plain(acc, (bf16_t*)(ws + WS_MKV), 1024, (pn - 26) * 256, row0 - T_, wr, wc, fr, fq); return; }
        if (pn >= 14) { EpiG eg{ws + WS_G, lds}; pg8::Unit ug{u.pm, pn - 14}; eg(acc, ug, wr, wc, fr, fq); return; }
        if (pn >= 12) { plain(acc, (bf16_t*)(ws + WS_MQ), 512, (pn - 12) * 256, row0, wr, wc, fr, fq); return; }
        if (pn == 11) {
            if (wc >= 2) plain(acc, (bf16_t*)(ws + WS_KVB), 256, 0, row0, wr, wc, fr, fq);
            else normed(acc, (bf16_t*)(ws + WS_KVB), 256, 0, row0, 1.0f, wr, wc, fr, fq);
            return;
        }
        if (pn >= 9) { normed(acc, (bf16_t*)(ws + WS_QB), 512, (pn - 9) * 256, row0, QSCALE64, wr, wc, fr, fq); return; }
        const int gi = pn / 3, ty = pn - 3 * gi;
        if (ty == 2) { plain(acc, (bf16_t*)(ws + WS_VA) + (size_t)gi * T_ * 256, 256, 0, row0, wr, wc, fr, fq); return; }
        if (ty == 0) normed(acc, (bf16_t*)(ws + WS_QA) + (size_t)gi * T_ * 256, 256, 0, row0, QSCALE64, wr, wc, fr, fq);
        else normed(acc, (bf16_t*)(ws + WS_KA) + (size_t)gi * T_ * 256, 256, 0, row0, 1.0f, wr, wc, fr, fq);
    }
};

namespace att {
typedef short v4i16_t __attribute__((ext_vector_type(4)));
__device__ __forceinline__ int crow(int r, int h) { return (r & 3) + 8 * (r >> 2) + 4 * h; }
__device__ __forceinline__ s16x4 vtr(LAS const unsigned char* p) { return __builtin_bit_cast(s16x4, __builtin_amdgcn_ds_read_tr16_b64_v4i16((LAS v4i16_t*)p)); }

constexpr int KROW64 = 144, VROW64 = 128, NKEYS_B = 384;
constexpr int LDS_K64 = 0, LDS_V64 = NKEYS_B * KROW64;
constexpr int LDS_K128 = 0, LDS_V128 = 65536;

constexpr float SM_THR = 20.0f;
template <int NT, int ND>
__device__ __forceinline__ void softmax_step(f32x16 (&s)[NT], float& mref, float& l, f32x16 (&o)[ND], bf16x8 (&pf)[NT][2]) {
    if (__any(mref != 0.f)) {
#pragma unroll
        for (int t = 0; t < NT; ++t)
#pragma unroll
            for (int r = 0; r < 16; ++r) s[t][r] -= mref;
    }
    float mx = s[0][0];
#pragma unroll
    for (int t = 0; t < NT; ++t)
#pragma unroll
        for (int r = 0; r < 16; ++r) mx = fmaxf(mx, s[t][r]);
    mx = fmaxf(mx, __shfl_xor(mx, 32));
    if (__any(mx > SM_THR)) {
        const float dl = fmaxf(mx, 0.f); mref += dl;
#pragma unroll
        for (int t = 0; t < NT; ++t)
#pragma unroll
            for (int r = 0; r < 16; ++r) s[t][r] -= dl;
        const float f = __builtin_amdgcn_exp2f(-dl); l *= f;
#pragma unroll
        for (int d = 0; d < ND; ++d)
#pragma unroll
            for (int r = 0; r < 16; ++r) o[d][r] *= f;
    }
    float ps0 = 0.f, ps1 = 0.f;
#pragma unroll
    for (int t = 0; t < NT; ++t)
#pragma unroll
        for (int r = 0; r < 16; r += 2) { s[t][r] = __builtin_amdgcn_exp2f(s[t][r]); s[t][r + 1] = __builtin_amdgcn_exp2f(s[t][r + 1]); ps0 += s[t][r]; ps1 += s[t][r + 1]; }
    l += ps0 + ps1;
#pragma unroll
    for (int t = 0; t < NT; ++t)
#pragma unroll
        for (int k = 0; k < 2; ++k) { u32x4 w; w.x = cvtpk(s[t][8 * k + 0], s[t][8 * k + 1]); w.y = cvtpk(s[t][8 * k + 2], s[t][8 * k + 3]); w.z = cvtpk(s[t][8 * k + 4], s[t][8 * k + 5]); w.w = cvtpk(s[t][8 * k + 6], s[t][8 * k + 7]);
            pf[t][k] = __builtin_bit_cast(bf16x8, w); }
}

struct BU { const bf16_t* q; const bf16_t* k; const bf16_t* v; bf16_t* o; float* lse; int qstride, kvstride, ostride, lsestride; float sink2; int W; int first; };
__device__ __forceinline__ void bu_load(const BU& u, int tid, u32x4 (&kr)[6], u32x4 (&vr)[6]) {
#pragma unroll
    for (int it = 0; it < 6; ++it) {
        const int c = tid + 512 * it, row = c >> 3, ch = c & 7;
        const bool valid = !(u.first && row < 128);
        const long off = (long)((valid ? row : 128) - 128) * (long)u.kvstride + ch * 8;
        kr[it] = *(const u32x4*)(u.k + off); vr[it] = *(const u32x4*)(u.v + off);
    }
}
__device__ __forceinline__ void bu_store(LAS unsigned char* lds, int tid, const u32x4 (&kr)[6], const u32x4 (&vr)[6], int first) {
#pragma unroll
    for (int it = 0; it < 6; ++it) {
        const int c = tid + 512 * it, row = c >> 3, ch = c & 7;
        const bool valid = !(first && row < 128);
        const u32x4 z = (u32x4){0u, 0u, 0u, 0u};
        *(LAS u32x4*)(lds + LDS_K64 + row * KROW64 + ch * 16) = valid ? kr[it] : z;
        *(LAS u32x4*)(lds + LDS_V64 + row * VROW64 + ((ch * 16) ^ (((row >> 1) & 1) << 6))) = valid ? vr[it] : z;
    }
}
__device__ __forceinline__ void bu_loadq(const BU& u, int wid, int lane, bf16x8 (&qf)[4]) {
    const int qi = 32 * wid + (lane & 31), h = lane >> 5;
#pragma unroll
    for (int d0 = 0; d0 < 4; ++d0) qf[d0] = *(const bf16x8*)(u.q + (size_t)qi * u.qstride + 16 * d0 + 8 * h);
}
template <int NT>
__device__ __forceinline__ void bu_step(LAS const unsigned char* kbase, LAS const unsigned char* vbase, int vsw, int kt0, int mask, int jlo, int jhi, int h, const bf16x8 (&qf)[4],
                                        float& mref, float& l, f32x16 (&o)[2]) {
    f32x16 s[NT];
#pragma unroll
    for (int d0 = 0; d0 < 4; ++d0)
#pragma unroll
        for (int t = 0; t < NT; ++t) { const bf16x8 kf = *(LAS const bf16x8*)(kbase + (kt0 + t) * 32 * KROW64 + d0 * 32); if (d0 == 0) { for (int r = 0; r < 16; ++r) s[t][r] = 0.f; } s[t] = __builtin_amdgcn_mfma_f32_32x32x16_bf16(kf, qf[d0], s[t], 0, 0, 0); }
    if (mask == 1) {
        const int L = jlo - 32 * kt0 - 4 * h;
#pragma unroll
        for (int r = 0; r < 16; ++r) { if (((r & 3) + 8 * (r >> 2)) < L) s[0][r] = -INFINITY; }
    } else if (mask == 2) {
        const int H = jhi - 32 * kt0 - 4 * h;
#pragma unroll
        for (int r = 0; r < 16; ++r) { if (((r & 3) + 8 * (r >> 2)) > H) s[0][r] = -INFINITY; }
    } else if (mask == 3) {
#pragma unroll
        for (int t = 0; t < NT; ++t) { const int L = jlo - 32 * (kt0 + t) - 4 * h; const unsigned span = (unsigned)(jhi - jlo);
#pragma unroll
            for (int r = 0; r < 16; ++r) { if ((unsigned)(((r & 3) + 8 * (r >> 2)) - L) > span) s[t][r] = -INFINITY; } }
    }
    bf16x8 pf[NT][2];
    softmax_step<NT, 2>(s, mref, l, o, pf);
#pragma unroll
    for (int t = 0; t < NT; ++t)
#pragma unroll
        for (int k = 0; k < 2; ++k)
#pragma unroll
            for (int d = 0; d < 2; ++d) {
                LAS const unsigned char* vp = vbase + ((kt0 + t) * 32 + 16 * k) * VROW64 + 64 * (d ^ vsw);
                const s16x4 lo = vtr(vp), hi = vtr(vp + 8 * VROW64);
                const bf16x8 vf = (bf16x8){lo[0], lo[1], lo[2], lo[3], hi[0], hi[1], hi[2], hi[3]};
                o[d] = __builtin_amdgcn_mfma_f32_32x32x16_bf16(vf, pf[t][k], o[d], 0, 0, 0);
            }
}
__device__ __forceinline__ void bu_compute(LAS unsigned char* lds, const BU& u, const bf16x8 (&qf)[4], int wid, int lane) {
    const int c = lane & 31, h = lane >> 5;
    const int qi = 32 * wid + c;
    float mref = 0.f, l = 0.f; f32x16 o[2];
#pragma unroll
    for (int r = 0; r < 16; ++r) { o[0][r] = 0.f; o[1][r] = 0.f; }
    int jlo = qi + 128 - u.W; if (u.first && jlo < 128) jlo = 128;
    const int jhi = qi + 128;
    const int qq = (lane & 15) >> 2;
    LAS const unsigned char* kbase = lds + LDS_K64 + c * KROW64 + 16 * h;
    LAS const unsigned char* vbase = lds + LDS_V64 + (4 * h + qq) * VROW64 + ((lane >> 4) & 1) * 32 + (lane & 3) * 8;
    const int vsw = (qq >> 1) & 1;
#pragma unroll 1
    for (int st = 0; st < 2; ++st) bu_step<2>(kbase, vbase, vsw, wid + 2 * st, u.first ? 3 : (st == 0 ? 1 : 0), jlo, jhi, h, qf, mref, l, o);
    bu_step<1>(kbase, vbase, vsw, wid + 4, u.first ? 3 : 2, jlo, jhi, h, qf, mref, l, o);
    float lt = l + __shfl_xor(l, 32);
    lt += __builtin_amdgcn_exp2f(u.sink2 - mref);
    const float inv = 1.0f / lt;
    bf16_t* orow = u.o + (size_t)qi * u.ostride;
#pragma unroll
    for (int d = 0; d < 2; ++d)
#pragma unroll
        for (int rg = 0; rg < 4; ++rg) { u32x2 w; w.x = cvtpk(o[d][4 * rg] * inv, o[d][4 * rg + 1] * inv); w.y = cvtpk(o[d][4 * rg + 2] * inv, o[d][4 * rg + 3] * inv);
            *(u32x2*)(orow + 32 * d + 8 * rg + 4 * h) = w; }
    if (u.lse && h == 0) u.lse[(size_t)qi * u.lsestride] = mref + __builtin_amdgcn_logf(lt);
}

__device__ __forceinline__ void mem_load(const bf16_t* kmem, const bf16_t* vmem, int tid, u32x4 (&kr)[8], u32x4 (&vr)[8]) {
#pragma unroll
    for (int it = 0; it < 8; ++it) { const int cc = tid + 512 * it, row = cc >> 4, ch = cc & 15;
        kr[it] = *(const u32x4*)(kmem + (size_t)row * 1024 + ch * 8); vr[it] = *(const u32x4*)(vmem + (size_t)row * 1024 + ch * 8); }
}
__device__ __forceinline__ void mem_unit(LAS unsigned char* lds, const u32x4 (&qraw)[8], const u32x4 (&kr)[8], const u32x4 (&vr)[8], LAS const unsigned char* gl, bf16_t* o0, size_t ostride, int tid, int wid, int lane) {
#pragma unroll
    for (int it = 0; it < 8; ++it) {
        const int cc = tid + 512 * it, row = cc >> 4, ch = cc & 15;
        *(LAS u32x4*)(lds + LDS_K128 + row * 256 + ((ch ^ (row & 15)) * 16)) = kr[it];
        *(LAS u32x4*)(lds + LDS_V128 + row * 256 + ((ch * 16) ^ ((row & 3) << 6))) = vr[it];
    }
    const int c = lane & 31, h = lane >> 5;
    const int qi = 32 * wid + c;
    bf16x8 qf[8];
    {
        u32x4 raw[8]; float ss = 0.f;
#pragma unroll
        for (int d0 = 0; d0 < 8; ++d0) { raw[d0] = qraw[d0];
#pragma unroll
            for (int e = 0; e < 4; ++e) { const float a = bflo(raw[d0][e]), b = bfhi(raw[d0][e]); ss += a * a + b * b; } }
        ss += __shfl_xor(ss, 32);
        const float rs = (1.0f / sqrtf(ss * (1.f / 128.f) + EPS_)) * QSCALE128;
#pragma unroll
        for (int d0 = 0; d0 < 8; ++d0) { const f32x4 g0 = *(LAS const f32x4*)(gl + 4 * (16 * d0 + 8 * h)), g1 = *(LAS const f32x4*)(gl + 4 * (16 * d0 + 8 * h + 4));
            u32x4 w; w.x = cvtpk(bflo(raw[d0].x) * rs * g0[0], bfhi(raw[d0].x) * rs * g0[1]); w.y = cvtpk(bflo(raw[d0].y) * rs * g0[2], bfhi(raw[d0].y) * rs * g0[3]);
            w.z = cvtpk(bflo(raw[d0].z) * rs * g1[0], bfhi(raw[d0].z) * rs * g1[1]); w.w = cvtpk(bflo(raw[d0].w) * rs * g1[2], bfhi(raw[d0].w) * rs * g1[3]);
            qf[d0] = __builtin_bit_cast(bf16x8, w); }
    }
    __syncthreads();
    {
        const int row = tid >> 1, hf = tid & 1; u32x4 raw[8]; float ss = 0.f;
#pragma unroll
        for (int i = 0; i < 8; ++i) { raw[i] = *(LAS const u32x4*)(lds + LDS_K128 + row * 256 + (((hf * 8 + i) ^ (row & 15)) * 16));
#pragma unroll
            for (int e = 0; e < 4; ++e) { const float a = bflo(raw[i][e]), b = bfhi(raw[i][e]); ss += a * a + b * b; } }
        ss += __shfl_xor(ss, 1);
        const float rs = 1.0f / sqrtf(ss * (1.f / 128.f) + EPS_);
#pragma unroll
        for (int i = 0; i < 8; ++i) { LAS const unsigned char* gp = gl + 512 + 4 * (64 * hf + 8 * i); const f32x4 g0 = *(LAS const f32x4*)gp, g1 = *(LAS const f32x4*)(gp + 16);
            u32x4 w; w.x = cvtpk(bflo(raw[i].x) * rs * g0[0], bfhi(raw[i].x) * rs * g0[1]); w.y = cvtpk(bflo(raw[i].y) * rs * g0[2], bfhi(raw[i].y) * rs * g0[3]);
            w.z = cvtpk(bflo(raw[i].z) * rs * g1[0], bfhi(raw[i].z) * rs * g1[1]); w.w = cvtpk(bflo(raw[i].w) * rs * g1[2], bfhi(raw[i].w) * rs * g1[3]);
            *(LAS u32x4*)(lds + LDS_K128 + row * 256 + (((hf * 8 + i) ^ (row & 15)) * 16)) = w; }
    }
    __syncthreads();
    float mref = 0.f, l = 0.f; f32x16 o[4];
#pragma unroll
    for (int r = 0; r < 16; ++r) {
#pragma unroll
        for (int d = 0; d < 4; ++d) o[d][r] = 0.f; }
    const int qq = (lane & 15) >> 2;
    LAS const unsigned char* vbase = lds + LDS_V128 + (4 * h + qq) * 256 + ((lane >> 4) & 1) * 32 + (lane & 3) * 8;
#pragma unroll 1
    for (int kt = 0; kt < 8; kt += 2) {
        f32x16 s[2];
#pragma unroll
        for (int d0 = 0; d0 < 8; ++d0)
#pragma unroll
            for (int t = 0; t < 2; ++t) { const int krow = (kt + t) * 32 + c;
                const bf16x8 kf = *(LAS const bf16x8*)(lds + LDS_K128 + krow * 256 + (((2 * d0 + h) ^ (krow & 15)) * 16)); if (d0 == 0) { for (int r = 0; r < 16; ++r) s[t][r] = 0.f; } s[t] = __builtin_amdgcn_mfma_f32_32x32x16_bf16(kf, qf[d0], s[t], 0, 0, 0); }
        bf16x8 pf[2][2];
        softmax_step<2, 4>(s, mref, l, o, pf);
#pragma unroll
        for (int t = 0; t < 2; ++t)
#pragma unroll
            for (int k = 0; k < 2; ++k)
#pragma unroll
                for (int d = 0; d < 4; ++d) {
                    LAS const unsigned char* vp = vbase + ((kt + t) * 32 + 16 * k) * 256 + 64 * (d ^ qq);
                    const s16x4 lo = vtr(vp), hi = vtr(vp + 8 * 256);
                    const bf16x8 vf = (bf16x8){lo[0], lo[1], lo[2], lo[3], hi[0], hi[1], hi[2], hi[3]};
                    o[d] = __builtin_amdgcn_mfma_f32_32x32x16_bf16(vf, pf[t][k], o[d], 0, 0, 0);
                }
    }
    const float inv = 1.0f / (l + __shfl_xor(l, 32));
    bf16_t* orow = o0 + (size_t)qi * ostride;
#pragma unroll
    for (int d = 0; d < 4; ++d)
#pragma unroll
        for (int rg = 0; rg < 4; ++rg) { u32x2 w; w.x = cvtpk(o[d][4 * rg] * inv, o[d][4 * rg + 1] * inv); w.y = cvtpk(o[d][4 * rg + 2] * inv, o[d][4 * rg + 3] * inv);
            *(u32x2*)(orow + 32 * d + 8 * rg + 4 * h) = w; }
    __syncthreads();
}
}

__device__ __forceinline__ att::BU get_bu(const Args& A, int vcu, int idx) {
    unsigned char* ws = A.ws; att::BU u;
    if (idx < 3) {
        const int gi = idx, b = vcu >> 6, hd = (vcu >> 4) & 3, i16 = vcu & 15;
        const int dl = (gi == 0) ? 1 : (gi == 1) ? 4 : 16;
        int r, qb; if (gi == 0) { r = 0; qb = i16; } else if (gi == 1) { r = i16 >> 2; qb = i16 & 3; } else { r = i16; qb = 0; }
        const int i0 = qb * 256;
        const size_t row0 = (size_t)b * SEQ_ + r + (size_t)dl * i0;
        const size_t base = (size_t)gi * T_ * 256 + row0 * 256 + hd * 64;
        u.q = (const bf16_t*)(ws + WS_QA) + base; u.k = (const bf16_t*)(ws + WS_KA) + base; u.v = (const bf16_t*)(ws + WS_VA) + base;
        u.o = (bf16_t*)((unsigned char*)A.out + DO_OAG) + base;
        u.lse = (float*)(ws + WS_LSE) + (size_t)gi * T_ * 4 + row0 * 4 + hd;
        u.qstride = dl * 256; u.kvstride = dl * 256; u.ostride = dl * 256; u.lsestride = dl * 4; u.sink2 = -INFINITY; u.W = 128; u.first = (i0 == 0);
    } else {
        const int uu = vcu + 256 * (idx - 3), b = uu >> 7, hq = (uu >> 4) & 7, qb = uu & 15, kvh = hq >> 2;
        const size_t row0 = (size_t)b * SEQ_ + (size_t)qb * 256;
        u.q = (const bf16_t*)(ws + WS_QB) + row0 * 512 + hq * 64;
        u.k = (const bf16_t*)(ws + WS_KVB) + row0 * 256 + kvh * 64; u.v = u.k + 128;
        u.o = (bf16_t*)((unsigned char*)A.out + DO_OCAT) + row0 * KCAT + 256 + hq * 64;
        u.lse = nullptr; u.qstride = 512; u.kvstride = 256; u.ostride = KCAT; u.lsestride = 0; u.sink2 = A.in[I_SINK][hq] * LOG2E; u.W = 127; u.first = (qb == 0);
    }
    return u;
}
__device__ __forceinline__ void p2_attention(const Args& A, LAS unsigned char* lds, int vcu, int tid, int wid, int lane) {
    unsigned char* ws = A.ws;
    const int mu = vcu, mb = mu >> 6, mhd = (mu >> 4) & 3, mqb = mu & 15;
    const bf16_t* km = (const bf16_t*)(ws + WS_MKV) + (size_t)mb * MEM_ * 1024 + mhd * 128;
    const size_t mrow0 = (size_t)mb * SEQ_ + (size_t)mqb * 256;
    const bf16_t* mq = (const bf16_t*)(ws + WS_MQ) + mrow0 * 512 + mhd * 128;
    LAS unsigned char* gl = lds + 131072;
    { const float* const pq = A.in[I_MQN]; const float* const pk = A.in[I_MKN];
      if (tid < 64) { const f32x4 gv = ((const f32x4*)(tid < 32 ? pq : pk))[tid & 31]; *(LAS f32x4*)(gl + 16 * tid) = gv; } }
    u32x4 mkr[8], mvr[8], mqr[8];
    {
        u32x4 kr[6], vr[6];
        { const att::BU u0 = get_bu(A, vcu, 0); att::bu_load(u0, tid, kr, vr); }
#pragma unroll 1
        for (int idx = 0; idx < 4; ++idx) {
            const att::BU u = get_bu(A, vcu, idx);
            att::bu_store(lds, tid, kr, vr, u.first);
            bf16x8 qf[4]; att::bu_loadq(u, wid, lane, qf);
            __syncthreads();
            { const att::BU un = get_bu(A, vcu, idx + 1); att::bu_load(un, tid, kr, vr); }
            att::bu_compute(lds, u, qf, wid, lane);
            asm volatile("" ::: "memory");
            __syncthreads();
        }
        {
            const att::BU u = get_bu(A, vcu, 4);
            att::bu_store(lds, tid, kr, vr, u.first);
            bf16x8 qf[4]; att::bu_loadq(u, wid, lane, qf);
            __syncthreads();
            att::mem_load(km, km + 512, tid, mkr, mvr);
            { const int qi = 32 * wid + (lane & 31), h = lane >> 5;
#pragma unroll
              for (int d0 = 0; d0 < 8; ++d0) mqr[d0] = *(const u32x4*)(mq + (size_t)qi * 512 + 16 * d0 + 8 * h); }
            att::bu_compute(lds, u, qf, wid, lane);
            asm volatile("" ::: "memory");
            __syncthreads();
        }
    }
    {
        bf16_t* o = (bf16_t*)((unsigned char*)A.out + DO_OCAT) + mrow0 * KCAT + 768 + mhd * 128;
        att::mem_unit(lds, mqr, mkr, mvr, gl, o, KCAT, tid, wid, lane);
    }
}

__device__ __forceinline__ void p2b_merge(const Args& A, int vcu, int G, int tid) {
    const bf16_t* oag = (const bf16_t*)((unsigned char*)A.out + DO_OAG);
    bf16_t* ocat = (bf16_t*)((unsigned char*)A.out + DO_OCAT);
    const float* lse = (const float*)(A.ws + WS_LSE);
    for (int idx = vcu * 512 + tid; idx < T_ * 32; idx += G * 512) {
        const int t = idx >> 5, ch = idx & 31, hd = ch >> 3;
        const float l0 = lse[(size_t)t * 4 + hd], l1 = lse[(size_t)T_ * 4 + (size_t)t * 4 + hd], l2 = lse[(size_t)2 * T_ * 4 + (size_t)t * 4 + hd];
        const float mx = fmaxf(l0, fmaxf(l1, l2));
        float w0 = __builtin_amdgcn_exp2f(l0 - mx), w1 = __builtin_amdgcn_exp2f(l1 - mx), w2 = __builtin_amdgcn_exp2f(l2 - mx);
        const float inv = 1.0f / (w0 + w1 + w2); w0 *= inv; w1 *= inv; w2 *= inv;
        const u32x4 a = *(const u32x4*)(oag + (size_t)t * 256 + ch * 8), b = *(const u32x4*)(oag + (size_t)T_ * 256 + (size_t)t * 256 + ch * 8), c = *(const u32x4*)(oag + (size_t)2 * T_ * 256 + (size_t)t * 256 + ch * 8);
        u32x4 w;
#pragma unroll
        for (int e = 0; e < 4; ++e) w[e] = cvtpk(w0 * bflo(a[e]) + w1 * bflo(b[e]) + w2 * bflo(c[e]), w0 * bfhi(a[e]) + w1 * bfhi(b[e]) + w2 * bfhi(c[e]));
        *(u32x4*)(ocat + (size_t)t * KCAT + ch * 8) = w;
    }
}

struct P3aOrder : pg8::StaticOrder {
    const bf16_t* oag; bf16_t* ocat; const float* lse;
    __device__ __forceinline__ void a_ready(const pg8::Unit& u) const {
#pragma unroll 1
        for (int i0 = threadIdx.x; i0 < 256 * 32; i0 += 2 * 512) {
            u32x4 a[2], b[2], c[2]; float l0[2], l1[2], l2[2];
#pragma unroll
            for (int j = 0; j < 2; ++j) { const int idx = i0 + 512 * j, t = u.pm * 256 + (idx >> 5), ch = idx & 31, hd = ch >> 3;
                l0[j] = lse[(size_t)t * 4 + hd]; l1[j] = lse[(size_t)T_ * 4 + (size_t)t * 4 + hd]; l2[j] = lse[(size_t)2 * T_ * 4 + (size_t)t * 4 + hd];
                a[j] = *(const u32x4*)(oag + (size_t)t * 256 + ch * 8); b[j] = *(const u32x4*)(oag + (size_t)T_ * 256 + (size_t)t * 256 + ch * 8); c[j] = *(const u32x4*)(oag + (size_t)2 * T_ * 256 + (size_t)t * 256 + ch * 8); }
#pragma unroll
            for (int j = 0; j < 2; ++j) { const int idx = i0 + 512 * j, t = u.pm * 256 + (idx >> 5), ch = idx & 31;
                const float mx = fmaxf(l0[j], fmaxf(l1[j], l2[j]));
                float w0 = __builtin_amdgcn_exp2f(l0[j] - mx), w1 = __builtin_amdgcn_exp2f(l1[j] - mx), w2 = __builtin_amdgcn_exp2f(l2[j] - mx);
                const float inv = 1.0f / (w0 + w1 + w2); w0 *= inv; w1 *= inv; w2 *= inv;
                u32x4 w;
#pragma unroll
                for (int e = 0; e < 4; ++e) w[e] = cvtpk(w0 * bflo(a[j][e]) + w1 * bflo(b[j][e]) + w2 * bflo(c[j][e]), w0 * bfhi(a[j][e]) + w1 * bfhi(b[j][e]) + w2 * bfhi(c[j][e]));
                *(u32x4*)(ocat + (size_t)t * KCAT + ch * 8) = w; }
        }
        asm volatile("s_waitcnt vmcnt(0)" ::: "memory"); __builtin_amdgcn_s_barrier(); asm volatile("" ::: "memory");
    }
};

__device__ __forceinline__ float ub(unsigned w, int i) { return (float)((w >> (8 * i)) & 0xffu); }
struct Epi3a {
    static constexpr bool PERM = true;
    const unsigned char* G; bf16_t* MERGED;
    bool skip = false;
    __device__ __forceinline__ void khook(f32x4 (&acc)[2][2][4][2], const pg8::Unit& u, int t, int wr, int wc, int fr, int fq) const {
        if (t != 4 && t != 12) return;
        const int gsel = (t == 4) ? 0 : 1024;
#pragma unroll
        for (int ai = 0; ai < 2; ++ai) {
            u32x2 ga[4][2], gb[4][2];
#pragma unroll
            for (int m = 0; m < 4; ++m) { const unsigned char* gp = G + (size_t)(u.pm * 256 + ai * 128 + wr * 64 + m * 16 + fr) * 3072 + gsel + u.pn * 256 + wc * 64 + 8 * fq;
#pragma unroll
                for (int bj = 0; bj < 2; ++bj) { ga[m][bj] = *(const u32x2*)(gp + 32 * bj); gb[m][bj] = *(const u32x2*)(gp + 1024 + 32 * bj); } }
            asm volatile("" ::: "memory");
#pragma unroll
            for (int m = 0; m < 4; ++m)
#pragma unroll
                for (int bj = 0; bj < 2; ++bj)
#pragma unroll
                    for (int n = 0; n < 2; ++n)
#pragma unroll
                        for (int e = 0; e < 4; ++e) acc[ai][bj][m][n][e] *= ub(ga[m][bj][n], e) * __builtin_amdgcn_rcpf(ub(gb[m][bj][n], e));
        }
    }
    __device__ __forceinline__ void operator()(const f32x4 (&acc)[2][2][4][2], const pg8::Unit& u, int wr, int wc, int fr, int fq) const {
        const int col = u.pn * 256 + wc * 64 + 8 * fq;
        u32x2 g2[2][4][2];
#pragma unroll
        for (int ai = 0; ai < 2; ++ai)
#pragma unroll
            for (int m = 0; m < 4; ++m) { const size_t row = (size_t)(u.pm * 256 + ai * 128 + wr * 64 + m * 16 + fr);
#pragma unroll
                for (int bj = 0; bj < 2; ++bj) g2[ai][m][bj] = *(const u32x2*)(G + row * 3072 + 2048 + col + 32 * bj); }
        asm volatile("" ::: "memory");
        const float k = 1.0f / 255.0f;
#pragma unroll
        for (int ai = 0; ai < 2; ++ai)
#pragma unroll
            for (int m = 0; m < 4; ++m) { const size_t row = (size_t)(u.pm * 256 + ai * 128 + wr * 64 + m * 16 + fr);
#pragma unroll
                for (int bj = 0; bj < 2; ++bj) { const u32x2 g = g2[ai][m][bj]; const f32x4 v0 = acc[ai][bj][m][0] * k, v1 = acc[ai][bj][m][1] * k;
                    u32x4 w; w.x = cvtpk(v0[0] * ub(g.x, 0), v0[1] * ub(g.x, 1)); w.y = cvtpk(v0[2] * ub(g.x, 2), v0[3] * ub(g.x, 3)); w.z = cvtpk(v1[0] * ub(g.y, 0), v1[1] * ub(g.y, 1)); w.w = cvtpk(v1[2] * ub(g.y, 2), v1[3] * ub(g.y, 3));
                    *(u32x4*)(MERGED + row * 1024 + col + 32 * bj) = w; } }
    }
};

struct Epi3b {
    static constexpr bool PERM = true;
    const float* x; bf16_t* X1L; bf16_t* X1B; float* SSQ;
    bool skip = false;
    __device__ __forceinline__ void operator()(const f32x4 (&acc)[2][2][4][2], const pg8::Unit& u, int wr, int wc, int fr, int fq) const {
        const int col = u.pn * 256 + wc * 64 + 8 * fq;
#pragma unroll
        for (int ai = 0; ai < 2; ++ai) {
            f32x4 xv[4][2][2];
#pragma unroll
            for (int m = 0; m < 4; ++m) { const size_t row = (size_t)(u.pm * 256 + ai * 128 + wr * 64 + m * 16 + fr);
#pragma unroll
                for (int bj = 0; bj < 2; ++bj) { const size_t off = row * 1024 + col + 32 * bj; xv[m][bj][0] = *(const f32x4*)(x + off); xv[m][bj][1] = *(const f32x4*)(x + off + 4); } }
            asm volatile("" ::: "memory");
#pragma unroll
            for (int m = 0; m < 4; ++m) { const size_t row = (size_t)(u.pm * 256 + ai * 128 + wr * 64 + m * 16 + fr); float ss = 0.f;
#pragma unroll
                for (int bj = 0; bj < 2; ++bj) { const size_t off = row * 1024 + col + 32 * bj;
                    const f32x4 o0 = xv[m][bj][0] + acc[ai][bj][m][0], o1 = xv[m][bj][1] + acc[ai][bj][m][1];
                    ss += (o0[0] * o0[0] + o0[1] * o0[1]) + (o0[2] * o0[2] + o0[3] * o0[3]) + (o1[0] * o1[0] + o1[1] * o1[1]) + (o1[2] * o1[2] + o1[3] * o1[3]);
                    u32x4 w; w.x = cvtpk(o0[0], o0[1]); w.y = cvtpk(o0[2], o0[3]); w.z = cvtpk(o1[0], o1[1]); w.w = cvtpk(o1[2], o1[3]);
                    *(u32x4*)(X1B + off) = w; }
                ss += xor16(ss); ss = sum_halves(ss);
                if (fq == 0) SSQ[row * 16 + u.pn * 4 + wc] = ss; }
            asm volatile("" ::: "memory");
        }
    }
};

struct Epi4 {
    static constexpr bool PERM = true;
    const float* convw; const float* convb; bf16_t* ACT; float* UE; float* UF; LAS float* xch; LAS const float* rtab; LAS const float* ctab;
    bool skip = false;
    __device__ __forceinline__ void operator()(f32x4 (&acc)[2][2][4][2], const pg8::Unit& u, int wr, int wc, int fr, int fq) const {
        const int lane = fr + 16 * fq;
        const int rowbase = u.pm * 256 + 128 * wr + 8 * fr;
        const int jj = 32 * wc + 8 * fq;
        const bool bstart = (u.pm & 15) == 0;
        {
            LAS const float* tb = rtab + ((u.pm >> 3) & 1) * 256 + 128 * wr + 8 * fr;
            const f32x4 ra = *(LAS const f32x4*)tb, rb = *(LAS const f32x4*)(tb + 4);
#pragma unroll
            for (int i = 0; i < 8; ++i) { const float rs = (i < 4) ? ra[i & 3] : rb[i & 3];
#pragma unroll
                for (int bj = 0; bj < 2; ++bj)
#pragma unroll
                    for (int n = 0; n < 2; ++n) acc[i >> 2][bj][i & 3][n] *= rs; }
        }
#define U4(bj, n, i) acc[(i) >> 2][bj][(i) & 3][n]
        if (wr == 0 && fr == 0) {
#pragma unroll
            for (int i = 0; i < 2; ++i)
#pragma unroll
                for (int bj = 0; bj < 2; ++bj)
#pragma unroll
                    for (int n = 0; n < 2; ++n) *(f32x4*)(UF + (size_t)(u.pm * 2 + i) * 5632 + u.pn * 256 + 128 * bj + jj + 4 * n) = U4(bj, n, i);
        }
        if (wr == 1 && fr == 15) {
#pragma unroll
            for (int i = 0; i < 2; ++i)
#pragma unroll
                for (int bj = 0; bj < 2; ++bj)
#pragma unroll
                    for (int n = 0; n < 2; ++n) *(f32x4*)(UE + (size_t)(u.pm * 2 + i) * 5632 + u.pn * 256 + 128 * bj + jj + 4 * n) = U4(bj, n, 6 + i);
        }
        if (wr == 0 && fr == 15) {
#pragma unroll
            for (int i = 0; i < 2; ++i)
#pragma unroll
                for (int bj = 0; bj < 2; ++bj)
#pragma unroll
                    for (int n = 0; n < 2; ++n) *(LAS f32x4*)(xch + ((((wc * 2 + i) * 2 + bj) * 2 + n) * 4 + fq) * 4) = U4(bj, n, 6 + i);
        }
        asm volatile("s_waitcnt lgkmcnt(0)" ::: "memory"); __builtin_amdgcn_s_barrier(); asm volatile("" ::: "memory");
        const int src = (lane & 48) | ((fr - 1) & 15);
        const int cha = u.pn * 128 + jj;
#pragma unroll
        for (int n = 0; n < 2; ++n) {
            asm volatile("" ::: "memory"); __builtin_amdgcn_sched_barrier(0);
            f32x4 p6[2], p7[2], w0[2], w1[2], w2[2], cb[2];
#pragma unroll
            for (int bj = 0; bj < 2; ++bj) {
                f32x4 h6 = (f32x4){0.f, 0.f, 0.f, 0.f}, h7 = h6;
                if (wr == 1) { h6 = *(LAS const f32x4*)(xch + ((((wc * 2 + 0) * 2 + bj) * 2 + n) * 4 + fq) * 4); h7 = *(LAS const f32x4*)(xch + ((((wc * 2 + 1) * 2 + bj) * 2 + n) * 4 + fq) * 4); }
#pragma unroll
                for (int e = 0; e < 4; ++e) { const float a6 = __shfl(U4(bj, n, 6)[e], src), a7 = __shfl(U4(bj, n, 7)[e], src); p6[bj][e] = (fr == 0) ? h6[e] : a6; p7[bj][e] = (fr == 0) ? h7[e] : a7; }
                LAS const float* ct = ctab + u.par * 1024 + bj * 512 + jj + 4 * n;
                w0[bj] = *(LAS const f32x4*)ct; w1[bj] = *(LAS const f32x4*)(ct + 128); w2[bj] = *(LAS const f32x4*)(ct + 256); cb[bj] = *(LAS const f32x4*)(ct + 384);
            }
#pragma unroll
            for (int i = 0; i < 8; ++i) {
                f32x4 c[2];
#pragma unroll
                for (int bj = 0; bj < 2; ++bj) {
                    const f32x4 um1 = (i >= 1) ? U4(bj, n, i >= 1 ? i - 1 : 0) : p7[bj];
                    const f32x4 um2 = (i >= 2) ? U4(bj, n, i >= 2 ? i - 2 : 0) : ((i == 1) ? p7[bj] : p6[bj]);
                    c[bj] = cb[bj] + w2[bj] * U4(bj, n, i) + w1[bj] * um1 + w0[bj] * um2;
                }
                f32x4 a;
#pragma unroll
                for (int e = 0; e < 4; ++e) { const float z = c[0][e]; a[e] = z * __builtin_amdgcn_rcpf(1.0f + __builtin_amdgcn_exp2f(-z * LOG2E)) * c[1][e]; }
                u32x2 w; w.x = cvtpk(a[0], a[1]); w.y = cvtpk(a[2], a[3]);
                const bool skip = (wr == 0 && fr == 0 && i < 2 && !bstart);
                if (!skip) *(u32x2*)(ACT + (size_t)(rowbase + i) * DFF_ + cha + 4 * n) = w;
            }
        }
#undef U4
    }
};

struct P4Order : pg8::StaticOrder {
    const float* SSQ; LAS float* rtab; mutable int lastpm; const float* convw; const float* convb; LAS unsigned char* ctab;
    __device__ __forceinline__ void a_ready(const pg8::Unit& u) const {
        { int t = threadIdx.x; asm volatile("" : "+v"(t)); const int w = __builtin_amdgcn_readfirstlane(t >> 6);
          if (w < 4) { const int bj = t >> 7, tap = (t >> 5) & 3, c4 = t & 31; const float* src = (tap < 3 ? convw + tap * 5632 : convb) + bj * DFF_ + u.pn * 128 + 4 * c4;
              __builtin_amdgcn_global_load_lds((const unsigned*)src, (LAS unsigned*)(ctab + u.par * 4096 + w * 1024), 16, 0, 0); } }
        if (u.pm == lastpm) return;
        lastpm = u.pm;
        const int t = threadIdx.x;
        if (t < 256) {
            const float* sp = SSQ + (size_t)(u.pm * 256 + t) * 16;
            const f32x4 s0 = *(const f32x4*)sp, s1 = *(const f32x4*)(sp + 4), s2 = *(const f32x4*)(sp + 8), s3 = *(const f32x4*)(sp + 12);
            const float tot = ((s0[0] + s0[1]) + (s0[2] + s0[3])) + ((s1[0] + s1[1]) + (s1[2] + s1[3])) + ((s2[0] + s2[1]) + (s2[2] + s2[3])) + ((s3[0] + s3[1]) + (s3[2] + s3[3]));
            rtab[((u.pm >> 3) & 1) * 256 + t] = 1.0f / sqrtf(tot * (1.f / 1024.f) + EPS_);
        }
    }
};

struct Epi5 {
    static constexpr bool PERM = true;
    const bf16_t* X1B; const bf16_t* X1L; float* dst;
    bool skip = false;
    __device__ __forceinline__ void operator()(const f32x4 (&acc)[2][2][4][2], const pg8::Unit& u, int wr, int wc, int fr, int fq) const {
        const int col = u.pn * 256 + wc * 64 + 8 * fq;
#pragma unroll
        for (int ai = 0; ai < 2; ++ai) {
            u32x4 hv[4][2];
#pragma unroll
            for (int m = 0; m < 4; ++m) { const size_t row = (size_t)(u.pm * 256 + ai * 128 + wr * 64 + m * 16 + fr);
#pragma unroll
                for (int bj = 0; bj < 2; ++bj) { const size_t off = row * 1024 + col + 32 * bj; hv[m][bj] = *(const u32x4*)(X1B + off); } }
            asm volatile("" ::: "memory");
#pragma unroll
            for (int m = 0; m < 4; ++m) { const size_t row = (size_t)(u.pm * 256 + ai * 128 + wr * 64 + m * 16 + fr);
#pragma unroll
                for (int bj = 0; bj < 2; ++bj) { float* q = dst + row * 1024 + col + 32 * bj; const u32x4 h = hv[m][bj];
                    const f32x4 x0 = (f32x4){bflo(h.x), bfhi(h.x), bflo(h.y), bfhi(h.y)};
                    const f32x4 x1 = (f32x4){bflo(h.z), bfhi(h.z), bflo(h.w), bfhi(h.w)};
                    *(f32x4*)q = x0 + acc[ai][bj][m][0]; *(f32x4*)(q + 4) = x1 + acc[ai][bj][m][1]; } }
            asm volatile("" ::: "memory");
        }
    }
};
struct P5Order : pg8::StaticOrder {
    const float* UE; const float* UF; const float* convw; const float* convb; bf16_t* ACT;
    __device__ __forceinline__ void a_ready(const pg8::Unit& u) const {
        if ((u.pm & 15) != 0) {
            for (int ch = threadIdx.x; ch < DFF_; ch += 512) {
                const int pa = 256 * (ch >> 7) + (ch & 127), pg = pa + 128;
                const float* e = UE + (size_t)((u.pm - 1) * 2) * 5632; const float* f = UF + (size_t)(u.pm * 2) * 5632;
                float r[2];
#pragma unroll
                for (int i = 0; i < 2; ++i) {
                    float cc[2];
#pragma unroll
                    for (int s = 0; s < 2; ++s) { const int p = s ? pg : pa, cch = s * DFF_ + ch;
                        const float um2 = e[p], um1 = e[5632 + p], u0 = f[p], u1 = f[5632 + p];
                        const float w0 = convw[cch], w1 = convw[5632 + cch], w2 = convw[2 * 5632 + cch], b = convb[cch];
                        cc[s] = (i == 0) ? b + w0 * um2 + w1 * um1 + w2 * u0 : b + w0 * um1 + w1 * u0 + w2 * u1; }
                    r[i] = cc[0] * __builtin_amdgcn_rcpf(1.0f + __builtin_amdgcn_exp2f(-cc[0] * LOG2E)) * cc[1];
                }
                const unsigned w = cvtpk(r[0], r[1]);
                ACT[(size_t)(u.pm * 256) * DFF_ + ch] = (bf16_t)(w & 0xffffu); ACT[(size_t)(u.pm * 256 + 1) * DFF_ + ch] = (bf16_t)(w >> 16);
            }
        }
        asm volatile("s_waitcnt vmcnt(0)" ::: "memory"); __builtin_amdgcn_s_barrier(); asm volatile("" ::: "memory");
    }
};

__device__ __forceinline__ Args opaque_args() {
    Args a{};
#if defined(__HIP_DEVICE_COMPILE__)
    typedef const __attribute__((address_space(4))) Args* KArgsPtr;
    KArgsPtr p = (KArgsPtr)__builtin_amdgcn_kernarg_segment_ptr(); asm volatile("" : "+s"(p));
#pragma unroll
    for (int i = 0; i < 25; ++i) a.in[i] = p->in[i];
    a.out = p->out; a.ws = p->ws; a.ph_lo = p->ph_lo; a.ph_hi = p->ph_hi; a.li = p->li; a.pad = p->pad;
#endif
    return a;
}
__device__ __forceinline__ int opaque_tid() { int t = threadIdx.x; asm volatile("" : "+v"(t)); return t; }
__global__ void __launch_bounds__(NWAVES * 64, 2) fwd_kernel(Args args_by_value) {
    const Args args0 = opaque_args();
    extern __shared__ __attribute__((aligned(16))) unsigned char lds_raw[];
    LAS unsigned char* lds = (LAS unsigned char*)lds_raw;
    volatile LAS unsigned* MISC = (volatile LAS unsigned*)(lds + MISC_OFF);
    const int tid = threadIdx.x, lane = tid & 63, wave = __builtin_amdgcn_readfirstlane(tid >> 6);
    const int G = gridDim.x; const int bx = blockIdx.x; const int vcu = (G % 8 == 0) ? (bx % 8) * (G / 8) + bx / 8 : bx;
    unsigned char* ws = args0.ws;
    gu32* ctl = (gu32*)(ws + WS_CTL);
    for (int u = tid; u < (LDS_BYTES - LDSCTL_OFF) / 4; u += NWAVES * 64) ((LAS unsigned*)(lds + LDSCTL_OFF))[u] = 0u;
    __syncthreads();
    XcdBarrier bar; bar.bar = g_barrier_words + args0.li * XCD_BAR_WORDS; bar.nx = G < 8 ? (unsigned)G : 8u; bar.x = (unsigned)bx % bar.nx; bar.nloc = ((unsigned)G - bar.x + bar.nx - 1u) / bar.nx;
#ifdef PROBE_PH
    const unsigned long long tk0 = __builtin_amdgcn_s_memrealtime(); int nst = 0;
#define GRID_BAR() do { if (!MK_MULTI) xcd_barrier(bar); if (bx == 0 && tid == 0) { ((float*)(ws + WS_CTL + 768 * 1024))[nst] = (float)(__builtin_amdgcn_s_memrealtime() - tk0); } ++nst; } while (0)
#else
#define GRID_BAR() do { if (!MK_MULTI) xcd_barrier(bar); } while (0)
#endif
    const int lo = args0.ph_lo, hi = args0.ph_hi;
#ifndef PHASE_MASK
#define PHASE_MASK 0xff
#endif
#define IN(k) (((PHASE_MASK >> (k)) & 1) && lo <= (k) && (k) < hi)
#define BOTH(k) (IN(k) && IN((k) + 1))

    if (IN(0)) { const Args args = opaque_args(); const int t_ = opaque_tid(); p0_prologue(args, lds, vcu, G, __builtin_amdgcn_readfirstlane(t_ >> 6), t_ & 63); if (BOTH(0)) GRID_BAR(); }
#ifdef PROBE_BARS
    for (int xb = 0; xb < PROBE_BARS; ++xb) GRID_BAR();
#endif

    if (IN(1)) { const Args args = opaque_args();
        constexpr int NUB = 64 * 26 + 16;
        const unsigned* ropep = (const unsigned*)((unsigned char*)args.out + DO_ROPE);
        {
            pg8::Gemm g{(const bf16_t*)(ws + WS_A1I8), (const bf16_t*)((unsigned char*)args.out + DO_WI8), T_ + NB_ * MEM_, NCAT, 512 + args0.pad};
            TileOrder S; S.init(0x3FFFFFFu, 1, G, bx);
            Epi1 E{ws, ropep, args.in[I_AQ], args.in[I_AK], args.in[I_BQ], args.in[I_BK], args.in[I_BGATE], (const float*)(ws + WS_RSC), (const float*)(ws + WS_CMAX), lds};
            pg8::gemm_phase<Epi1, TileOrder, true, false, false, 2, true>(lds + RING_OFF, g, S, E);
            { const int nrem = NUB % G;
              const int t_ = opaque_tid(), w_ = __builtin_amdgcn_readfirstlane(t_ >> 6), l_ = t_ & 63;
              if (nrem == 0) p0_late_weights<0>(args, bx * NWAVES + w_, G * NWAVES, l_);
              else if (bx >= nrem) p0_late_weights<0>(args, (bx - nrem) * NWAVES + w_, (G - nrem) * NWAVES, l_); }
        }
        if (BOTH(1)) GRID_BAR();
    }

    if (IN(2)) { const Args args = opaque_args(); const int t_ = opaque_tid(); p2_attention(args, lds, vcu, t_, __builtin_amdgcn_readfirstlane(t_ >> 6), t_ & 63); if (BOTH(2)) GRID_BAR(); }


    if (IN(4)) { const Args args = opaque_args();
        pg8::Gemm g{(const bf16_t*)((unsigned char*)args.out + DO_OCAT), (const bf16_t*)(ws + WS_WO), T_, 1024, KCAT};
        P3aOrder S; S.init(T_, 1024, G, bx);
        S.oag = (const bf16_t*)((unsigned char*)args.out + DO_OAG); S.ocat = (bf16_t*)((unsigned char*)args.out + DO_OCAT); S.lse = (const float*)(ws + WS_LSE);
        Epi3a E{(const unsigned char*)(ws + WS_G), (bf16_t*)(ws + WS_MERGED)};
        pg8::gemm_phase<Epi3a, P3aOrder, false, false, true>(lds + RING_OFF, g, S, E);
        if (BOTH(4)) GRID_BAR();
    }

    if (IN(5)) { const Args args = opaque_args();
        pg8::Gemm g{(const bf16_t*)(ws + WS_MERGED), (const bf16_t*)(ws + WS_WOUT), T_, 1024, 1024};
        pg8::StaticOrder S; S.init(T_, 1024, G, bx);
        Epi3b E{args.in[I_X], (bf16_t*)(ws + WS_X1L), (bf16_t*)(ws + WS_X1B), (float*)(ws + WS_SSQ)};
        pg8::gemm_phase<Epi3b, pg8::StaticOrder, false, false, false>(lds + RING_OFF, g, S, E);
        if (BOTH(5)) GRID_BAR();
    }

    if (IN(6)) { const Args args = opaque_args();
        pg8::Gemm g{(const bf16_t*)(ws + WS_X1B), (const bf16_t*)(ws + WS_WUP), T_, 5632, 1024};
        P4Order S; S.init(T_, 5632, G, bx); S.SSQ = (const float*)(ws + WS_SSQ); S.rtab = (LAS float*)(lds + XCH_OFF + 2048); S.lastpm = -1; S.convw = args.in[I_CONVW]; S.convb = args.in[I_CONVB]; S.ctab = lds + CTAB_OFF;
        Epi4 E{args.in[I_CONVW], args.in[I_CONVB], (bf16_t*)(ws + WS_ACT), (float*)(ws + WS_UE), (float*)(ws + WS_UF), (LAS float*)(lds + XCH_OFF), (LAS const float*)(lds + XCH_OFF + 2048), (LAS const float*)(lds + CTAB_OFF)};
#ifdef PROBE_NOEPI
        E.skip = (args0.li == 1);
#endif
        pg8::gemm_phase<Epi4, P4Order, true, true, false>(lds + RING_OFF, g, S, E);
        { const int nrem = (64 * 22) % G;
          const int t_ = opaque_tid(), w_ = __builtin_amdgcn_readfirstlane(t_ >> 6), l_ = t_ & 63;
          if (nrem == 0) p0_late_weights<1>(args, bx * NWAVES + w_, G * NWAVES, l_);
          else if (bx >= nrem) p0_late_weights<1>(args, (bx - nrem) * NWAVES + w_, (G - nrem) * NWAVES, l_); }
        if (BOTH(6)) GRID_BAR();
    }

    if (IN(7)) { const Args args = opaque_args();
        pg8::Gemm g{(const bf16_t*)(ws + WS_ACT), (const bf16_t*)(ws + WS_WDOWN), T_, 1024, DFF_};
        P5Order S; S.init(T_, 1024, G, bx);
        S.UE = (const float*)(ws + WS_UE); S.UF = (const float*)(ws + WS_UF); S.convw = args.in[I_CONVW]; S.convb = args.in[I_CONVB]; S.ACT = (bf16_t*)(ws + WS_ACT);
        Epi5 E{(const bf16_t*)(ws + WS_X1B), (const bf16_t*)(ws + WS_X1L), args.out};
        pg8::gemm_phase<Epi5, P5Order, false, false, false>(lds + RING_OFF, g, S, E);
    }
#ifdef PROBE_PH
    if (IN(7) && bx == 0 && tid == 0) { asm volatile("s_waitcnt vmcnt(0)" ::: "memory"); float* st = (float*)(ws + WS_CTL + 768 * 1024); st[nst] = (float)(__builtin_amdgcn_s_memrealtime() - tk0);
        args.out[5] = 1000.0f * (1000.0f * floorf(st[PROBE_PH] / 1000.0f + 0.5f)); }
#endif
#ifdef PROBE_TS
    if (IN(7) && bx == 0 && tid == 0) { asm volatile("s_waitcnt vmcnt(0)" ::: "memory"); const float* dbg = (const float*)(ws + WS_CTL + 512 * 1024); args.out[5] = 1000.0f * (400.0f * floorf(dbg[PROBE_TS - 1] / 400.0f + 0.5f)); }
#endif
#undef IN
#undef BOTH
#undef GRID_BAR
}

extern "C" void kernel_launch(void* const* d_in, const int* in_sizes, int n_in, void* d_out, int out_size, void* d_ws, size_t ws_size, hipStream_t stream) {
    static int grid = 0;
    if (grid == 0) {
        if (n_in != 25 || out_size != T_ * DM_ || ws_size < WS_END) { fprintf(stderr, "kernel_launch: unexpected shapes (n_in %d, out %d, ws %zu); nothing launched\n", n_in, out_size, ws_size); grid = -1; return; }
        int dev = 0, cus = 0, per_cu = 0;
        if (hipGetDevice(&dev) != hipSuccess || hipDeviceGetAttribute(&cus, hipDeviceAttributeMultiprocessorCount, dev) != hipSuccess) { grid = -1; return; }
        if (hipFuncSetAttribute((const void*)fwd_kernel, hipFuncAttributeMaxDynamicSharedMemorySize, LDS_BYTES) != hipSuccess) { fprintf(stderr, "kernel_launch: hipFuncSetAttribute failed\n"); grid = -1; return; }
        if (hipOccupancyMaxActiveBlocksPerMultiprocessor(&per_cu, (const void*)fwd_kernel, NWAVES * 64, LDS_BYTES) != hipSuccess || per_cu < 1) { fprintf(stderr, "kernel_launch: occupancy query says %d blocks per CU\n", per_cu); }
        (void)hipGetLastError();
        grid = cus;
        if (grid != 256) fprintf(stderr, "kernel_launch: %d CUs (the phase schedules expect 256)\n", grid);
    }
    if (grid < 0) return;
    Args a{};
    for (int i = 0; i < 25; ++i) a.in[i] = (const float*)d_in[i];
    a.out = (float*)d_out; a.ws = (unsigned char*)d_ws;
#if MK_MULTI
    for (int p = 0; p < NPHASES; ++p) { a.ph_lo = p; a.ph_hi = p + 1; a.li = p; hipLaunchKernelGGL(fwd_kernel, dim3(grid), dim3(NWAVES * 64), LDS_BYTES, stream, a); }
#elif defined(PROBE_PHASE)
    a.ph_lo = 0; a.ph_hi = PROBE_PHASE + 1; a.li = 0;
    hipLaunchKernelGGL(fwd_kernel, dim3(grid), dim3(NWAVES * 64), LDS_BYTES, stream, a);
    a.ph_lo = PROBE_PHASE; a.ph_hi = NPHASES; a.li = 1;
    hipLaunchKernelGGL(fwd_kernel, dim3(grid), dim3(NWAVES * 64), LDS_BYTES, stream, a);
#else
    a.ph_lo = 0; a.ph_hi = NPHASES; a.li = 0;
    hipLaunchKernelGGL(fwd_kernel, dim3(grid), dim3(NWAVES * 64), LDS_BYTES, stream, a);
#endif
}
```

```cpp
#include <hip/hip_runtime.h>
#include <cstdio>
#include <cstdint>

#ifndef MK_MULTI
#define MK_MULTI 0
#endif
#define LAS __attribute__((address_space(3)))
#define GAS __attribute__((address_space(1)))
typedef unsigned short bf16_t;
typedef short bf16x8 __attribute__((ext_vector_type(8)));
typedef short s16x4 __attribute__((ext_vector_type(4)));
typedef float f32x4 __attribute__((ext_vector_type(4)));
typedef float f32x16 __attribute__((ext_vector_type(16)));
typedef unsigned u32x4 __attribute__((ext_vector_type(4)));
typedef unsigned u32x2 __attribute__((ext_vector_type(2)));
typedef int v4i32 __attribute__((ext_vector_type(4)));
typedef int v8i32 __attribute__((ext_vector_type(8)));

constexpr int T_ = 16384, SEQ_ = 4096, NB_ = 4, DM_ = 1024, MEM_ = 256, DFF_ = 2816;
constexpr int NCAT = 7680;
constexpr int KCAT = 1280;
constexpr float EPS_ = 1e-6f;
constexpr float LOG2E = 1.4426950408889634f;
constexpr float QSCALE64 = 0.125f * LOG2E;
constexpr float QSCALE128 = 0.08838834764831845f * LOG2E;

__device__ __forceinline__ unsigned cvtpk(float lo, float hi) {
    typedef float f2 __attribute__((ext_vector_type(2))); typedef __bf16 b2 __attribute__((ext_vector_type(2)));
    f2 v = {lo, hi}; b2 b = __builtin_convertvector(v, b2); return __builtin_bit_cast(unsigned, b);
}
__device__ __forceinline__ float xor16(float v) { return __int_as_float(__builtin_amdgcn_ds_swizzle(__float_as_int(v), 0x401F)); }
__device__ __forceinline__ float sum_halves(float v) { const auto rr = __builtin_amdgcn_permlane32_swap(__float_as_uint(v), __float_as_uint(v), false, false); return __uint_as_float(rr[0]) + __uint_as_float(rr[1]); }
__device__ __forceinline__ float bflo(unsigned w) { return __uint_as_float(w << 16); }
__device__ __forceinline__ float bfhi(unsigned w) { return __uint_as_float(w & 0xffff0000u); }

namespace pg8 {
constexpr int BM = 256, BK = 64, HALF = 128, HTB = HALF * BK * 2, STAGE_BYTES = 8 * HTB, NXCD = 8, WGM = 8;
__host__ __device__ __forceinline__ int lds_byte(int r, int c) { const int st = (r >> 4) * 2 + (c >> 5), rr = r & 15, cc = c & 31, ob = rr * 64 + cc * 2; return st * 1024 + (ob ^ (((ob >> 9) & 1) << 5)); }
__host__ __device__ __forceinline__ void stage_rc(int b, int& R, int& C) { const int st = b / 1024, sb = b % 1024, swz = sb ^ (((sb >> 9) & 1) << 5); R = (st >> 1) * 16 + swz / 64; C = (st & 1) * 32 + (swz % 64) / 2; }
__host__ __device__ __forceinline__ int perm32(int rho) { const int n = rho >> 4, i = rho & 15; return 8 * (i >> 2) + 4 * n + (i & 3); }

struct Unit { int pm, pn, par; };
struct Gemm { const bf16_t* A; const bf16_t* Bt; int M, N, K; };

struct StaticOrder {
    int nM, nN, nwg, G, c, wgm;
    __host__ __device__ void init(int M, int N, int G_, int c_, int wgm_ = WGM) { nM = M / BM; nN = N / BM; nwg = nM * nN; G = G_; c = c_; wgm = wgm_; }
    __host__ __device__ bool next(int i, Unit& u) const {
        const long L = (long)i * G + c; if (L >= nwg) return false;
        int wgid = (int)L; { const int q = nwg / NXCD, r = nwg % NXCD, xcd = wgid % NXCD, off = wgid / NXCD; wgid = (xcd < r ? xcd * (q + 1) : r * (q + 1) + (xcd - r) * q) + off; }
        const int nig = wgm * nN, gid = wgid / nig, fm = gid * wgm, gsz = (nM - fm) < wgm ? (nM - fm) : wgm;
        u.pm = fm + ((wgid % nig) % gsz); u.pn = (wgid % nig) / gsz; return true;
    }
    __device__ __forceinline__ void a_ready(const Unit&) const {}
    __device__ __forceinline__ void done(const Unit&) const {}
};

template <class Epi, class Sched, bool ALIGN_EPI, bool PERMA, bool KHOOK, int QM = 0, bool PREF = false>
__device__ __forceinline__ void gemm_phase(LAS unsigned char* lds, const Gemm g, const Sched& S, const Epi& E) {
    constexpr bool FP8 = (QM == 1), I8 = (QM == 2);
    int tid_ = threadIdx.x; asm volatile("" : "+v"(tid_));
    const int tid = tid_, wid = __builtin_amdgcn_readfirstlane(tid >> 6), lane = tid & 63, wr = wid >> 2, wc = wid & 3, fr = lane & 15, fq = lane >> 4;
    const int K = g.K, nt = K / BK;
    unsigned voffA0, voffA1, voffB;
    { int R, C; stage_rc(tid * 16, R, C); const int Rb = (R & ~31) + perm32(R & 31);
        if (PERMA) { const int rw = R >> 6, rm = (R >> 4) & 3, rf = R & 15; voffA0 = (unsigned)((128 * rw + 8 * rf + rm) * K + C) * 2u; voffA1 = (unsigned)((128 * rw + 8 * rf + 4 + rm) * K + C) * 2u; }
        else { voffA0 = (unsigned)(R * K + C) * 2u; voffA1 = voffA0; }
        voffB = (unsigned)(Rb * K + C) * 2u; }
    const size_t pstep_voffA0 = (size_t)(PERMA ? 128 : 64) * K * 2, pstep_voffA1 = pstep_voffA0, pstep_voffB = (size_t)64 * K * 2;
    const size_t kstep = (size_t)(BK * 2);
    const size_t hstep = (size_t)HALF * K * 2;
    const size_t ahs = PERMA ? (size_t)0 : hstep;
    const size_t tstep = 2 * hstep;
    const unsigned ldsw = (unsigned)wid * 1024u;
    const int aoff = lds_byte(wr * 64 + fr, fq * 8), boff = lds_byte(wc * 32 + fr, fq * 8);
#define PG8_SA(b, h) (((b) * 2 + (h)) * HTB)
#define PG8_SB(b, h) ((4 + (b) * 2 + (h)) * HTB)
#define PG8_STAGE(bufoff, gbase, voff) do { _Pragma("unroll") for (int _i = 0; _i < 2; ++_i) { unsigned _v = (voff); asm volatile("" : "+v"(_v));     \
        __builtin_amdgcn_global_load_lds((const unsigned*)((const char*)(gbase) + _i * PG8_PSTEP(voff) + _v), (LAS unsigned*)(lds + (bufoff) + ldsw + _i * 8192), 16, 0, 0); } } while (0)
#define PG8_PSTEP(voff) pstep_##voff
#define PG8_LD8(p) __builtin_shufflevector(*(const LAS v4i32*)(p), *(const LAS v4i32*)((p) + 1024), 0, 1, 2, 3, 4, 5, 6, 7)
#define PG8_LDA(dst, b, h) do { if constexpr (false) { _Pragma("unroll") for (int m = 0; m < 4; ++m) dst##8[m] = PG8_LD8(lds + PG8_SA(b, h) + aoff + m * 2048); } \
        else { _Pragma("unroll") for (int m = 0; m < 4; ++m) _Pragma("unroll") for (int k = 0; k < 2; ++k) dst[m][k] = *(const LAS bf16x8*)(lds + PG8_SA(b, h) + aoff + m * 2048 + k * 1024); } } while (0)
#define PG8_LDB(dst, b, h) do { if constexpr (false) { _Pragma("unroll") for (int n = 0; n < 2; ++n) dst##8[n] = PG8_LD8(lds + PG8_SB(b, h) + boff + n * 2048); } \
        else { _Pragma("unroll") for (int n = 0; n < 2; ++n) _Pragma("unroll") for (int k = 0; k < 2; ++k) dst[n][k] = *(const LAS bf16x8*)(lds + PG8_SB(b, h) + boff + n * 2048 + k * 1024); } } while (0)
#define PG8_CAT(x) __builtin_shufflevector(__builtin_bit_cast(v4i32, (x)[0]), __builtin_bit_cast(v4i32, (x)[1]), 0, 1, 2, 3, 4, 5, 6, 7)
#define PG8_MMA(ai, bj, At, Bt) do { if constexpr (FP8) __builtin_amdgcn_sched_barrier(0); __builtin_amdgcn_s_setprio(1); _Pragma("unroll") for (int m = 0; m < 4; ++m) _Pragma("unroll") for (int n = 0; n < 2; ++n) { \
        if constexpr (FP8) acc[ai][bj][m][n] = __builtin_amdgcn_mfma_scale_f32_16x16x128_f8f6f4(PG8_CAT(Bt[n]), PG8_CAT(At[m]), acc[ai][bj][m][n], 0, 0, 0, 0, 0, 0); \
        else if constexpr (I8) { _Pragma("unroll") for (int k = 0; k < 2; ++k) acc[ai][bj][m][n] = __builtin_bit_cast(f32x4, __builtin_amdgcn_mfma_i32_16x16x64_i8(__builtin_bit_cast(v4i32, Bt[n][k]), __builtin_bit_cast(v4i32, At[m][k]), __builtin_bit_cast(v4i32, acc[ai][bj][m][n]), 0, 0, 0)); } \
        else { _Pragma("unroll") for (int k = 0; k < 2; ++k) acc[ai][bj][m][n] = __builtin_amdgcn_mfma_f32_16x16x32_bf16(Bt[n][k], At[m][k], acc[ai][bj][m][n], 0, 0, 0); } } if constexpr (FP8) __builtin_amdgcn_sched_barrier(0); __builtin_amdgcn_s_setprio(0); if constexpr (FP8) __builtin_amdgcn_sched_barrier(0); } while (0)
#define PG8_WAIT_V(n) asm volatile("s_waitcnt vmcnt(" #n ")" ::: "memory")
#define PG8_WAIT_L(n) asm volatile("s_waitcnt lgkmcnt(" #n ")" ::: "memory")
#define PG8_BAR __builtin_amdgcn_s_barrier()
#define PG8_SCHED __builtin_amdgcn_sched_barrier(0)
    Unit cur, nxt; int ui = 0;
    if (!S.next(0, cur)) return;
    cur.par = 0;
    f32x4 acc[2][2][4][2];
#pragma unroll
    for (int a = 0; a < 2; ++a)
#pragma unroll
        for (int b = 0; b < 2; ++b)
#pragma unroll
            for (int m = 0; m < 4; ++m)
#pragma unroll
                for (int n = 0; n < 2; ++n) acc[a][b][m][n] = (f32x4){0.f, 0.f, 0.f, 0.f};
    bf16x8 At[4][2], B0[2][2], B1[2][2];
    v8i32 At8[4], B08[2], B18[2];
    const char* cA = (const char*)g.A + (size_t)cur.pm * tstep; const char* cB = (const char*)g.Bt + (size_t)cur.pn * tstep;
    S.a_ready(cur);
    PG8_STAGE(PG8_SB(0, 0), cB, voffB); PG8_STAGE(PG8_SB(0, 1), cB + hstep, voffB); PG8_STAGE(PG8_SA(0, 0), cA, voffA0); PG8_STAGE(PG8_SA(0, 1), cA + ahs, voffA1);
    if (wr == 1) PG8_BAR;
    PG8_WAIT_V(2); PG8_BAR;
    PG8_STAGE(PG8_SB(1, 0), cB + kstep, voffB); PG8_STAGE(PG8_SA(1, 0), cA + kstep, voffA0); PG8_STAGE(PG8_SB(1, 1), cB + hstep + kstep, voffB);
    PG8_WAIT_V(6); PG8_BAR;
    for (;;) {
        const bool has_next = S.next(ui + 1, nxt); nxt.par = (ui + 1) & 1;
        const char* nA = has_next ? (const char*)g.A + (size_t)nxt.pm * tstep : cA; const char* nB = has_next ? (const char*)g.Bt + (size_t)nxt.pn * tstep : cB;
        for (int t = 0; t < nt; t += 2) {
            const bool last = (t == nt - 2);
            const char* a1 = cA + (size_t)(t + 1) * kstep;
            const char* a2 = last ? nA : cA + (size_t)(t + 2) * kstep; const char* b2 = last ? nB : cB + (size_t)(t + 2) * kstep;
            const char* a3 = a2 + kstep; const char* b3 = b2 + kstep;
            asm volatile("" : "+s"(a1), "+s"(a2), "+s"(b2), "+s"(a3), "+s"(b3));
            if (last && has_next) S.a_ready(nxt);
            if constexpr (KHOOK) { int l3_ = threadIdx.x; asm volatile("" : "+v"(l3_)); E.khook(acc, cur, t, wr, wc, l3_ & 15, (l3_ >> 4) & 3); }
            PG8_LDB(B0, 0, 0); PG8_LDB(B1, 0, 1); PG8_SCHED; PG8_LDA(At, 0, 0); PG8_STAGE(PG8_SA(1, 1), a1 + ahs, voffA1);
            PG8_WAIT_V(8); PG8_WAIT_L(0); PG8_BAR;
            if constexpr (PREF) { if (t == 0 && wr == 0) E.prefetch(cur, wid); }
            PG8_MMA(0, 0, At, B0); PG8_MMA(0, 1, At, B1); PG8_BAR; PG8_SCHED;
            PG8_LDA(At, 0, 1); PG8_STAGE(PG8_SB(0, 0), b2, voffB); PG8_STAGE(PG8_SB(0, 1), b2 + hstep, voffB); PG8_STAGE(PG8_SA(0, 0), a2, voffA0);
            PG8_WAIT_V(8); PG8_WAIT_L(0); PG8_BAR; PG8_MMA(1, 0, At, B0); PG8_MMA(1, 1, At, B1); PG8_BAR; PG8_SCHED;
            PG8_LDB(B0, 1, 0); PG8_LDB(B1, 1, 1); PG8_SCHED; PG8_LDA(At, 1, 0); PG8_STAGE(PG8_SA(0, 1), a2 + ahs, voffA1);
            PG8_WAIT_V(8); PG8_WAIT_L(0); PG8_BAR; PG8_MMA(0, 0, At, B0); PG8_MMA(0, 1, At, B1); PG8_BAR; PG8_SCHED;
            PG8_LDA(At, 1, 1); PG8_STAGE(PG8_SB(1, 0), b3, voffB); PG8_STAGE(PG8_SB(1, 1), b3 + hstep, voffB); PG8_STAGE(PG8_SA(1, 0), a3, voffA0);
            PG8_WAIT_V(8); PG8_WAIT_L(0); PG8_BAR; PG8_MMA(1, 0, At, B0); PG8_MMA(1, 1, At, B1); PG8_BAR; PG8_SCHED;
        }
        if constexpr (ALIGN_EPI) { if (wr == 0) PG8_BAR; }
        { int l2_ = threadIdx.x; asm volatile("" : "+v"(l2_)); const int fr2 = l2_ & 15, fq2 = (l2_ >> 4) & 3;
          if (!E.skip) E(acc, cur, wr, wc, fr2, fq2); } S.done(cur);
        if (!has_next) break;
#pragma unroll
        for (int a = 0; a < 2; ++a)
#pragma unroll
            for (int b = 0; b < 2; ++b)
#pragma unroll
                for (int m = 0; m < 4; ++m)
#pragma unroll
                    for (int n = 0; n < 2; ++n) acc[a][b][m][n] = (f32x4){0.f, 0.f, 0.f, 0.f};
        cur = nxt; cA = nA; cB = nB; ++ui;
        if constexpr (ALIGN_EPI) { if (wr == 1) PG8_BAR; }
    }
    PG8_WAIT_V(0);
    if constexpr (!ALIGN_EPI) { if (wr == 0) PG8_BAR; }
    PG8_BAR;
#undef PG8_SA
#undef PG8_SB
#undef PG8_STAGE
#undef PG8_PSTEP
#undef PG8_LDA
#undef PG8_LDB
#undef PG8_MMA
#undef PG8_CAT
#undef PG8_LD8
#undef PG8_WAIT_V
#undef PG8_WAIT_L
#undef PG8_BAR
#undef PG8_SCHED
}
}

constexpr size_t MiB = 1u << 20;
constexpr size_t WS_CTL = 0, CTL_ZERO_BYTES = 1 * MiB;
constexpr size_t WS_WO = 1 * MiB;
constexpr size_t WS_WOUT = 4 * MiB;
constexpr size_t WS_WUP = 6 * MiB;
constexpr size_t WS_WDOWN = 17 * MiB;
constexpr size_t WS_SSQ = 23 * MiB;
constexpr size_t WS_UE = 24 * MiB;
constexpr size_t WS_UF = 27 * MiB;
constexpr size_t WS_LSE = 30 * MiB;
constexpr size_t WS_MKV = 31 * MiB;
constexpr size_t WS_G = 34 * MiB;
constexpr size_t WS_A1I8 = 84 * MiB;
constexpr size_t WS_RSC = 23 * MiB;
constexpr size_t WS_CMAX = 23 * MiB + 128 * 1024;
constexpr size_t WS_ACT = 34 * MiB;
constexpr size_t WS_QA = 130 * MiB;
constexpr size_t WS_KA = 154 * MiB;
constexpr size_t WS_VA = 178 * MiB;
constexpr size_t WS_MERGED = 130 * MiB;
constexpr size_t WS_X1B = 162 * MiB;
constexpr size_t WS_X1L = 194 * MiB;
constexpr size_t WS_QB = 202 * MiB;
constexpr size_t WS_KVB = 218 * MiB;
constexpr size_t WS_MQ = 226 * MiB;
constexpr size_t WS_END = 242 * MiB;
constexpr size_t DO_WI8 = 34 * MiB;
constexpr size_t DO_ROPE = 49 * MiB;
constexpr size_t DO_OCAT = 0;
constexpr size_t DO_OAG = 40 * MiB;

constexpr int CW_TMO = 0, CW_BAR = 4096;

constexpr int RING_OFF = 0, RING_BYTES = 131072;
constexpr int XCH_OFF = RING_BYTES;
constexpr int LDSCTL_OFF = RING_BYTES + 4096, MISC_OFF = LDSCTL_OFF + 320;
constexpr int LDS_BYTES = 147456;
constexpr int P1T_ROPE = 131072, P1T_CS = 139264, P1T_BIAS = 140288, P1T_RSC = 141312, P1T_GAIN = 142336;
constexpr int CTAB_OFF = 139264;
constexpr int NWAVES = 8;
constexpr int NPHASES = 8;

typedef GAS unsigned gu32;
#define RLX_AGENT __ATOMIC_RELAXED, __HIP_MEMORY_SCOPE_AGENT
#define LDS_WAIT() asm volatile("s_waitcnt lgkmcnt(0)" ::: "memory")
#define VM_WAIT() asm volatile("s_waitcnt vmcnt(0)" ::: "memory")

#define XB_TMO      128
#define XB_XCNT(j)  (256  + 64 * (j))
#define XB_XSUB(j)  (1280 + 64 * (j))
#define XB_XGEN(j)  (2304 + 64 * (j))
#define XB_TOP      3328
#define XB_TOPGEN   3392
#define XCD_BAR_WORDS 3456
#define XB_SPIN_CAP (1u << 18)
__device__ __forceinline__ unsigned xb_ld(unsigned* p)              { return __hip_atomic_load(p, __ATOMIC_RELAXED, __HIP_MEMORY_SCOPE_AGENT); }
__device__ __forceinline__ unsigned xb_add(unsigned* p, unsigned v) { return __hip_atomic_fetch_add(p, v, __ATOMIC_RELAXED, __HIP_MEMORY_SCOPE_AGENT); }
__device__ __forceinline__ unsigned xb_xcc_id() { return (unsigned)__builtin_amdgcn_s_getreg((3 << 11) | 20) & 0xFu; }
#define XB_SPIN(cond, bar) do { unsigned _sp = 0; while (cond) { __builtin_amdgcn_s_sleep(1); \
    if ((++_sp & 255u) == 0u) { if (xb_ld(&(bar)[XB_TMO])) break; if (_sp > XB_SPIN_CAP) { atomicAdd(&(bar)[XB_TMO], 1u); break; } } } } while (0)
__device__ unsigned g_barrier_words[2 * XCD_BAR_WORDS];
struct XcdBarrier { unsigned* bar; unsigned x, nloc, nx; };
__device__ __forceinline__ void xcd_barrier(const XcdBarrier& b) {
    asm volatile("s_waitcnt vmcnt(0)" ::: "memory");
    __syncthreads();
    if (threadIdx.x == 0) {
        unsigned* bar = b.bar;
        __builtin_amdgcn_s_waitcnt(0);
        const unsigned nloc = b.nloc, nx = b.nx;
        const unsigned old = xb_add(&bar[XB_XSUB(b.x)], 1u);
        const unsigned gen = old / nloc;
        if (old + 1u == (gen + 1u) * nloc) {
            __builtin_amdgcn_fence(__ATOMIC_RELEASE, "agent");
            asm volatile("s_waitcnt vmcnt(0)" ::: "memory");
            const unsigned og = xb_add(&bar[XB_TOP], 1u);
            const unsigned tg = og / nx;
            if (og + 1u == (tg + 1u) * nx) xb_add(&bar[XB_TOPGEN], 1u);
            else XB_SPIN(xb_ld(&bar[XB_TOPGEN]) == tg, bar);
            __builtin_amdgcn_fence(__ATOMIC_ACQUIRE, "agent");
            xb_add(&bar[XB_XGEN(b.x)], 1u);
            asm volatile("s_waitcnt vmcnt(0)" ::: "memory");
        } else {
            XB_SPIN(xb_ld(&bar[XB_XGEN(b.x)]) == gen, bar);
            __builtin_amdgcn_fence(__ATOMIC_ACQUIRE, "agent");
            asm volatile("s_waitcnt vmcnt(0)" ::: "memory");
        }
    }
    __syncthreads();
}

struct Args {
    const float* in[25]; float* out; unsigned char* ws; int ph_lo, ph_hi, li, pad;
};
enum { I_X = 0, I_MEM, I_POS, I_ATTN_NORM, I_W_IN, I_AQ, I_AK, I_BQ, I_BK, I_SINK, I_MEM_NORM, I_W_MKV, I_MQN, I_MKN, I_WOA, I_WOB, I_WOM, I_WGATE, I_BGATE, I_WOUT, I_FFN_NORM, I_WUP, I_CONVW, I_CONVB, I_WDOWN };

__host__ __device__ __forceinline__ int map_uniform(int n) { const int c = n & 255; return (n & ~255) + 128 * ((c >> 5) & 1) + 32 * (c >> 6) + (c & 31); }
__host__ __device__ __forceinline__ int map_up(int n) { return n < DFF_ ? 256 * (n >> 7) + (n & 127) : 256 * ((n - DFF_) >> 7) + 128 + ((n - DFF_) & 127); }

__device__ __forceinline__ float wave_sum(float v) {
#pragma unroll
    for (int o = 1; o < 64; o <<= 1) v += __shfl_xor(v, o);
    return v;
}
template <int MAP>
__device__ __forceinline__ void p0_transpose_item(const float* W, int K, int N, bf16_t* WT, int noff, int pitch, int koff, const float* kscale, LAS float*  , int item, int lane) {
    const int nblk = N / 32, kb = item / nblk, nb = item % nblk, k0 = 64 * kb + 8 * (lane >> 3), n0 = 32 * nb;
    f32x4 v[8];
#pragma unroll
    for (int i = 0; i < 8; ++i) v[i] = *(const f32x4*)(W + (size_t)(k0 + i) * N + n0 + 4 * (lane & 7));
    if (kscale) { const f32x4 s0 = *(const f32x4*)(kscale + k0), s1 = *(const f32x4*)(kscale + k0 + 4);
#pragma unroll
        for (int i = 0; i < 8; ++i) v[i] = v[i] * (i < 4 ? s0[i & 3] : s1[i & 3]); }
    const int r0 = (MAP == 0 ? map_uniform(noff + n0) : map_up(noff + n0)) + 4 * (lane & 7);
#pragma unroll
    for (int e = 0; e < 4; ++e) { u32x4 o; o.x = cvtpk(v[0][e], v[1][e]); o.y = cvtpk(v[2][e], v[3][e]); o.z = cvtpk(v[4][e], v[5][e]); o.w = cvtpk(v[6][e], v[7][e]);
        *(GAS u32x4*)(WT + (size_t)(r0 + e) * pitch + koff + k0 + 0) = o; }
}
constexpr float I8MAGIC = 12582912.0f;
__device__ __forceinline__ unsigned pack_i8(float m0, float m1, float m2, float m3) {
    const unsigned p01 = __builtin_amdgcn_perm(__float_as_uint(m1), __float_as_uint(m0), 0x0c0c0400u);
    const unsigned p23 = __builtin_amdgcn_perm(__float_as_uint(m3), __float_as_uint(m2), 0x0c0c0400u);
    return p01 | (p23 << 16);
}
__device__ __forceinline__ float wave_max(float v) {
#pragma unroll
    for (int o = 1; o < 64; o <<= 1) v = fmaxf(v, __shfl_xor(v, o));
    return v;
}
__device__ __forceinline__ void p0_quant_weight_block(const float* W, int N, int nb, int coff, unsigned char* WT, float* cmax, LAS float* part, int wave, int lane) {
    const int n0 = 32 * nb;
    f32x4 v[2][8];
#pragma unroll
    for (int it = 0; it < 2; ++it) { const int k0 = 128 * wave + 64 * it + 8 * (lane >> 3);
#pragma unroll
        for (int i = 0; i < 8; ++i) v[it][i] = *(const f32x4*)(W + (size_t)(k0 + i) * N + n0 + 4 * (lane & 7)); }
    f32x4 mx = {0.f, 0.f, 0.f, 0.f};
#pragma unroll
    for (int it = 0; it < 2; ++it)
#pragma unroll
        for (int i = 0; i < 8; ++i)
#pragma unroll
            for (int e = 0; e < 4; ++e) mx[e] = fmaxf(mx[e], fabsf(v[it][i][e]));
#pragma unroll
    for (int o = 8; o < 64; o <<= 1)
#pragma unroll
        for (int e = 0; e < 4; ++e) mx[e] = fmaxf(mx[e], __shfl_xor(mx[e], o));
    if (lane < 8) *(LAS f32x4*)(part + wave * 32 + 4 * lane) = mx;
    __syncthreads();
    f32x4 cm = *(const LAS f32x4*)(part + 4 * (lane & 7));
#pragma unroll
    for (int w = 1; w < 8; ++w) { const f32x4 o = *(const LAS f32x4*)(part + w * 32 + 4 * (lane & 7));
#pragma unroll
        for (int e = 0; e < 4; ++e) cm[e] = fmaxf(cm[e], o[e]); }
    if (wave == 0 && lane < 8) *(f32x4*)(cmax + coff + n0 + 4 * lane) = cm;
    f32x4 inv;
#pragma unroll
    for (int e = 0; e < 4; ++e) inv[e] = cm[e] > 0.f ? 127.0f / cm[e] : 0.f;
    const int r0 = map_uniform(coff + n0) + 4 * (lane & 7);
#pragma unroll
    for (int it = 0; it < 2; ++it) { const int k0 = 128 * wave + 64 * it + 8 * (lane >> 3);
#pragma unroll
        for (int e = 0; e < 4; ++e) { u32x2 o;
            o.x = pack_i8(__builtin_fmaf(v[it][0][e], inv[e], I8MAGIC), __builtin_fmaf(v[it][1][e], inv[e], I8MAGIC), __builtin_fmaf(v[it][2][e], inv[e], I8MAGIC), __builtin_fmaf(v[it][3][e], inv[e], I8MAGIC));
            o.y = pack_i8(__builtin_fmaf(v[it][4][e], inv[e], I8MAGIC), __builtin_fmaf(v[it][5][e], inv[e], I8MAGIC), __builtin_fmaf(v[it][6][e], inv[e], I8MAGIC), __builtin_fmaf(v[it][7][e], inv[e], I8MAGIC));
            *(GAS u32x2*)(WT + (size_t)(r0 + e) * 1024 + k0) = o; } }
    __syncthreads();
}
template <int NR>
__device__ __forceinline__ void rms_rows_to_i8(const float* xrow, size_t rstride, const float* gain, unsigned char* orow, float* rsc, int lane) {
    const GAS f32x4* gr = (const GAS f32x4*)gain + lane;
    f32x4 v[NR][4]; float s[NR], mx[NR];
#pragma unroll
    for (int r = 0; r < NR; ++r) { const GAS f32x4* xr = (const GAS f32x4*)(xrow + r * rstride) + lane;
#pragma unroll
        for (int j = 0; j < 4; ++j) v[r][j] = xr[64 * j]; }
    f32x4 g[4];
#pragma unroll
    for (int j = 0; j < 4; ++j) g[j] = gr[64 * j];
#pragma unroll
    for (int r = 0; r < NR; ++r) { s[r] = 0.f;
#pragma unroll
        for (int j = 0; j < 4; ++j) s[r] += (v[r][j].x * v[r][j].x + v[r][j].y * v[r][j].y) + (v[r][j].z * v[r][j].z + v[r][j].w * v[r][j].w); }
#pragma unroll
    for (int r = 0; r < NR; ++r) { const float rstd = 1.0f / sqrtf(wave_sum(s[r]) * (1.f / 1024.f) + EPS_); mx[r] = 0.f;
#pragma unroll
        for (int j = 0; j < 4; ++j) { v[r][j] = v[r][j] * rstd * g[j];
            mx[r] = fmaxf(fmaxf(mx[r], fmaxf(fabsf(v[r][j].x), fabsf(v[r][j].y))), fmaxf(fabsf(v[r][j].z), fabsf(v[r][j].w))); } }
#pragma unroll
    for (int r = 0; r < NR; ++r) mx[r] = wave_max(mx[r]);
#pragma unroll
    for (int r = 0; r < NR; ++r) { const float inv = mx[r] > 0.f ? 127.0f / mx[r] : 0.f;
        GAS unsigned* o4 = (GAS unsigned*)(orow + r * rstride) + lane;
#pragma unroll
        for (int j = 0; j < 4; ++j) o4[64 * j] = pack_i8(__builtin_fmaf(v[r][j].x, inv, I8MAGIC), __builtin_fmaf(v[r][j].y, inv, I8MAGIC), __builtin_fmaf(v[r][j].z, inv, I8MAGIC), __builtin_fmaf(v[r][j].w, inv, I8MAGIC));
        if (lane == 0) rsc[r] = mx[r] * (1.0f / 127.0f); }
}
__device__ __forceinline__ void sincos_f(float ang, float& co, float& si) {
    const double x = (double)ang; const double n = __builtin_rint(x * 0.63661977236758134308);
    double r = __builtin_fma(-n, 1.5707963267948966192, x); r = __builtin_fma(-n, 6.123233995736766036e-17, r);
    const double r2 = r * r;
    double s = -1.0 / 6227020800.0; s = s * r2 + 1.0 / 39916800.0; s = s * r2 - 1.0 / 362880.0; s = s * r2 + 1.0 / 5040.0; s = s * r2 - 1.0 / 120.0; s = s * r2 + 1.0 / 6.0; s = r - r * r2 * s;
    double c = 1.0 / 479001600.0; c = c * r2 - 1.0 / 3628800.0; c = c * r2 + 1.0 / 40320.0; c = c * r2 - 1.0 / 720.0; c = c * r2 + 1.0 / 24.0; c = c * r2 - 0.5; c = c * r2 + 1.0;
    const int q = (int)((long long)n & 3);
    const double cs = (q == 0) ? c : (q == 1) ? -s : (q == 2) ? -c : s;
    const double sn = (q == 0) ? s : (q == 1) ? c : (q == 2) ? -s : -c;
    co = (float)cs; si = (float)sn;
}

struct Frame {
    LAS unsigned char* lds;
    int tid, lane, wave, vcu, G;
    const Args* a;
};

__device__ __forceinline__ void p0_prologue(const Args& A, LAS unsigned char* lds, int vcu, int G, int wave, int lane) {
    const int gw = vcu * NWAVES + wave, NGW = G * NWAVES;
    unsigned char* wi8 = (unsigned char*)A.out + DO_WI8;
    unsigned char* a1 = A.ws + WS_A1I8;
    float* rsc = (float*)(A.ws + WS_RSC); float* cmax = (float*)(A.ws + WS_CMAX);
    unsigned* rope = (unsigned*)((unsigned char*)A.out + DO_ROPE);
    constexpr int B_IN = 3584 / 32, B_GATE = 3072 / 32, B_MKV = 1024 / 32;
    for (int it = vcu; it < B_IN + B_GATE + B_MKV; it += G) {
        LAS float* part = (LAS float*)(lds + RING_OFF);
        if (it < B_IN) p0_quant_weight_block(A.in[I_W_IN], 3584, it, 0, wi8, cmax, part, wave, lane);
        else if (it < B_IN + B_GATE) p0_quant_weight_block(A.in[I_WGATE], 3072, it - B_IN, 3584, wi8, cmax, part, wave, lane);
        else p0_quant_weight_block(A.in[I_W_MKV], 1024, it - B_IN - B_GATE, 6656, wi8, cmax, part, wave, lane);
    }
    for (int m = 4 * gw; m < T_ + NB_ * MEM_; m += 4 * NGW) {
        if (m < T_) rms_rows_to_i8<4>(A.in[I_X] + (size_t)m * DM_, DM_, A.in[I_ATTN_NORM], a1 + (size_t)m * DM_, rsc + m, lane);
        else rms_rows_to_i8<4>(A.in[I_MEM] + (size_t)(m - T_) * DM_, DM_, A.in[I_MEM_NORM], a1 + (size_t)m * DM_, rsc + m, lane);
    }
    const int* pos = (const int*)A.in[I_POS];
    for (int idx = gw * 64 + lane; idx < T_ * 8; idx += NGW * 64) {
        const int t = idx >> 3, i = idx & 7;
        const float fr = (i == 0) ? 1.0f : (i == 1) ? 0.193922758102417f : (i == 2) ? 0.03760603442788124f : (i == 3) ? 0.007292666472494602f : (i == 4) ? 0.0014142136787995696f
                       : (i == 5) ? 0.00027424818836152554f : (i == 6) ? 5.318298644851893e-05f : 1.031338433676865e-05f;
        const float ang = (float)pos[t] * fr; float co, si; sincos_f(ang, co, si);
        rope[idx] = (unsigned)__builtin_bit_cast(unsigned short, (_Float16)co) | ((unsigned)__builtin_bit_cast(unsigned short, (_Float16)si) << 16);
    }
}

struct TItem { const float* W; bf16_t* WT; const float* kscale; int N, noff, pitch, koff, map, item; };
__device__ __forceinline__ void ti_load(const TItem& d, int lane, f32x4 (&v)[8], f32x4 (&sc)[2]) {
    const int nblk = d.N / 32, kb = d.item / nblk, nb = d.item % nblk, k0 = 64 * kb + 8 * (lane >> 3), n0 = 32 * nb;
#pragma unroll
    for (int i = 0; i < 8; ++i) v[i] = *(const f32x4*)(d.W + (size_t)(k0 + i) * d.N + n0 + 4 * (lane & 7));
    if (d.kscale) { sc[0] = *(const f32x4*)(d.kscale + k0); sc[1] = *(const f32x4*)(d.kscale + k0 + 4); }
}
__device__ __forceinline__ void ti_store(const TItem& d, int lane, f32x4 (&v)[8], const f32x4 (&sc)[2]) {
    const int nblk = d.N / 32, kb = d.item / nblk, nb = d.item % nblk, k0 = 64 * kb + 8 * (lane >> 3), n0 = 32 * nb;
    if (d.kscale) {
#pragma unroll
        for (int i = 0; i < 8; ++i) v[i] = v[i] * (i < 4 ? sc[0][i & 3] : sc[1][i & 3]); }
    const int r0 = (d.map == 0 ? map_uniform(d.noff + n0) : map_up(d.noff + n0)) + 4 * (lane & 7);
#pragma unroll
    for (int e = 0; e < 4; ++e) { u32x4 o; o.x = cvtpk(v[0][e], v[1][e]); o.y = cvtpk(v[2][e], v[3][e]); o.z = cvtpk(v[4][e], v[5][e]); o.w = cvtpk(v[6][e], v[7][e]);
        *(GAS u32x4*)(d.WT + (size_t)(r0 + e) * d.pitch + d.koff + k0) = o; }
}
template <int PART>
__device__ __forceinline__ bool late_item(const Args& A, int it, TItem& d) {
    constexpr int I_OA = (256 / 64) * (1024 / 32), I_OB = (512 / 64) * (1024 / 32), I_OM = I_OB, I_OUT = (1024 / 64) * (1024 / 32);
    constexpr int I_UP = (1024 / 64) * (5632 / 32), I_DOWN = (2816 / 64) * (1024 / 32);
    bf16_t* wo = (bf16_t*)(A.ws + WS_WO);
    if (PART == 1) { if (it >= I_DOWN) return false; d = TItem{A.in[I_WDOWN], (bf16_t*)(A.ws + WS_WDOWN), nullptr, 1024, 0, 2816, 0, 0, it}; return true; }
    int r = it;
    if (r < I_OA) { d = TItem{A.in[I_WOA], wo, nullptr, 1024, 0, KCAT, 0, 0, r}; return true; } r -= I_OA;
    if (r < I_OB) { d = TItem{A.in[I_WOB], wo, nullptr, 1024, 0, KCAT, 256, 0, r}; return true; } r -= I_OB;
    if (r < I_OM) { d = TItem{A.in[I_WOM], wo, nullptr, 1024, 0, KCAT, 768, 0, r}; return true; } r -= I_OM;
    if (r < I_OUT) { d = TItem{A.in[I_WOUT], (bf16_t*)(A.ws + WS_WOUT), nullptr, 1024, 0, 1024, 0, 0, r}; return true; } r -= I_OUT;
    if (r < I_UP) { d = TItem{A.in[I_WUP], (bf16_t*)(A.ws + WS_WUP), A.in[I_FFN_NORM], 5632, 0, 1024, 0, 1, r}; return true; }
    return false;
}
template <int PART>
__device__ __forceinline__ void p0_late_weights(const Args& A, int gw, int ngw, int lane) {
    constexpr int NB = 3;
    for (int it = gw; ; it += NB * ngw) {
        TItem d[NB]; bool ok[NB]; f32x4 v[NB][8], sc[NB][2];
#pragma unroll
        for (int b = 0; b < NB; ++b) { ok[b] = late_item<PART>(A, it + b * ngw, d[b]); if (ok[b]) ti_load(d[b], lane, v[b], sc[b]); }
        if (!ok[0]) break;
#pragma unroll
        for (int b = 0; b < NB; ++b) if (ok[b]) ti_store(d[b], lane, v[b], sc[b]);
    }
}

struct TileOrder {
    pg8::StaticOrder so; unsigned mask; int mkv;
    __device__ void init(unsigned mask_, int mkv_, int G, int c) { mask = mask_; mkv = mkv_; so.init(T_, 256 * __builtin_popcount(mask_), G, c, 4); }
    __device__ bool next(int i, pg8::Unit& u) const {
        if (so.next(i, u)) { unsigned m = mask; for (int k = 0; k < u.pn; ++k) m &= m - 1u; u.pn = __builtin_ctz(m); return true; }
        if (!mkv) return false;
        const long L = (long)i * so.G + so.c - so.nwg; if (L < 0 || L >= 16) return false;
        u.pm = 64 + (int)(L >> 2); u.pn = 26 + (int)(L & 3); return true;
    }
    __device__ __forceinline__ void a_ready(const pg8::Unit&) const {}
    __device__ __forceinline__ void done(const pg8::Unit&) const {}
};

__device__ __forceinline__ f32x4 cvt_i32(const f32x4& a) { const v4i32 i = __builtin_bit_cast(v4i32, a); return (f32x4){(float)i[0], (float)i[1], (float)i[2], (float)i[3]}; }

__device__ __forceinline__ float h2f_lo(unsigned w) { return (float)__builtin_bit_cast(_Float16, (unsigned short)(w & 0xffffu)); }
__device__ __forceinline__ float h2f_hi(unsigned w) { return (float)__builtin_bit_cast(_Float16, (unsigned short)(w >> 16)); }

struct EpiG {
    static constexpr bool PERM = true;
    unsigned char* G; LAS const unsigned char* lds;
    bool skip = false;
    __device__ __forceinline__ void operator()(const f32x4 (&acc)[2][2][4][2], const pg8::Unit& u, int wr, int wc, int fr, int fq) const {
        const int col0 = u.pn * 256, row0 = u.pm * 256;
        f32x4 bv[2][2], cs[2][2];
#pragma unroll
        for (int bj = 0; bj < 2; ++bj)
#pragma unroll
            for (int n = 0; n < 2; ++n) { const int j = wc * 64 + 32 * bj + 8 * fq + 4 * n; bv[bj][n] = *(LAS const f32x4*)(lds + P1T_BIAS + 4 * j) * (-LOG2E); cs[bj][n] = *(LAS const f32x4*)(lds + P1T_CS + 4 * j) * (-LOG2E / 127.0f); }
        float rsv[2][4];
#pragma unroll
        for (int ai = 0; ai < 2; ++ai)
#pragma unroll
            for (int m = 0; m < 4; ++m) rsv[ai][m] = *(LAS const float*)(lds + P1T_RSC + 4 * (ai * 128 + wr * 64 + m * 16 + fr));
#pragma unroll
        for (int ai = 0; ai < 2; ++ai)
#pragma unroll
            for (int m = 0; m < 4; ++m) { unsigned char* rowp = G + (size_t)(row0 + ai * 128 + wr * 64 + m * 16 + fr) * 3072 + col0 + wc * 64 + 8 * fq;
#pragma unroll
                for (int bj = 0; bj < 2; ++bj) { u32x2 w;
#pragma unroll
                    for (int n = 0; n < 2; ++n) { const f32x4 z = (cvt_i32(acc[ai][bj][m][n]) * rsv[ai][m]) * cs[bj][n] + bv[bj][n]; unsigned q[4];
#pragma unroll
                        for (int e = 0; e < 4; ++e) { const float g = __builtin_amdgcn_rcpf(1.0f + __builtin_amdgcn_exp2f(z[e])); const unsigned qi = (unsigned)(g * 255.0f + 0.5f); q[e] = qi < 1u ? 1u : qi; }
                        w[n] = q[0] | (q[1] << 8) | (q[2] << 16) | (q[3] << 24); }
                    *(u32x2*)(rowp + 32 * bj) = w; } }
    }
};

struct Epi1 {
    static constexpr bool PERM = true;
    unsigned char* ws; const unsigned* rope; const float *aq, *ak, *bq, *bk, *bgate; const float* rsc; const float* cmax; LAS unsigned char* lds;
    bool skip = false;
    __device__ __forceinline__ void prefetch(const pg8::Unit& u, int w) const {
        int lane = threadIdx.x; asm volatile("" : "+v"(lane)); lane &= 63;
        const int pn = u.pn, pm = u.pm;
        if (pm < 64 && pn < 12) {
#pragma unroll
            for (int j = 0; j < 2; ++j) { const int piece = 2 * w + j;
                __builtin_amdgcn_global_load_lds((const unsigned*)((const char*)rope + (size_t)pm * 8192 + piece * 1024 + lane * 16), (LAS unsigned*)(lds + P1T_ROPE + piece * 1024), 16, 0, 0); }
        }
        if (w == 0) __builtin_amdgcn_global_load_lds((const unsigned*)(cmax + pn * 256 + lane * 4), (LAS unsigned*)(lds + P1T_CS), 16, 0, 0);
        else if (w == 1) { if (pn >= 14 && pn < 26) __builtin_amdgcn_global_load_lds((const unsigned*)(bgate + (pn - 14) * 256 + lane * 4), (LAS unsigned*)(lds + P1T_BIAS), 16, 0, 0); }
        else if (w == 2) __builtin_amdgcn_global_load_lds((const unsigned*)(rsc + pm * 256 + lane * 4), (LAS unsigned*)(lds + P1T_RSC), 16, 0, 0);
        else if (pn < 12) { const int gi = pn / 3, ty = pn - 3 * gi;
            const float* gp = (pn >= 11) ? bk : (pn >= 9) ? bq : (ty == 0) ? aq + 64 * gi : ak + 64 * gi;
            if (lane < 16) __builtin_amdgcn_global_load_lds((const unsigned*)(gp + lane * 4), (LAS unsigned*)(lds + P1T_GAIN), 16, 0, 0); }
    }
    __device__ __forceinline__ void plain(const f32x4 (&acc)[2][2][4][2], bf16_t* dst, int ld, int col0, int row0, int wr, int wc, int fr, int fq) const {
        f32x4 cs[2][2];
#pragma unroll
        for (int bj = 0; bj < 2; ++bj)
#pragma unroll
            for (int n = 0; n < 2; ++n) cs[bj][n] = *(LAS const f32x4*)(lds + P1T_CS + 4 * (wc * 64 + 32 * bj + 8 * fq + 4 * n)) * (1.0f / 127.0f);
        float rsv[2][4];
#pragma unroll
        for (int ai = 0; ai < 2; ++ai)
#pragma unroll
            for (int m = 0; m < 4; ++m) rsv[ai][m] = *(LAS const float*)(lds + P1T_RSC + 4 * (ai * 128 + wr * 64 + m * 16 + fr));
#pragma unroll
        for (int ai = 0; ai < 2; ++ai)
#pragma unroll
            for (int m = 0; m < 4; ++m) { bf16_t* rowp = dst + (size_t)(row0 + ai * 128 + wr * 64 + m * 16 + fr) * ld + col0 + wc * 64 + 8 * fq;
#pragma unroll
                for (int bj = 0; bj < 2; ++bj) { const f32x4 v0 = cvt_i32(acc[ai][bj][m][0]) * rsv[ai][m] * cs[bj][0], v1 = cvt_i32(acc[ai][bj][m][1]) * rsv[ai][m] * cs[bj][1];
                    u32x4 w; w.x = cvtpk(v0[0], v0[1]); w.y = cvtpk(v0[2], v0[3]); w.z = cvtpk(v1[0], v1[1]); w.w = cvtpk(v1[2], v1[3]);
                    *(u32x4*)(rowp + 32 * bj) = w; } }
    }
    __device__ __forceinline__ void normed(const f32x4 (&acc)[2][2][4][2], bf16_t* dst, int ld, int col0, int row0, float scale, int wr, int wc, int fr, int fq) const {
        f32x4 g[2][2], cs[2][2];
#pragma unroll
        for (int bj = 0; bj < 2; ++bj)
#pragma unroll
            for (int n = 0; n < 2; ++n) { g[bj][n] = *(LAS const f32x4*)(lds + P1T_GAIN + 4 * (32 * bj + 8 * fq + 4 * n)) * scale; cs[bj][n] = *(LAS const f32x4*)(lds + P1T_CS + 4 * (wc * 64 + 32 * bj + 8 * fq + 4 * n)) * (1.0f / 127.0f); }
#pragma unroll
        for (int aim = 0; aim < 4; ++aim) {
            const int ai = aim >> 1;
            u32x4 rw[2][2]; float rsv[2];
#pragma unroll
            for (int mm = 0; mm < 2; ++mm) { const int tr = ai * 128 + wr * 64 + (2 * (aim & 1) + mm) * 16 + fr; rsv[mm] = *(LAS const float*)(lds + P1T_RSC + 4 * tr);
#pragma unroll
                for (int n = 0; n < 2; ++n) rw[mm][n] = *(LAS const u32x4*)(lds + P1T_ROPE + 32 * tr + 16 * n); }
#pragma unroll
            for (int mm = 0; mm < 2; ++mm) { const int m = 2 * (aim & 1) + mm;
                const int row = row0 + ai * 128 + wr * 64 + m * 16 + fr;
                f32x4 v[2][2];
                float ss = 0.f;
#pragma unroll
                for (int bj = 0; bj < 2; ++bj)
#pragma unroll
                    for (int n = 0; n < 2; ++n) { const f32x4 x = cvt_i32(acc[ai][bj][m][n]) * cs[bj][n]; v[bj][n] = x; ss += (x[0] * x[0] + x[1] * x[1]) + (x[2] * x[2] + x[3] * x[3]); }
                ss += xor16(ss); ss = sum_halves(ss);
                const float rq = rsv[mm];
                const float rs = rq / sqrtf(ss * (rq * rq * (1.f / 64.f)) + EPS_);
#pragma unroll
                for (int bj = 0; bj < 2; ++bj)
#pragma unroll
                    for (int n = 0; n < 2; ++n) v[bj][n] = v[bj][n] * rs * g[bj][n];
#pragma unroll
                for (int n = 0; n < 2; ++n) {
                    const u32x4 cw = rw[mm][n];
                    const f32x4 co = {h2f_lo(cw[0]), h2f_lo(cw[1]), h2f_lo(cw[2]), h2f_lo(cw[3])}, si = {h2f_hi(cw[0]), h2f_hi(cw[1]), h2f_hi(cw[2]), h2f_hi(cw[3])};
                    f32x4 pr;
#pragma unroll
                    for (int e = 0; e < 4; ++e) pr[e] = xor16(v[0][n][e]);
                    const f32x4 r0 = v[0][n] * co - pr * si, r1 = v[0][n] * co + pr * si;
                    v[0][n] = (fq == 0) ? r0 : (fq == 1) ? r1 : v[0][n];
                }
                bf16_t* rowp = dst + (size_t)row * ld + col0 + wc * 64 + 8 * fq;
#pragma unroll
                for (int bj = 0; bj < 2; ++bj) { u32x4 w; w.x = cvtpk(v[bj][0][0], v[bj][0][1]); w.y = cvtpk(v[bj][0][2], v[bj][0][3]); w.z = cvtpk(v[bj][1][0], v[bj][1][1]); w.w = cvtpk(v[bj][1][2], v[bj][1][3]);
                    *(u32x4*)(rowp + 32 * bj) = w; }
            }
        }
    }
    __device__ __forceinline__ void operator()(const f32x4 (&acc)[2][2][4][2], const pg8::Unit& u, int wr, int wc, int fr, int fq) const {
        const int pn = u.pn, row0 = u.pm * 256;
        if (pn >= 26) { plain(acc, (bf16_t*)(ws + WS_MKV), 1024, (pn - 26) * 256, row0 - T_, wr, wc, fr, fq); return; }
        if (pn >= 14) { EpiG eg{ws + WS_G, lds}; pg8::Unit ug{u.pm, pn - 14}; eg(acc, ug, wr, wc, fr, fq); return; }
        if (pn >= 12) { plain(acc, (bf16_t*)(ws + WS_MQ), 512, (pn - 12) * 256, row0, wr, wc, fr, fq); return; }
        if (pn == 11) {
            if (wc >= 2) plain(acc, (bf16_t*)(ws + WS_KVB), 256, 0, row0, wr, wc, fr, fq);
            else normed(acc, (bf16_t*)(ws + WS_KVB), 256, 0, row0, 1.0f, wr, wc, fr, fq);
            return;
        }
        if (pn >= 9) { normed(acc, (bf16_t*)(ws + WS_QB), 512, (pn - 9) * 256, row0, QSCALE64, wr, wc, fr, fq); return; }
        const int gi = pn / 3, ty = pn - 3 * gi;
        if (ty == 2) { plain(acc, (bf16_t*)(ws + WS_VA) + (size_t)gi * T_ * 256, 256, 0, row0, wr, wc, fr, fq); return; }
        if (ty == 0) normed(acc, (bf16_t*)(ws + WS_QA) + (size_t)gi * T_ * 256, 256, 0, row0, QSCALE64, wr, wc, fr, fq);
        else normed(acc, (bf16_t*)(ws + WS_KA) + (size_t)gi * T_ * 256, 256, 0, row0, 1.0f, wr, wc, fr, fq);
    }
};

namespace att {
typedef short v4i16_t __attribute__((ext_vector_type(4)));
__device__ __forceinline__ int crow(int r, int h) { return (r & 3) + 8 * (r >> 2) + 4 * h; }
__device__ __forceinline__ s16x4 vtr(LAS const unsigned char* p) { return __builtin_bit_cast(s16x4, __builtin_amdgcn_ds_read_tr16_b64_v4i16((LAS v4i16_t*)p)); }

constexpr int KROW64 = 144, VROW64 = 128, NKEYS_B = 384;
constexpr int LDS_K64 = 0, LDS_V64 = NKEYS_B * KROW64;
constexpr int LDS_K128 = 0, LDS_V128 = 65536;

constexpr float SM_THR = 20.0f;
template <int NT, int ND>
__device__ __forceinline__ void softmax_step(f32x16 (&s)[NT], float& mref, float& l, f32x16 (&o)[ND], bf16x8 (&pf)[NT][2]) {
    if (__any(mref != 0.f)) {
#pragma unroll
        for (int t = 0; t < NT; ++t)
#pragma unroll
            for (int r = 0; r < 16; ++r) s[t][r] -= mref;
    }
    float mx = s[0][0];
#pragma unroll
    for (int t = 0; t < NT; ++t)
#pragma unroll
        for (int r = 0; r < 16; ++r) mx = fmaxf(mx, s[t][r]);
    mx = fmaxf(mx, __shfl_xor(mx, 32));
    if (__any(mx > SM_THR)) {
        const float dl = fmaxf(mx, 0.f); mref += dl;
#pragma unroll
        for (int t = 0; t < NT; ++t)
#pragma unroll
            for (int r = 0; r < 16; ++r) s[t][r] -= dl;
        const float f = __builtin_amdgcn_exp2f(-dl); l *= f;
#pragma unroll
        for (int d = 0; d < ND; ++d)
#pragma unroll
            for (int r = 0; r < 16; ++r) o[d][r] *= f;
    }
    float ps0 = 0.f, ps1 = 0.f;
#pragma unroll
    for (int t = 0; t < NT; ++t)
#pragma unroll
        for (int r = 0; r < 16; r += 2) { s[t][r] = __builtin_amdgcn_exp2f(s[t][r]); s[t][r + 1] = __builtin_amdgcn_exp2f(s[t][r + 1]); ps0 += s[t][r]; ps1 += s[t][r + 1]; }
    l += ps0 + ps1;
#pragma unroll
    for (int t = 0; t < NT; ++t)
#pragma unroll
        for (int k = 0; k < 2; ++k) { u32x4 w; w.x = cvtpk(s[t][8 * k + 0], s[t][8 * k + 1]); w.y = cvtpk(s[t][8 * k + 2], s[t][8 * k + 3]); w.z = cvtpk(s[t][8 * k + 4], s[t][8 * k + 5]); w.w = cvtpk(s[t][8 * k + 6], s[t][8 * k + 7]);
            pf[t][k] = __builtin_bit_cast(bf16x8, w); }
}

struct BU { const bf16_t* q; const bf16_t* k; const bf16_t* v; bf16_t* o; float* lse; int qstride, kvstride, ostride, lsestride; float sink2; int W; int first; };
__device__ __forceinline__ void bu_load(const BU& u, int tid, u32x4 (&kr)[6], u32x4 (&vr)[6]) {
#pragma unroll
    for (int it = 0; it < 6; ++it) {
        const int c = tid + 512 * it, row = c >> 3, ch = c & 7;
        const bool valid = !(u.first && row < 128);
        const long off = (long)((valid ? row : 128) - 128) * (long)u.kvstride + ch * 8;
        kr[it] = *(const u32x4*)(u.k + off); vr[it] = *(const u32x4*)(u.v + off);
    }
}
__device__ __forceinline__ void bu_store(LAS unsigned char* lds, int tid, const u32x4 (&kr)[6], const u32x4 (&vr)[6], int first) {
#pragma unroll
    for (int it = 0; it < 6; ++it) {
        const int c = tid + 512 * it, row = c >> 3, ch = c & 7;
        const bool valid = !(first && row < 128);
        const u32x4 z = (u32x4){0u, 0u, 0u, 0u};
        *(LAS u32x4*)(lds + LDS_K64 + row * KROW64 + ch * 16) = valid ? kr[it] : z;
        *(LAS u32x4*)(lds + LDS_V64 + row * VROW64 + ((ch * 16) ^ (((row >> 1) & 1) << 6))) = valid ? vr[it] : z;
    }
}
__device__ __forceinline__ void bu_loadq(const BU& u, int wid, int lane, bf16x8 (&qf)[4]) {
    const int qi = 32 * wid + (lane & 31), h = lane >> 5;
#pragma unroll
    for (int d0 = 0; d0 < 4; ++d0) qf[d0] = *(const bf16x8*)(u.q + (size_t)qi * u.qstride + 16 * d0 + 8 * h);
}
template <int NT>
__device__ __forceinline__ void bu_step(LAS const unsigned char* kbase, LAS const unsigned char* vbase, int vsw, int kt0, int mask, int jlo, int jhi, int h, const bf16x8 (&qf)[4],
                                        float& mref, float& l, f32x16 (&o)[2]) {
    f32x16 s[NT];
#pragma unroll
    for (int d0 = 0; d0 < 4; ++d0)
#pragma unroll
        for (int t = 0; t < NT; ++t) { const bf16x8 kf = *(LAS const bf16x8*)(kbase + (kt0 + t) * 32 * KROW64 + d0 * 32); if (d0 == 0) { for (int r = 0; r < 16; ++r) s[t][r] = 0.f; } s[t] = __builtin_amdgcn_mfma_f32_32x32x16_bf16(kf, qf[d0], s[t], 0, 0, 0); }
    if (mask == 1) {
        const int L = jlo - 32 * kt0 - 4 * h;
#pragma unroll
        for (int r = 0; r < 16; ++r) { if (((r & 3) + 8 * (r >> 2)) < L) s[0][r] = -INFINITY; }
    } else if (mask == 2) {
        const int H = jhi - 32 * kt0 - 4 * h;
#pragma unroll
        for (int r = 0; r < 16; ++r) { if (((r & 3) + 8 * (r >> 2)) > H) s[0][r] = -INFINITY; }
    } else if (mask == 3) {
#pragma unroll
        for (int t = 0; t < NT; ++t) { const int L = jlo - 32 * (kt0 + t) - 4 * h; const unsigned span = (unsigned)(jhi - jlo);
#pragma unroll
            for (int r = 0; r < 16; ++r) { if ((unsigned)(((r & 3) + 8 * (r >> 2)) - L) > span) s[t][r] = -INFINITY; } }
    }
    bf16x8 pf[NT][2];
    softmax_step<NT, 2>(s, mref, l, o, pf);
#pragma unroll
    for (int t = 0; t < NT; ++t)
#pragma unroll
        for (int k = 0; k < 2; ++k)
#pragma unroll
            for (int d = 0; d < 2; ++d) {
                LAS const unsigned char* vp = vbase + ((kt0 + t) * 32 + 16 * k) * VROW64 + 64 * (d ^ vsw);
                const s16x4 lo = vtr(vp), hi = vtr(vp + 8 * VROW64);
                const bf16x8 vf = (bf16x8){lo[0], lo[1], lo[2], lo[3], hi[0], hi[1], hi[2], hi[3]};
                o[d] = __builtin_amdgcn_mfma_f32_32x32x16_bf16(vf, pf[t][k], o[d], 0, 0, 0);
            }
}
__device__ __forceinline__ void bu_compute(LAS unsigned char* lds, const BU& u, const bf16x8 (&qf)[4], int wid, int lane) {
    const int c = lane & 31, h = lane >> 5;
    const int qi = 32 * wid + c;
    float mref = 0.f, l = 0.f; f32x16 o[2];
#pragma unroll
    for (int r = 0; r < 16; ++r) { o[0][r] = 0.f; o[1][r] = 0.f; }
    int jlo = qi + 128 - u.W; if (u.first && jlo < 128) jlo = 128;
    const int jhi = qi + 128;
    const int qq = (lane & 15) >> 2;
    LAS const unsigned char* kbase = lds + LDS_K64 + c * KROW64 + 16 * h;
    LAS const unsigned char* vbase = lds + LDS_V64 + (4 * h + qq) * VROW64 + ((lane >> 4) & 1) * 32 + (lane & 3) * 8;
    const int vsw = (qq >> 1) & 1;
#pragma unroll 1
    for (int st = 0; st < 2; ++st) bu_step<2>(kbase, vbase, vsw, wid + 2 * st, u.first ? 3 : (st == 0 ? 1 : 0), jlo, jhi, h, qf, mref, l, o);
    bu_step<1>(kbase, vbase, vsw, wid + 4, u.first ? 3 : 2, jlo, jhi, h, qf, mref, l, o);
    float lt = l + __shfl_xor(l, 32);
    lt += __builtin_amdgcn_exp2f(u.sink2 - mref);
    const float inv = 1.0f / lt;
    bf16_t* orow = u.o + (size_t)qi * u.ostride;
#pragma unroll
    for (int d = 0; d < 2; ++d)
#pragma unroll
        for (int rg = 0; rg < 4; ++rg) { u32x2 w; w.x = cvtpk(o[d][4 * rg] * inv, o[d][4 * rg + 1] * inv); w.y = cvtpk(o[d][4 * rg + 2] * inv, o[d][4 * rg + 3] * inv);
            *(u32x2*)(orow + 32 * d + 8 * rg + 4 * h) = w; }
    if (u.lse && h == 0) u.lse[(size_t)qi * u.lsestride] = mref + __builtin_amdgcn_logf(lt);
}

__device__ __forceinline__ void mem_load(const bf16_t* kmem, const bf16_t* vmem, int tid, u32x4 (&kr)[8], u32x4 (&vr)[8]) {
#pragma unroll
    for (int it = 0; it < 8; ++it) { const int cc = tid + 512 * it, row = cc >> 4, ch = cc & 15;
        kr[it] = *(const u32x4*)(kmem + (size_t)row * 1024 + ch * 8); vr[it] = *(const u32x4*)(vmem + (size_t)row * 1024 + ch * 8); }
}
__device__ __forceinline__ void mem_unit(LAS unsigned char* lds, const u32x4 (&qraw)[8], const u32x4 (&kr)[8], const u32x4 (&vr)[8], LAS const unsigned char* gl, bf16_t* o0, size_t ostride, int tid, int wid, int lane) {
#pragma unroll
    for (int it = 0; it < 8; ++it) {
        const int cc = tid + 512 * it, row = cc >> 4, ch = cc & 15;
        *(LAS u32x4*)(lds + LDS_K128 + row * 256 + ((ch ^ (row & 15)) * 16)) = kr[it];
        *(LAS u32x4*)(lds + LDS_V128 + row * 256 + ((ch * 16) ^ ((row & 3) << 6))) = vr[it];
    }
    const int c = lane & 31, h = lane >> 5;
    const int qi = 32 * wid + c;
    bf16x8 qf[8];
    {
        u32x4 raw[8]; float ss = 0.f;
#pragma unroll
        for (int d0 = 0; d0 < 8; ++d0) { raw[d0] = qraw[d0];
#pragma unroll
            for (int e = 0; e < 4; ++e) { const float a = bflo(raw[d0][e]), b = bfhi(raw[d0][e]); ss += a * a + b * b; } }
        ss += __shfl_xor(ss, 32);
        const float rs = (1.0f / sqrtf(ss * (1.f / 128.f) + EPS_)) * QSCALE128;
#pragma unroll
        for (int d0 = 0; d0 < 8; ++d0) { const f32x4 g0 = *(LAS const f32x4*)(gl + 4 * (16 * d0 + 8 * h)), g1 = *(LAS const f32x4*)(gl + 4 * (16 * d0 + 8 * h + 4));
            u32x4 w; w.x = cvtpk(bflo(raw[d0].x) * rs * g0[0], bfhi(raw[d0].x) * rs * g0[1]); w.y = cvtpk(bflo(raw[d0].y) * rs * g0[2], bfhi(raw[d0].y) * rs * g0[3]);
            w.z = cvtpk(bflo(raw[d0].z) * rs * g1[0], bfhi(raw[d0].z) * rs * g1[1]); w.w = cvtpk(bflo(raw[d0].w) * rs * g1[2], bfhi(raw[d0].w) * rs * g1[3]);
            qf[d0] = __builtin_bit_cast(bf16x8, w); }
    }
    __syncthreads();
    {
        const int row = tid >> 1, hf = tid & 1; u32x4 raw[8]; float ss = 0.f;
#pragma unroll
        for (int i = 0; i < 8; ++i) { raw[i] = *(LAS const u32x4*)(lds + LDS_K128 + row * 256 + (((hf * 8 + i) ^ (row & 15)) * 16));
#pragma unroll
            for (int e = 0; e < 4; ++e) { const float a = bflo(raw[i][e]), b = bfhi(raw[i][e]); ss += a * a + b * b; } }
        ss += __shfl_xor(ss, 1);
        const float rs = 1.0f / sqrtf(ss * (1.f / 128.f) + EPS_);
#pragma unroll
        for (int i = 0; i < 8; ++i) { LAS const unsigned char* gp = gl + 512 + 4 * (64 * hf + 8 * i); const f32x4 g0 = *(LAS const f32x4*)gp, g1 = *(LAS const f32x4*)(gp + 16);
            u32x4 w; w.x = cvtpk(bflo(raw[i].x) * rs * g0[0], bfhi(raw[i].x) * rs * g0[1]); w.y = cvtpk(bflo(raw[i].y) * rs * g0[2], bfhi(raw[i].y) * rs * g0[3]);
            w.z = cvtpk(bflo(raw[i].z) * rs * g1[0], bfhi(raw[i].z) * rs * g1[1]); w.w = cvtpk(bflo(raw[i].w) * rs * g1[2], bfhi(raw[i].w) * rs * g1[3]);
            *(LAS u32x4*)(lds + LDS_K128 + row * 256 + (((hf * 8 + i) ^ (row & 15)) * 16)) = w; }
    }
    __syncthreads();
    float mref = 0.f, l = 0.f; f32x16 o[4];
#pragma unroll
    for (int r = 0; r < 16; ++r) {
#pragma unroll
        for (int d = 0; d < 4; ++d) o[d][r] = 0.f; }
    const int qq = (lane & 15) >> 2;
    LAS const unsigned char* vbase = lds + LDS_V128 + (4 * h + qq) * 256 + ((lane >> 4) & 1) * 32 + (lane & 3) * 8;
#pragma unroll 1
    for (int kt = 0; kt < 8; kt += 2) {
        f32x16 s[2];
#pragma unroll
        for (int d0 = 0; d0 < 8; ++d0)
#pragma unroll
            for (int t = 0; t < 2; ++t) { const int krow = (kt + t) * 32 + c;
                const bf16x8 kf = *(LAS const bf16x8*)(lds + LDS_K128 + krow * 256 + (((2 * d0 + h) ^ (krow & 15)) * 16)); if (d0 == 0) { for (int r = 0; r < 16; ++r) s[t][r] = 0.f; } s[t] = __builtin_amdgcn_mfma_f32_32x32x16_bf16(kf, qf[d0], s[t], 0, 0, 0); }
        bf16x8 pf[2][2];
        softmax_step<2, 4>(s, mref, l, o, pf);
#pragma unroll
        for (int t = 0; t < 2; ++t)
#pragma unroll
            for (int k = 0; k < 2; ++k)
#pragma unroll
                for (int d = 0; d < 4; ++d) {
                    LAS const unsigned char* vp = vbase + ((kt + t) * 32 + 16 * k) * 256 + 64 * (d ^ qq);
                    const s16x4 lo = vtr(vp), hi = vtr(vp + 8 * 256);
                    const bf16x8 vf = (bf16x8){lo[0], lo[1], lo[2], lo[3], hi[0], hi[1], hi[2], hi[3]};
                    o[d] = __builtin_amdgcn_mfma_f32_32x32x16_bf16(vf, pf[t][k], o[d], 0, 0, 0);
                }
    }
    const float inv = 1.0f / (l + __shfl_xor(l, 32));
    bf16_t* orow = o0 + (size_t)qi * ostride;
#pragma unroll
    for (int d = 0; d < 4; ++d)
#pragma unroll
        for (int rg = 0; rg < 4; ++rg) { u32x2 w; w.x = cvtpk(o[d][4 * rg] * inv, o[d][4 * rg + 1] * inv); w.y = cvtpk(o[d][4 * rg + 2] * inv, o[d][4 * rg + 3] * inv);
            *(u32x2*)(orow + 32 * d + 8 * rg + 4 * h) = w; }
    __syncthreads();
}
}

__device__ __forceinline__ att::BU get_bu(const Args& A, int vcu, int idx) {
    unsigned char* ws = A.ws; att::BU u;
    if (idx < 3) {
        const int gi = idx, b = vcu >> 6, hd = (vcu >> 4) & 3, i16 = vcu & 15;
        const int dl = (gi == 0) ? 1 : (gi == 1) ? 4 : 16;
        int r, qb; if (gi == 0) { r = 0; qb = i16; } else if (gi == 1) { r = i16 >> 2; qb = i16 & 3; } else { r = i16; qb = 0; }
        const int i0 = qb * 256;
        const size_t row0 = (size_t)b * SEQ_ + r + (size_t)dl * i0;
        const size_t base = (size_t)gi * T_ * 256 + row0 * 256 + hd * 64;
        u.q = (const bf16_t*)(ws + WS_QA) + base; u.k = (const bf16_t*)(ws + WS_KA) + base; u.v = (const bf16_t*)(ws + WS_VA) + base;
        u.o = (bf16_t*)((unsigned char*)A.out + DO_OAG) + base;
        u.lse = (float*)(ws + WS_LSE) + (size_t)gi * T_ * 4 + row0 * 4 + hd;
        u.qstride = dl * 256; u.kvstride = dl * 256; u.ostride = dl * 256; u.lsestride = dl * 4; u.sink2 = -INFINITY; u.W = 128; u.first = (i0 == 0);
    } else {
        const int uu = vcu + 256 * (idx - 3), b = uu >> 7, hq = (uu >> 4) & 7, qb = uu & 15, kvh = hq >> 2;
        const size_t row0 = (size_t)b * SEQ_ + (size_t)qb * 256;
        u.q = (const bf16_t*)(ws + WS_QB) + row0 * 512 + hq * 64;
        u.k = (const bf16_t*)(ws + WS_KVB) + row0 * 256 + kvh * 64; u.v = u.k + 128;
        u.o = (bf16_t*)((unsigned char*)A.out + DO_OCAT) + row0 * KCAT + 256 + hq * 64;
        u.lse = nullptr; u.qstride = 512; u.kvstride = 256; u.ostride = KCAT; u.lsestride = 0; u.sink2 = A.in[I_SINK][hq] * LOG2E; u.W = 127; u.first = (qb == 0);
    }
    return u;
}
__device__ __forceinline__ void p2_attention(const Args& A, LAS unsigned char* lds, int vcu, int tid, int wid, int lane) {
    unsigned char* ws = A.ws;
    const int mu = vcu, mb = mu >> 6, mhd = (mu >> 4) & 3, mqb = mu & 15;
    const bf16_t* km = (const bf16_t*)(ws + WS_MKV) + (size_t)mb * MEM_ * 1024 + mhd * 128;
    const size_t mrow0 = (size_t)mb * SEQ_ + (size_t)mqb * 256;
    const bf16_t* mq = (const bf16_t*)(ws + WS_MQ) + mrow0 * 512 + mhd * 128;
    LAS unsigned char* gl = lds + 131072;
    { const float* const pq = A.in[I_MQN]; const float* const pk = A.in[I_MKN];
      if (tid < 64) { const f32x4 gv = ((const f32x4*)(tid < 32 ? pq : pk))[tid & 31]; *(LAS f32x4*)(gl + 16 * tid) = gv; } }
    u32x4 mkr[8], mvr[8], mqr[8];
    {
        u32x4 kr[6], vr[6];
        { const att::BU u0 = get_bu(A, vcu, 0); att::bu_load(u0, tid, kr, vr); }
#pragma unroll 1
        for (int idx = 0; idx < 4; ++idx) {
            const att::BU u = get_bu(A, vcu, idx);
            att::bu_store(lds, tid, kr, vr, u.first);
            bf16x8 qf[4]; att::bu_loadq(u, wid, lane, qf);
            __syncthreads();
            { const att::BU un = get_bu(A, vcu, idx + 1); att::bu_load(un, tid, kr, vr); }
            att::bu_compute(lds, u, qf, wid, lane);
            asm volatile("" ::: "memory");
            __syncthreads();
        }
        {
            const att::BU u = get_bu(A, vcu, 4);
            att::bu_store(lds, tid, kr, vr, u.first);
            bf16x8 qf[4]; att::bu_loadq(u, wid, lane, qf);
            __syncthreads();
            att::mem_load(km, km + 512, tid, mkr, mvr);
            { const int qi = 32 * wid + (lane & 31), h = lane >> 5;
#pragma unroll
              for (int d0 = 0; d0 < 8; ++d0) mqr[d0] = *(const u32x4*)(mq + (size_t)qi * 512 + 16 * d0 + 8 * h); }
            att::bu_compute(lds, u, qf, wid, lane);
            asm volatile("" ::: "memory");
            __syncthreads();
        }
    }
    {
        bf16_t* o = (bf16_t*)((unsigned char*)A.out + DO_OCAT) + mrow0 * KCAT + 768 + mhd * 128;
        att::mem_unit(lds, mqr, mkr, mvr, gl, o, KCAT, tid, wid, lane);
    }
}

__device__ __forceinline__ void p2b_merge(const Args& A, int vcu, int G, int tid) {
    const bf16_t* oag = (const bf16_t*)((unsigned char*)A.out + DO_OAG);
    bf16_t* ocat = (bf16_t*)((unsigned char*)A.out + DO_OCAT);
    const float* lse = (const float*)(A.ws + WS_LSE);
    for (int idx = vcu * 512 + tid; idx < T_ * 32; idx += G * 512) {
        const int t = idx >> 5, ch = idx & 31, hd = ch >> 3;
        const float l0 = lse[(size_t)t * 4 + hd], l1 = lse[(size_t)T_ * 4 + (size_t)t * 4 + hd], l2 = lse[(size_t)2 * T_ * 4 + (size_t)t * 4 + hd];
        const float mx = fmaxf(l0, fmaxf(l1, l2));
        float w0 = __builtin_amdgcn_exp2f(l0 - mx), w1 = __builtin_amdgcn_exp2f(l1 - mx), w2 = __builtin_amdgcn_exp2f(l2 - mx);
        const float inv = 1.0f / (w0 + w1 + w2); w0 *= inv; w1 *= inv; w2 *= inv;
        const u32x4 a = *(const u32x4*)(oag + (size_t)t * 256 + ch * 8), b = *(const u32x4*)(oag + (size_t)T_ * 256 + (size_t)t * 256 + ch * 8), c = *(const u32x4*)(oag + (size_t)2 * T_ * 256 + (size_t)t * 256 + ch * 8);
        u32x4 w;
#pragma unroll
        for (int e = 0; e < 4; ++e) w[e] = cvtpk(w0 * bflo(a[e]) + w1 * bflo(b[e]) + w2 * bflo(c[e]), w0 * bfhi(a[e]) + w1 * bfhi(b[e]) + w2 * bfhi(c[e]));
        *(u32x4*)(ocat + (size_t)t * KCAT + ch * 8) = w;
    }
}

struct P3aOrder : pg8::StaticOrder {
    const bf16_t* oag; bf16_t* ocat; const float* lse;
    __device__ __forceinline__ void a_ready(const pg8::Unit& u) const {
#pragma unroll 1
        for (int i0 = threadIdx.x; i0 < 256 * 32; i0 += 2 * 512) {
            u32x4 a[2], b[2], c[2]; float l0[2], l1[2], l2[2];
#pragma unroll
            for (int j = 0; j < 2; ++j) { const int idx = i0 + 512 * j, t = u.pm * 256 + (idx >> 5), ch = idx & 31, hd = ch >> 3;
                l0[j] = lse[(size_t)t * 4 + hd]; l1[j] = lse[(size_t)T_ * 4 + (size_t)t * 4 + hd]; l2[j] = lse[(size_t)2 * T_ * 4 + (size_t)t * 4 + hd];
                a[j] = *(const u32x4*)(oag + (size_t)t * 256 + ch * 8); b[j] = *(const u32x4*)(oag + (size_t)T_ * 256 + (size_t)t * 256 + ch * 8); c[j] = *(const u32x4*)(oag + (size_t)2 * T_ * 256 + (size_t)t * 256 + ch * 8); }
#pragma unroll
            for (int j = 0; j < 2; ++j) { const int idx = i0 + 512 * j, t = u.pm * 256 + (idx >> 5), ch = idx & 31;
                const float mx = fmaxf(l0[j], fmaxf(l1[j], l2[j]));
                float w0 = __builtin_amdgcn_exp2f(l0[j] - mx), w1 = __builtin_amdgcn_exp2f(l1[j] - mx), w2 = __builtin_amdgcn_exp2f(l2[j] - mx);
                const float inv = 1.0f / (w0 + w1 + w2); w0 *= inv; w1 *= inv; w2 *= inv;
                u32x4 w;
#pragma unroll
                for (int e = 0; e < 4; ++e) w[e] = cvtpk(w0 * bflo(a[j][e]) + w1 * bflo(b[j][e]) + w2 * bflo(c[j][e]), w0 * bfhi(a[j][e]) + w1 * bfhi(b[j][e]) + w2 * bfhi(c[j][e]));
                *(u32x4*)(ocat + (size_t)t * KCAT + ch * 8) = w; }
        }
        asm volatile("s_waitcnt vmcnt(0)" ::: "memory"); __builtin_amdgcn_s_barrier(); asm volatile("" ::: "memory");
    }
};

__device__ __forceinline__ float ub(unsigned w, int i) { return (float)((w >> (8 * i)) & 0xffu); }
struct Epi3a {
    static constexpr bool PERM = true;
    const unsigned char* G; bf16_t* MERGED;
    bool skip = false;
    __device__ __forceinline__ void khook(f32x4 (&acc)[2][2][4][2], const pg8::Unit& u, int t, int wr, int wc, int fr, int fq) const {
        if (t != 4 && t != 12) return;
        const int gsel = (t == 4) ? 0 : 1024;
#pragma unroll
        for (int ai = 0; ai < 2; ++ai) {
            u32x2 ga[4][2], gb[4][2];
#pragma unroll
            for (int m = 0; m < 4; ++m) { const unsigned char* gp = G + (size_t)(u.pm * 256 + ai * 128 + wr * 64 + m * 16 + fr) * 3072 + gsel + u.pn * 256 + wc * 64 + 8 * fq;
#pragma unroll
                for (int bj = 0; bj < 2; ++bj) { ga[m][bj] = *(const u32x2*)(gp + 32 * bj); gb[m][bj] = *(const u32x2*)(gp + 1024 + 32 * bj); } }
            asm volatile("" ::: "memory");
#pragma unroll
            for (int m = 0; m < 4; ++m)
#pragma unroll
                for (int bj = 0; bj < 2; ++bj)
#pragma unroll
                    for (int n = 0; n < 2; ++n)
#pragma unroll
                        for (int e = 0; e < 4; ++e) acc[ai][bj][m][n][e] *= ub(ga[m][bj][n], e) * __builtin_amdgcn_rcpf(ub(gb[m][bj][n], e));
        }
    }
    __device__ __forceinline__ void operator()(const f32x4 (&acc)[2][2][4][2], const pg8::Unit& u, int wr, int wc, int fr, int fq) const {
        const int col = u.pn * 256 + wc * 64 + 8 * fq;
        u32x2 g2[2][4][2];
#pragma unroll
        for (int ai = 0; ai < 2; ++ai)
#pragma unroll
            for (int m = 0; m < 4; ++m) { const size_t row = (size_t)(u.pm * 256 + ai * 128 + wr * 64 + m * 16 + fr);
#pragma unroll
                for (int bj = 0; bj < 2; ++bj) g2[ai][m][bj] = *(const u32x2*)(G + row * 3072 + 2048 + col + 32 * bj); }
        asm volatile("" ::: "memory");
        const float k = 1.0f / 255.0f;
#pragma unroll
        for (int ai = 0; ai < 2; ++ai)
#pragma unroll
            for (int m = 0; m < 4; ++m) { const size_t row = (size_t)(u.pm * 256 + ai * 128 + wr * 64 + m * 16 + fr);
#pragma unroll
                for (int bj = 0; bj < 2; ++bj) { const u32x2 g = g2[ai][m][bj]; const f32x4 v0 = acc[ai][bj][m][0] * k, v1 = acc[ai][bj][m][1] * k;
                    u32x4 w; w.x = cvtpk(v0[0] * ub(g.x, 0), v0[1] * ub(g.x, 1)); w.y = cvtpk(v0[2] * ub(g.x, 2), v0[3] * ub(g.x, 3)); w.z = cvtpk(v1[0] * ub(g.y, 0), v1[1] * ub(g.y, 1)); w.w = cvtpk(v1[2] * ub(g.y, 2), v1[3] * ub(g.y, 3));
                    *(u32x4*)(MERGED + row * 1024 + col + 32 * bj) = w; } }
    }
};

struct Epi3b {
    static constexpr bool PERM = true;
    const float* x; bf16_t* X1L; bf16_t* X1B; float* SSQ;
    bool skip = false;
    __device__ __forceinline__ void operator()(const f32x4 (&acc)[2][2][4][2], const pg8::Unit& u, int wr, int wc, int fr, int fq) const {
        const int col = u.pn * 256 + wc * 64 + 8 * fq;
#pragma unroll
        for (int ai = 0; ai < 2; ++ai) {
            f32x4 xv[4][2][2];
#pragma unroll
            for (int m = 0; m < 4; ++m) { const size_t row = (size_t)(u.pm * 256 + ai * 128 + wr * 64 + m * 16 + fr);
#pragma unroll
                for (int bj = 0; bj < 2; ++bj) { const size_t off = row * 1024 + col + 32 * bj; xv[m][bj][0] = *(const f32x4*)(x + off); xv[m][bj][1] = *(const f32x4*)(x + off + 4); } }
            asm volatile("" ::: "memory");
#pragma unroll
            for (int m = 0; m < 4; ++m) { const size_t row = (size_t)(u.pm * 256 + ai * 128 + wr * 64 + m * 16 + fr); float ss = 0.f;
#pragma unroll
                for (int bj = 0; bj < 2; ++bj) { const size_t off = row * 1024 + col + 32 * bj;
                    const f32x4 o0 = xv[m][bj][0] + acc[ai][bj][m][0], o1 = xv[m][bj][1] + acc[ai][bj][m][1];
                    ss += (o0[0] * o0[0] + o0[1] * o0[1]) + (o0[2] * o0[2] + o0[3] * o0[3]) + (o1[0] * o1[0] + o1[1] * o1[1]) + (o1[2] * o1[2] + o1[3] * o1[3]);
                    u32x4 w; w.x = cvtpk(o0[0], o0[1]); w.y = cvtpk(o0[2], o0[3]); w.z = cvtpk(o1[0], o1[1]); w.w = cvtpk(o1[2], o1[3]);
                    *(u32x4*)(X1B + off) = w; }
                ss += xor16(ss); ss = sum_halves(ss);
                if (fq == 0) SSQ[row * 16 + u.pn * 4 + wc] = ss; }
            asm volatile("" ::: "memory");
        }
    }
};

struct Epi4 {
    static constexpr bool PERM = true;
    const float* convw; const float* convb; bf16_t* ACT; float* UE; float* UF; LAS float* xch; LAS const float* rtab; LAS const float* ctab;
    bool skip = false;
    __device__ __forceinline__ void operator()(f32x4 (&acc)[2][2][4][2], const pg8::Unit& u, int wr, int wc, int fr, int fq) const {
        const int lane = fr + 16 * fq;
        const int rowbase = u.pm * 256 + 128 * wr + 8 * fr;
        const int jj = 32 * wc + 8 * fq;
        const bool bstart = (u.pm & 15) == 0;
        {
            LAS const float* tb = rtab + ((u.pm >> 3) & 1) * 256 + 128 * wr + 8 * fr;
            const f32x4 ra = *(LAS const f32x4*)tb, rb = *(LAS const f32x4*)(tb + 4);
#pragma unroll
            for (int i = 0; i < 8; ++i) { const float rs = (i < 4) ? ra[i & 3] : rb[i & 3];
#pragma unroll
                for (int bj = 0; bj < 2; ++bj)
#pragma unroll
                    for (int n = 0; n < 2; ++n) acc[i >> 2][bj][i & 3][n] *= rs; }
        }
#define U4(bj, n, i) acc[(i) >> 2][bj][(i) & 3][n]
        if (wr == 0 && fr == 0) {
#pragma unroll
            for (int i = 0; i < 2; ++i)
#pragma unroll
                for (int bj = 0; bj < 2; ++bj)
#pragma unroll
                    for (int n = 0; n < 2; ++n) *(f32x4*)(UF + (size_t)(u.pm * 2 + i) * 5632 + u.pn * 256 + 128 * bj + jj + 4 * n) = U4(bj, n, i);
        }
        if (wr == 1 && fr == 15) {
#pragma unroll
            for (int i = 0; i < 2; ++i)
#pragma unroll
                for (int bj = 0; bj < 2; ++bj)
#pragma unroll
                    for (int n = 0; n < 2; ++n) *(f32x4*)(UE + (size_t)(u.pm * 2 + i) * 5632 + u.pn * 256 + 128 * bj + jj + 4 * n) = U4(bj, n, 6 + i);
        }
        if (wr == 0 && fr == 15) {
#pragma unroll
            for (int i = 0; i < 2; ++i)
#pragma unroll
                for (int bj = 0; bj < 2; ++bj)
#pragma unroll
                    for (int n = 0; n < 2; ++n) *(LAS f32x4*)(xch + ((((wc * 2 + i) * 2 + bj) * 2 + n) * 4 + fq) * 4) = U4(bj, n, 6 + i);
        }
        asm volatile("s_waitcnt lgkmcnt(0)" ::: "memory"); __builtin_amdgcn_s_barrier(); asm volatile("" ::: "memory");
        const int src = (lane & 48) | ((fr - 1) & 15);
        const int cha = u.pn * 128 + jj;
#pragma unroll
        for (int n = 0; n < 2; ++n) {
            asm volatile("" ::: "memory"); __builtin_amdgcn_sched_barrier(0);
            f32x4 p6[2], p7[2], w0[2], w1[2], w2[2], cb[2];
#pragma unroll
            for (int bj = 0; bj < 2; ++bj) {
                f32x4 h6 = (f32x4){0.f, 0.f, 0.f, 0.f}, h7 = h6;
                if (wr == 1) { h6 = *(LAS const f32x4*)(xch + ((((wc * 2 + 0) * 2 + bj) * 2 + n) * 4 + fq) * 4); h7 = *(LAS const f32x4*)(xch + ((((wc * 2 + 1) * 2 + bj) * 2 + n) * 4 + fq) * 4); }
#pragma unroll
                for (int e = 0; e < 4; ++e) { const float a6 = __shfl(U4(bj, n, 6)[e], src), a7 = __shfl(U4(bj, n, 7)[e], src); p6[bj][e] = (fr == 0) ? h6[e] : a6; p7[bj][e] = (fr == 0) ? h7[e] : a7; }
                LAS const float* ct = ctab + u.par * 1024 + bj * 512 + jj + 4 * n;
                w0[bj] = *(LAS const f32x4*)ct; w1[bj] = *(LAS const f32x4*)(ct + 128); w2[bj] = *(LAS const f32x4*)(ct + 256); cb[bj] = *(LAS const f32x4*)(ct + 384);
            }
#pragma unroll
            for (int i = 0; i < 8; ++i) {
                f32x4 c[2];
#pragma unroll
                for (int bj = 0; bj < 2; ++bj) {
                    const f32x4 um1 = (i >= 1) ? U4(bj, n, i >= 1 ? i - 1 : 0) : p7[bj];
                    const f32x4 um2 = (i >= 2) ? U4(bj, n, i >= 2 ? i - 2 : 0) : ((i == 1) ? p7[bj] : p6[bj]);
                    c[bj] = cb[bj] + w2[bj] * U4(bj, n, i) + w1[bj] * um1 + w0[bj] * um2;
                }
                f32x4 a;
#pragma unroll
                for (int e = 0; e < 4; ++e) { const float z = c[0][e]; a[e] = z * __builtin_amdgcn_rcpf(1.0f + __builtin_amdgcn_exp2f(-z * LOG2E)) * c[1][e]; }
                u32x2 w; w.x = cvtpk(a[0], a[1]); w.y = cvtpk(a[2], a[3]);
                const bool skip = (wr == 0 && fr == 0 && i < 2 && !bstart);
                if (!skip) *(u32x2*)(ACT + (size_t)(rowbase + i) * DFF_ + cha + 4 * n) = w;
            }
        }
#undef U4
    }
};

struct P4Order : pg8::StaticOrder {
    const float* SSQ; LAS float* rtab; mutable int lastpm; const float* convw; const float* convb; LAS unsigned char* ctab;
    __device__ __forceinline__ void a_ready(const pg8::Unit& u) const {
        { int t = threadIdx.x; asm volatile("" : "+v"(t)); const int w = __builtin_amdgcn_readfirstlane(t >> 6);
          if (w < 4) { const int bj = t >> 7, tap = (t >> 5) & 3, c4 = t & 31; const float* src = (tap < 3 ? convw + tap * 5632 : convb) + bj * DFF_ + u.pn * 128 + 4 * c4;
              __builtin_amdgcn_global_load_lds((const unsigned*)src, (LAS unsigned*)(ctab + u.par * 4096 + w * 1024), 16, 0, 0); } }
        if (u.pm == lastpm) return;
        lastpm = u.pm;
        const int t = threadIdx.x;
        if (t < 256) {
            const float* sp = SSQ + (size_t)(u.pm * 256 + t) * 16;
            const f32x4 s0 = *(const f32x4*)sp, s1 = *(const f32x4*)(sp + 4), s2 = *(const f32x4*)(sp + 8), s3 = *(const f32x4*)(sp + 12);
            const float tot = ((s0[0] + s0[1]) + (s0[2] + s0[3])) + ((s1[0] + s1[1]) + (s1[2] + s1[3])) + ((s2[0] + s2[1]) + (s2[2] + s2[3])) + ((s3[0] + s3[1]) + (s3[2] + s3[3]));
            rtab[((u.pm >> 3) & 1) * 256 + t] = 1.0f / sqrtf(tot * (1.f / 1024.f) + EPS_);
        }
    }
};

struct Epi5 {
    static constexpr bool PERM = true;
    const bf16_t* X1B; const bf16_t* X1L; float* dst;
    bool skip = false;
    __device__ __forceinline__ void operator()(const f32x4 (&acc)[2][2][4][2], const pg8::Unit& u, int wr, int wc, int fr, int fq) const {
        const int col = u.pn * 256 + wc * 64 + 8 * fq;
#pragma unroll
        for (int ai = 0; ai < 2; ++ai) {
            u32x4 hv[4][2];
#pragma unroll
            for (int m = 0; m < 4; ++m) { const size_t row = (size_t)(u.pm * 256 + ai * 128 + wr * 64 + m * 16 + fr);
#pragma unroll
                for (int bj = 0; bj < 2; ++bj) { const size_t off = row * 1024 + col + 32 * bj; hv[m][bj] = *(const u32x4*)(X1B + off); } }
            asm volatile("" ::: "memory");
#pragma unroll
            for (int m = 0; m < 4; ++m) { const size_t row = (size_t)(u.pm * 256 + ai * 128 + wr * 64 + m * 16 + fr);
#pragma unroll
                for (int bj = 0; bj < 2; ++bj) { float* q = dst + row * 1024 + col + 32 * bj; const u32x4 h = hv[m][bj];
                    const f32x4 x0 = (f32x4){bflo(h.x), bfhi(h.x), bflo(h.y), bfhi(h.y)};
                    const f32x4 x1 = (f32x4){bflo(h.z), bfhi(h.z), bflo(h.w), bfhi(h.w)};
                    *(f32x4*)q = x0 + acc[ai][bj][m][0]; *(f32x4*)(q + 4) = x1 + acc[ai][bj][m][1]; } }
            asm volatile("" ::: "memory");
        }
    }
};
struct P5Order : pg8::StaticOrder {
    const float* UE; const float* UF; const float* convw; const float* convb; bf16_t* ACT;
    __device__ __forceinline__ void a_ready(const pg8::Unit& u) const {
        if ((u.pm & 15) != 0) {
            for (int ch = threadIdx.x; ch < DFF_; ch += 512) {
                const int pa = 256 * (ch >> 7) + (ch & 127), pg = pa + 128;
                const float* e = UE + (size_t)((u.pm - 1) * 2) * 5632; const float* f = UF + (size_t)(u.pm * 2) * 5632;
                float r[2];
#pragma unroll
                for (int i = 0; i < 2; ++i) {
                    float cc[2];
#pragma unroll
                    for (int s = 0; s < 2; ++s) { const int p = s ? pg : pa, cch = s * DFF_ + ch;
                        const float um2 = e[p], um1 = e[5632 + p], u0 = f[p], u1 = f[5632 + p];
                        const float w0 = convw[cch], w1 = convw[5632 + cch], w2 = convw[2 * 5632 + cch], b = convb[cch];
                        cc[s] = (i == 0) ? b + w0 * um2 + w1 * um1 + w2 * u0 : b + w0 * um1 + w1 * u0 + w2 * u1; }
                    r[i] = cc[0] * __builtin_amdgcn_rcpf(1.0f + __builtin_amdgcn_exp2f(-cc[0] * LOG2E)) * cc[1];
                }
                const unsigned w = cvtpk(r[0], r[1]);
                ACT[(size_t)(u.pm * 256) * DFF_ + ch] = (bf16_t)(w & 0xffffu); ACT[(size_t)(u.pm * 256 + 1) * DFF_ + ch] = (bf16_t)(w >> 16);
            }
        }
        asm volatile("s_waitcnt vmcnt(0)" ::: "memory"); __builtin_amdgcn_s_barrier(); asm volatile("" ::: "memory");
    }
};

__device__ __forceinline__ Args opaque_args() {
    Args a{};
#if defined(__HIP_DEVICE_COMPILE__)
    typedef const __attribute__((address_space(4))) Args* KArgsPtr;
    KArgsPtr p = (KArgsPtr)__builtin_amdgcn_kernarg_segment_ptr(); asm volatile("" : "+s"(p));
#pragma unroll
    for (int i = 0; i < 25; ++i) a.in[i] = p->in[i];
    a.out = p->out; a.ws = p->ws; a.ph_lo = p->ph_lo; a.ph_hi = p->ph_hi; a.li = p->li; a.pad = p->pad;
#endif
    return a;
}
__device__ __forceinline__ int opaque_tid() { int t = threadIdx.x; asm volatile("" : "+v"(t)); return t; }
__global__ void __launch_bounds__(NWAVES * 64, 2) fwd_kernel(Args args_by_value) {
    const Args args0 = opaque_args();
    extern __shared__ __attribute__((aligned(16))) unsigned char lds_raw[];
    LAS unsigned char* lds = (LAS unsigned char*)lds_raw;
    volatile LAS unsigned* MISC = (volatile LAS unsigned*)(lds + MISC_OFF);
    const int tid = threadIdx.x, lane = tid & 63, wave = __builtin_amdgcn_readfirstlane(tid >> 6);
    const int G = gridDim.x; const int bx = blockIdx.x; const int vcu = (G % 8 == 0) ? (bx % 8) * (G / 8) + bx / 8 : bx;
    unsigned char* ws = args0.ws;
    gu32* ctl = (gu32*)(ws + WS_CTL);
    for (int u = tid; u < (LDS_BYTES - LDSCTL_OFF) / 4; u += NWAVES * 64) ((LAS unsigned*)(lds + LDSCTL_OFF))[u] = 0u;
    __syncthreads();
    XcdBarrier bar; bar.bar = g_barrier_words + args0.li * XCD_BAR_WORDS; bar.nx = G < 8 ? (unsigned)G : 8u; bar.x = (unsigned)bx % bar.nx; bar.nloc = ((unsigned)G - bar.x + bar.nx - 1u) / bar.nx;
#ifdef PROBE_PH
    const unsigned long long tk0 = __builtin_amdgcn_s_memrealtime(); int nst = 0;
#define GRID_BAR() do { if (!MK_MULTI) xcd_barrier(bar); if (bx == 0 && tid == 0) { ((float*)(ws + WS_CTL + 768 * 1024))[nst] = (float)(__builtin_amdgcn_s_memrealtime() - tk0); } ++nst; } while (0)
#else
#define GRID_BAR() do { if (!MK_MULTI) xcd_barrier(bar); } while (0)
#endif
    const int lo = args0.ph_lo, hi = args0.ph_hi;
#ifndef PHASE_MASK
#define PHASE_MASK 0xff
#endif
#define IN(k) (((PHASE_MASK >> (k)) & 1) && lo <= (k) && (k) < hi)
#define BOTH(k) (IN(k) && IN((k) + 1))

    if (IN(0)) { const Args args = opaque_args(); const int t_ = opaque_tid(); p0_prologue(args, lds, vcu, G, __builtin_amdgcn_readfirstlane(t_ >> 6), t_ & 63); if (BOTH(0)) GRID_BAR(); }
#ifdef PROBE_BARS
    for (int xb = 0; xb < PROBE_BARS; ++xb) GRID_BAR();
#endif

    if (IN(1)) { const Args args = opaque_args();
        constexpr int NUB = 64 * 26 + 16;
        const unsigned* ropep = (const unsigned*)((unsigned char*)args.out + DO_ROPE);
        {
            pg8::Gemm g{(const bf16_t*)(ws + WS_A1I8), (const bf16_t*)((unsigned char*)args.out + DO_WI8), T_ + NB_ * MEM_, NCAT, 512 + args0.pad};
            TileOrder S; S.init(0x3FFFFFFu, 1, G, bx);
            Epi1 E{ws, ropep, args.in[I_AQ], args.in[I_AK], args.in[I_BQ], args.in[I_BK], args.in[I_BGATE], (const float*)(ws + WS_RSC), (const float*)(ws + WS_CMAX), lds};
            pg8::gemm_phase<Epi1, TileOrder, true, false, false, 2, true>(lds + RING_OFF, g, S, E);
            { const int nrem = NUB % G;
              const int t_ = opaque_tid(), w_ = __builtin_amdgcn_readfirstlane(t_ >> 6), l_ = t_ & 63;
              if (nrem == 0) p0_late_weights<0>(args, bx * NWAVES + w_, G * NWAVES, l_);
              else if (bx >= nrem) p0_late_weights<0>(args, (bx - nrem) * NWAVES + w_, (G - nrem) * NWAVES, l_); }
        }
        if (BOTH(1)) GRID_BAR();
    }

    if (IN(2)) { const Args args = opaque_args(); const int t_ = opaque_tid(); p2_attention(args, lds, vcu, t_, __builtin_amdgcn_readfirstlane(t_ >> 6), t_ & 63); if (BOTH(2)) GRID_BAR(); }


    if (IN(4)) { const Args args = opaque_args();
        pg8::Gemm g{(const bf16_t*)((unsigned char*)args.out + DO_OCAT), (const bf16_t*)(ws + WS_WO), T_, 1024, KCAT};
        P3aOrder S; S.init(T_, 1024, G, bx);
        S.oag = (const bf16_t*)((unsigned char*)args.out + DO_OAG); S.ocat = (bf16_t*)((unsigned char*)args.out + DO_OCAT); S.lse = (const float*)(ws + WS_LSE);
        Epi3a E{(const unsigned char*)(ws + WS_G), (bf16_t*)(ws + WS_MERGED)};
        pg8::gemm_phase<Epi3a, P3aOrder, false, false, true>(lds + RING_OFF, g, S, E);
        if (BOTH(4)) GRID_BAR();
    }

    if (IN(5)) { const Args args = opaque_args();
        pg8::Gemm g{(const bf16_t*)(ws + WS_MERGED), (const bf16_t*)(ws + WS_WOUT), T_, 1024, 1024};
        pg8::StaticOrder S; S.init(T_, 1024, G, bx);
        Epi3b E{args.in[I_X], (bf16_t*)(ws + WS_X1L), (bf16_t*)(ws + WS_X1B), (float*)(ws + WS_SSQ)};
        pg8::gemm_phase<Epi3b, pg8::StaticOrder, false, false, false>(lds + RING_OFF, g, S, E);
        if (BOTH(5)) GRID_BAR();
    }

    if (IN(6)) { const Args args = opaque_args();
        pg8::Gemm g{(const bf16_t*)(ws + WS_X1B), (const bf16_t*)(ws + WS_WUP), T_, 5632, 1024};
        P4Order S; S.init(T_, 5632, G, bx); S.SSQ = (const float*)(ws + WS_SSQ); S.rtab = (LAS float*)(lds + XCH_OFF + 2048); S.lastpm = -1; S.convw = args.in[I_CONVW]; S.convb = args.in[I_CONVB]; S.ctab = lds + CTAB_OFF;
        Epi4 E{args.in[I_CONVW], args.in[I_CONVB], (bf16_t*)(ws + WS_ACT), (float*)(ws + WS_UE), (float*)(ws + WS_UF), (LAS float*)(lds + XCH_OFF), (LAS const float*)(lds + XCH_OFF + 2048), (LAS const float*)(lds + CTAB_OFF)};
#ifdef PROBE_NOEPI
        E.skip = (args0.li == 1);
#endif
        pg8::gemm_phase<Epi4, P4Order, true, true, false>(lds + RING_OFF, g, S, E);
        { const int nrem = (64 * 22) % G;
          const int t_ = opaque_tid(), w_ = __builtin_amdgcn_readfirstlane(t_ >> 6), l_ = t_ & 63;
          if (nrem == 0) p0_late_weights<1>(args, bx * NWAVES + w_, G * NWAVES, l_);
          else if (bx >= nrem) p0_late_weights<1>(args, (bx - nrem) * NWAVES + w_, (G - nrem) * NWAVES, l_); }
        if (BOTH(6)) GRID_BAR();
    }

    if (IN(7)) { const Args args = opaque_args();
        pg8::Gemm g{(const bf16_t*)(ws + WS_ACT), (const bf16_t*)(ws + WS_WDOWN), T_, 1024, DFF_};
        P5Order S; S.init(T_, 1024, G, bx);
        S.UE = (const float*)(ws + WS_UE); S.UF = (const float*)(ws + WS_UF); S.convw = args.in[I_CONVW]; S.convb = args.in[I_CONVB]; S.ACT = (bf16_t*)(ws + WS_ACT);
        Epi5 E{(const bf16_t*)(ws + WS_X1B), (const bf16_t*)(ws + WS_X1L), args.out};
        pg8::gemm_phase<Epi5, P5Order, false, false, false>(lds + RING_OFF, g, S, E);
    }
#ifdef PROBE_PH
    if (IN(7) && bx == 0 && tid == 0) { asm volatile("s_waitcnt vmcnt(0)" ::: "memory"); float* st = (float*)(ws + WS_CTL + 768 * 1024); st[nst] = (float)(__builtin_amdgcn_s_memrealtime() - tk0);
        args.out[5] = 1000.0f * (1000.0f * floorf(st[PROBE_PH] / 1000.0f + 0.5f)); }
#endif
#ifdef PROBE_TS
    if (IN(7) && bx == 0 && tid == 0) { asm volatile("s_waitcnt vmcnt(0)" ::: "memory"); const float* dbg = (const float*)(ws + WS_CTL + 512 * 1024); args.out[5] = 1000.0f * (400.0f * floorf(dbg[PROBE_TS - 1] / 400.0f + 0.5f)); }
#endif
#undef IN
#undef BOTH
#undef GRID_BAR
}

extern "C" void kernel_launch(void* const* d_in, const int* in_sizes, int n_in, void* d_out, int out_size, void* d_ws, size_t ws_size, hipStream_t stream) {
    static int grid = 0;
    if (grid == 0) {
        if (n_in != 25 || out_size != T_ * DM_ || ws_size < WS_END) { fprintf(stderr, "kernel_launch: unexpected shapes (n_in %d, out %d, ws %zu); nothing launched\n", n_in, out_size, ws_size); grid = -1; return; }
        int dev = 0, cus = 0, per_cu = 0;
        if (hipGetDevice(&dev) != hipSuccess || hipDeviceGetAttribute(&cus, hipDeviceAttributeMultiprocessorCount, dev) != hipSuccess) { grid = -1; return; }
        if (hipFuncSetAttribute((const void*)fwd_kernel, hipFuncAttributeMaxDynamicSharedMemorySize, LDS_BYTES) != hipSuccess) { fprintf(stderr, "kernel_launch: hipFuncSetAttribute failed\n"); grid = -1; return; }
        if (hipOccupancyMaxActiveBlocksPerMultiprocessor(&per_cu, (const void*)fwd_kernel, NWAVES * 64, LDS_BYTES) != hipSuccess || per_cu < 1) { fprintf(stderr, "kernel_launch: occupancy query says %d blocks per CU\n", per_cu); }
        (void)hipGetLastError();
        grid = cus;
        if (grid != 256) fprintf(stderr, "kernel_launch: %d CUs (the phase schedules expect 256)\n", grid);
    }
    if (grid < 0) return;
    Args a{};
    for (int i = 0; i < 25; ++i) a.in[i] = (const float*)d_in[i];
    a.out = (float*)d_out; a.ws = (unsigned char*)d_ws;
#if MK_MULTI
    for (int p = 0; p < NPHASES; ++p) { a.ph_lo = p; a.ph_hi = p + 1; a.li = p; hipLaunchKernelGGL(fwd_kernel, dim3(grid), dim3(NWAVES * 64), LDS_BYTES, stream, a); }
#elif defined(PROBE_PHASE)
    a.ph_lo = 0; a.ph_hi = PROBE_PHASE + 1; a.li = 0;
    hipLaunchKernelGGL(fwd_kernel, dim3(grid), dim3(NWAVES * 64), LDS_BYTES, stream, a);
    a.ph_lo = PROBE_PHASE; a.ph_hi = NPHASES; a.li = 1;
    hipLaunchKernelGGL(fwd_kernel, dim3(grid), dim3(NWAVES * 64), LDS_BYTES, stream, a);
#else
    a.ph_lo = 0; a.ph_hi = NPHASES; a.li = 0;
    hipLaunchKernelGGL(fwd_kernel, dim3(grid), dim3(NWAVES * 64), LDS_BYTES, stream, a);
#endif
}
```

```cpp
#include <hip/hip_runtime.h>
#include <cstdio>
#include <cstdint>

#ifndef MK_MULTI
#define MK_MULTI 0
#endif
#define LAS __attribute__((address_space(3)))
#define GAS __attribute__((address_space(1)))
typedef unsigned short bf16_t;
typedef short bf16x8 __attribute__((ext_vector_type(8)));
typedef short s16x4 __attribute__((ext_vector_type(4)));
typedef float f32x4 __attribute__((ext_vector_type(4)));
typedef float f32x16 __attribute__((ext_vector_type(16)));
typedef unsigned u32x4 __attribute__((ext_vector_type(4)));
typedef unsigned u32x2 __attribute__((ext_vector_type(2)));
typedef int v4i32 __attribute__((ext_vector_type(4)));
typedef int v8i32 __attribute__((ext_vector_type(8)));

constexpr int T_ = 16384, SEQ_ = 4096, NB_ = 4, DM_ = 1024, MEM_ = 256, DFF_ = 2816;
constexpr int NCAT = 7680;
constexpr int KCAT = 1280;
constexpr float EPS_ = 1e-6f;
constexpr float LOG2E = 1.4426950408889634f;
constexpr float QSCALE64 = 0.125f * LOG2E;
constexpr float QSCALE128 = 0.08838834764831845f * LOG2E;

__device__ __forceinline__ unsigned cvtpk(float lo, float hi) {
    typedef float f2 __attribute__((ext_vector_type(2))); typedef __bf16 b2 __attribute__((ext_vector_type(2)));
    f2 v = {lo, hi}; b2 b = __builtin_convertvector(v, b2); return __builtin_bit_cast(unsigned, b);
}
__device__ __forceinline__ float xor16(float v) { return __int_as_float(__builtin_amdgcn_ds_swizzle(__float_as_int(v), 0x401F)); }
__device__ __forceinline__ float sum_halves(float v) { const auto rr = __builtin_amdgcn_permlane32_swap(__float_as_uint(v), __float_as_uint(v), false, false); return __uint_as_float(rr[0]) + __uint_as_float(rr[1]); }
__device__ __forceinline__ float bflo(unsigned w) { return __uint_as_float(w << 16); }
__device__ __forceinline__ float bfhi(unsigned w) { return __uint_as_float(w & 0xffff0000u); }

namespace pg8 {
constexpr int BM = 256, BK = 64, HALF = 128, HTB = HALF * BK * 2, STAGE_BYTES = 8 * HTB, NXCD = 8, WGM = 8;
__host__ __device__ __forceinline__ int lds_byte(int r, int c) { const int st = (r >> 4) * 2 + (c >> 5), rr = r & 15, cc = c & 31, ob = rr * 64 + cc * 2; return st * 1024 + (ob ^ (((ob >> 9) & 1) << 5)); }
__host__ __device__ __forceinline__ void stage_rc(int b, int& R, int& C) { const int st = b / 1024, sb = b % 1024, swz = sb ^ (((sb >> 9) & 1) << 5); R = (st >> 1) * 16 + swz / 64; C = (st & 1) * 32 + (swz % 64) / 2; }
__host__ __device__ __forceinline__ int perm32(int rho) { const int n = rho >> 4, i = rho & 15; return 8 * (i >> 2) + 4 * n + (i & 3); }

struct Unit { int pm, pn, par; };
struct Gemm { const bf16_t* A; const bf16_t* Bt; int M, N, K; };

struct StaticOrder {
    int nM, nN, nwg, G, c, wgm;
    __host__ __device__ void init(int M, int N, int G_, int c_, int wgm_ = WGM) { nM = M / BM; nN = N / BM; nwg = nM * nN; G = G_; c = c_; wgm = wgm_; }
    __host__ __device__ bool next(int i, Unit& u) const {
        const long L = (long)i * G + c; if (L >= nwg) return false;
        int wgid = (int)L; { const int q = nwg / NXCD, r = nwg % NXCD, xcd = wgid % NXCD, off = wgid / NXCD; wgid = (xcd < r ? xcd * (q + 1) : r * (q + 1) + (xcd - r) * q) + off; }
        const int nig = wgm * nN, gid = wgid / nig, fm = gid * wgm, gsz = (nM - fm) < wgm ? (nM - fm) : wgm;
        u.pm = fm + ((wgid % nig) % gsz); u.pn = (wgid % nig) / gsz; return true;
    }
    __device__ __forceinline__ void a_ready(const Unit&) const {}
    __device__ __forceinline__ void done(const Unit&) const {}
};

template <class Epi, class Sched, bool ALIGN_EPI, bool PERMA, bool KHOOK, int QM = 0, bool PREF = false>
__device__ __forceinline__ void gemm_phase(LAS unsigned char* lds, const Gemm g, const Sched& S, const Epi& E) {
    constexpr bool FP8 = (QM == 1), I8 = (QM == 2);
    int tid_ = threadIdx.x; asm volatile("" : "+v"(tid_));
    const int tid = tid_, wid = __builtin_amdgcn_readfirstlane(tid >> 6), lane = tid & 63, wr = wid >> 2, wc = wid & 3, fr = lane & 15, fq = lane >> 4;
    const int K = g.K, nt = K / BK;
    unsigned voffA0, voffA1, voffB;
    { int R, C; stage_rc(tid * 16, R, C); const int Rb = (R & ~31) + perm32(R & 31);
        if (PERMA) { const int rw = R >> 6, rm = (R >> 4) & 3, rf = R & 15; voffA0 = (unsigned)((128 * rw + 8 * rf + rm) * K + C) * 2u; voffA1 = (unsigned)((128 * rw + 8 * rf + 4 + rm) * K + C) * 2u; }
        else { voffA0 = (unsigned)(R * K + C) * 2u; voffA1 = voffA0; }
        voffB = (unsigned)(Rb * K + C) * 2u; }
    const size_t pstep_voffA0 = (size_t)(PERMA ? 128 : 64) * K * 2, pstep_voffA1 = pstep_voffA0, pstep_voffB = (size_t)64 * K * 2;
    const size_t kstep = (size_t)(BK * 2);
    const size_t hstep = (size_t)HALF * K * 2;
    const size_t ahs = PERMA ? (size_t)0 : hstep;
    const size_t tstep = 2 * hstep;
    const unsigned ldsw = (unsigned)wid * 1024u;
    const int aoff = lds_byte(wr * 64 + fr, fq * 8), boff = lds_byte(wc * 32 + fr, fq * 8);
#define PG8_SA(b, h) (((b) * 2 + (h)) * HTB)
#define PG8_SB(b, h) ((4 + (b) * 2 + (h)) * HTB)
#define PG8_STAGE(bufoff, gbase, voff) do { _Pragma("unroll") for (int _i = 0; _i < 2; ++_i) { unsigned _v = (voff); asm volatile("" : "+v"(_v));     \
        __builtin_amdgcn_global_load_lds((const unsigned*)((const char*)(gbase) + _i * PG8_PSTEP(voff) + _v), (LAS unsigned*)(lds + (bufoff) + ldsw + _i * 8192), 16, 0, 0); } } while (0)
#define PG8_PSTEP(voff) pstep_##voff
#define PG8_LD8(p) __builtin_shufflevector(*(const LAS v4i32*)(p), *(const LAS v4i32*)((p) + 1024), 0, 1, 2, 3, 4, 5, 6, 7)
#define PG8_LDA(dst, b, h) do { if constexpr (false) { _Pragma("unroll") for (int m = 0; m < 4; ++m) dst##8[m] = PG8_LD8(lds + PG8_SA(b, h) + aoff + m * 2048); } \
        else { _Pragma("unroll") for (int m = 0; m < 4; ++m) _Pragma("unroll") for (int k = 0; k < 2; ++k) dst[m][k] = *(const LAS bf16x8*)(lds + PG8_SA(b, h) + aoff + m * 2048 + k * 1024); } } while (0)
#define PG8_LDB(dst, b, h) do { if constexpr (false) { _Pragma("unroll") for (int n = 0; n < 2; ++n) dst##8[n] = PG8_LD8(lds + PG8_SB(b, h) + boff + n * 2048); } \
        else { _Pragma("unroll") for (int n = 0; n < 2; ++n) _Pragma("unroll") for (int k = 0; k < 2; ++k) dst[n][k] = *(const LAS bf16x8*)(lds + PG8_SB(b, h) + boff + n * 2048 + k * 1024); } } while (0)
#define PG8_CAT(x) __builtin_shufflevector(__builtin_bit_cast(v4i32, (x)[0]), __builtin_bit_cast(v4i32, (x)[1]), 0, 1, 2, 3, 4, 5, 6, 7)
#define PG8_MMA(ai, bj, At, Bt) do { if constexpr (FP8) __builtin_amdgcn_sched_barrier(0); __builtin_amdgcn_s_setprio(1); _Pragma("unroll") for (int m = 0; m < 4; ++m) _Pragma("unroll") for (int n = 0; n < 2; ++n) { \
        if constexpr (FP8) acc[ai][bj][m][n] = __builtin_amdgcn_mfma_scale_f32_16x16x128_f8f6f4(PG8_CAT(Bt[n]), PG8_CAT(At[m]), acc[ai][bj][m][n], 0, 0, 0, 0, 0, 0); \
        else if constexpr (I8) { _Pragma("unroll") for (int k = 0; k < 2; ++k) acc[ai][bj][m][n] = __builtin_bit_cast(f32x4, __builtin_amdgcn_mfma_i32_16x16x64_i8(__builtin_bit_cast(v4i32, Bt[n][k]), __builtin_bit_cast(v4i32, At[m][k]), __builtin_bit_cast(v4i32, acc[ai][bj][m][n]), 0, 0, 0)); } \
        else { _Pragma("unroll") for (int k = 0; k < 2; ++k) acc[ai][bj][m][n] = __builtin_amdgcn_mfma_f32_16x16x32_bf16(Bt[n][k], At[m][k], acc[ai][bj][m][n], 0, 0, 0); } } if constexpr (FP8) __builtin_amdgcn_sched_barrier(0); __builtin_amdgcn_s_setprio(0); if constexpr (FP8) __builtin_amdgcn_sched_barrier(0); } while (0)
#define PG8_WAIT_V(n) asm volatile("s_waitcnt vmcnt(" #n ")" ::: "memory")
#define PG8_WAIT_L(n) asm volatile("s_waitcnt lgkmcnt(" #n ")" ::: "memory")
#define PG8_BAR __builtin_amdgcn_s_barrier()
#define PG8_SCHED __builtin_amdgcn_sched_barrier(0)
    Unit cur, nxt; int ui = 0;
    if (!S.next(0, cur)) return;
    cur.par = 0;
    f32x4 acc[2][2][4][2];
#pragma unroll
    for (int a = 0; a < 2; ++a)
#pragma unroll
        for (int b = 0; b < 2; ++b)
#pragma unroll
            for (int m = 0; m < 4; ++m)
#pragma unroll
                for (int n = 0; n < 2; ++n) acc[a][b][m][n] = (f32x4){0.f, 0.f, 0.f, 0.f};
    bf16x8 At[4][2], B0[2][2], B1[2][2];
    v8i32 At8[4], B08[2], B18[2];
    const char* cA = (const char*)g.A + (size_t)cur.pm * tstep; const char* cB = (const char*)g.Bt + (size_t)cur.pn * tstep;
    S.a_ready(cur);
    PG8_STAGE(PG8_SB(0, 0), cB, voffB); PG8_STAGE(PG8_SB(0, 1), cB + hstep, voffB); PG8_STAGE(PG8_SA(0, 0), cA, voffA0); PG8_STAGE(PG8_SA(0, 1), cA + ahs, voffA1);
    if (wr == 1) PG8_BAR;
    PG8_WAIT_V(2); PG8_BAR;
    PG8_STAGE(PG8_SB(1, 0), cB + kstep, voffB); PG8_STAGE(PG8_SA(1, 0), cA + kstep, voffA0); PG8_STAGE(PG8_SB(1, 1), cB + hstep + kstep, voffB);
    PG8_WAIT_V(6); PG8_BAR;
    for (;;) {
        const bool has_next = S.next(ui + 1, nxt); nxt.par = (ui + 1) & 1;
        const char* nA = has_next ? (const char*)g.A + (size_t)nxt.pm * tstep : cA; const char* nB = has_next ? (const char*)g.Bt + (size_t)nxt.pn * tstep : cB;
        for (int t = 0; t < nt; t += 2) {
            const bool last = (t == nt - 2);
            const char* a1 = cA + (size_t)(t + 1) * kstep;
            const char* a2 = last ? nA : cA + (size_t)(t + 2) * kstep; const char* b2 = last ? nB : cB + (size_t)(t + 2) * kstep;
            const char* a3 = a2 + kstep; const char* b3 = b2 + kstep;
            asm volatile("" : "+s"(a1), "+s"(a2), "+s"(b2), "+s"(a3), "+s"(b3));
            if (last && has_next) S.a_ready(nxt);
            if constexpr (KHOOK) { int l3_ = threadIdx.x; asm volatile("" : "+v"(l3_)); E.khook(acc, cur, t, wr, wc, l3_ & 15, (l3_ >> 4) & 3); }
            PG8_LDB(B0, 0, 0); PG8_LDB(B1, 0, 1); PG8_SCHED; PG8_LDA(At, 0, 0); PG8_STAGE(PG8_SA(1, 1), a1 + ahs, voffA1);
            PG8_WAIT_V(8); PG8_WAIT_L(0); PG8_BAR;
            if constexpr (PREF) { if (t == 0 && wr == 0) E.prefetch(cur, wid); }
            PG8_MMA(0, 0, At, B0); PG8_MMA(0, 1, At, B1); PG8_BAR; PG8_SCHED;
            PG8_LDA(At, 0, 1); PG8_STAGE(PG8_SB(0, 0), b2, voffB); PG8_STAGE(PG8_SB(0, 1), b2 + hstep, voffB); PG8_STAGE(PG8_SA(0, 0), a2, voffA0);
            PG8_WAIT_V(8); PG8_WAIT_L(0); PG8_BAR; PG8_MMA(1, 0, At, B0); PG8_MMA(1, 1, At, B1); PG8_BAR; PG8_SCHED;
            PG8_LDB(B0, 1, 0); PG8_LDB(B1, 1, 1); PG8_SCHED; PG8_LDA(At, 1, 0); PG8_STAGE(PG8_SA(0, 1), a2 + ahs, voffA1);
            PG8_WAIT_V(8); PG8_WAIT_L(0); PG8_BAR; PG8_MMA(0, 0, At, B0); PG8_MMA(0, 1, At, B1); PG8_BAR; PG8_SCHED;
            PG8_LDA(At, 1, 1); PG8_STAGE(PG8_SB(1, 0), b3, voffB); PG8_STAGE(PG8_SB(1, 1), b3 + hstep, voffB); PG8_STAGE(PG8_SA(1, 0), a3, voffA0);
            PG8_WAIT_V(8); PG8_WAIT_L(0); PG8_BAR; PG8_MMA(1, 0, At, B0); PG8_MMA(1, 1, At, B1); PG8_BAR; PG8_SCHED;
        }
        if constexpr (ALIGN_EPI) { if (wr == 0) PG8_BAR; }
        { int l2_ = threadIdx.x; asm volatile("" : "+v"(l2_)); const int fr2 = l2_ & 15, fq2 = (l2_ >> 4) & 3;
          if (!E.skip) E(acc, cur, wr, wc, fr2, fq2); } S.done(cur);
        if (!has_next) break;
#pragma unroll
        for (int a = 0; a < 2; ++a)
#pragma unroll
            for (int b = 0; b < 2; ++b)
#pragma unroll
                for (int m = 0; m < 4; ++m)
#pragma unroll
                    for (int n = 0; n < 2; ++n) acc[a][b][m][n] = (f32x4){0.f, 0.f, 0.f, 0.f};
        cur = nxt; cA = nA; cB = nB; ++ui;
        if constexpr (ALIGN_EPI) { if (wr == 1) PG8_BAR; }
    }
    PG8_WAIT_V(0);
    if constexpr (!ALIGN_EPI) { if (wr == 0) PG8_BAR; }
    PG8_BAR;
#undef PG8_SA
#undef PG8_SB
#undef PG8_STAGE
#undef PG8_PSTEP
#undef PG8_LDA
#undef PG8_LDB
#undef PG8_MMA
#undef PG8_CAT
#undef PG8_LD8
#undef PG8_WAIT_V
#undef PG8_WAIT_L
#undef PG8_BAR
#undef PG8_SCHED
}
}

constexpr size_t MiB = 1u << 20;
constexpr size_t WS_CTL = 0, CTL_ZERO_BYTES = 1 * MiB;
constexpr size_t WS_WO = 1 * MiB;
constexpr size_t WS_WOUT = 4 * MiB;
constexpr size_t WS_WUP = 6 * MiB;
constexpr size_t WS_WDOWN = 17 * MiB;
constexpr size_t WS_SSQ = 23 * MiB;
constexpr size_t WS_UE = 24 * MiB;
constexpr size_t WS_UF = 27 * MiB;
constexpr size_t WS_LSE = 30 * MiB;
constexpr size_t WS_MKV = 31 * MiB;
constexpr size_t WS_G = 34 * MiB;
constexpr size_t WS_A1I8 = 84 * MiB;
constexpr size_t WS_RSC = 23 * MiB;
constexpr size_t WS_CMAX = 23 * MiB + 128 * 1024;
constexpr size_t WS_ACT = 34 * MiB;
constexpr size_t WS_QA = 130 * MiB;
constexpr size_t WS_KA = 154 * MiB;
constexpr size_t WS_VA = 178 * MiB;
constexpr size_t WS_MERGED = 130 * MiB;
constexpr size_t WS_X1B = 162 * MiB;
constexpr size_t WS_X1L = 194 * MiB;
constexpr size_t WS_QB = 202 * MiB;
constexpr size_t WS_KVB = 218 * MiB;
constexpr size_t WS_MQ = 226 * MiB;
constexpr size_t WS_END = 242 * MiB;
constexpr size_t DO_WI8 = 34 * MiB;
constexpr size_t DO_ROPE = 49 * MiB;
constexpr size_t DO_OCAT = 0;
constexpr size_t DO_OAG = 40 * MiB;

constexpr int CW_TMO = 0, CW_BAR = 4096;

constexpr int RING_OFF = 0, RING_BYTES = 131072;
constexpr int XCH_OFF = RING_BYTES;
constexpr int LDSCTL_OFF = RING_BYTES + 4096, MISC_OFF = LDSCTL_OFF + 320;
constexpr int LDS_BYTES = 147456;
constexpr int P1T_ROPE = 131072, P1T_CS = 139264, P1T_BIAS = 140288, P1T_RSC = 141312, P1T_GAIN = 142336;
constexpr int CTAB_OFF = 139264;
constexpr int NWAVES = 8;
constexpr int NPHASES = 8;

typedef GAS unsigned gu32;
#define RLX_AGENT __ATOMIC_RELAXED, __HIP_MEMORY_SCOPE_AGENT
#define LDS_WAIT() asm volatile("s_waitcnt lgkmcnt(0)" ::: "memory")
#define VM_WAIT() asm volatile("s_waitcnt vmcnt(0)" ::: "memory")

#define XB_TMO      128
#define XB_XCNT(j)  (256  + 64 * (j))
#define XB_XSUB(j)  (1280 + 64 * (j))
#define XB_XGEN(j)  (2304 + 64 * (j))
#define XB_TOP      3328
#define XB_TOPGEN   3392
#define XCD_BAR_WORDS 3456
#define XB_SPIN_CAP (1u << 18)
__device__ __forceinline__ unsigned xb_ld(unsigned* p)              { return __hip_atomic_load(p, __ATOMIC_RELAXED, __HIP_MEMORY_SCOPE_AGENT); }
__device__ __forceinline__ unsigned xb_add(unsigned* p, unsigned v) { return __hip_atomic_fetch_add(p, v, __ATOMIC_RELAXED, __HIP_MEMORY_SCOPE_AGENT); }
__device__ __forceinline__ unsigned xb_xcc_id() { return (unsigned)__builtin_amdgcn_s_getreg((3 << 11) | 20) & 0xFu; }
#define XB_SPIN(cond, bar) do { unsigned _sp = 0; while (cond) { __builtin_amdgcn_s_sleep(1); \
    if ((++_sp & 255u) == 0u) { if (xb_ld(&(bar)[XB_TMO])) break; if (_sp > XB_SPIN_CAP) { atomicAdd(&(bar)[XB_TMO], 1u); break; } } } } while (0)
__device__ unsigned g_barrier_words[2 * XCD_BAR_WORDS];
struct XcdBarrier { unsigned* bar; unsigned x, nloc, nx; };
__device__ __forceinline__ void xcd_barrier(const XcdBarrier& b) {
    asm volatile("s_waitcnt vmcnt(0)" ::: "memory");
    __syncthreads();
    if (threadIdx.x == 0) {
        unsigned* bar = b.bar;
        __builtin_amdgcn_s_waitcnt(0);
        const unsigned nloc = b.nloc, nx = b.nx;
        const unsigned old = xb_add(&bar[XB_XSUB(b.x)], 1u);
        const unsigned gen = old / nloc;
        if (old + 1u == (gen + 1u) * nloc) {
            __builtin_amdgcn_fence(__ATOMIC_RELEASE, "agent");
            asm volatile("s_waitcnt vmcnt(0)" ::: "memory");
            const unsigned og = xb_add(&bar[XB_TOP], 1u);
            const unsigned tg = og / nx;
            if (og + 1u == (tg + 1u) * nx) xb_add(&bar[XB_TOPGEN], 1u);
            else XB_SPIN(xb_ld(&bar[XB_TOPGEN]) == tg, bar);
            __builtin_amdgcn_fence(__ATOMIC_ACQUIRE, "agent");
            xb_add(&bar[XB_XGEN(b.x)], 1u);
            asm volatile("s_waitcnt vmcnt(0)" ::: "memory");
        } else {
            XB_SPIN(xb_ld(&bar[XB_XGEN(b.x)]) == gen, bar);
            __builtin_amdgcn_fence(__ATOMIC_ACQUIRE, "agent");
            asm volatile("s_waitcnt vmcnt(0)" ::: "memory");
        }
    }
    __syncthreads();
}

struct Args {
    const float* in[25]; float* out; unsigned char* ws; int ph_lo, ph_hi, li, pad;
};
enum { I_X = 0, I_MEM, I_POS, I_ATTN_NORM, I_W_IN, I_AQ, I_AK, I_BQ, I_BK, I_SINK, I_MEM_NORM, I_W_MKV, I_MQN, I_MKN, I_WOA, I_WOB, I_WOM, I_WGATE, I_BGATE, I_WOUT, I_FFN_NORM, I_WUP, I_CONVW, I_CONVB, I_WDOWN };

__host__ __device__ __forceinline__ int map_uniform(int n) { const int c = n & 255; return (n & ~255) + 128 * ((c >> 5) & 1) + 32 * (c >> 6) + (c & 31); }
__host__ __device__ __forceinline__ int map_up(int n) { return n < DFF_ ? 256 * (n >> 7) + (n & 127) : 256 * ((n - DFF_) >> 7) + 128 + ((n - DFF_) & 127); }

__device__ __forceinline__ float wave_sum(float v) {
#pragma unroll
    for (int o = 1; o < 64; o <<= 1) v += __shfl_xor(v, o);
    return v;
}
template <int MAP>
__device__ __forceinline__ void p0_transpose_item(const float* W, int K, int N, bf16_t* WT, int noff, int pitch, int koff, const float* kscale, LAS float*  , int item, int lane) {
    const int nblk = N / 32, kb = item / nblk, nb = item % nblk, k0 = 64 * kb + 8 * (lane >> 3), n0 = 32 * nb;
    f32x4 v[8];
#pragma unroll
    for (int i = 0; i < 8; ++i) v[i] = *(const f32x4*)(W + (size_t)(k0 + i) * N + n0 + 4 * (lane & 7));
    if (kscale) { const f32x4 s0 = *(const f32x4*)(kscale + k0), s1 = *(const f32x4*)(kscale + k0 + 4);
#pragma unroll
        for (int i = 0; i < 8; ++i) v[i] = v[i] * (i < 4 ? s0[i & 3] : s1[i & 3]); }
    const int r0 = (MAP == 0 ? map_uniform(noff + n0) : map_up(noff + n0)) + 4 * (lane & 7);
#pragma unroll
    for (int e = 0; e < 4; ++e) { u32x4 o; o.x = cvtpk(v[0][e], v[1][e]); o.y = cvtpk(v[2][e], v[3][e]); o.z = cvtpk(v[4][e], v[5][e]); o.w = cvtpk(v[6][e], v[7][e]);
        *(GAS u32x4*)(WT + (size_t)(r0 + e) * pitch + koff + k0 + 0) = o; }
}
constexpr float I8MAGIC = 12582912.0f;
__device__ __forceinline__ unsigned pack_i8(float m0, float m1, float m2, float m3) {
    const unsigned p01 = __builtin_amdgcn_perm(__float_as_uint(m1), __float_as_uint(m0), 0x0c0c0400u);
    const unsigned p23 = __builtin_amdgcn_perm(__float_as_uint(m3), __float_as_uint(m2), 0x0c0c0400u);
    return p01 | (p23 << 16);
}
__device__ __forceinline__ float wave_max(float v) {
#pragma unroll
    for (int o = 1; o < 64; o <<= 1) v = fmaxf(v, __shfl_xor(v, o));
    return v;
}
__device__ __forceinline__ void p0_quant_weight_block(const float* W, int N, int nb, int coff, unsigned char* WT, float* cmax, LAS float* part, int wave, int lane) {
    const int n0 = 32 * nb;
    f32x4 v[2][8];
#pragma unroll
    for (int it = 0; it < 2; ++it) { const int k0 = 128 * wave + 64 * it + 8 * (lane >> 3);
#pragma unroll
        for (int i = 0; i < 8; ++i) v[it][i] = *(const f32x4*)(W + (size_t)(k0 + i) * N + n0 + 4 * (lane & 7)); }
    f32x4 mx = {0.f, 0.f, 0.f, 0.f};
#pragma unroll
    for (int it = 0; it < 2; ++it)
#pragma unroll
        for (int i = 0; i < 8; ++i)
#pragma unroll
            for (int e = 0; e < 4; ++e) mx[e] = fmaxf(mx[e], fabsf(v[it][i][e]));
#pragma unroll
    for (int o = 8; o < 64; o <<= 1)
#pragma unroll
        for (int e = 0; e < 4; ++e) mx[e] = fmaxf(mx[e], __shfl_xor(mx[e], o));
    if (lane < 8) *(LAS f32x4*)(part + wave * 32 + 4 * lane) = mx;
    __syncthreads();
    f32x4 cm = *(const LAS f32x4*)(part + 4 * (lane & 7));
#pragma unroll
    for (int w = 1; w < 8; ++w) { const f32x4 o = *(const LAS f32x4*)(part + w * 32 + 4 * (lane & 7));
#pragma unroll
        for (int e = 0; e < 4; ++e) cm[e] = fmaxf(cm[e], o[e]); }
    if (wave == 0 && lane < 8) *(f32x4*)(cmax + coff + n0 + 4 * lane) = cm;
    f32x4 inv;
#pragma unroll
    for (int e = 0; e < 4; ++e) inv[e] = cm[e] > 0.f ? 127.0f / cm[e] : 0.f;
    const int r0 = map_uniform(coff + n0) + 4 * (lane & 7);
#pragma unroll
    for (int it = 0; it < 2; ++it) { const int k0 = 128 * wave + 64 * it + 8 * (lane >> 3);
#pragma unroll
        for (int e = 0; e < 4; ++e) { u32x2 o;
            o.x = pack_i8(__builtin_fmaf(v[it][0][e], inv[e], I8MAGIC), __builtin_fmaf(v[it][1][e], inv[e], I8MAGIC), __builtin_fmaf(v[it][2][e], inv[e], I8MAGIC), __builtin_fmaf(v[it][3][e], inv[e], I8MAGIC));
            o.y = pack_i8(__builtin_fmaf(v[it][4][e], inv[e], I8MAGIC), __builtin_fmaf(v[it][5][e], inv[e], I8MAGIC), __builtin_fmaf(v[it][6][e], inv[e], I8MAGIC), __builtin_fmaf(v[it][7][e], inv[e], I8MAGIC));
            *(GAS u32x2*)(WT + (size_t)(r0 + e) * 1024 + k0) = o; } }
    __syncthreads();
}
template <int NR>
__device__ __forceinline__ void rms_rows_to_i8(const float* xrow, size_t rstride, const float* gain, unsigned char* orow, float* rsc, int lane) {
    const GAS f32x4* gr = (const GAS f32x4*)gain + lane;
    f32x4 v[NR][4]; float s[NR], mx[NR];
#pragma unroll
    for (int r = 0; r < NR; ++r) { const GAS f32x4* xr = (const GAS f32x4*)(xrow + r * rstride) + lane;
#pragma unroll
        for (int j = 0; j < 4; ++j) v[r][j] = xr[64 * j]; }
    f32x4 g[4];
#pragma unroll
    for (int j = 0; j < 4; ++j) g[j] = gr[64 * j];
#pragma unroll
    for (int r = 0; r < NR; ++r) { s[r] = 0.f;
#pragma unroll
        for (int j = 0; j < 4; ++j) s[r] += (v[r][j].x * v[r][j].x + v[r][j].y * v[r][j].y) + (v[r][j].z * v[r][j].z + v[r][j].w * v[r][j].w); }
#pragma unroll
    for (int r = 0; r < NR; ++r) { const float rstd = 1.0f / sqrtf(wave_sum(s[r]) * (1.f / 1024.f) + EPS_); mx[r] = 0.f;
#pragma unroll
        for (int j = 0; j < 4; ++j) { v[r][j] = v[r][j] * rstd * g[j];
            mx[r] = fmaxf(fmaxf(mx[r], fmaxf(fabsf(v[r][j].x), fabsf(v[r][j].y))), fmaxf(fabsf(v[r][j].z), fabsf(v[r][j].w))); } }
#pragma unroll
    for (int r = 0; r < NR; ++r) mx[r] = wave_max(mx[r]);
#pragma unroll
    for (int r = 0; r < NR; ++r) { const float inv = mx[r] > 0.f ? 127.0f / mx[r] : 0.f;
        GAS unsigned* o4 = (GAS unsigned*)(orow + r * rstride) + lane;
#pragma unroll
        for (int j = 0; j < 4; ++j) o4[64 * j] = pack_i8(__builtin_fmaf(v[r][j].x, inv, I8MAGIC), __builtin_fmaf(v[r][j].y, inv, I8MAGIC), __builtin_fmaf(v[r][j].z, inv, I8MAGIC), __builtin_fmaf(v[r][j].w, inv, I8MAGIC));
        if (lane == 0) rsc[r] = mx[r] * (1.0f / 127.0f); }
}
__device__ __forceinline__ void sincos_f(float ang, float& co, float& si) {
    const double x = (double)ang; const double n = __builtin_rint(x * 0.63661977236758134308);
    double r = __builtin_fma(-n, 1.5707963267948966192, x); r = __builtin_fma(-n, 6.123233995736766036e-17, r);
    const double r2 = r * r;
    double s = -1.0 / 6227020800.0; s = s * r2 + 1.0 / 39916800.0; s = s * r2 - 1.0 / 362880.0; s = s * r2 + 1.0 / 5040.0; s = s * r2 - 1.0 / 120.0; s = s * r2 + 1.0 / 6.0; s = r - r * r2 * s;
    double c = 1.0 / 479001600.0; c = c * r2 - 1.0 / 3628800.0; c = c * r2 + 1.0 / 40320.0; c = c * r2 - 1.0 / 720.0; c = c * r2 + 1.0 / 24.0; c = c * r2 - 0.5; c = c * r2 + 1.0;
    const int q = (int)((long long)n & 3);
    const double cs = (q == 0) ? c : (q == 1) ? -s : (q == 2) ? -c : s;
    const double sn = (q == 0) ? s : (q == 1) ? c : (q == 2) ? -s : -c;
    co = (float)cs; si = (float)sn;
}

struct Frame {
    LAS unsigned char* lds;
    int tid, lane, wave, vcu, G;
    const Args* a;
};

__device__ __forceinline__ void p0_prologue(const Args& A, LAS unsigned char* lds, int vcu, int G, int wave, int lane) {
    const int gw = vcu * NWAVES + wave, NGW = G * NWAVES;
    unsigned char* wi8 = (unsigned char*)A.out + DO_WI8;
    unsigned char* a1 = A.ws + WS_A1I8;
    float* rsc = (float*)(A.ws + WS_RSC); float* cmax = (float*)(A.ws + WS_CMAX);
    unsigned* rope = (unsigned*)((unsigned char*)A.out + DO_ROPE);
    constexpr int B_IN = 3584 / 32, B_GATE = 3072 / 32, B_MKV = 1024 / 32;
    for (int it = vcu; it < B_IN + B_GATE + B_MKV; it += G) {
        LAS float* part = (LAS float*)(lds + RING_OFF);
        if (it < B_IN) p0_quant_weight_block(A.in[I_W_IN], 3584, it, 0, wi8, cmax, part, wave, lane);
        else if (it < B_IN + B_GATE) p0_quant_weight_block(A.in[I_WGATE], 3072, it - B_IN, 3584, wi8, cmax, part, wave, lane);
        else p0_quant_weight_block(A.in[I_W_MKV], 1024, it - B_IN - B_GATE, 6656, wi8, cmax, part, wave, lane);
    }
    for (int m = 4 * gw; m < T_ + NB_ * MEM_; m += 4 * NGW) {
        if (m < T_) rms_rows_to_i8<4>(A.in[I_X] + (size_t)m * DM_, DM_, A.in[I_ATTN_NORM], a1 + (size_t)m * DM_, rsc + m, lane);
        else rms_rows_to_i8<4>(A.in[I_MEM] + (size_t)(m - T_) * DM_, DM_, A.in[I_MEM_NORM], a1 + (size_t)m * DM_, rsc + m, lane);
    }
    const int* pos = (const int*)A.in[I_POS];
    for (int idx = gw * 64 + lane; idx < T_ * 8; idx += NGW * 64) {
        const int t = idx >> 3, i = idx & 7;
        const float fr = (i == 0) ? 1.0f : (i == 1) ? 0.193922758102417f : (i == 2) ? 0.03760603442788124f : (i == 3) ? 0.007292666472494602f : (i == 4) ? 0.0014142136787995696f
                       : (i == 5) ? 0.00027424818836152554f : (i == 6) ? 5.318298644851893e-05f : 1.031338433676865e-05f;
        const float ang = (float)pos[t] * fr; float co, si; sincos_f(ang, co, si);
        rope[idx] = (unsigned)__builtin_bit_cast(unsigned short, (_Float16)co) | ((unsigned)__builtin_bit_cast(unsigned short, (_Float16)si) << 16);
    }
}

struct TItem { const float* W; bf16_t* WT; const float* kscale; int N, noff, pitch, koff, map, item; };
__device__ __forceinline__ void ti_load(const TItem& d, int lane, f32x4 (&v)[8], f32x4 (&sc)[2]) {
    const int nblk = d.N / 32, kb = d.item / nblk, nb = d.item % nblk, k0 = 64 * kb + 8 * (lane >> 3), n0 = 32 * nb;
#pragma unroll
    for (int i = 0; i < 8; ++i) v[i] = *(const f32x4*)(d.W + (size_t)(k0 + i) * d.N + n0 + 4 * (lane & 7));
    if (d.kscale) { sc[0] = *(const f32x4*)(d.kscale + k0); sc[1] = *(const f32x4*)(d.kscale + k0 + 4); }
}
__device__ __forceinline__ void ti_store(const TItem& d, int lane, f32x4 (&v)[8], const f32x4 (&sc)[2]) {
    const int nblk = d.N / 32, kb = d.item / nblk, nb = d.item % nblk, k0 = 64 * kb + 8 * (lane >> 3), n0 = 32 * nb;
    if (d.kscale) {
#pragma unroll
        for (int i = 0; i < 8; ++i) v[i] = v[i] * (i < 4 ? sc[0][i & 3] : sc[1][i & 3]); }
    const int r0 = (d.map == 0 ? map_uniform(d.noff + n0) : map_up(d.noff + n0)) + 4 * (lane & 7);
#pragma unroll
    for (int e = 0; e < 4; ++e) { u32x4 o; o.x = cvtpk(v[0][e], v[1][e]); o.y = cvtpk(v[2][e], v[3][e]); o.z = cvtpk(v[4][e], v[5][e]); o.w = cvtpk(v[6][e], v[7][e]);
        *(GAS u32x4*)(d.WT + (size_t)(r0 + e) * d.pitch + d.koff + k0) = o; }
}
template <int PART>
__device__ __forceinline__ bool late_item(const Args& A, int it, TItem& d) {
    constexpr int I_OA = (256 / 64) * (1024 / 32), I_OB = (512 / 64) * (1024 / 32), I_OM = I_OB, I_OUT = (1024 / 64) * (1024 / 32);
    constexpr int I_UP = (1024 / 64) * (5632 / 32), I_DOWN = (2816 / 64) * (1024 / 32);
    bf16_t* wo = (bf16_t*)(A.ws + WS_WO);
    if (PART == 1) { if (it >= I_DOWN) return false; d = TItem{A.in[I_WDOWN], (bf16_t*)(A.ws + WS_WDOWN), nullptr, 1024, 0, 2816, 0, 0, it}; return true; }
    int r = it;
    if (r < I_OA) { d = TItem{A.in[I_WOA], wo, nullptr, 1024, 0, KCAT, 0, 0, r}; return true; } r -= I_OA;
    if (r < I_OB) { d = TItem{A.in[I_WOB], wo, nullptr, 1024, 0, KCAT, 256, 0, r}; return true; } r -= I_OB;
    if (r < I_OM) { d = TItem{A.in[I_WOM], wo, nullptr, 1024, 0, KCAT, 768, 0, r}; return true; } r -= I_OM;
    if (r < I_OUT) { d = TItem{A.in[I_WOUT], (bf16_t*)(A.ws + WS_WOUT), nullptr, 1024, 0, 1024, 0, 0, r}; return true; } r -= I_OUT;
    if (r < I_UP) { d = TItem{A.in[I_WUP], (bf16_t*)(A.ws + WS_WUP), A.in[I_FFN_NORM], 5632, 0, 1024, 0, 1, r}; return true; }
    return false;
}
template <int PART>
__device__ __forceinline__ void p0_late_weights(const Args& A, int gw, int ngw, int lane) {
    constexpr int NB = 3;
    for (int it = gw; ; it += NB * ngw) {
        TItem d[NB]; bool ok[NB]; f32x4 v[NB][8], sc[NB][2];
#pragma unroll
        for (int b = 0; b < NB; ++b) { ok[b] = late_item<PART>(A, it + b * ngw, d[b]); if (ok[b]) ti_load(d[b], lane, v[b], sc[b]); }
        if (!ok[0]) break;
#pragma unroll
        for (int b = 0; b < NB; ++b) if (ok[b]) ti_store(d[b], lane, v[b], sc[b]);
    }
}

struct TileOrder {
    pg8::StaticOrder so; unsigned mask; int mkv;
    __device__ void init(unsigned mask_, int mkv_, int G, int c) { mask = mask_; mkv = mkv_; so.init(T_, 256 * __builtin_popcount(mask_), G, c, 4); }
    __device__ bool next(int i, pg8::Unit& u) const {
        if (so.next(i, u)) { unsigned m = mask; for (int k = 0; k < u.pn; ++k) m &= m - 1u; u.pn = __builtin_ctz(m); return true; }
        if (!mkv) return false;
        const long L = (long)i * so.G + so.c - so.nwg; if (L < 0 || L >= 16) return false;
        u.pm = 64 + (int)(L >> 2); u.pn = 26 + (int)(L & 3); return true;
    }
    __device__ __forceinline__ void a_ready(const pg8::Unit&) const {}
    __device__ __forceinline__ void done(const pg8::Unit&) const {}
};

__device__ __forceinline__ f32x4 cvt_i32(const f32x4& a) { const v4i32 i = __builtin_bit_cast(v4i32, a); return (f32x4){(float)i[0], (float)i[1], (float)i[2], (float)i[3]}; }

__device__ __forceinline__ float h2f_lo(unsigned w) { return (float)__builtin_bit_cast(_Float16, (unsigned short)(w & 0xffffu)); }
__device__ __forceinline__ float h2f_hi(unsigned w) { return (float)__builtin_bit_cast(_Float16, (unsigned short)(w >> 16)); }

struct EpiG {
    static constexpr bool PERM = true;
    unsigned char* G; LAS const unsigned char* lds;
    bool skip = false;
    __device__ __forceinline__ void operator()(const f32x4 (&acc)[2][2][4][2], const pg8::Unit& u, int wr, int wc, int fr, int fq) const {
        const int col0 = u.pn * 256, row0 = u.pm * 256;
        f32x4 bv[2][2], cs[2][2];
#pragma unroll
        for (int bj = 0; bj < 2; ++bj)
#pragma unroll
            for (int n = 0; n < 2; ++n) { const int j = wc * 64 + 32 * bj + 8 * fq + 4 * n; bv[bj][n] = *(LAS const f32x4*)(lds + P1T_BIAS + 4 * j) * (-LOG2E); cs[bj][n] = *(LAS const f32x4*)(lds + P1T_CS + 4 * j) * (-LOG2E / 127.0f); }
        float rsv[2][4];
#pragma unroll
        for (int ai = 0; ai < 2; ++ai)
#pragma unroll
            for (int m = 0; m < 4; ++m) rsv[ai][m] = *(LAS const float*)(lds + P1T_RSC + 4 * (ai * 128 + wr * 64 + m * 16 + fr));
#pragma unroll
        for (int ai = 0; ai < 2; ++ai)
#pragma unroll
            for (int m = 0; m < 4; ++m) { unsigned char* rowp = G + (size_t)(row0 + ai * 128 + wr * 64 + m * 16 + fr) * 3072 + col0 + wc * 64 + 8 * fq;
#pragma unroll
                for (int bj = 0; bj < 2; ++bj) { u32x2 w;
#pragma unroll
                    for (int n = 0; n < 2; ++n) { const f32x4 z = (cvt_i32(acc[ai][bj][m][n]) * rsv[ai][m]) * cs[bj][n] + bv[bj][n]; unsigned q[4];
#pragma unroll
                        for (int e = 0; e < 4; ++e) { const float g = __builtin_amdgcn_rcpf(1.0f + __builtin_amdgcn_exp2f(z[e])); const unsigned qi = (unsigned)(g * 255.0f + 0.5f); q[e] = qi < 1u ? 1u : qi; }
                        w[n] = q[0] | (q[1] << 8) | (q[2] << 16) | (q[3] << 24); }
                    *(u32x2*)(rowp + 32 * bj) = w; } }
    }
};

struct Epi1 {
    static constexpr bool PERM = true;
    unsigned char* ws; const unsigned* rope; const float *aq, *ak, *bq, *bk, *bgate; const float* rsc; const float* cmax; LAS unsigned char* lds;
    bool skip = false;
    __device__ __forceinline__ void prefetch(const pg8::Unit& u, int w) const {
        int lane = threadIdx.x; asm volatile("" : "+v"(lane)); lane &= 63;
        const int pn = u.pn, pm = u.pm;
        if (pm < 64 && pn < 12) {
#pragma unroll
            for (int j = 0; j < 2; ++j) { const int piece = 2 * w + j;
                __builtin_amdgcn_global_load_lds((const unsigned*)((const char*)rope + (size_t)pm * 8192 + piece * 1024 + lane * 16), (LAS unsigned*)(lds + P1T_ROPE + piece * 1024), 16, 0, 0); }
        }
        if (w == 0) __builtin_amdgcn_global_load_lds((const unsigned*)(cmax + pn * 256 + lane * 4), (LAS unsigned*)(lds + P1T_CS), 16, 0, 0);
        else if (w == 1) { if (pn >= 14 && pn < 26) __builtin_amdgcn_global_load_lds((const unsigned*)(bgate + (pn - 14) * 256 + lane * 4), (LAS unsigned*)(lds + P1T_BIAS), 16, 0, 0); }
        else if (w == 2) __builtin_amdgcn_global_load_lds((const unsigned*)(rsc + pm * 256 + lane * 4), (LAS unsigned*)(lds + P1T_RSC), 16, 0, 0);
        else if (pn < 12) { const int gi = pn / 3, ty = pn - 3 * gi;
            const float* gp = (pn >= 11) ? bk : (pn >= 9) ? bq : (ty == 0) ? aq + 64 * gi : ak + 64 * gi;
            if (lane < 16) __builtin_amdgcn_global_load_lds((const unsigned*)(gp + lane * 4), (LAS unsigned*)(lds + P1T_GAIN), 16, 0, 0); }
    }
    __device__ __forceinline__ void plain(const f32x4 (&acc)[2][2][4][2], bf16_t* dst, int ld, int col0, int row0, int wr, int wc, int fr, int fq) const {
        f32x4 cs[2][2];
#pragma unroll
        for (int bj = 0; bj < 2; ++bj)
#pragma unroll
            for (int n = 0; n < 2; ++n) cs[bj][n] = *(LAS const f32x4*)(lds + P1T_CS + 4 * (wc * 64 + 32 * bj + 8 * fq + 4 * n)) * (1.0f / 127.0f);
        float rsv[2][4];
#pragma unroll
        for (int ai = 0; ai < 2; ++ai)
#pragma unroll
            for (int m = 0; m < 4; ++m) rsv[ai][m] = *(LAS const float*)(lds + P1T_RSC + 4 * (ai * 128 + wr * 64 + m * 16 + fr));
#pragma unroll
        for (int ai = 0; ai < 2; ++ai)
#pragma unroll
            for (int m = 0; m < 4; ++m) { bf16_t* rowp = dst + (size_t)(row0 + ai * 128 + wr * 64 + m * 16 + fr) * ld + col0 + wc * 64 + 8 * fq;
#pragma unroll
                for (int bj = 0; bj < 2; ++bj) { const f32x4 v0 = cvt_i32(acc[ai][bj][m][0]) * rsv[ai][m] * cs[bj][0], v1 = cvt_i32(acc[ai][bj][m][1]) * rsv[ai][m] * cs[bj][1];
                    u32x4 w; w.x = cvtpk(v0[0], v0[1]); w.y = cvtpk(v0[2], v0[3]); w.z = cvtpk(v1[0], v1[1]); w.w = cvtpk(v1[2], v1[3]);
                    *(u32x4*)(rowp + 32 * bj) = w; } }
    }
    __device__ __forceinline__ void normed(const f32x4 (&acc)[2][2][4][2], bf16_t* dst, int ld, int col0, int row0, float scale, int wr, int wc, int fr, int fq) const {
        f32x4 g[2][2], cs[2][2];
#pragma unroll
        for (int bj = 0; bj < 2; ++bj)
#pragma unroll
            for (int n = 0; n < 2; ++n) { g[bj][n] = *(LAS const f32x4*)(lds + P1T_GAIN + 4 * (32 * bj + 8 * fq + 4 * n)) * scale; cs[bj][n] = *(LAS const f32x4*)(lds + P1T_CS + 4 * (wc * 64 + 32 * bj + 8 * fq + 4 * n)) * (1.0f / 127.0f); }
#pragma unroll
        for (int aim = 0; aim < 4; ++aim) {
            const int ai = aim >> 1;
            u32x4 rw[2][2]; float rsv[2];
#pragma unroll
            for (int mm = 0; mm < 2; ++mm) { const int tr = ai * 128 + wr * 64 + (2 * (aim & 1) + mm) * 16 + fr; rsv[mm] = *(LAS const float*)(lds + P1T_RSC + 4 * tr);
#pragma unroll
                for (int n = 0; n < 2; ++n) rw[mm][n] = *(LAS const u32x4*)(lds + P1T_ROPE + 32 * tr + 16 * n); }
#pragma unroll
            for (int mm = 0; mm < 2; ++mm) { const int m = 2 * (aim & 1) + mm;
                const int row = row0 + ai * 128 + wr * 64 + m * 16 + fr;
                f32x4 v[2][2];
                float ss = 0.f;
#pragma unroll
                for (int bj = 0; bj < 2; ++bj)
#pragma unroll
                    for (int n = 0; n < 2; ++n) { const f32x4 x = cvt_i32(acc[ai][bj][m][n]) * cs[bj][n]; v[bj][n] = x; ss += (x[0] * x[0] + x[1] * x[1]) + (x[2] * x[2] + x[3] * x[3]); }
                ss += xor16(ss); ss = sum_halves(ss);
                const float rq = rsv[mm];
                const float rs = rq / sqrtf(ss * (rq * rq * (1.f / 64.f)) + EPS_);
#pragma unroll
                for (int bj = 0; bj < 2; ++bj)
#pragma unroll
                    for (int n = 0; n < 2; ++n) v[bj][n] = v[bj][n] * rs * g[bj][n];
#pragma unroll
                for (int n = 0; n < 2; ++n) {
                    const u32x4 cw = rw[mm][n];
                    const f32x4 co = {h2f_lo(cw[0]), h2f_lo(cw[1]), h2f_lo(cw[2]), h2f_lo(cw[3])}, si = {h2f_hi(cw[0]), h2f_hi(cw[1]), h2f_hi(cw[2]), h2f_hi(cw[3])};
                    f32x4 pr;
#pragma unroll
                    for (int e = 0; e < 4; ++e) pr[e] = xor16(v[0][n][e]);
                    const f32x4 r0 = v[0][n] * co - pr * si, r1 = v[0][n] * co + pr * si;
                    v[0][n] = (fq == 0) ? r0 : (fq == 1) ? r1 : v[0][n];
                }
                bf16_t* rowp = dst + (size_t)row * ld + col0 + wc * 64 + 8 * fq;
#pragma unroll
                for (int bj = 0; bj < 2; ++bj) { u32x4 w; w.x = cvtpk(v[bj][0][0], v[bj][0][1]); w.y = cvtpk(v[bj][0][2], v[bj][0][3]); w.z = cvtpk(v[bj][1][0], v[bj][1][1]); w.w = cvtpk(v[bj][1][2], v[bj][1][3]);
                    *(u32x4*)(rowp + 32 * bj) = w; }
            }
        }
    }
    __device__ __forceinline__ void operator()(const f32x4 (&acc)[2][2][4][2], const pg8::Unit& u, int wr, int wc, int fr, int fq) const {
        const int pn = u.pn, row0 = u.pm * 256;
        if (pn >= 26) { plain(acc, (bf16_t*)(ws + WS_MKV), 1024, (pn - 26) * 256, row0 - T_, wr, wc, fr, fq); return; }
        if (pn >= 14) { EpiG eg{ws + WS_G, lds}; pg8::Unit ug{u.pm, pn - 14}; eg(acc, ug, wr, wc, fr, fq); return; }
        if (pn >= 12) { plain(acc, (bf16_t*)(ws + WS_MQ), 512, (pn - 12) * 256, row0, wr, wc, fr, fq); return; }
        if (pn == 11) {
            if (wc >= 2) plain(acc, (bf16_t*)(ws + WS_KVB), 256, 0, row0, wr, wc, fr, fq);
            else normed(acc, (bf16_t*)(ws + WS_KVB), 256, 0, row0, 1.0f, wr, wc, fr, fq);
            return;
        }
        if (pn >= 9) { normed(acc, (bf16_t*)(ws + WS_QB), 512, (pn - 9) * 256, row0, QSCALE64, wr, wc, fr, fq); return; }
        const int gi = pn / 3, ty = pn - 3 * gi;
        if (ty == 2) { plain(acc, (bf16_t*)(ws + WS_VA) + (size_t)gi * T_ * 256, 256, 0, row0, wr, wc, fr, fq); return; }
        if (ty == 0) normed(acc, (bf16_t*)(ws + WS_QA) + (size_t)gi * T_ * 256, 256, 0, row0, QSCALE64, wr, wc, fr, fq);
        else normed(acc, (bf16_t*)(ws + WS_KA) + (size_t)gi * T_ * 256, 256, 0, row0, 1.0f, wr, wc, fr, fq);
    }
};

namespace att {
typedef short v4i16_t __attribute__((ext_vector_type(4)));
__device__ __forceinline__ int crow(int r, int h) { return (r & 3) + 8 * (r >> 2) + 4 * h; }
__device__ __forceinline__ s16x4 vtr(LAS const unsigned char* p) { return __builtin_bit_cast(s16x4, __builtin_amdgcn_ds_read_tr16_b64_v4i16((LAS v4i16_t*)p)); }

constexpr int KROW64 = 144, VROW64 = 128, NKEYS_B = 384;
constexpr int LDS_K64 = 0, LDS_V64 = NKEYS_B * KROW64;
constexpr int LDS_K128 = 0, LDS_V128 = 65536;

constexpr float SM_THR = 20.0f;
template <int NT, int ND>
__device__ __forceinline__ void softmax_step(f32x16 (&s)[NT], float& mref, float& l, f32x16 (&o)[ND], bf16x8 (&pf)[NT][2]) {
    if (__any(mref != 0.f)) {
#pragma unroll
        for (int t = 0; t < NT; ++t)
#pragma unroll
            for (int r = 0; r < 16; ++r) s[t][r] -= mref;
    }
    float mx = s[0][0];
#pragma unroll
    for (int t = 0; t < NT; ++t)
#pragma unroll
        for (int r = 0; r < 16; ++r) mx = fmaxf(mx, s[t][r]);
    mx = fmaxf(mx, __shfl_xor(mx, 32));
    if (__any(mx > SM_THR)) {
        const float dl = fmaxf(mx, 0.f); mref += dl;
#pragma unroll
        for (int t = 0; t < NT; ++t)
#pragma unroll
            for (int r = 0; r < 16; ++r) s[t][r] -= dl;
        const float f = __builtin_amdgcn_exp2f(-dl); l *= f;
#pragma unroll
        for (int d = 0; d < ND; ++d)
#pragma unroll
            for (int r = 0; r < 16; ++r) o[d][r] *= f;
    }
    float ps0 = 0.f, ps1 = 0.f;
#pragma unroll
    for (int t = 0; t < NT; ++t)
#pragma unroll
        for (int r = 0; r < 16; r += 2) { s[t][r] = __builtin_amdgcn_exp2f(s[t][r]); s[t][r + 1] = __builtin_amdgcn_exp2f(s[t][r + 1]); ps0 += s[t][r]; ps1 += s[t][r + 1]; }
    l += ps0 + ps1;
#pragma unroll
    for (int t = 0; t < NT; ++t)
#pragma unroll
        for (int k = 0; k < 2; ++k) { u32x4 w; w.x = cvtpk(s[t][8 * k + 0], s[t][8 * k + 1]); w.y = cvtpk(s[t][8 * k + 2], s[t][8 * k + 3]); w.z = cvtpk(s[t][8 * k + 4], s[t][8 * k + 5]); w.w = cvtpk(s[t][8 * k + 6], s[t][8 * k + 7]);
            pf[t][k] = __builtin_bit_cast(bf16x8, w); }
}

struct BU { const bf16_t* q; const bf16_t* k; const bf16_t* v; bf16_t* o; float* lse; int qstride, kvstride, ostride, lsestride; float sink2; int W; int first; };
__device__ __forceinline__ void bu_load(const BU& u, int tid, u32x4 (&kr)[6], u32x4 (&vr)[6]) {
#pragma unroll
    for (int it = 0; it < 6; ++it) {
        const int c = tid + 512 * it, row = c >> 3, ch = c & 7;
        const bool valid = !(u.first && row < 128);
        const long off = (long)((valid ? row : 128) - 128) * (long)u.kvstride + ch * 8;
        kr[it] = *(const u32x4*)(u.k + off); vr[it] = *(const u32x4*)(u.v + off);
    }
}
__device__ __forceinline__ void bu_store(LAS unsigned char* lds, int tid, const u32x4 (&kr)[6], const u32x4 (&vr)[6], int first) {
#pragma unroll
    for (int it = 0; it < 6; ++it) {
        const int c = tid + 512 * it, row = c >> 3, ch = c & 7;
        const bool valid = !(first && row < 128);
        const u32x4 z = (u32x4){0u, 0u, 0u, 0u};
        *(LAS u32x4*)(lds + LDS_K64 + row * KROW64 + ch * 16) = valid ? kr[it] : z;
        *(LAS u32x4*)(lds + LDS_V64 + row * VROW64 + ((ch * 16) ^ (((row >> 1) & 1) << 6))) = valid ? vr[it] : z;
    }
}
__device__ __forceinline__ void bu_loadq(const BU& u, int wid, int lane, bf16x8 (&qf)[4]) {
    const int qi = 32 * wid + (lane & 31), h = lane >> 5;
#pragma unroll
    for (int d0 = 0; d0 < 4; ++d0) qf[d0] = *(const bf16x8*)(u.q + (size_t)qi * u.qstride + 16 * d0 + 8 * h);
}
template <int NT>
__device__ __forceinline__ void bu_step(LAS const unsigned char* kbase, LAS const unsigned char* vbase, int vsw, int kt0, int mask, int jlo, int jhi, int h, const bf16x8 (&qf)[4],
                                        float& mref, float& l, f32x16 (&o)[2]) {
    f32x16 s[NT];
#pragma unroll
    for (int d0 = 0; d0 < 4; ++d0)
#pragma unroll
        for (int t = 0; t < NT; ++t) { const bf16x8 kf = *(LAS const bf16x8*)(kbase + (kt0 + t) * 32 * KROW64 + d0 * 32); if (d0 == 0) { for (int r = 0; r < 16; ++r) s[t][r] = 0.f; } s[t] = __builtin_amdgcn_mfma_f32_32x32x16_bf16(kf, qf[d0], s[t], 0, 0, 0); }
    if (mask == 1) {
        const int L = jlo - 32 * kt0 - 4 * h;
#pragma unroll
        for (int r = 0; r < 16; ++r) { if (((r & 3) + 8 * (r >> 2)) < L) s[0][r] = -INFINITY; }
    } else if (mask == 2) {
        const int H = jhi - 32 * kt0 - 4 * h;
#pragma unroll
        for (int r = 0; r < 16; ++r) { if (((r & 3) + 8 * (r >> 2)) > H) s[0][r] = -INFINITY; }
    } else if (mask == 3) {
#pragma unroll
        for (int t = 0; t < NT; ++t) { const int L = jlo - 32 * (kt0 + t) - 4 * h; const unsigned span = (unsigned)(jhi - jlo);
#pragma unroll
            for (int r = 0; r < 16; ++r) { if ((unsigned)(((r & 3) + 8 * (r >> 2)) - L) > span) s[t][r] = -INFINITY; } }
    }
    bf16x8 pf[NT][2];
    softmax_step<NT, 2>(s, mref, l, o, pf);
#pragma unroll
    for (int t = 0; t < NT; ++t)
#pragma unroll
        for (int k = 0; k < 2; ++k)
#pragma unroll
            for (int d = 0; d < 2; ++d) {
                LAS const unsigned char* vp = vbase + ((kt0 + t) * 32 + 16 * k) * VROW64 + 64 * (d ^ vsw);
                const s16x4 lo = vtr(vp), hi = vtr(vp + 8 * VROW64);
                const bf16x8 vf = (bf16x8){lo[0], lo[1], lo[2], lo[3], hi[0], hi[1], hi[2], hi[3]};
                o[d] = __builtin_amdgcn_mfma_f32_32x32x16_bf16(vf, pf[t][k], o[d], 0, 0, 0);
            }
}
__device__ __forceinline__ void bu_compute(LAS unsigned char* lds, const BU& u, const bf16x8 (&qf)[4], int wid, int lane) {
    const int c = lane & 31, h = lane >> 5;
    const int qi = 32 * wid + c;
    float mref = 0.f, l = 0.f; f32x16 o[2];
#pragma unroll
    for (int r = 0; r < 16; ++r) { o[0][r] = 0.f; o[1][r] = 0.f; }
    int jlo = qi + 128 - u.W; if (u.first && jlo < 128) jlo = 128;
    const int jhi = qi + 128;
    const int qq = (lane & 15) >> 2;
    LAS const unsigned char* kbase = lds + LDS_K64 + c * KROW64 + 16 * h;
    LAS const unsigned char* vbase = lds + LDS_V64 + (4 * h + qq) * VROW64 + ((lane >> 4) & 1) * 32 + (lane & 3) * 8;
    const int vsw = (qq >> 1) & 1;
#pragma unroll 1
    for (int st = 0; st < 2; ++st) bu_step<2>(kbase, vbase, vsw, wid + 2 * st, u.first ? 3 : (st == 0 ? 1 : 0), jlo, jhi, h, qf, mref, l, o);
    bu_step<1>(kbase, vbase, vsw, wid + 4, u.first ? 3 : 2, jlo, jhi, h, qf, mref, l, o);
    float lt = l + __shfl_xor(l, 32);
    lt += __builtin_amdgcn_exp2f(u.sink2 - mref);
    const float inv = 1.0f / lt;
    bf16_t* orow = u.o + (size_t)qi * u.ostride;
#pragma unroll
    for (int d = 0; d < 2; ++d)
#pragma unroll
        for (int rg = 0; rg < 4; ++rg) { u32x2 w; w.x = cvtpk(o[d][4 * rg] * inv, o[d][4 * rg + 1] * inv); w.y = cvtpk(o[d][4 * rg + 2] * inv, o[d][4 * rg + 3] * inv);
            *(u32x2*)(orow + 32 * d + 8 * rg + 4 * h) = w; }
    if (u.lse && h == 0) u.lse[(size_t)qi * u.lsestride] = mref + __builtin_amdgcn_logf(lt);
}

__device__ __forceinline__ void mem_load(const bf16_t* kmem, const bf16_t* vmem, int tid, u32x4 (&kr)[8], u32x4 (&vr)[8]) {
#pragma unroll
    for (int it = 0; it < 8; ++it) { const int cc = tid + 512 * it, row = cc >> 4, ch = cc & 15;
        kr[it] = *(const u32x4*)(kmem + (size_t)row * 1024 + ch * 8); vr[it] = *(const u32x4*)(vmem + (size_t)row * 1024 + ch * 8); }
}
__device__ __forceinline__ void mem_unit(LAS unsigned char* lds, const u32x4 (&qraw)[8], const u32x4 (&kr)[8], const u32x4 (&vr)[8], LAS const unsigned char* gl, bf16_t* o0, size_t ostride, int tid, int wid, int lane) {
#pragma unroll
    for (int it = 0; it < 8; ++it) {
        const int cc = tid + 512 * it, row = cc >> 4, ch = cc & 15;
        *(LAS u32x4*)(lds + LDS_K128 + row * 256 + ((ch ^ (row & 15)) * 16)) = kr[it];
        *(LAS u32x4*)(lds + LDS_V128 + row * 256 + ((ch * 16) ^ ((row & 3) << 6))) = vr[it];
    }
    const int c = lane & 31, h = lane >> 5;
    const int qi = 32 * wid + c;
    bf16x8 qf[8];
    {
        u32x4 raw[8]; float ss = 0.f;
#pragma unroll
        for (int d0 = 0; d0 < 8; ++d0) { raw[d0] = qraw[d0];
#pragma unroll
            for (int e = 0; e < 4; ++e) { const float a = bflo(raw[d0][e]), b = bfhi(raw[d0][e]); ss += a * a + b * b; } }
        ss += __shfl_xor(ss, 32);
        const float rs = (1.0f / sqrtf(ss * (1.f / 128.f) + EPS_)) * QSCALE128;
#pragma unroll
        for (int d0 = 0; d0 < 8; ++d0) { const f32x4 g0 = *(LAS const f32x4*)(gl + 4 * (16 * d0 + 8 * h)), g1 = *(LAS const f32x4*)(gl + 4 * (16 * d0 + 8 * h + 4));
            u32x4 w; w.x = cvtpk(bflo(raw[d0].x) * rs * g0[0], bfhi(raw[d0].x) * rs * g0[1]); w.y = cvtpk(bflo(raw[d0].y) * rs * g0[2], bfhi(raw[d0].y) * rs * g0[3]);
            w.z = cvtpk(bflo(raw[d0].z) * rs * g1[0], bfhi(raw[d0].z) * rs * g1[1]); w.w = cvtpk(bflo(raw[d0].w) * rs * g1[2], bfhi(raw[d0].w) * rs * g1[3]);
            qf[d0] = __builtin_bit_cast(bf16x8, w); }
    }
    __syncthreads();
    {
        const int row = tid >> 1, hf = tid & 1; u32x4 raw[8]; float ss = 0.f;
#pragma unroll
        for (int i = 0; i < 8; ++i) { raw[i] = *(LAS const u32x4*)(lds + LDS_K128 + row * 256 + (((hf * 8 + i) ^ (row & 15)) * 16));
#pragma unroll
            for (int e = 0; e < 4; ++e) { const float a = bflo(raw[i][e]), b = bfhi(raw[i][e]); ss += a * a + b * b; } }
        ss += __shfl_xor(ss, 1);
        const float rs = 1.0f / sqrtf(ss * (1.f / 128.f) + EPS_);
#pragma unroll
        for (int i = 0; i < 8; ++i) { LAS const unsigned char* gp = gl + 512 + 4 * (64 * hf + 8 * i); const f32x4 g0 = *(LAS const f32x4*)gp, g1 = *(LAS const f32x4*)(gp + 16);
            u32x4 w; w.x = cvtpk(bflo(raw[i].x) * rs * g0[0], bfhi(raw[i].x) * rs * g0[1]); w.y = cvtpk(bflo(raw[i].y) * rs * g0[2], bfhi(raw[i].y) * rs * g0[3]);
            w.z = cvtpk(bflo(raw[i].z) * rs * g1[0], bfhi(raw[i].z) * rs * g1[1]); w.w = cvtpk(bflo(raw[i].w) * rs * g1[2], bfhi(raw[i].w) * rs * g1[3]);
            *(LAS u32x4*)(lds + LDS_K128 + row * 256 + (((hf * 8 + i) ^ (row & 15)) * 16)) = w; }
    }
    __syncthreads();
    float mref = 0.f, l = 0.f; f32x16 o[4];
#pragma unroll
    for (int r = 0; r < 16; ++r) {
#pragma unroll
        for (int d = 0; d < 4; ++d) o[d][r] = 0.f; }
    const int qq = (lane & 15) >> 2;
    LAS const unsigned char* vbase = lds + LDS_V128 + (4 * h + qq) * 256 + ((lane >> 4) & 1) * 32 + (lane & 3) * 8;
#pragma unroll 1
    for (int kt = 0; kt < 8; kt += 2) {
        f32x16 s[2];
#pragma unroll
        for (int d0 = 0; d0 < 8; ++d0)
#pragma unroll
            for (int t = 0; t < 2; ++t) { const int krow = (kt + t) * 32 + c;
                const bf16x8 kf = *(LAS const bf16x8*)(lds + LDS_K128 + krow * 256 + (((2 * d0 + h) ^ (krow & 15)) * 16)); if (d0 == 0) { for (int r = 0; r < 16; ++r) s[t][r] = 0.f; } s[t] = __builtin_amdgcn_mfma_f32_32x32x16_bf16(kf, qf[d0], s[t], 0, 0, 0); }
        bf16x8 pf[2][2];
        softmax_step<2, 4>(s, mref, l, o, pf);
#pragma unroll
        for (int t = 0; t < 2; ++t)
#pragma unroll
            for (int k = 0; k < 2; ++k)
#pragma unroll
                for (int d = 0; d < 4; ++d) {
                    LAS const unsigned char* vp = vbase + ((kt + t) * 32 + 16 * k) * 256 + 64 * (d ^ qq);
                    const s16x4 lo = vtr(vp), hi = vtr(vp + 8 * 256);
                    const bf16x8 vf = (bf16x8){lo[0], lo[1], lo[2], lo[3], hi[0], hi[1], hi[2], hi[3]};
                    o[d] = __builtin_amdgcn_mfma_f32_32x32x16_bf16(vf, pf[t][k], o[d], 0, 0, 0);
                }
    }
    const float inv = 1.0f / (l + __shfl_xor(l, 32));
    bf16_t* orow = o0 + (size_t)qi * ostride;
#pragma unroll
    for (int d = 0; d < 4; ++d)
#pragma unroll
        for (int rg = 0; rg < 4; ++rg) { u32x2 w; w.x = cvtpk(o[d][4 * rg] * inv, o[d][4 * rg + 1] * inv); w.y = cvtpk(o[d][4 * rg + 2] * inv, o[d][4 * rg + 3] * inv);
            *(u32x2*)(orow + 32 * d + 8 * rg + 4 * h) = w; }
    __syncthreads();
}
}

__device__ __forceinline__ att::BU get_bu(const Args& A, int vcu, int idx) {
    unsigned char* ws = A.ws; att::BU u;
    if (idx < 3) {
        const int gi = idx, b = vcu >> 6, hd = (vcu >> 4) & 3, i16 = vcu & 15;
        const int dl = (gi == 0) ? 1 : (gi == 1) ? 4 : 16;
        int r, qb; if (gi == 0) { r = 0; qb = i16; } else if (gi == 1) { r = i16 >> 2; qb = i16 & 3; } else { r = i16; qb = 0; }
        const int i0 = qb * 256;
        const size_t row0 = (size_t)b * SEQ_ + r + (size_t)dl * i0;
        const size_t base = (size_t)gi * T_ * 256 + row0 * 256 + hd * 64;
        u.q = (const bf16_t*)(ws + WS_QA) + base; u.k = (const bf16_t*)(ws + WS_KA) + base; u.v = (const bf16_t*)(ws + WS_VA) + base;
        u.o = (bf16_t*)((unsigned char*)A.out + DO_OAG) + base;
        u.lse = (float*)(ws + WS_LSE) + (size_t)gi * T_ * 4 + row0 * 4 + hd;
        u.qstride = dl * 256; u.kvstride = dl * 256; u.ostride = dl * 256; u.lsestride = dl * 4; u.sink2 = -INFINITY; u.W = 128; u.first = (i0 == 0);
    } else {
        const int uu = vcu + 256 * (idx - 3), b = uu >> 7, hq = (uu >> 4) & 7, qb = uu & 15, kvh = hq >> 2;
        const size_t row0 = (size_t)b * SEQ_ + (size_t)qb * 256;
        u.q = (const bf16_t*)(ws + WS_QB) + row0 * 512 + hq * 64;
        u.k = (const bf16_t*)(ws + WS_KVB) + row0 * 256 + kvh * 64; u.v = u.k + 128;
        u.o = (bf16_t*)((unsigned char*)A.out + DO_OCAT) + row0 * KCAT + 256 + hq * 64;
        u.lse = nullptr; u.qstride = 512; u.kvstride = 256; u.ostride = KCAT; u.lsestride = 0; u.sink2 = A.in[I_SINK][hq] * LOG2E; u.W = 127; u.first = (qb == 0);
    }
    return u;
}
__device__ __forceinline__ void p2_attention(const Args& A, LAS unsigned char* lds, int vcu, int tid, int wid, int lane) {
    unsigned char* ws = A.ws;
    const int mu = vcu, mb = mu >> 6, mhd = (mu >> 4) & 3, mqb = mu & 15;
    const bf16_t* km = (const bf16_t*)(ws + WS_MKV) + (size_t)mb * MEM_ * 1024 + mhd * 128;
    const size_t mrow0 = (size_t)mb * SEQ_ + (size_t)mqb * 256;
    const bf16_t* mq = (const bf16_t*)(ws + WS_MQ) + mrow0 * 512 + mhd * 128;
    LAS unsigned char* gl = lds + 131072;
    { const float* const pq = A.in[I_MQN]; const float* const pk = A.in[I_MKN];
      if (tid < 64) { const f32x4 gv = ((const f32x4*)(tid < 32 ? pq : pk))[tid & 31]; *(LAS f32x4*)(gl + 16 * tid) = gv; } }
    u32x4 mkr[8], mvr[8], mqr[8];
    {
        u32x4 kr[6], vr[6];
        { const att::BU u0 = get_bu(A, vcu, 0); att::bu_load(u0, tid, kr, vr); }
#pragma unroll 1
        for (int idx = 0; idx < 4; ++idx) {
            const att::BU u = get_bu(A, vcu, idx);
            att::bu_store(lds, tid, kr, vr, u.first);
            bf16x8 qf[4]; att::bu_loadq(u, wid, lane, qf);
            __syncthreads();
            { const att::BU un = get_bu(A, vcu, idx + 1); att::bu_load(un, tid, kr, vr); }
            att::bu_compute(lds, u, qf, wid, lane);
            asm volatile("" ::: "memory");
            __syncthreads();
        }
        {
            const att::BU u = get_bu(A, vcu, 4);
            att::bu_store(lds, tid, kr, vr, u.first);
            bf16x8 qf[4]; att::bu_loadq(u, wid, lane, qf);
            __syncthreads();
            att::mem_load(km, km + 512, tid, mkr, mvr);
            { const int qi = 32 * wid + (lane & 31), h = lane >> 5;
#pragma unroll
              for (int d0 = 0; d0 < 8; ++d0) mqr[d0] = *(const u32x4*)(mq + (size_t)qi * 512 + 16 * d0 + 8 * h); }
            att::bu_compute(lds, u, qf, wid, lane);
            asm volatile("" ::: "memory");
            __syncthreads();
        }
    }
    {
        bf16_t* o = (bf16_t*)((unsigned char*)A.out + DO_OCAT) + mrow0 * KCAT + 768 + mhd * 128;
        att::mem_unit(lds, mqr, mkr, mvr, gl, o, KCAT, tid, wid, lane);
    }
}

__device__ __forceinline__ void p2b_merge(const Args& A, int vcu, int G, int tid) {
    const bf16_t* oag = (const bf16_t*)((unsigned char*)A.out + DO_OAG);
    bf16_t* ocat = (bf16_t*)((unsigned char*)A.out + DO_OCAT);
    const float* lse = (const float*)(A.ws + WS_LSE);
    for (int idx = vcu * 512 + tid; idx < T_ * 32; idx += G * 512) {
        const int t = idx >> 5, ch = idx & 31, hd = ch >> 3;
        const float l0 = lse[(size_t)t * 4 + hd], l1 = lse[(size_t)T_ * 4 + (size_t)t * 4 + hd], l2 = lse[(size_t)2 * T_ * 4 + (size_t)t * 4 + hd];
        const float mx = fmaxf(l0, fmaxf(l1, l2));
        float w0 = __builtin_amdgcn_exp2f(l0 - mx), w1 = __builtin_amdgcn_exp2f(l1 - mx), w2 = __builtin_amdgcn_exp2f(l2 - mx);
        const float inv = 1.0f / (w0 + w1 + w2); w0 *= inv; w1 *= inv; w2 *= inv;
        const u32x4 a = *(const u32x4*)(oag + (size_t)t * 256 + ch * 8), b = *(const u32x4*)(oag + (size_t)T_ * 256 + (size_t)t * 256 + ch * 8), c = *(const u32x4*)(oag + (size_t)2 * T_ * 256 + (size_t)t * 256 + ch * 8);
        u32x4 w;
#pragma unroll
        for (int e = 0; e < 4; ++e) w[e] = cvtpk(w0 * bflo(a[e]) + w1 * bflo(b[e]) + w2 * bflo(c[e]), w0 * bfhi(a[e]) + w1 * bfhi(b[e]) + w2 * bfhi(c[e]));
        *(u32x4*)(ocat + (size_t)t * KCAT + ch * 8) = w;
    }
}

struct P3aOrder : pg8::StaticOrder {
    const bf16_t* oag; bf16_t* ocat; const float* lse;
    __device__ __forceinline__ void a_ready(const pg8::Unit& u) const {
#pragma unroll 1
        for (int i0 = threadIdx.x; i0 < 256 * 32; i0 += 2 * 512) {
            u32x4 a[2], b[2], c[2]; float l0[2], l1[2], l2[2];
#pragma unroll
            for (int j = 0; j < 2; ++j) { const int idx = i0 + 512 * j, t = u.pm * 256 + (idx >> 5), ch = idx & 31, hd = ch >> 3;
                l0[j] = lse[(size_t)t * 4 + hd]; l1[j] = lse[(size_t)T_ * 4 + (size_t)t * 4 + hd]; l2[j] = lse[(size_t)2 * T_ * 4 + (size_t)t * 4 + hd];
                a[j] = *(const u32x4*)(oag + (size_t)t * 256 + ch * 8); b[j] = *(const u32x4*)(oag + (size_t)T_ * 256 + (size_t)t * 256 + ch * 8); c[j] = *(const u32x4*)(oag + (size_t)2 * T_ * 256 + (size_t)t * 256 + ch * 8); }
#pragma unroll
            for (int j = 0; j < 2; ++j) { const int idx = i0 + 512 * j, t = u.pm * 256 + (idx >> 5), ch = idx & 31;
                const float mx = fmaxf(l0[j], fmaxf(l1[j], l2[j]));
                float w0 = __builtin_amdgcn_exp2f(l0[j] - mx), w1 = __builtin_amdgcn_exp2f(l1[j] - mx), w2 = __builtin_amdgcn_exp2f(l2[j] - mx);
                const float inv = 1.0f / (w0 + w1 + w2); w0 *= inv; w1 *= inv; w2 *= inv;
                u32x4 w;
#pragma unroll
                for (int e = 0; e < 4; ++e) w[e] = cvtpk(w0 * bflo(a[j][e]) + w1 * bflo(b[j][e]) + w2 * bflo(c[j][e]), w0 * bfhi(a[j][e]) + w1 * bfhi(b[j][e]) + w2 * bfhi(c[j][e]));
                *(u32x4*)(ocat + (size_t)t * KCAT + ch * 8) = w; }
        }
        asm volatile("s_waitcnt vmcnt(0)" ::: "memory"); __builtin_amdgcn_s_barrier(); asm volatile("" ::: "memory");
    }
};

__device__ __forceinline__ float ub(unsigned w, int i) { return (float)((w >> (8 * i)) & 0xffu); }
struct Epi3a {
    static constexpr bool PERM = true;
    const unsigned char* G; bf16_t* MERGED;
    bool skip = false;
    __device__ __forceinline__ void khook(f32x4 (&acc)[2][2][4][2], const pg8::Unit& u, int t, int wr, int wc, int fr, int fq) const {
        if (t != 4 && t != 12) return;
        const int gsel = (t == 4) ? 0 : 1024;
#pragma unroll
        for (int ai = 0; ai < 2; ++ai) {
            u32x2 ga[4][2], gb[4][2];
#pragma unroll
            for (int m = 0; m < 4; ++m) { const unsigned char* gp = G + (size_t)(u.pm * 256 + ai * 128 + wr * 64 + m * 16 + fr) * 3072 + gsel + u.pn * 256 + wc * 64 + 8 * fq;
#pragma unroll
                for (int bj = 0; bj < 2; ++bj) { ga[m][bj] = *(const u32x2*)(gp + 32 * bj); gb[m][bj] = *(const u32x2*)(gp + 1024 + 32 * bj); } }
            asm volatile("" ::: "memory");
#pragma unroll
            for (int m = 0; m < 4; ++m)
#pragma unroll
                for (int bj = 0; bj < 2; ++bj)
#pragma unroll
                    for (int n = 0; n < 2; ++n)
#pragma unroll
                        for (int e = 0; e < 4; ++e) acc[ai][bj][m][n][e] *= ub(ga[m][bj][n], e) * __builtin_amdgcn_rcpf(ub(gb[m][bj][n], e));
        }
    }
    __device__ __forceinline__ void operator()(const f32x4 (&acc)[2][2][4][2], const pg8::Unit& u, int wr, int wc, int fr, int fq) const {
        const int col = u.pn * 256 + wc * 64 + 8 * fq;
        u32x2 g2[2][4][2];
#pragma unroll
        for (int ai = 0; ai < 2; ++ai)
#pragma unroll
            for (int m = 0; m < 4; ++m) { const size_t row = (size_t)(u.pm * 256 + ai * 128 + wr * 64 + m * 16 + fr);
#pragma unroll
                for (int bj = 0; bj < 2; ++bj) g2[ai][m][bj] = *(const u32x2*)(G + row * 3072 + 2048 + col + 32 * bj); }
        asm volatile("" ::: "memory");
        const float k = 1.0f / 255.0f;
#pragma unroll
        for (int ai = 0; ai < 2; ++ai)
#pragma unroll
            for (int m = 0; m < 4; ++m) { const size_t row = (size_t)(u.pm * 256 + ai * 128 + wr * 64 + m * 16 + fr);
#pragma unroll
                for (int bj = 0; bj < 2; ++bj) { const u32x2 g = g2[ai][m][bj]; const f32x4 v0 = acc[ai][bj][m][0] * k, v1 = acc[ai][bj][m][1] * k;
                    u32x4 w; w.x = cvtpk(v0[0] * ub(g.x, 0), v0[1] * ub(g.x, 1)); w.y = cvtpk(v0[2] * ub(g.x, 2), v0[3] * ub(g.x, 3)); w.z = cvtpk(v1[0] * ub(g.y, 0), v1[1] * ub(g.y, 1)); w.w = cvtpk(v1[2] * ub(g.y, 2), v1[3] * ub(g.y, 3));
                    *(u32x4*)(MERGED + row * 1024 + col + 32 * bj) = w; } }
    }
};

struct Epi3b {
    static constexpr bool PERM = true;
    const float* x; bf16_t* X1L; bf16_t* X1B; float* SSQ;
    bool skip = false;
    __device__ __forceinline__ void operator()(const f32x4 (&acc)[2][2][4][2], const pg8::Unit& u, int wr, int wc, int fr, int fq) const {
        const int col = u.pn * 256 + wc * 64 + 8 * fq;
#pragma unroll
        for (int ai = 0; ai < 2; ++ai) {
            f32x4 xv[4][2][2];
#pragma unroll
            for (int m = 0; m < 4; ++m) { const size_t row = (size_t)(u.pm * 256 + ai * 128 + wr * 64 + m * 16 + fr);
#pragma unroll
                for (int bj = 0; bj < 2; ++bj) { const size_t off = row * 1024 + col + 32 * bj; xv[m][bj][0] = *(const f32x4*)(x + off); xv[m][bj][1] = *(const f32x4*)(x + off + 4); } }
            asm volatile("" ::: "memory");
#pragma unroll
            for (int m = 0; m < 4; ++m) { const size_t row = (size_t)(u.pm * 256 + ai * 128 + wr * 64 + m * 16 + fr); float ss = 0.f;
#pragma unroll
                for (int bj = 0; bj < 2; ++bj) { const size_t off = row * 1024 + col + 32 * bj;
                    const f32x4 o0 = xv[m][bj][0] + acc[ai][bj][m][0], o1 = xv[m][bj][1] + acc[ai][bj][m][1];
                    ss += (o0[0] * o0[0] + o0[1] * o0[1]) + (o0[2] * o0[2] + o0[3] * o0[3]) + (o1[0] * o1[0] + o1[1] * o1[1]) + (o1[2] * o1[2] + o1[3] * o1[3]);
                    u32x4 w; w.x = cvtpk(o0[0], o0[1]); w.y = cvtpk(o0[2], o0[3]); w.z = cvtpk(o1[0], o1[1]); w.w = cvtpk(o1[2], o1[3]);
                    *(u32x4*)(X1B + off) = w; }
                ss += xor16(ss); ss = sum_halves(ss);
                if (fq == 0) SSQ[row * 16 + u.pn * 4 + wc] = ss; }
            asm volatile("" ::: "memory");
        }
    }
};

struct Epi4 {
    static constexpr bool PERM = true;
    const float* convw; const float* convb; bf16_t* ACT; float* UE; float* UF; LAS float* xch; LAS const float* rtab; LAS const float* ctab;
    bool skip = false;
    __device__ __forceinline__ void operator()(f32x4 (&acc)[2][2][4][2], const pg8::Unit& u, int wr, int wc, int fr, int fq) const {
        const int lane = fr + 16 * fq;
        const int rowbase = u.pm * 256 + 128 * wr + 8 * fr;
        const int jj = 32 * wc + 8 * fq;
        const bool bstart = (u.pm & 15) == 0;
        {
            LAS const float* tb = rtab + ((u.pm >> 2) & 1) * 256 + 128 * wr + 8 * fr;
            const f32x4 ra = *(LAS const f32x4*)tb, rb = *(LAS const f32x4*)(tb + 4);
#pragma unroll
            for (int i = 0; i < 8; ++i) { const float rs = (i < 4) ? ra[i & 3] : rb[i & 3];
#pragma unroll
                for (int bj = 0; bj < 2; ++bj)
#pragma unroll
                    for (int n = 0; n < 2; ++n) acc[i >> 2][bj][i & 3][n] *= rs; }
        }
#define U4(bj, n, i) acc[(i) >> 2][bj][(i) & 3][n]
        if (wr == 0 && fr == 0) {
#pragma unroll
            for (int i = 0; i < 2; ++i)
#pragma unroll
                for (int bj = 0; bj < 2; ++bj)
#pragma unroll
                    for (int n = 0; n < 2; ++n) *(f32x4*)(UF + (size_t)(u.pm * 2 + i) * 5632 + u.pn * 256 + 128 * bj + jj + 4 * n) = U4(bj, n, i);
        }
        if (wr == 1 && fr == 15) {
#pragma unroll
            for (int i = 0; i < 2; ++i)
#pragma unroll
                for (int bj = 0; bj < 2; ++bj)
#pragma unroll
                    for (int n = 0; n < 2; ++n) *(f32x4*)(UE + (size_t)(u.pm * 2 + i) * 5632 + u.pn * 256 + 128 * bj + jj + 4 * n) = U4(bj, n, 6 + i);
        }
        if (wr == 0 && fr == 15) {
#pragma unroll
            for (int i = 0; i < 2; ++i)
#pragma unroll
                for (int bj = 0; bj < 2; ++bj)
#pragma unroll
                    for (int n = 0; n < 2; ++n) *(LAS f32x4*)(xch + ((((wc * 2 + i) * 2 + bj) * 2 + n) * 4 + fq) * 4) = U4(bj, n, 6 + i);
        }
        asm volatile("s_waitcnt lgkmcnt(0)" ::: "memory"); __builtin_amdgcn_s_barrier(); asm volatile("" ::: "memory");
        const int src = (lane & 48) | ((fr - 1) & 15);
        const int cha = u.pn * 128 + jj;
#pragma unroll
        for (int n = 0; n < 2; ++n) {
            asm volatile("" ::: "memory"); __builtin_amdgcn_sched_barrier(0);
            f32x4 p6[2], p7[2], w0[2], w1[2], w2[2], cb[2];
#pragma unroll
            for (int bj = 0; bj < 2; ++bj) {
                f32x4 h6 = (f32x4){0.f, 0.f, 0.f, 0.f}, h7 = h6;
                if (wr == 1) { h6 = *(LAS const f32x4*)(xch + ((((wc * 2 + 0) * 2 + bj) * 2 + n) * 4 + fq) * 4); h7 = *(LAS const f32x4*)(xch + ((((wc * 2 + 1) * 2 + bj) * 2 + n) * 4 + fq) * 4); }
#pragma unroll
                for (int e = 0; e < 4; ++e) { const float a6 = __shfl(U4(bj, n, 6)[e], src), a7 = __shfl(U4(bj, n, 7)[e], src); p6[bj][e] = (fr == 0) ? h6[e] : a6; p7[bj][e] = (fr == 0) ? h7[e] : a7; }
                LAS const float* ct = ctab + u.par * 1024 + bj * 512 + jj + 4 * n;
                w0[bj] = *(LAS const f32x4*)ct; w1[bj] = *(LAS const f32x4*)(ct + 128); w2[bj] = *(LAS const f32x4*)(ct + 256); cb[bj] = *(LAS const f32x4*)(ct + 384);
            }
#pragma unroll
            for (int i = 0; i < 8; ++i) {
                f32x4 c[2];
#pragma unroll
                for (int bj = 0; bj < 2; ++bj) {
                    const f32x4 um1 = (i >= 1) ? U4(bj, n, i >= 1 ? i - 1 : 0) : p7[bj];
                    const f32x4 um2 = (i >= 2) ? U4(bj, n, i >= 2 ? i - 2 : 0) : ((i == 1) ? p7[bj] : p6[bj]);
                    c[bj] = cb[bj] + w2[bj] * U4(bj, n, i) + w1[bj] * um1 + w0[bj] * um2;
                }
                f32x4 a;
#pragma unroll
                for (int e = 0; e < 4; ++e) { const float z = c[0][e]; a[e] = z * __builtin_amdgcn_rcpf(1.0f + __builtin_amdgcn_exp2f(-z * LOG2E)) * c[1][e]; }
                u32x2 w; w.x = cvtpk(a[0], a[1]); w.y = cvtpk(a[2], a[3]);
                const bool skip = (wr == 0 && fr == 0 && i < 2 && !bstart);
                if (!skip) *(u32x2*)(ACT + (size_t)(rowbase + i) * DFF_ + cha + 4 * n) = w;
            }
        }
#undef U4
    }
};

struct P4Order : pg8::StaticOrder {
    const float* SSQ; LAS float* rtab; mutable int lastpm; const float* convw; const float* convb; LAS unsigned char* ctab;
    __device__ __forceinline__ void a_ready(const pg8::Unit& u) const {
        { int t = threadIdx.x; asm volatile("" : "+v"(t)); const int w = __builtin_amdgcn_readfirstlane(t >> 6);
          if (w < 4) { const int bj = t >> 7, tap = (t >> 5) & 3, c4 = t & 31; const float* src = (tap < 3 ? convw + tap * 5632 : convb) + bj * DFF_ + u.pn * 128 + 4 * c4;
              __builtin_amdgcn_global_load_lds((const unsigned*)src, (LAS unsigned*)(ctab + u.par * 4096 + w * 1024), 16, 0, 0); } }
        if (u.pm == lastpm) return;
        lastpm = u.pm;
        const int t = threadIdx.x;
        if (t < 256) {
            const float* sp = SSQ + (size_t)(u.pm * 256 + t) * 16;
            const f32x4 s0 = *(const f32x4*)sp, s1 = *(const f32x4*)(sp + 4), s2 = *(const f32x4*)(sp + 8), s3 = *(const f32x4*)(sp + 12);
            const float tot = ((s0[0] + s0[1]) + (s0[2] + s0[3])) + ((s1[0] + s1[1]) + (s1[2] + s1[3])) + ((s2[0] + s2[1]) + (s2[2] + s2[3])) + ((s3[0] + s3[1]) + (s3[2] + s3[3]));
            rtab[((u.pm >> 2) & 1) * 256 + t] = 1.0f / sqrtf(tot * (1.f / 1024.f) + EPS_);
        }
    }
};

struct Epi5 {
    static constexpr bool PERM = true;
    const bf16_t* X1B; const bf16_t* X1L; float* dst;
    bool skip = false;
    __device__ __forceinline__ void operator()(const f32x4 (&acc)[2][2][4][2], const pg8::Unit& u, int wr, int wc, int fr, int fq) const {
        const int col = u.pn * 256 + wc * 64 + 8 * fq;
#pragma unroll
        for (int ai = 0; ai < 2; ++ai) {
            u32x4 hv[4][2];
#pragma unroll
            for (int m = 0; m < 4; ++m) { const size_t row = (size_t)(u.pm * 256 + ai * 128 + wr * 64 + m * 16 + fr);
#pragma unroll
                for (int bj = 0; bj < 2; ++bj) { const size_t off = row * 1024 + col + 32 * bj; hv[m][bj] = *(const u32x4*)(X1B + off); } }
            asm volatile("" ::: "memory");
#pragma unroll
            for (int m = 0; m < 4; ++m) { const size_t row = (size_t)(u.pm * 256 + ai * 128 + wr * 64 + m * 16 + fr);
#pragma unroll
                for (int bj = 0; bj < 2; ++bj) { float* q = dst + row * 1024 + col + 32 * bj; const u32x4 h = hv[m][bj];
                    const f32x4 x0 = (f32x4){bflo(h.x), bfhi(h.x), bflo(h.y), bfhi(h.y)};
                    const f32x4 x1 = (f32x4){bflo(h.z), bfhi(h.z), bflo(h.w), bfhi(h.w)};
                    *(f32x4*)q = x0 + acc[ai][bj][m][0]; *(f32x4*)(q + 4) = x1 + acc[ai][bj][m][1]; } }
            asm volatile("" ::: "memory");
        }
    }
};
struct P5Order : pg8::StaticOrder {
    const float* UE; const float* UF; const float* convw; const float* convb; bf16_t* ACT;
    __device__ __forceinline__ void a_ready(const pg8::Unit& u) const {
        if ((u.pm & 15) != 0) {
            for (int ch = threadIdx.x; ch < DFF_; ch += 512) {
                const int pa = 256 * (ch >> 7) + (ch & 127), pg = pa + 128;
                const float* e = UE + (size_t)((u.pm - 1) * 2) * 5632; const float* f = UF + (size_t)(u.pm * 2) * 5632;
                float r[2];
#pragma unroll
                for (int i = 0; i < 2; ++i) {
                    float cc[2];
#pragma unroll
                    for (int s = 0; s < 2; ++s) { const int p = s ? pg : pa, cch = s * DFF_ + ch;
                        const float um2 = e[p], um1 = e[5632 + p], u0 = f[p], u1 = f[5632 + p];
                        const float w0 = convw[cch], w1 = convw[5632 + cch], w2 = convw[2 * 5632 + cch], b = convb[cch];
                        cc[s] = (i == 0) ? b + w0 * um2 + w1 * um1 + w2 * u0 : b + w0 * um1 + w1 * u0 + w2 * u1; }
                    r[i] = cc[0] * __builtin_amdgcn_rcpf(1.0f + __builtin_amdgcn_exp2f(-cc[0] * LOG2E)) * cc[1];
                }
                const unsigned w = cvtpk(r[0], r[1]);
                ACT[(size_t)(u.pm * 256) * DFF_ + ch] = (bf16_t)(w & 0xffffu); ACT[(size_t)(u.pm * 256 + 1) * DFF_ + ch] = (bf16_t)(w >> 16);
            }
        }
        asm volatile("s_waitcnt vmcnt(0)" ::: "memory"); __builtin_amdgcn_s_barrier(); asm volatile("" ::: "memory");
    }
};

__device__ __forceinline__ Args opaque_args() {
    Args a{};
#if defined(__HIP_DEVICE_COMPILE__)
    typedef const __attribute__((address_space(4))) Args* KArgsPtr;
    KArgsPtr p = (KArgsPtr)__builtin_amdgcn_kernarg_segment_ptr(); asm volatile("" : "+s"(p));
#pragma unroll
    for (int i = 0; i < 25; ++i) a.in[i] = p->in[i];
    a.out = p->out; a.ws = p->ws; a.ph_lo = p->ph_lo; a.ph_hi = p->ph_hi; a.li = p->li; a.pad = p->pad;
#endif
    return a;
}
__device__ __forceinline__ int opaque_tid() { int t = threadIdx.x; asm volatile("" : "+v"(t)); return t; }
__global__ void __launch_bounds__(NWAVES * 64, 2) fwd_kernel(Args args_by_value) {
    const Args args0 = opaque_args();
    extern __shared__ __attribute__((aligned(16))) unsigned char lds_raw[];
    LAS unsigned char* lds = (LAS unsigned char*)lds_raw;
    volatile LAS unsigned* MISC = (volatile LAS unsigned*)(lds + MISC_OFF);
    const int tid = threadIdx.x, lane = tid & 63, wave = __builtin_amdgcn_readfirstlane(tid >> 6);
    const int G = gridDim.x; const int bx = blockIdx.x; const int vcu = (G % 8 == 0) ? (bx % 8) * (G / 8) + bx / 8 : bx;
    unsigned char* ws = args0.ws;
    gu32* ctl = (gu32*)(ws + WS_CTL);
    for (int u = tid; u < (LDS_BYTES - LDSCTL_OFF) / 4; u += NWAVES * 64) ((LAS unsigned*)(lds + LDSCTL_OFF))[u] = 0u;
    __syncthreads();
    XcdBarrier bar; bar.bar = g_barrier_words + args0.li * XCD_BAR_WORDS; bar.nx = G < 8 ? (unsigned)G : 8u; bar.x = (unsigned)bx % bar.nx; bar.nloc = ((unsigned)G - bar.x + bar.nx - 1u) / bar.nx;
#ifdef PROBE_PH
    const unsigned long long tk0 = __builtin_amdgcn_s_memrealtime(); int nst = 0;
#define GRID_BAR() do { if (!MK_MULTI) xcd_barrier(bar); if (bx == 0 && tid == 0) { ((float*)(ws + WS_CTL + 768 * 1024))[nst] = (float)(__builtin_amdgcn_s_memrealtime() - tk0); } ++nst; } while (0)
#else
#define GRID_BAR() do { if (!MK_MULTI) xcd_barrier(bar); } while (0)
#endif
    const int lo = args0.ph_lo, hi = args0.ph_hi;
#ifndef PHASE_MASK
#define PHASE_MASK 0xff
#endif
#define IN(k) (((PHASE_MASK >> (k)) & 1) && lo <= (k) && (k) < hi)
#define BOTH(k) (IN(k) && IN((k) + 1))

    if (IN(0)) { const Args args = opaque_args(); const int t_ = opaque_tid(); p0_prologue(args, lds, vcu, G, __builtin_amdgcn_readfirstlane(t_ >> 6), t_ & 63); if (BOTH(0)) GRID_BAR(); }
#ifdef PROBE_BARS
    for (int xb = 0; xb < PROBE_BARS; ++xb) GRID_BAR();
#endif

    if (IN(1)) { const Args args = opaque_args();
        constexpr int NUB = 64 * 26 + 16;
        const unsigned* ropep = (const unsigned*)((unsigned char*)args.out + DO_ROPE);
        {
            pg8::Gemm g{(const bf16_t*)(ws + WS_A1I8), (const bf16_t*)((unsigned char*)args.out + DO_WI8), T_ + NB_ * MEM_, NCAT, 512 + args0.pad};
            TileOrder S; S.init(0x3FFFFFFu, 1, G, bx);
            Epi1 E{ws, ropep, args.in[I_AQ], args.in[I_AK], args.in[I_BQ], args.in[I_BK], args.in[I_BGATE], (const float*)(ws + WS_RSC), (const float*)(ws + WS_CMAX), lds};
            pg8::gemm_phase<Epi1, TileOrder, true, false, false, 2, true>(lds + RING_OFF, g, S, E);
            { const int nrem = NUB % G;
              const int t_ = opaque_tid(), w_ = __builtin_amdgcn_readfirstlane(t_ >> 6), l_ = t_ & 63;
              if (nrem == 0) p0_late_weights<0>(args, bx * NWAVES + w_, G * NWAVES, l_);
              else if (bx >= nrem) p0_late_weights<0>(args, (bx - nrem) * NWAVES + w_, (G - nrem) * NWAVES, l_); }
        }
        if (BOTH(1)) GRID_BAR();
    }

    if (IN(2)) { const Args args = opaque_args(); const int t_ = opaque_tid(); p2_attention(args, lds, vcu, t_, __builtin_amdgcn_readfirstlane(t_ >> 6), t_ & 63); if (BOTH(2)) GRID_BAR(); }


    if (IN(4)) { const Args args = opaque_args();
        pg8::Gemm g{(const bf16_t*)((unsigned char*)args.out + DO_OCAT), (const bf16_t*)(ws + WS_WO), T_, 1024, KCAT};
        P3aOrder S; S.init(T_, 1024, G, bx);
        S.oag = (const bf16_t*)((unsigned char*)args.out + DO_OAG); S.ocat = (bf16_t*)((unsigned char*)args.out + DO_OCAT); S.lse = (const float*)(ws + WS_LSE);
        Epi3a E{(const unsigned char*)(ws + WS_G), (bf16_t*)(ws + WS_MERGED)};
        pg8::gemm_phase<Epi3a, P3aOrder, false, false, true>(lds + RING_OFF, g, S, E);
        if (BOTH(4)) GRID_BAR();
    }

    if (IN(5)) { const Args args = opaque_args();
        pg8::Gemm g{(const bf16_t*)(ws + WS_MERGED), (const bf16_t*)(ws + WS_WOUT), T_, 1024, 1024};
        pg8::StaticOrder S; S.init(T_, 1024, G, bx);
        Epi3b E{args.in[I_X], (bf16_t*)(ws + WS_X1L), (bf16_t*)(ws + WS_X1B), (float*)(ws + WS_SSQ)};
        pg8::gemm_phase<Epi3b, pg8::StaticOrder, false, false, false>(lds + RING_OFF, g, S, E);
        if (BOTH(5)) GRID_BAR();
    }

    if (IN(6)) { const Args args = opaque_args();
        pg8::Gemm g{(const bf16_t*)(ws + WS_X1B), (const bf16_t*)(ws + WS_WUP), T_, 5632, 1024};
          P4Order S; S.init(T_, 5632, G, bx, 4); S.SSQ = (const float*)(ws + WS_SSQ); S.rtab = (LAS float*)(lds + XCH_OFF + 2048); S.lastpm = -1; S.convw = args.in[I_CONVW]; S.convb = args.in[I_CONVB]; S.ctab = lds + CTAB_OFF;
        Epi4 E{args.in[I_CONVW], args.in[I_CONVB], (bf16_t*)(ws + WS_ACT), (float*)(ws + WS_UE), (float*)(ws + WS_UF), (LAS float*)(lds + XCH_OFF), (LAS const float*)(lds + XCH_OFF + 2048), (LAS const float*)(lds + CTAB_OFF)};
#ifdef PROBE_NOEPI
        E.skip = (args0.li == 1);
#endif
        pg8::gemm_phase<Epi4, P4Order, true, true, false>(lds + RING_OFF, g, S, E);
        { const int nrem = (64 * 22) % G;
          const int t_ = opaque_tid(), w_ = __builtin_amdgcn_readfirstlane(t_ >> 6), l_ = t_ & 63;
          if (nrem == 0) p0_late_weights<1>(args, bx * NWAVES + w_, G * NWAVES, l_);
          else if (bx >= nrem) p0_late_weights<1>(args, (bx - nrem) * NWAVES + w_, (G - nrem) * NWAVES, l_); }
        if (BOTH(6)) GRID_BAR();
    }

    if (IN(7)) { const Args args = opaque_args();
        pg8::Gemm g{(const bf16_t*)(ws + WS_ACT), (const bf16_t*)(ws + WS_WDOWN), T_, 1024, DFF_};
        P5Order S; S.init(T_, 1024, G, bx);
        S.UE = (const float*)(ws + WS_UE); S.UF = (const float*)(ws + WS_UF); S.convw = args.in[I_CONVW]; S.convb = args.in[I_CONVB]; S.ACT = (bf16_t*)(ws + WS_ACT);
        Epi5 E{(const bf16_t*)(ws + WS_X1B), (const bf16_t*)(ws + WS_X1L), args.out};
        pg8::gemm_phase<Epi5, P5Order, false, false, false>(lds + RING_OFF, g, S, E);
    }
#ifdef PROBE_PH
    if (IN(7) && bx == 0 && tid == 0) { asm volatile("s_waitcnt vmcnt(0)" ::: "memory"); float* st = (float*)(ws + WS_CTL + 768 * 1024); st[nst] = (float)(__builtin_amdgcn_s_memrealtime() - tk0);
        args.out[5] = 1000.0f * (1000.0f * floorf(st[PROBE_PH] / 1000.0f + 0.5f)); }
#endif
#ifdef PROBE_TS
    if (IN(7) && bx == 0 && tid == 0) { asm volatile("s_waitcnt vmcnt(0)" ::: "memory"); const float* dbg = (const float*)(ws + WS_CTL + 512 * 1024); args.out[5] = 1000.0f * (400.0f * floorf(dbg[PROBE_TS - 1] / 400.0f + 0.5f)); }
#endif
#undef IN
#undef BOTH
#undef GRID_BAR
}

extern "C" void kernel_launch(void* const* d_in, const int* in_sizes, int n_in, void* d_out, int out_size, void* d_ws, size_t ws_size, hipStream_t stream) {
    static int grid = 0;
    if (grid == 0) {
        if (n_in != 25 || out_size != T_ * DM_ || ws_size < WS_END) { fprintf(stderr, "kernel_launch: unexpected shapes (n_in %d, out %d, ws %zu); nothing launched\n", n_in, out_size, ws_size); grid = -1; return; }
        int dev = 0, cus = 0, per_cu = 0;
        if (hipGetDevice(&dev) != hipSuccess || hipDeviceGetAttribute(&cus, hipDeviceAttributeMultiprocessorCount, dev) != hipSuccess) { grid = -1; return; }
        if (hipFuncSetAttribute((const void*)fwd_kernel, hipFuncAttributeMaxDynamicSharedMemorySize, LDS_BYTES) != hipSuccess) { fprintf(stderr, "kernel_launch: hipFuncSetAttribute failed\n"); grid = -1; return; }
        if (hipOccupancyMaxActiveBlocksPerMultiprocessor(&per_cu, (const void*)fwd_kernel, NWAVES * 64, LDS_BYTES) != hipSuccess || per_cu < 1) { fprintf(stderr, "kernel_launch: occupancy query says %d blocks per CU\n", per_cu); }
        (void)hipGetLastError();
        grid = cus;
        if (grid != 256) fprintf(stderr, "kernel_launch: %d CUs (the phase schedules expect 256)\n", grid);
    }
    if (grid < 0) return;
    Args a{};
    for (int i = 0; i < 25; ++i) a.in[i] = (const float*)d_in[i];
    a.out = (float*)d_out; a.ws = (unsigned char*)d_ws;
#if MK_MULTI
    for (int p = 0; p < NPHASES; ++p) { a.ph_lo = p; a.ph_hi = p + 1; a.li = p; hipLaunchKernelGGL(fwd_kernel, dim3(grid), dim3(NWAVES * 64), LDS_BYTES, stream, a); }
#elif defined(PROBE_PHASE)
    a.ph_lo = 0; a.ph_hi = PROBE_PHASE + 1; a.li = 0;
    hipLaunchKernelGGL(fwd_kernel, dim3(grid), dim3(NWAVES * 64), LDS_BYTES, stream, a);
    a.ph_lo = PROBE_PHASE; a.ph_hi = NPHASES; a.li = 1;
    hipLaunchKernelGGL(fwd_kernel, dim3(grid), dim3(NWAVES * 64), LDS_BYTES, stream, a);
#else
    a.ph_lo = 0; a.ph_hi = NPHASES; a.li = 0;
    hipLaunchKernelGGL(fwd_kernel, dim3(grid), dim3(NWAVES * 64), LDS_BYTES, stream, a);
#endif
}
```

```cpp
#include <hip/hip_runtime.h>
#include <cstdio>
#include <cstdint>

#ifndef MK_MULTI
#define MK_MULTI 0
#endif
#define LAS __attribute__((address_space(3)))
#define GAS __attribute__((address_space(1)))
typedef unsigned short bf16_t;
typedef short bf16x8 __attribute__((ext_vector_type(8)));
typedef short s16x4 __attribute__((ext_vector_type(4)));
typedef float f32x4 __attribute__((ext_vector_type(4)));
typedef float f32x16 __attribute__((ext_vector_type(16)));
typedef unsigned u32x4 __attribute__((ext_vector_type(4)));
typedef unsigned u32x2 __attribute__((ext_vector_type(2)));
typedef int v4i32 __attribute__((ext_vector_type(4)));
typedef int v8i32 __attribute__((ext_vector_type(8)));

constexpr int T_ = 16384, SEQ_ = 4096, NB_ = 4, DM_ = 1024, MEM_ = 256, DFF_ = 2816;
constexpr int NCAT = 7680;
constexpr int KCAT = 1280;
constexpr float EPS_ = 1e-6f;
constexpr float LOG2E = 1.4426950408889634f;
constexpr float QSCALE64 = 0.125f * LOG2E;
constexpr float QSCALE128 = 0.08838834764831845f * LOG2E;

__device__ __forceinline__ unsigned cvtpk(float lo, float hi) {
    typedef float f2 __attribute__((ext_vector_type(2))); typedef __bf16 b2 __attribute__((ext_vector_type(2)));
    f2 v = {lo, hi}; b2 b = __builtin_convertvector(v, b2); return __builtin_bit_cast(unsigned, b);
}
__device__ __forceinline__ float xor16(float v) { return __int_as_float(__builtin_amdgcn_ds_swizzle(__float_as_int(v), 0x401F)); }
__device__ __forceinline__ float sum_halves(float v) { const auto rr = __builtin_amdgcn_permlane32_swap(__float_as_uint(v), __float_as_uint(v), false, false); return __uint_as_float(rr[0]) + __uint_as_float(rr[1]); }
__device__ __forceinline__ float bflo(unsigned w) { return __uint_as_float(w << 16); }
__device__ __forceinline__ float bfhi(unsigned w) { return __uint_as_float(w & 0xffff0000u); }

namespace pg8 {
constexpr int BM = 256, BK = 64, HALF = 128, HTB = HALF * BK * 2, STAGE_BYTES = 8 * HTB, NXCD = 8, WGM = 8;
__host__ __device__ __forceinline__ int lds_byte(int r, int c) { const int st = (r >> 4) * 2 + (c >> 5), rr = r & 15, cc = c & 31, ob = rr * 64 + cc * 2; return st * 1024 + (ob ^ (((ob >> 9) & 1) << 5)); }
__host__ __device__ __forceinline__ void stage_rc(int b, int& R, int& C) { const int st = b / 1024, sb = b % 1024, swz = sb ^ (((sb >> 9) & 1) << 5); R = (st >> 1) * 16 + swz / 64; C = (st & 1) * 32 + (swz % 64) / 2; }
__host__ __device__ __forceinline__ int perm32(int rho) { const int n = rho >> 4, i = rho & 15; return 8 * (i >> 2) + 4 * n + (i & 3); }

struct Unit { int pm, pn, par; };
struct Gemm { const bf16_t* A; const bf16_t* Bt; int M, N, K; };

struct StaticOrder {
    int nM, nN, nwg, G, c, wgm;
    __host__ __device__ void init(int M, int N, int G_, int c_, int wgm_ = WGM) { nM = M / BM; nN = N / BM; nwg = nM * nN; G = G_; c = c_; wgm = wgm_; }
    __host__ __device__ bool next(int i, Unit& u) const {
        const long L = (long)i * G + c; if (L >= nwg) return false;
        int wgid = (int)L; { const int q = nwg / NXCD, r = nwg % NXCD, xcd = wgid % NXCD, off = wgid / NXCD; wgid = (xcd < r ? xcd * (q + 1) : r * (q + 1) + (xcd - r) * q) + off; }
        const int nig = wgm * nN, gid = wgid / nig, fm = gid * wgm, gsz = (nM - fm) < wgm ? (nM - fm) : wgm;
        u.pm = fm + ((wgid % nig) % gsz); u.pn = (wgid % nig) / gsz; return true;
    }
    __device__ __forceinline__ void a_ready(const Unit&) const {}
    __device__ __forceinline__ void done(const Unit&) const {}
};

template <class Epi, class Sched, bool ALIGN_EPI, bool PERMA, bool KHOOK, int QM = 0, bool PREF = false>
__device__ __forceinline__ void gemm_phase(LAS unsigned char* lds, const Gemm g, const Sched& S, const Epi& E) {
    constexpr bool FP8 = (QM == 1), I8 = (QM == 2);
    int tid_ = threadIdx.x; asm volatile("" : "+v"(tid_));
    const int tid = tid_, wid = __builtin_amdgcn_readfirstlane(tid >> 6), lane = tid & 63, wr = wid >> 2, wc = wid & 3, fr = lane & 15, fq = lane >> 4;
    const int K = g.K, nt = K / BK;
    unsigned voffA0, voffA1, voffB;
    { int R, C; stage_rc(tid * 16, R, C); const int Rb = (R & ~31) + perm32(R & 31);
        if (PERMA) { const int rw = R >> 6, rm = (R >> 4) & 3, rf = R & 15; voffA0 = (unsigned)((128 * rw + 8 * rf + rm) * K + C) * 2u; voffA1 = (unsigned)((128 * rw + 8 * rf + 4 + rm) * K + C) * 2u; }
        else { voffA0 = (unsigned)(R * K + C) * 2u; voffA1 = voffA0; }
        voffB = (unsigned)(Rb * K + C) * 2u; }
    const size_t pstep_voffA0 = (size_t)(PERMA ? 128 : 64) * K * 2, pstep_voffA1 = pstep_voffA0, pstep_voffB = (size_t)64 * K * 2;
    const size_t kstep = (size_t)(BK * 2);
    const size_t hstep = (size_t)HALF * K * 2;
    const size_t ahs = PERMA ? (size_t)0 : hstep;
    const size_t tstep = 2 * hstep;
    const unsigned ldsw = (unsigned)wid * 1024u;
    const int aoff = lds_byte(wr * 64 + fr, fq * 8), boff = lds_byte(wc * 32 + fr, fq * 8);
#define PG8_SA(b, h) (((b) * 2 + (h)) * HTB)
#define PG8_SB(b, h) ((4 + (b) * 2 + (h)) * HTB)
#define PG8_STAGE(bufoff, gbase, voff) do { _Pragma("unroll") for (int _i = 0; _i < 2; ++_i) { unsigned _v = (voff); asm volatile("" : "+v"(_v));     \
        __builtin_amdgcn_global_load_lds((const unsigned*)((const char*)(gbase) + _i * PG8_PSTEP(voff) + _v), (LAS unsigned*)(lds + (bufoff) + ldsw + _i * 8192), 16, 0, 0); } } while (0)
#define PG8_PSTEP(voff) pstep_##voff
#define PG8_LD8(p) __builtin_shufflevector(*(const LAS v4i32*)(p), *(const LAS v4i32*)((p) + 1024), 0, 1, 2, 3, 4, 5, 6, 7)
#define PG8_LDA(dst, b, h) do { if constexpr (false) { _Pragma("unroll") for (int m = 0; m < 4; ++m) dst##8[m] = PG8_LD8(lds + PG8_SA(b, h) + aoff + m * 2048); } \
        else { _Pragma("unroll") for (int m = 0; m < 4; ++m) _Pragma("unroll") for (int k = 0; k < 2; ++k) dst[m][k] = *(const LAS bf16x8*)(lds + PG8_SA(b, h) + aoff + m * 2048 + k * 1024); } } while (0)
#define PG8_LDB(dst, b, h) do { if constexpr (false) { _Pragma("unroll") for (int n = 0; n < 2; ++n) dst##8[n] = PG8_LD8(lds + PG8_SB(b, h) + boff + n * 2048); } \
        else { _Pragma("unroll") for (int n = 0; n < 2; ++n) _Pragma("unroll") for (int k = 0; k < 2; ++k) dst[n][k] = *(const LAS bf16x8*)(lds + PG8_SB(b, h) + boff + n * 2048 + k * 1024); } } while (0)
#define PG8_CAT(x) __builtin_shufflevector(__builtin_bit_cast(v4i32, (x)[0]), __builtin_bit_cast(v4i32, (x)[1]), 0, 1, 2, 3, 4, 5, 6, 7)
#define PG8_MMA(ai, bj, At, Bt) do { if constexpr (FP8) __builtin_amdgcn_sched_barrier(0); __builtin_amdgcn_s_setprio(1); _Pragma("unroll") for (int m = 0; m < 4; ++m) _Pragma("unroll") for (int n = 0; n < 2; ++n) { \
        if constexpr (FP8) acc[ai][bj][m][n] = __builtin_amdgcn_mfma_scale_f32_16x16x128_f8f6f4(PG8_CAT(Bt[n]), PG8_CAT(At[m]), acc[ai][bj][m][n], 0, 0, 0, 0, 0, 0); \
        else if constexpr (I8) { _Pragma("unroll") for (int k = 0; k < 2; ++k) acc[ai][bj][m][n] = __builtin_bit_cast(f32x4, __builtin_amdgcn_mfma_i32_16x16x64_i8(__builtin_bit_cast(v4i32, Bt[n][k]), __builtin_bit_cast(v4i32, At[m][k]), __builtin_bit_cast(v4i32, acc[ai][bj][m][n]), 0, 0, 0)); } \
        else { _Pragma("unroll") for (int k = 0; k < 2; ++k) acc[ai][bj][m][n] = __builtin_amdgcn_mfma_f32_16x16x32_bf16(Bt[n][k], At[m][k], acc[ai][bj][m][n], 0, 0, 0); } } if constexpr (FP8) __builtin_amdgcn_sched_barrier(0); __builtin_amdgcn_s_setprio(0); if constexpr (FP8) __builtin_amdgcn_sched_barrier(0); } while (0)
#define PG8_WAIT_V(n) asm volatile("s_waitcnt vmcnt(" #n ")" ::: "memory")
#define PG8_WAIT_L(n) asm volatile("s_waitcnt lgkmcnt(" #n ")" ::: "memory")
#define PG8_BAR __builtin_amdgcn_s_barrier()
#define PG8_SCHED __builtin_amdgcn_sched_barrier(0)
    Unit cur, nxt; int ui = 0;
    if (!S.next(0, cur)) return;
    cur.par = 0;
    f32x4 acc[2][2][4][2];
#pragma unroll
    for (int a = 0; a < 2; ++a)
#pragma unroll
        for (int b = 0; b < 2; ++b)
#pragma unroll
            for (int m = 0; m < 4; ++m)
#pragma unroll
                for (int n = 0; n < 2; ++n) acc[a][b][m][n] = (f32x4){0.f, 0.f, 0.f, 0.f};
    bf16x8 At[4][2], B0[2][2], B1[2][2];
    v8i32 At8[4], B08[2], B18[2];
    const char* cA = (const char*)g.A + (size_t)cur.pm * tstep; const char* cB = (const char*)g.Bt + (size_t)cur.pn * tstep;
    S.a_ready(cur);
    PG8_STAGE(PG8_SB(0, 0), cB, voffB); PG8_STAGE(PG8_SB(0, 1), cB + hstep, voffB); PG8_STAGE(PG8_SA(0, 0), cA, voffA0); PG8_STAGE(PG8_SA(0, 1), cA + ahs, voffA1);
    if (wr == 1) PG8_BAR;
    PG8_WAIT_V(2); PG8_BAR;
    PG8_STAGE(PG8_SB(1, 0), cB + kstep, voffB); PG8_STAGE(PG8_SA(1, 0), cA + kstep, voffA0); PG8_STAGE(PG8_SB(1, 1), cB + hstep + kstep, voffB);
    PG8_WAIT_V(6); PG8_BAR;
    for (;;) {
        const bool has_next = S.next(ui + 1, nxt); nxt.par = (ui + 1) & 1;
        const char* nA = has_next ? (const char*)g.A + (size_t)nxt.pm * tstep : cA; const char* nB = has_next ? (const char*)g.Bt + (size_t)nxt.pn * tstep : cB;
        for (int t = 0; t < nt; t += 2) {
            const bool last = (t == nt - 2);
            const char* a1 = cA + (size_t)(t + 1) * kstep;
            const char* a2 = last ? nA : cA + (size_t)(t + 2) * kstep; const char* b2 = last ? nB : cB + (size_t)(t + 2) * kstep;
            const char* a3 = a2 + kstep; const char* b3 = b2 + kstep;
            asm volatile("" : "+s"(a1), "+s"(a2), "+s"(b2), "+s"(a3), "+s"(b3));
            if (last && has_next) S.a_ready(nxt);
            if constexpr (KHOOK) { int l3_ = threadIdx.x; asm volatile("" : "+v"(l3_)); E.khook(acc, cur, t, wr, wc, l3_ & 15, (l3_ >> 4) & 3); }
            PG8_LDB(B0, 0, 0); PG8_LDB(B1, 0, 1); PG8_SCHED; PG8_LDA(At, 0, 0); PG8_STAGE(PG8_SA(1, 1), a1 + ahs, voffA1);
            PG8_WAIT_V(8); PG8_WAIT_L(0); PG8_BAR;
            if constexpr (PREF) { if (t == 0 && wr == 0) E.prefetch(cur, wid); }
            PG8_MMA(0, 0, At, B0); PG8_MMA(0, 1, At, B1); PG8_BAR; PG8_SCHED;
            PG8_LDA(At, 0, 1); PG8_STAGE(PG8_SB(0, 0), b2, voffB); PG8_STAGE(PG8_SB(0, 1), b2 + hstep, voffB); PG8_STAGE(PG8_SA(0, 0), a2, voffA0);
            PG8_WAIT_V(8); PG8_WAIT_L(0); PG8_BAR; PG8_MMA(1, 0, At, B0); PG8_MMA(1, 1, At, B1); PG8_BAR; PG8_SCHED;
            PG8_LDB(B0, 1, 0); PG8_LDB(B1, 1, 1); PG8_SCHED; PG8_LDA(At, 1, 0); PG8_STAGE(PG8_SA(0, 1), a2 + ahs, voffA1);
            PG8_WAIT_V(8); PG8_WAIT_L(0); PG8_BAR; PG8_MMA(0, 0, At, B0); PG8_MMA(0, 1, At, B1); PG8_BAR; PG8_SCHED;
            PG8_LDA(At, 1, 1); PG8_STAGE(PG8_SB(1, 0), b3, voffB); PG8_STAGE(PG8_SB(1, 1), b3 + hstep, voffB); PG8_STAGE(PG8_SA(1, 0), a3, voffA0);
            PG8_WAIT_V(8); PG8_WAIT_L(0); PG8_BAR; PG8_MMA(1, 0, At, B0); PG8_MMA(1, 1, At, B1); PG8_BAR; PG8_SCHED;
        }
        if constexpr (ALIGN_EPI) { if (wr == 0) PG8_BAR; }
        { int l2_ = threadIdx.x; asm volatile("" : "+v"(l2_)); const int fr2 = l2_ & 15, fq2 = (l2_ >> 4) & 3;
          if (!E.skip) E(acc, cur, wr, wc, fr2, fq2); } S.done(cur);
        if (!has_next) break;
#pragma unroll
        for (int a = 0; a < 2; ++a)
#pragma unroll
            for (int b = 0; b < 2; ++b)
#pragma unroll
                for (int m = 0; m < 4; ++m)
#pragma unroll
                    for (int n = 0; n < 2; ++n) acc[a][b][m][n] = (f32x4){0.f, 0.f, 0.f, 0.f};
        cur = nxt; cA = nA; cB = nB; ++ui;
        if constexpr (ALIGN_EPI) { if (wr == 1) PG8_BAR; }
    }
    PG8_WAIT_V(0);
    if constexpr (!ALIGN_EPI) { if (wr == 0) PG8_BAR; }
    PG8_BAR;
#undef PG8_SA
#undef PG8_SB
#undef PG8_STAGE
#undef PG8_PSTEP
#undef PG8_LDA
#undef PG8_LDB
#undef PG8_MMA
#undef PG8_CAT
#undef PG8_LD8
#undef PG8_WAIT_V
#undef PG8_WAIT_L
#undef PG8_BAR
#undef PG8_SCHED
}
}

constexpr size_t MiB = 1u << 20;
constexpr size_t WS_CTL = 0, CTL_ZERO_BYTES = 1 * MiB;
constexpr size_t WS_WO = 1 * MiB;
constexpr size_t WS_WOUT = 4 * MiB;
constexpr size_t WS_WUP = 6 * MiB;
constexpr size_t WS_WDOWN = 17 * MiB;
constexpr size_t WS_SSQ = 23 * MiB;
constexpr size_t WS_UE = 24 * MiB;
constexpr size_t WS_UF = 27 * MiB;
constexpr size_t WS_LSE = 30 * MiB;
constexpr size_t WS_MKV = 31 * MiB;
constexpr size_t WS_G = 34 * MiB;
constexpr size_t WS_A1I8 = 84 * MiB;
constexpr size_t WS_RSC = 23 * MiB;
constexpr size_t WS_CMAX = 23 * MiB + 128 * 1024;
constexpr size_t WS_ACT = 34 * MiB;
constexpr size_t WS_QA = 130 * MiB;
constexpr size_t WS_KA = 154 * MiB;
constexpr size_t WS_VA = 178 * MiB;
constexpr size_t WS_MERGED = 130 * MiB;
constexpr size_t WS_X1B = 162 * MiB;
constexpr size_t WS_X1L = 194 * MiB;
constexpr size_t WS_QB = 202 * MiB;
constexpr size_t WS_KVB = 218 * MiB;
constexpr size_t WS_MQ = 226 * MiB;
constexpr size_t WS_END = 242 * MiB;
constexpr size_t DO_WI8 = 34 * MiB;
constexpr size_t DO_ROPE = 49 * MiB;
constexpr size_t DO_OCAT = 0;
constexpr size_t DO_OAG = 40 * MiB;

constexpr int CW_TMO = 0, CW_BAR = 4096;

constexpr int RING_OFF = 0, RING_BYTES = 131072;
constexpr int XCH_OFF = RING_BYTES;
constexpr int LDSCTL_OFF = RING_BYTES + 4096, MISC_OFF = LDSCTL_OFF + 320;
constexpr int LDS_BYTES = 147456;
constexpr int P1T_ROPE = 131072, P1T_CS = 139264, P1T_BIAS = 140288, P1T_RSC = 141312, P1T_GAIN = 142336;
constexpr int CTAB_OFF = 139264;
constexpr int NWAVES = 8;
constexpr int NPHASES = 8;

typedef GAS unsigned gu32;
#define RLX_AGENT __ATOMIC_RELAXED, __HIP_MEMORY_SCOPE_AGENT
#define LDS_WAIT() asm volatile("s_waitcnt lgkmcnt(0)" ::: "memory")
#define VM_WAIT() asm volatile("s_waitcnt vmcnt(0)" ::: "memory")

#define XB_TMO      128
#define XB_XCNT(j)  (256  + 64 * (j))
#define XB_XSUB(j)  (1280 + 64 * (j))
#define XB_XGEN(j)  (2304 + 64 * (j))
#define XB_TOP      3328
#define XB_TOPGEN   3392
#define XCD_BAR_WORDS 3456
#define XB_SPIN_CAP (1u << 18)
__device__ __forceinline__ unsigned xb_ld(unsigned* p)              { return __hip_atomic_load(p, __ATOMIC_RELAXED, __HIP_MEMORY_SCOPE_AGENT); }
__device__ __forceinline__ unsigned xb_add(unsigned* p, unsigned v) { return __hip_atomic_fetch_add(p, v, __ATOMIC_RELAXED, __HIP_MEMORY_SCOPE_AGENT); }
__device__ __forceinline__ unsigned xb_xcc_id() { return (unsigned)__builtin_amdgcn_s_getreg((3 << 11) | 20) & 0xFu; }
#define XB_SPIN(cond, bar) do { unsigned _sp = 0; while (cond) { __builtin_amdgcn_s_sleep(1); \
    if ((++_sp & 255u) == 0u) { if (xb_ld(&(bar)[XB_TMO])) break; if (_sp > XB_SPIN_CAP) { atomicAdd(&(bar)[XB_TMO], 1u); break; } } } } while (0)
__device__ unsigned g_barrier_words[2 * XCD_BAR_WORDS];
struct XcdBarrier { unsigned* bar; unsigned x, nloc, nx; };
__device__ __forceinline__ void xcd_barrier(const XcdBarrier& b) {
    asm volatile("s_waitcnt vmcnt(0)" ::: "memory");
    __syncthreads();
    if (threadIdx.x == 0) {
        unsigned* bar = b.bar;
        __builtin_amdgcn_s_waitcnt(0);
        const unsigned nloc = b.nloc, nx = b.nx;
        const unsigned old = xb_add(&bar[XB_XSUB(b.x)], 1u);
        const unsigned gen = old / nloc;
        if (old + 1u == (gen + 1u) * nloc) {
            __builtin_amdgcn_fence(__ATOMIC_RELEASE, "agent");
            asm volatile("s_waitcnt vmcnt(0)" ::: "memory");
            const unsigned og = xb_add(&bar[XB_TOP], 1u);
            const unsigned tg = og / nx;
            if (og + 1u == (tg + 1u) * nx) xb_add(&bar[XB_TOPGEN], 1u);
            else XB_SPIN(xb_ld(&bar[XB_TOPGEN]) == tg, bar);
            __builtin_amdgcn_fence(__ATOMIC_ACQUIRE, "agent");
            xb_add(&bar[XB_XGEN(b.x)], 1u);
            asm volatile("s_waitcnt vmcnt(0)" ::: "memory");
        } else {
            XB_SPIN(xb_ld(&bar[XB_XGEN(b.x)]) == gen, bar);
            __builtin_amdgcn_fence(__ATOMIC_ACQUIRE, "agent");
            asm volatile("s_waitcnt vmcnt(0)" ::: "memory");
        }
    }
    __syncthreads();
}

struct Args {
    const float* in[25]; float* out; unsigned char* ws; int ph_lo, ph_hi, li, pad;
};
enum { I_X = 0, I_MEM, I_POS, I_ATTN_NORM, I_W_IN, I_AQ, I_AK, I_BQ, I_BK, I_SINK, I_MEM_NORM, I_W_MKV, I_MQN, I_MKN, I_WOA, I_WOB, I_WOM, I_WGATE, I_BGATE, I_WOUT, I_FFN_NORM, I_WUP, I_CONVW, I_CONVB, I_WDOWN };

__host__ __device__ __forceinline__ int map_uniform(int n) { const int c = n & 255; return (n & ~255) + 128 * ((c >> 5) & 1) + 32 * (c >> 6) + (c & 31); }
__host__ __device__ __forceinline__ int map_up(int n) { return n < DFF_ ? 256 * (n >> 7) + (n & 127) : 256 * ((n - DFF_) >> 7) + 128 + ((n - DFF_) & 127); }

__device__ __forceinline__ float wave_sum(float v) {
#pragma unroll
    for (int o = 1; o < 64; o <<= 1) v += __shfl_xor(v, o);
    return v;
}
template <int MAP>
__device__ __forceinline__ void p0_transpose_item(const float* W, int K, int N, bf16_t* WT, int noff, int pitch, int koff, const float* kscale, LAS float*  , int item, int lane) {
    const int nblk = N / 32, kb = item / nblk, nb = item % nblk, k0 = 64 * kb + 8 * (lane >> 3), n0 = 32 * nb;
    f32x4 v[8];
#pragma unroll
    for (int i = 0; i < 8; ++i) v[i] = *(const f32x4*)(W + (size_t)(k0 + i) * N + n0 + 4 * (lane & 7));
    if (kscale) { const f32x4 s0 = *(const f32x4*)(kscale + k0), s1 = *(const f32x4*)(kscale + k0 + 4);
#pragma unroll
        for (int i = 0; i < 8; ++i) v[i] = v[i] * (i < 4 ? s0[i & 3] : s1[i & 3]); }
    const int r0 = (MAP == 0 ? map_uniform(noff + n0) : map_up(noff + n0)) + 4 * (lane & 7);
#pragma unroll
    for (int e = 0; e < 4; ++e) { u32x4 o; o.x = cvtpk(v[0][e], v[1][e]); o.y = cvtpk(v[2][e], v[3][e]); o.z = cvtpk(v[4][e], v[5][e]); o.w = cvtpk(v[6][e], v[7][e]);
        *(GAS u32x4*)(WT + (size_t)(r0 + e) * pitch + koff + k0 + 0) = o; }
}
constexpr float I8MAGIC = 12582912.0f;
__device__ __forceinline__ unsigned pack_i8(float m0, float m1, float m2, float m3) {
    const unsigned p01 = __builtin_amdgcn_perm(__float_as_uint(m1), __float_as_uint(m0), 0x0c0c0400u);
    const unsigned p23 = __builtin_amdgcn_perm(__float_as_uint(m3), __float_as_uint(m2), 0x0c0c0400u);
    return p01 | (p23 << 16);
}
__device__ __forceinline__ float wave_max(float v) {
#pragma unroll
    for (int o = 1; o < 64; o <<= 1) v = fmaxf(v, __shfl_xor(v, o));
    return v;
}
__device__ __forceinline__ void p0_quant_weight_block(const float* W, int N, int nb, int coff, unsigned char* WT, float* cmax, LAS float* part, int wave, int lane) {
    const int n0 = 32 * nb;
    f32x4 v[2][8];
#pragma unroll
    for (int it = 0; it < 2; ++it) { const int k0 = 128 * wave + 64 * it + 8 * (lane >> 3);
#pragma unroll
        for (int i = 0; i < 8; ++i) v[it][i] = *(const f32x4*)(W + (size_t)(k0 + i) * N + n0 + 4 * (lane & 7)); }
    f32x4 mx = {0.f, 0.f, 0.f, 0.f};
#pragma unroll
    for (int it = 0; it < 2; ++it)
#pragma unroll
        for (int i = 0; i < 8; ++i)
#pragma unroll
            for (int e = 0; e < 4; ++e) mx[e] = fmaxf(mx[e], fabsf(v[it][i][e]));
#pragma unroll
    for (int o = 8; o < 64; o <<= 1)
#pragma unroll
        for (int e = 0; e < 4; ++e) mx[e] = fmaxf(mx[e], __shfl_xor(mx[e], o));
    if (lane < 8) *(LAS f32x4*)(part + wave * 32 + 4 * lane) = mx;
    __syncthreads();
    f32x4 cm = *(const LAS f32x4*)(part + 4 * (lane & 7));
#pragma unroll
    for (int w = 1; w < 8; ++w) { const f32x4 o = *(const LAS f32x4*)(part + w * 32 + 4 * (lane & 7));
#pragma unroll
        for (int e = 0; e < 4; ++e) cm[e] = fmaxf(cm[e], o[e]); }
    if (wave == 0 && lane < 8) *(f32x4*)(cmax + coff + n0 + 4 * lane) = cm;
    f32x4 inv;
#pragma unroll
    for (int e = 0; e < 4; ++e) inv[e] = cm[e] > 0.f ? 127.0f / cm[e] : 0.f;
    const int r0 = map_uniform(coff + n0) + 4 * (lane & 7);
#pragma unroll
    for (int it = 0; it < 2; ++it) { const int k0 = 128 * wave + 64 * it + 8 * (lane >> 3);
#pragma unroll
        for (int e = 0; e < 4; ++e) { u32x2 o;
            o.x = pack_i8(__builtin_fmaf(v[it][0][e], inv[e], I8MAGIC), __builtin_fmaf(v[it][1][e], inv[e], I8MAGIC), __builtin_fmaf(v[it][2][e], inv[e], I8MAGIC), __builtin_fmaf(v[it][3][e], inv[e], I8MAGIC));
            o.y = pack_i8(__builtin_fmaf(v[it][4][e], inv[e], I8MAGIC), __builtin_fmaf(v[it][5][e], inv[e], I8MAGIC), __builtin_fmaf(v[it][6][e], inv[e], I8MAGIC), __builtin_fmaf(v[it][7][e], inv[e], I8MAGIC));
            *(GAS u32x2*)(WT + (size_t)(r0 + e) * 1024 + k0) = o; } }
    __syncthreads();
}
template <int NR>
__device__ __forceinline__ void rms_rows_to_i8(const float* xrow, size_t rstride, const float* gain, unsigned char* orow, float* rsc, int lane) {
    const GAS f32x4* gr = (const GAS f32x4*)gain + lane;
    f32x4 v[NR][4]; float s[NR], mx[NR];
#pragma unroll
    for (int r = 0; r < NR; ++r) { const GAS f32x4* xr = (const GAS f32x4*)(xrow + r * rstride) + lane;
#pragma unroll
        for (int j = 0; j < 4; ++j) v[r][j] = xr[64 * j]; }
    f32x4 g[4];
#pragma unroll
    for (int j = 0; j < 4; ++j) g[j] = gr[64 * j];
#pragma unroll
    for (int r = 0; r < NR; ++r) { s[r] = 0.f;
#pragma unroll
        for (int j = 0; j < 4; ++j) s[r] += (v[r][j].x * v[r][j].x + v[r][j].y * v[r][j].y) + (v[r][j].z * v[r][j].z + v[r][j].w * v[r][j].w); }
#pragma unroll
    for (int r = 0; r < NR; ++r) { const float rstd = 1.0f / sqrtf(wave_sum(s[r]) * (1.f / 1024.f) + EPS_); mx[r] = 0.f;
#pragma unroll
        for (int j = 0; j < 4; ++j) { v[r][j] = v[r][j] * rstd * g[j];
            mx[r] = fmaxf(fmaxf(mx[r], fmaxf(fabsf(v[r][j].x), fabsf(v[r][j].y))), fmaxf(fabsf(v[r][j].z), fabsf(v[r][j].w))); } }
#pragma unroll
    for (int r = 0; r < NR; ++r) mx[r] = wave_max(mx[r]);
#pragma unroll
    for (int r = 0; r < NR; ++r) { const float inv = mx[r] > 0.f ? 127.0f / mx[r] : 0.f;
        GAS unsigned* o4 = (GAS unsigned*)(orow + r * rstride) + lane;
#pragma unroll
        for (int j = 0; j < 4; ++j) o4[64 * j] = pack_i8(__builtin_fmaf(v[r][j].x, inv, I8MAGIC), __builtin_fmaf(v[r][j].y, inv, I8MAGIC), __builtin_fmaf(v[r][j].z, inv, I8MAGIC), __builtin_fmaf(v[r][j].w, inv, I8MAGIC));
        if (lane == 0) rsc[r] = mx[r] * (1.0f / 127.0f); }
}
__device__ __forceinline__ void sincos_f(float ang, float& co, float& si) {
    const double x = (double)ang; const double n = __builtin_rint(x * 0.63661977236758134308);
    double r = __builtin_fma(-n, 1.5707963267948966192, x); r = __builtin_fma(-n, 6.123233995736766036e-17, r);
    const double r2 = r * r;
    double s = -1.0 / 6227020800.0; s = s * r2 + 1.0 / 39916800.0; s = s * r2 - 1.0 / 362880.0; s = s * r2 + 1.0 / 5040.0; s = s * r2 - 1.0 / 120.0; s = s * r2 + 1.0 / 6.0; s = r - r * r2 * s;
    double c = 1.0 / 479001600.0; c = c * r2 - 1.0 / 3628800.0; c = c * r2 + 1.0 / 40320.0; c = c * r2 - 1.0 / 720.0; c = c * r2 + 1.0 / 24.0; c = c * r2 - 0.5; c = c * r2 + 1.0;
    const int q = (int)((long long)n & 3);
    const double cs = (q == 0) ? c : (q == 1) ? -s : (q == 2) ? -c : s;
    const double sn = (q == 0) ? s : (q == 1) ? c : (q == 2) ? -s : -c;
    co = (float)cs; si = (float)sn;
}

struct Frame {
    LAS unsigned char* lds;
    int tid, lane, wave, vcu, G;
    const Args* a;
};

__device__ __forceinline__ void p0_prologue(const Args& A, LAS unsigned char* lds, int vcu, int G, int wave, int lane) {
    const int gw = vcu * NWAVES + wave, NGW = G * NWAVES;
    unsigned char* wi8 = (unsigned char*)A.out + DO_WI8;
    unsigned char* a1 = A.ws + WS_A1I8;
    float* rsc = (float*)(A.ws + WS_RSC); float* cmax = (float*)(A.ws + WS_CMAX);
    unsigned* rope = (unsigned*)((unsigned char*)A.out + DO_ROPE);
    constexpr int B_IN = 3584 / 32, B_GATE = 3072 / 32, B_MKV = 1024 / 32;
    for (int it = vcu; it < B_IN + B_GATE + B_MKV; it += G) {
        LAS float* part = (LAS float*)(lds + RING_OFF);
        if (it < B_IN) p0_quant_weight_block(A.in[I_W_IN], 3584, it, 0, wi8, cmax, part, wave, lane);
        else if (it < B_IN + B_GATE) p0_quant_weight_block(A.in[I_WGATE], 3072, it - B_IN, 3584, wi8, cmax, part, wave, lane);
        else p0_quant_weight_block(A.in[I_W_MKV], 1024, it - B_IN - B_GATE, 6656, wi8, cmax, part, wave, lane);
    }
    for (int m = 4 * gw; m < T_ + NB_ * MEM_; m += 4 * NGW) {
        if (m < T_) rms_rows_to_i8<4>(A.in[I_X] + (size_t)m * DM_, DM_, A.in[I_ATTN_NORM], a1 + (size_t)m * DM_, rsc + m, lane);
        else rms_rows_to_i8<4>(A.in[I_MEM] + (size_t)(m - T_) * DM_, DM_, A.in[I_MEM_NORM], a1 + (size_t)m * DM_, rsc + m, lane);
    }
    const int* pos = (const int*)A.in[I_POS];
    for (int idx = gw * 64 + lane; idx < T_ * 8; idx += NGW * 64) {
        const int t = idx >> 3, i = idx & 7;
        const float fr = (i == 0) ? 1.0f : (i == 1) ? 0.193922758102417f : (i == 2) ? 0.03760603442788124f : (i == 3) ? 0.007292666472494602f : (i == 4) ? 0.0014142136787995696f
                       : (i == 5) ? 0.00027424818836152554f : (i == 6) ? 5.318298644851893e-05f : 1.031338433676865e-05f;
        const float ang = (float)pos[t] * fr; float co, si; sincos_f(ang, co, si);
        rope[idx] = (unsigned)__builtin_bit_cast(unsigned short, (_Float16)co) | ((unsigned)__builtin_bit_cast(unsigned short, (_Float16)si) << 16);
    }
}

struct TItem { const float* W; bf16_t* WT; const float* kscale; int N, noff, pitch, koff, map, item; };
__device__ __forceinline__ void ti_load(const TItem& d, int lane, f32x4 (&v)[8], f32x4 (&sc)[2]) {
    const int nblk = d.N / 32, kb = d.item / nblk, nb = d.item % nblk, k0 = 64 * kb + 8 * (lane >> 3), n0 = 32 * nb;
#pragma unroll
    for (int i = 0; i < 8; ++i) v[i] = *(const f32x4*)(d.W + (size_t)(k0 + i) * d.N + n0 + 4 * (lane & 7));
    if (d.kscale) { sc[0] = *(const f32x4*)(d.kscale + k0); sc[1] = *(const f32x4*)(d.kscale + k0 + 4); }
}
__device__ __forceinline__ void ti_store(const TItem& d, int lane, f32x4 (&v)[8], const f32x4 (&sc)[2]) {
    const int nblk = d.N / 32, kb = d.item / nblk, nb = d.item % nblk, k0 = 64 * kb + 8 * (lane >> 3), n0 = 32 * nb;
    if (d.kscale) {
#pragma unroll
        for (int i = 0; i < 8; ++i) v[i] = v[i] * (i < 4 ? sc[0][i & 3] : sc[1][i & 3]); }
    const int r0 = (d.map == 0 ? map_uniform(d.noff + n0) : map_up(d.noff + n0)) + 4 * (lane & 7);
#pragma unroll
    for (int e = 0; e < 4; ++e) { u32x4 o; o.x = cvtpk(v[0][e], v[1][e]); o.y = cvtpk(v[2][e], v[3][e]); o.z = cvtpk(v[4][e], v[5][e]); o.w = cvtpk(v[6][e], v[7][e]);
        *(GAS u32x4*)(d.WT + (size_t)(r0 + e) * d.pitch + d.koff + k0) = o; }
}
template <int PART>
__device__ __forceinline__ bool late_item(const Args& A, int it, TItem& d) {
    constexpr int I_OA = (256 / 64) * (1024 / 32), I_OB = (512 / 64) * (1024 / 32), I_OM = I_OB, I_OUT = (1024 / 64) * (1024 / 32);
    constexpr int I_UP = (1024 / 64) * (5632 / 32), I_DOWN = (2816 / 64) * (1024 / 32);
    bf16_t* wo = (bf16_t*)(A.ws + WS_WO);
    if (PART == 1) { if (it >= I_DOWN) return false; d = TItem{A.in[I_WDOWN], (bf16_t*)(A.ws + WS_WDOWN), nullptr, 1024, 0, 2816, 0, 0, it}; return true; }
    int r = it;
    if (r < I_OA) { d = TItem{A.in[I_WOA], wo, nullptr, 1024, 0, KCAT, 0, 0, r}; return true; } r -= I_OA;
    if (r < I_OB) { d = TItem{A.in[I_WOB], wo, nullptr, 1024, 0, KCAT, 256, 0, r}; return true; } r -= I_OB;
    if (r < I_OM) { d = TItem{A.in[I_WOM], wo, nullptr, 1024, 0, KCAT, 768, 0, r}; return true; } r -= I_OM;
    if (r < I_OUT) { d = TItem{A.in[I_WOUT], (bf16_t*)(A.ws + WS_WOUT), nullptr, 1024, 0, 1024, 0, 0, r}; return true; } r -= I_OUT;
    if (r < I_UP) { d = TItem{A.in[I_WUP], (bf16_t*)(A.ws + WS_WUP), A.in[I_FFN_NORM], 5632, 0, 1024, 0, 1, r}; return true; }
    return false;
}
template <int PART>
__device__ __forceinline__ void p0_late_weights(const Args& A, int gw, int ngw, int lane) {
    constexpr int NB = 3;
    for (int it = gw; ; it += NB * ngw) {
        TItem d[NB]; bool ok[NB]; f32x4 v[NB][8], sc[NB][2];
#pragma unroll
        for (int b = 0; b < NB; ++b) { ok[b] = late_item<PART>(A, it + b * ngw, d[b]); if (ok[b]) ti_load(d[b], lane, v[b], sc[b]); }
        if (!ok[0]) break;
#pragma unroll
        for (int b = 0; b < NB; ++b) if (ok[b]) ti_store(d[b], lane, v[b], sc[b]);
    }
}

struct TileOrder {
    pg8::StaticOrder so; unsigned mask; int mkv;
    __device__ void init(unsigned mask_, int mkv_, int G, int c) { mask = mask_; mkv = mkv_; so.init(T_, 256 * __builtin_popcount(mask_), G, c, 4); }
    __device__ bool next(int i, pg8::Unit& u) const {
        if (so.next(i, u)) { const int k = u.pn; const unsigned long long tb = k < 12 ? 0xa48a2524e620c20ull : k < 24 ? 0xcaef6ace0e6e188ull : 0x22full; u.pn = (int)((tb >> (5 * (k % 12))) & 31ull); return true; }
        if (!mkv) return false;
        const long L = (long)i * so.G + so.c - so.nwg; if (L < 0 || L >= 16) return false;
        u.pm = 64 + (int)(L >> 2); u.pn = 26 + (int)(L & 3); return true;
    }
    __device__ __forceinline__ void a_ready(const pg8::Unit&) const {}
    __device__ __forceinline__ void done(const pg8::Unit&) const {}
};

__device__ __forceinline__ f32x4 cvt_i32(const f32x4& a) { const v4i32 i = __builtin_bit_cast(v4i32, a); return (f32x4){(float)i[0], (float)i[1], (float)i[2], (float)i[3]}; }

__device__ __forceinline__ float h2f_lo(unsigned w) { return (float)__builtin_bit_cast(_Float16, (unsigned short)(w & 0xffffu)); }
__device__ __forceinline__ float h2f_hi(unsigned w) { return (float)__builtin_bit_cast(_Float16, (unsigned short)(w >> 16)); }

struct EpiG {
    static constexpr bool PERM = true;
    unsigned char* G; LAS const unsigned char* lds;
    bool skip = false;
    __device__ __forceinline__ void operator()(const f32x4 (&acc)[2][2][4][2], const pg8::Unit& u, int wr, int wc, int fr, int fq) const {
        const int col0 = u.pn * 256, row0 = u.pm * 256;
        f32x4 bv[2][2], cs[2][2];
#pragma unroll
        for (int bj = 0; bj < 2; ++bj)
#pragma unroll
            for (int n = 0; n < 2; ++n) { const int j = wc * 64 + 32 * bj + 8 * fq + 4 * n; bv[bj][n] = *(LAS const f32x4*)(lds + P1T_BIAS + 4 * j) * (-LOG2E); cs[bj][n] = *(LAS const f32x4*)(lds + P1T_CS + 4 * j) * (-LOG2E / 127.0f); }
        float rsv[2][4];
#pragma unroll
        for (int ai = 0; ai < 2; ++ai)
#pragma unroll
            for (int m = 0; m < 4; ++m) rsv[ai][m] = *(LAS const float*)(lds + P1T_RSC + 4 * (ai * 128 + wr * 64 + m * 16 + fr));
#pragma unroll
        for (int ai = 0; ai < 2; ++ai)
#pragma unroll
            for (int m = 0; m < 4; ++m) { unsigned char* rowp = G + (size_t)(row0 + ai * 128 + wr * 64 + m * 16 + fr) * 3072 + col0 + wc * 64 + 8 * fq;
#pragma unroll
                for (int bj = 0; bj < 2; ++bj) { u32x2 w;
#pragma unroll
                    for (int n = 0; n < 2; ++n) { const f32x4 z = (cvt_i32(acc[ai][bj][m][n]) * rsv[ai][m]) * cs[bj][n] + bv[bj][n]; unsigned q[4];
#pragma unroll
                        for (int e = 0; e < 4; ++e) { const float g = __builtin_amdgcn_rcpf(1.0f + __builtin_amdgcn_exp2f(z[e])); const unsigned qi = (unsigned)(g * 255.0f + 0.5f); q[e] = qi < 1u ? 1u : qi; }
                        w[n] = q[0] | (q[1] << 8) | (q[2] << 16) | (q[3] << 24); }
                    *(u32x2*)(rowp + 32 * bj) = w; } }
    }
};

struct Epi1 {
    static constexpr bool PERM = true;
    unsigned char* ws; const unsigned* rope; const float *aq, *ak, *bq, *bk, *bgate; const float* rsc; const float* cmax; LAS unsigned char* lds;
    bool skip = false;
    __device__ __forceinline__ void prefetch(const pg8::Unit& u, int w) const {
        int lane = threadIdx.x; asm volatile("" : "+v"(lane)); lane &= 63;
        const int pn = u.pn, pm = u.pm;
        if (pm < 64 && pn < 12) {
#pragma unroll
            for (int j = 0; j < 2; ++j) { const int piece = 2 * w + j;
                __builtin_amdgcn_global_load_lds((const unsigned*)((const char*)rope + (size_t)pm * 8192 + piece * 1024 + lane * 16), (LAS unsigned*)(lds + P1T_ROPE + piece * 1024), 16, 0, 0); }
        }
        if (w == 0) __builtin_amdgcn_global_load_lds((const unsigned*)(cmax + pn * 256 + lane * 4), (LAS unsigned*)(lds + P1T_CS), 16, 0, 0);
        else if (w == 1) { if (pn >= 14 && pn < 26) __builtin_amdgcn_global_load_lds((const unsigned*)(bgate + (pn - 14) * 256 + lane * 4), (LAS unsigned*)(lds + P1T_BIAS), 16, 0, 0); }
        else if (w == 2) __builtin_amdgcn_global_load_lds((const unsigned*)(rsc + pm * 256 + lane * 4), (LAS unsigned*)(lds + P1T_RSC), 16, 0, 0);
        else if (pn < 12) { const int gi = pn / 3, ty = pn - 3 * gi;
            const float* gp = (pn >= 11) ? bk : (pn >= 9) ? bq : (ty == 0) ? aq + 64 * gi : ak + 64 * gi;
            if (lane < 16) __builtin_amdgcn_global_load_lds((const unsigned*)(gp + lane * 4), (LAS unsigned*)(lds + P1T_GAIN), 16, 0, 0); }
    }
    __device__ __forceinline__ void plain(const f32x4 (&acc)[2][2][4][2], bf16_t* dst, int ld, int col0, int row0, int wr, int wc, int fr, int fq) const {
        f32x4 cs[2][2];
#pragma unroll
        for (int bj = 0; bj < 2; ++bj)
#pragma unroll
            for (int n = 0; n < 2; ++n) cs[bj][n] = *(LAS const f32x4*)(lds + P1T_CS + 4 * (wc * 64 + 32 * bj + 8 * fq + 4 * n)) * (1.0f / 127.0f);
        float rsv[2][4];
#pragma unroll
        for (int ai = 0; ai < 2; ++ai)
#pragma unroll
            for (int m = 0; m < 4; ++m) rsv[ai][m] = *(LAS const float*)(lds + P1T_RSC + 4 * (ai * 128 + wr * 64 + m * 16 + fr));
#pragma unroll
        for (int ai = 0; ai < 2; ++ai)
#pragma unroll
            for (int m = 0; m < 4; ++m) { bf16_t* rowp = dst + (size_t)(row0 + ai * 128 + wr * 64 + m * 16 + fr) * ld + col0 + wc * 64 + 8 * fq;
#pragma unroll
                for (int bj = 0; bj < 2; ++bj) { const f32x4 v0 = cvt_i32(acc[ai][bj][m][0]) * rsv[ai][m] * cs[bj][0], v1 = cvt_i32(acc[ai][bj][m][1]) * rsv[ai][m] * cs[bj][1];
                    u32x4 w; w.x = cvtpk(v0[0], v0[1]); w.y = cvtpk(v0[2], v0[3]); w.z = cvtpk(v1[0], v1[1]); w.w = cvtpk(v1[2], v1[3]);
                    *(u32x4*)(rowp + 32 * bj) = w; } }
    }
    __device__ __forceinline__ void normed(const f32x4 (&acc)[2][2][4][2], bf16_t* dst, int ld, int col0, int row0, float scale, int wr, int wc, int fr, int fq) const {
        f32x4 g[2][2], cs[2][2];
#pragma unroll
        for (int bj = 0; bj < 2; ++bj)
#pragma unroll
            for (int n = 0; n < 2; ++n) { g[bj][n] = *(LAS const f32x4*)(lds + P1T_GAIN + 4 * (32 * bj + 8 * fq + 4 * n)) * scale; cs[bj][n] = *(LAS const f32x4*)(lds + P1T_CS + 4 * (wc * 64 + 32 * bj + 8 * fq + 4 * n)) * (1.0f / 127.0f); }
#pragma unroll
        for (int aim = 0; aim < 4; ++aim) {
            const int ai = aim >> 1;
            u32x4 rw[2][2]; float rsv[2];
#pragma unroll
            for (int mm = 0; mm < 2; ++mm) { const int tr = ai * 128 + wr * 64 + (2 * (aim & 1) + mm) * 16 + fr; rsv[mm] = *(LAS const float*)(lds + P1T_RSC + 4 * tr);
#pragma unroll
                for (int n = 0; n < 2; ++n) rw[mm][n] = *(LAS const u32x4*)(lds + P1T_ROPE + 32 * tr + 16 * n); }
#pragma unroll
            for (int mm = 0; mm < 2; ++mm) { const int m = 2 * (aim & 1) + mm;
                const int row = row0 + ai * 128 + wr * 64 + m * 16 + fr;
                f32x4 v[2][2];
                float ss = 0.f;
#pragma unroll
                for (int bj = 0; bj < 2; ++bj)
#pragma unroll
                    for (int n = 0; n < 2; ++n) { const f32x4 x = cvt_i32(acc[ai][bj][m][n]) * cs[bj][n]; v[bj][n] = x; ss += (x[0] * x[0] + x[1] * x[1]) + (x[2] * x[2] + x[3] * x[3]); }
                ss += xor16(ss); ss = sum_halves(ss);
                const float rq = rsv[mm];
                const float rs = rq / sqrtf(ss * (rq * rq * (1.f / 64.f)) + EPS_);
#pragma unroll
                for (int bj = 0; bj < 2; ++bj)
#pragma unroll
                    for (int n = 0; n < 2; ++n) v[bj][n] = v[bj][n] * rs * g[bj][n];
#pragma unroll
                for (int n = 0; n < 2; ++n) {
                    const u32x4 cw = rw[mm][n];
                    const f32x4 co = {h2f_lo(cw[0]), h2f_lo(cw[1]), h2f_lo(cw[2]), h2f_lo(cw[3])}, si = {h2f_hi(cw[0]), h2f_hi(cw[1]), h2f_hi(cw[2]), h2f_hi(cw[3])};
                    f32x4 pr;
#pragma unroll
                    for (int e = 0; e < 4; ++e) pr[e] = xor16(v[0][n][e]);
                    const f32x4 r0 = v[0][n] * co - pr * si, r1 = v[0][n] * co + pr * si;
                    v[0][n] = (fq == 0) ? r0 : (fq == 1) ? r1 : v[0][n];
                }
                bf16_t* rowp = dst + (size_t)row * ld + col0 + wc * 64 + 8 * fq;
#pragma unroll
                for (int bj = 0; bj < 2; ++bj) { u32x4 w; w.x = cvtpk(v[bj][0][0], v[bj][0][1]); w.y = cvtpk(v[bj][0][2], v[bj][0][3]); w.z = cvtpk(v[bj][1][0], v[bj][1][1]); w.w = cvtpk(v[bj][1][2], v[bj][1][3]);
                    *(u32x4*)(rowp + 32 * bj) = w; }
            }
        }
    }
    __device__ __forceinline__ void operator()(const f32x4 (&acc)[2][2][4][2], const pg8::Unit& u, int wr, int wc, int fr, int fq) const {
        const int pn = u.pn, row0 = u.pm * 256;
        if (pn >= 26) { plain(acc, (bf16_t*)(ws + WS_MKV), 1024, (pn - 26) * 256, row0 - T_, wr, wc, fr, fq); return; }
        if (pn >= 14) { EpiG eg{ws + WS_G, lds}; pg8::Unit ug{u.pm, pn - 14}; eg(acc, ug, wr, wc, fr, fq); return; }
        if (pn >= 12) { plain(acc, (bf16_t*)(ws + WS_MQ), 512, (pn - 12) * 256, row0, wr, wc, fr, fq); return; }
        if (pn == 11) {
            if (wc >= 2) plain(acc, (bf16_t*)(ws + WS_KVB), 256, 0, row0, wr, wc, fr, fq);
            else normed(acc, (bf16_t*)(ws + WS_KVB), 256, 0, row0, 1.0f, wr, wc, fr, fq);
            return;
        }
        if (pn >= 9) { normed(acc, (bf16_t*)(ws + WS_QB), 512, (pn - 9) * 256, row0, QSCALE64, wr, wc, fr, fq); return; }
        const int gi = pn / 3, ty = pn - 3 * gi;
        if (ty == 2) { plain(acc, (bf16_t*)(ws + WS_VA) + (size_t)gi * T_ * 256, 256, 0, row0, wr, wc, fr, fq); return; }
        if (ty == 0) normed(acc, (bf16_t*)(ws + WS_QA) + (size_t)gi * T_ * 256, 256, 0, row0, QSCALE64, wr, wc, fr, fq);
        else normed(acc, (bf16_t*)(ws + WS_KA) + (size_t)gi * T_ * 256, 256, 0, row0, 1.0f, wr, wc, fr, fq);
    }
};

namespace att {
typedef short v4i16_t __attribute__((ext_vector_type(4)));
__device__ __forceinline__ int crow(int r, int h) { return (r & 3) + 8 * (r >> 2) + 4 * h; }
__device__ __forceinline__ s16x4 vtr(LAS const unsigned char* p) { return __builtin_bit_cast(s16x4, __builtin_amdgcn_ds_read_tr16_b64_v4i16((LAS v4i16_t*)p)); }

constexpr int KROW64 = 144, VROW64 = 128, NKEYS_B = 384;
constexpr int LDS_K64 = 0, LDS_V64 = NKEYS_B * KROW64;
constexpr int LDS_K128 = 0, LDS_V128 = 65536;

constexpr float SM_THR = 20.0f;
template <int NT, int ND>
__device__ __forceinline__ void softmax_step(f32x16 (&s)[NT], float& mref, float& l, f32x16 (&o)[ND], bf16x8 (&pf)[NT][2]) {
    if (__any(mref != 0.f)) {
#pragma unroll
        for (int t = 0; t < NT; ++t)
#pragma unroll
            for (int r = 0; r < 16; ++r) s[t][r] -= mref;
    }
    float mx = s[0][0];
#pragma unroll
    for (int t = 0; t < NT; ++t)
#pragma unroll
        for (int r = 0; r < 16; ++r) mx = fmaxf(mx, s[t][r]);
    mx = fmaxf(mx, __shfl_xor(mx, 32));
    if (__any(mx > SM_THR)) {
        const float dl = fmaxf(mx, 0.f); mref += dl;
#pragma unroll
        for (int t = 0; t < NT; ++t)
#pragma unroll
            for (int r = 0; r < 16; ++r) s[t][r] -= dl;
        const float f = __builtin_amdgcn_exp2f(-dl); l *= f;
#pragma unroll
        for (int d = 0; d < ND; ++d)
#pragma unroll
            for (int r = 0; r < 16; ++r) o[d][r] *= f;
    }
    float ps0 = 0.f, ps1 = 0.f;
#pragma unroll
    for (int t = 0; t < NT; ++t)
#pragma unroll
        for (int r = 0; r < 16; r += 2) { s[t][r] = __builtin_amdgcn_exp2f(s[t][r]); s[t][r + 1] = __builtin_amdgcn_exp2f(s[t][r + 1]); ps0 += s[t][r]; ps1 += s[t][r + 1]; }
    l += ps0 + ps1;
#pragma unroll
    for (int t = 0; t < NT; ++t)
#pragma unroll
        for (int k = 0; k < 2; ++k) { u32x4 w; w.x = cvtpk(s[t][8 * k + 0], s[t][8 * k + 1]); w.y = cvtpk(s[t][8 * k + 2], s[t][8 * k + 3]); w.z = cvtpk(s[t][8 * k + 4], s[t][8 * k + 5]); w.w = cvtpk(s[t][8 * k + 6], s[t][8 * k + 7]);
            pf[t][k] = __builtin_bit_cast(bf16x8, w); }
}

struct BU { const bf16_t* q; const bf16_t* k; const bf16_t* v; bf16_t* o; float* lse; int qstride, kvstride, ostride, lsestride; float sink2; int W; int first; };
__device__ __forceinline__ void bu_load(const BU& u, int tid, u32x4 (&kr)[6], u32x4 (&vr)[6]) {
#pragma unroll
    for (int it = 0; it < 6; ++it) {
        const int c = tid + 512 * it, row = c >> 3, ch = c & 7;
        const bool valid = !(u.first && row < 128);
        const long off = (long)((valid ? row : 128) - 128) * (long)u.kvstride + ch * 8;
        kr[it] = *(const u32x4*)(u.k + off); vr[it] = *(const u32x4*)(u.v + off);
    }
}
__device__ __forceinline__ void bu_store(LAS unsigned char* lds, int tid, const u32x4 (&kr)[6], const u32x4 (&vr)[6], int first) {
#pragma unroll
    for (int it = 0; it < 6; ++it) {
        const int c = tid + 512 * it, row = c >> 3, ch = c & 7;
        const bool valid = !(first && row < 128);
        const u32x4 z = (u32x4){0u, 0u, 0u, 0u};
        *(LAS u32x4*)(lds + LDS_K64 + row * KROW64 + ch * 16) = valid ? kr[it] : z;
        *(LAS u32x4*)(lds + LDS_V64 + row * VROW64 + ((ch * 16) ^ (((row >> 1) & 1) << 6))) = valid ? vr[it] : z;
    }
}
__device__ __forceinline__ void bu_loadq(const BU& u, int wid, int lane, bf16x8 (&qf)[4]) {
    const int qi = 32 * wid + (lane & 31), h = lane >> 5;
#pragma unroll
    for (int d0 = 0; d0 < 4; ++d0) qf[d0] = *(const bf16x8*)(u.q + (size_t)qi * u.qstride + 16 * d0 + 8 * h);
}
template <int NT>
__device__ __forceinline__ void bu_step(LAS const unsigned char* kbase, LAS const unsigned char* vbase, int vsw, int kt0, int mask, int jlo, int jhi, int h, const bf16x8 (&qf)[4],
                                        float& mref, float& l, f32x16 (&o)[2]) {
    f32x16 s[NT];
#pragma unroll
    for (int d0 = 0; d0 < 4; ++d0)
#pragma unroll
        for (int t = 0; t < NT; ++t) { const bf16x8 kf = *(LAS const bf16x8*)(kbase + (kt0 + t) * 32 * KROW64 + d0 * 32); if (d0 == 0) { for (int r = 0; r < 16; ++r) s[t][r] = 0.f; } s[t] = __builtin_amdgcn_mfma_f32_32x32x16_bf16(kf, qf[d0], s[t], 0, 0, 0); }
    if (mask == 1) {
        const int L = jlo - 32 * kt0 - 4 * h;
#pragma unroll
        for (int r = 0; r < 16; ++r) { if (((r & 3) + 8 * (r >> 2)) < L) s[0][r] = -INFINITY; }
    } else if (mask == 2) {
        const int H = jhi - 32 * kt0 - 4 * h;
#pragma unroll
        for (int r = 0; r < 16; ++r) { if (((r & 3) + 8 * (r >> 2)) > H) s[0][r] = -INFINITY; }
    } else if (mask == 3) {
#pragma unroll
        for (int t = 0; t < NT; ++t) { const int L = jlo - 32 * (kt0 + t) - 4 * h; const unsigned span = (unsigned)(jhi - jlo);
#pragma unroll
            for (int r = 0; r < 16; ++r) { if ((unsigned)(((r & 3) + 8 * (r >> 2)) - L) > span) s[t][r] = -INFINITY; } }
    }
    bf16x8 pf[NT][2];
    softmax_step<NT, 2>(s, mref, l, o, pf);
#pragma unroll
    for (int t = 0; t < NT; ++t)
#pragma unroll
        for (int k = 0; k < 2; ++k)
#pragma unroll
            for (int d = 0; d < 2; ++d) {
                LAS const unsigned char* vp = vbase + ((kt0 + t) * 32 + 16 * k) * VROW64 + 64 * (d ^ vsw);
                const s16x4 lo = vtr(vp), hi = vtr(vp + 8 * VROW64);
                const bf16x8 vf = (bf16x8){lo[0], lo[1], lo[2], lo[3], hi[0], hi[1], hi[2], hi[3]};
                o[d] = __builtin_amdgcn_mfma_f32_32x32x16_bf16(vf, pf[t][k], o[d], 0, 0, 0);
            }
}
__device__ __forceinline__ void bu_compute(LAS unsigned char* lds, const BU& u, const bf16x8 (&qf)[4], int wid, int lane) {
    const int c = lane & 31, h = lane >> 5;
    const int qi = 32 * wid + c;
    float mref = 0.f, l = 0.f; f32x16 o[2];
#pragma unroll
    for (int r = 0; r < 16; ++r) { o[0][r] = 0.f; o[1][r] = 0.f; }
    int jlo = qi + 128 - u.W; if (u.first && jlo < 128) jlo = 128;
    const int jhi = qi + 128;
    const int qq = (lane & 15) >> 2;
    LAS const unsigned char* kbase = lds + LDS_K64 + c * KROW64 + 16 * h;
    LAS const unsigned char* vbase = lds + LDS_V64 + (4 * h + qq) * VROW64 + ((lane >> 4) & 1) * 32 + (lane & 3) * 8;
    const int vsw = (qq >> 1) & 1;
#pragma unroll 1
    for (int st = 0; st < 2; ++st) bu_step<2>(kbase, vbase, vsw, wid + 2 * st, u.first ? 3 : (st == 0 ? 1 : 0), jlo, jhi, h, qf, mref, l, o);
    bu_step<1>(kbase, vbase, vsw, wid + 4, u.first ? 3 : 2, jlo, jhi, h, qf, mref, l, o);
    float lt = l + __shfl_xor(l, 32);
    lt += __builtin_amdgcn_exp2f(u.sink2 - mref);
    const float inv = 1.0f / lt;
    bf16_t* orow = u.o + (size_t)qi * u.ostride;
#pragma unroll
    for (int d = 0; d < 2; ++d)
#pragma unroll
        for (int rg = 0; rg < 4; ++rg) { u32x2 w; w.x = cvtpk(o[d][4 * rg] * inv, o[d][4 * rg + 1] * inv); w.y = cvtpk(o[d][4 * rg + 2] * inv, o[d][4 * rg + 3] * inv);
            *(u32x2*)(orow + 32 * d + 8 * rg + 4 * h) = w; }
    if (u.lse && h == 0) u.lse[(size_t)qi * u.lsestride] = mref + __builtin_amdgcn_logf(lt);
}

__device__ __forceinline__ void mem_load(const bf16_t* kmem, const bf16_t* vmem, int tid, u32x4 (&kr)[8], u32x4 (&vr)[8]) {
#pragma unroll
    for (int it = 0; it < 8; ++it) { const int cc = tid + 512 * it, row = cc >> 4, ch = cc & 15;
        kr[it] = *(const u32x4*)(kmem + (size_t)row * 1024 + ch * 8); vr[it] = *(const u32x4*)(vmem + (size_t)row * 1024 + ch * 8); }
}
__device__ __forceinline__ void mem_unit(LAS unsigned char* lds, const u32x4 (&qraw)[8], const u32x4 (&kr)[8], const u32x4 (&vr)[8], LAS const unsigned char* gl, bf16_t* o0, size_t ostride, int tid, int wid, int lane) {
#pragma unroll
    for (int it = 0; it < 8; ++it) {
        const int cc = tid + 512 * it, row = cc >> 4, ch = cc & 15;
        *(LAS u32x4*)(lds + LDS_K128 + row * 256 + ((ch ^ (row & 15)) * 16)) = kr[it];
        *(LAS u32x4*)(lds + LDS_V128 + row * 256 + ((ch * 16) ^ ((row & 3) << 6))) = vr[it];
    }
    const int c = lane & 31, h = lane >> 5;
    const int qi = 32 * wid + c;
    bf16x8 qf[8];
    {
        u32x4 raw[8]; float ss = 0.f;
#pragma unroll
        for (int d0 = 0; d0 < 8; ++d0) { raw[d0] = qraw[d0];
#pragma unroll
            for (int e = 0; e < 4; ++e) { const float a = bflo(raw[d0][e]), b = bfhi(raw[d0][e]); ss += a * a + b * b; } }
        ss += __shfl_xor(ss, 32);
        const float rs = (1.0f / sqrtf(ss * (1.f / 128.f) + EPS_)) * QSCALE128;
#pragma unroll
        for (int d0 = 0; d0 < 8; ++d0) { const f32x4 g0 = *(LAS const f32x4*)(gl + 4 * (16 * d0 + 8 * h)), g1 = *(LAS const f32x4*)(gl + 4 * (16 * d0 + 8 * h + 4));
            u32x4 w; w.x = cvtpk(bflo(raw[d0].x) * rs * g0[0], bfhi(raw[d0].x) * rs * g0[1]); w.y = cvtpk(bflo(raw[d0].y) * rs * g0[2], bfhi(raw[d0].y) * rs * g0[3]);
            w.z = cvtpk(bflo(raw[d0].z) * rs * g1[0], bfhi(raw[d0].z) * rs * g1[1]); w.w = cvtpk(bflo(raw[d0].w) * rs * g1[2], bfhi(raw[d0].w) * rs * g1[3]);
            qf[d0] = __builtin_bit_cast(bf16x8, w); }
    }
    __syncthreads();
    {
        const int row = tid >> 1, hf = tid & 1; u32x4 raw[8]; float ss = 0.f;
#pragma unroll
        for (int i = 0; i < 8; ++i) { raw[i] = *(LAS const u32x4*)(lds + LDS_K128 + row * 256 + (((hf * 8 + i) ^ (row & 15)) * 16));
#pragma unroll
            for (int e = 0; e < 4; ++e) { const float a = bflo(raw[i][e]), b = bfhi(raw[i][e]); ss += a * a + b * b; } }
        ss += __shfl_xor(ss, 1);
        const float rs = 1.0f / sqrtf(ss * (1.f / 128.f) + EPS_);
#pragma unroll
        for (int i = 0; i < 8; ++i) { LAS const unsigned char* gp = gl + 512 + 4 * (64 * hf + 8 * i); const f32x4 g0 = *(LAS const f32x4*)gp, g1 = *(LAS const f32x4*)(gp + 16);
            u32x4 w; w.x = cvtpk(bflo(raw[i].x) * rs * g0[0], bfhi(raw[i].x) * rs * g0[1]); w.y = cvtpk(bflo(raw[i].y) * rs * g0[2], bfhi(raw[i].y) * rs * g0[3]);
            w.z = cvtpk(bflo(raw[i].z) * rs * g1[0], bfhi(raw[i].z) * rs * g1[1]); w.w = cvtpk(bflo(raw[i].w) * rs * g1[2], bfhi(raw[i].w) * rs * g1[3]);
            *(LAS u32x4*)(lds + LDS_K128 + row * 256 + (((hf * 8 + i) ^ (row & 15)) * 16)) = w; }
    }
    __syncthreads();
    float mref = 0.f, l = 0.f; f32x16 o[4];
#pragma unroll
    for (int r = 0; r < 16; ++r) {
#pragma unroll
        for (int d = 0; d < 4; ++d) o[d][r] = 0.f; }
    const int qq = (lane & 15) >> 2;
    LAS const unsigned char* vbase = lds + LDS_V128 + (4 * h + qq) * 256 + ((lane >> 4) & 1) * 32 + (lane & 3) * 8;
#pragma unroll 1
    for (int kt = 0; kt < 8; kt += 2) {
        f32x16 s[2];
#pragma unroll
        for (int d0 = 0; d0 < 8; ++d0)
#pragma unroll
            for (int t = 0; t < 2; ++t) { const int krow = (kt + t) * 32 + c;
                const bf16x8 kf = *(LAS const bf16x8*)(lds + LDS_K128 + krow * 256 + (((2 * d0 + h) ^ (krow & 15)) * 16)); if (d0 == 0) { for (int r = 0; r < 16; ++r) s[t][r] = 0.f; } s[t] = __builtin_amdgcn_mfma_f32_32x32x16_bf16(kf, qf[d0], s[t], 0, 0, 0); }
        bf16x8 pf[2][2];
        softmax_step<2, 4>(s, mref, l, o, pf);
#pragma unroll
        for (int t = 0; t < 2; ++t)
#pragma unroll
            for (int k = 0; k < 2; ++k)
#pragma unroll
                for (int d = 0; d < 4; ++d) {
                    LAS const unsigned char* vp = vbase + ((kt + t) * 32 + 16 * k) * 256 + 64 * (d ^ qq);
                    const s16x4 lo = vtr(vp), hi = vtr(vp + 8 * 256);
                    const bf16x8 vf = (bf16x8){lo[0], lo[1], lo[2], lo[3], hi[0], hi[1], hi[2], hi[3]};
                    o[d] = __builtin_amdgcn_mfma_f32_32x32x16_bf16(vf, pf[t][k], o[d], 0, 0, 0);
                }
    }
    const float inv = 1.0f / (l + __shfl_xor(l, 32));
    bf16_t* orow = o0 + (size_t)qi * ostride;
#pragma unroll
    for (int d = 0; d < 4; ++d)
#pragma unroll
        for (int rg = 0; rg < 4; ++rg) { u32x2 w; w.x = cvtpk(o[d][4 * rg] * inv, o[d][4 * rg + 1] * inv); w.y = cvtpk(o[d][4 * rg + 2] * inv, o[d][4 * rg + 3] * inv);
            *(u32x2*)(orow + 32 * d + 8 * rg + 4 * h) = w; }
    __syncthreads();
}
}

__device__ __forceinline__ att::BU get_bu(const Args& A, int vcu, int idx) {
    unsigned char* ws = A.ws; att::BU u;
    if (idx < 3) {
        const int gi = idx, b = vcu >> 6, hd = (vcu >> 4) & 3, i16 = vcu & 15;
        const int dl = (gi == 0) ? 1 : (gi == 1) ? 4 : 16;
        int r, qb; if (gi == 0) { r = 0; qb = i16; } else if (gi == 1) { r = i16 >> 2; qb = i16 & 3; } else { r = i16; qb = 0; }
        const int i0 = qb * 256;
        const size_t row0 = (size_t)b * SEQ_ + r + (size_t)dl * i0;
        const size_t base = (size_t)gi * T_ * 256 + row0 * 256 + hd * 64;
        u.q = (const bf16_t*)(ws + WS_QA) + base; u.k = (const bf16_t*)(ws + WS_KA) + base; u.v = (const bf16_t*)(ws + WS_VA) + base;
        u.o = (bf16_t*)((unsigned char*)A.out + DO_OAG) + base;
        u.lse = (float*)(ws + WS_LSE) + (size_t)gi * T_ * 4 + row0 * 4 + hd;
        u.qstride = dl * 256; u.kvstride = dl * 256; u.ostride = dl * 256; u.lsestride = dl * 4; u.sink2 = -INFINITY; u.W = 128; u.first = (i0 == 0);
    } else {
        const int uu = vcu + 256 * (idx - 3), b = uu >> 7, hq = (uu >> 4) & 7, qb = uu & 15, kvh = hq >> 2;
        const size_t row0 = (size_t)b * SEQ_ + (size_t)qb * 256;
        u.q = (const bf16_t*)(ws + WS_QB) + row0 * 512 + hq * 64;
        u.k = (const bf16_t*)(ws + WS_KVB) + row0 * 256 + kvh * 64; u.v = u.k + 128;
        u.o = (bf16_t*)((unsigned char*)A.out + DO_OCAT) + row0 * KCAT + 256 + hq * 64;
        u.lse = nullptr; u.qstride = 512; u.kvstride = 256; u.ostride = KCAT; u.lsestride = 0; u.sink2 = A.in[I_SINK][hq] * LOG2E; u.W = 127; u.first = (qb == 0);
    }
    return u;
}
__device__ __forceinline__ void p2_attention(const Args& A, LAS unsigned char* lds, int vcu, int tid, int wid, int lane) {
    unsigned char* ws = A.ws;
    const int mu = vcu, mb = mu >> 6, mhd = (mu >> 4) & 3, mqb = mu & 15;
    const bf16_t* km = (const bf16_t*)(ws + WS_MKV) + (size_t)mb * MEM_ * 1024 + mhd * 128;
    const size_t mrow0 = (size_t)mb * SEQ_ + (size_t)mqb * 256;
    const bf16_t* mq = (const bf16_t*)(ws + WS_MQ) + mrow0 * 512 + mhd * 128;
    LAS unsigned char* gl = lds + 131072;
    { const float* const pq = A.in[I_MQN]; const float* const pk = A.in[I_MKN];
      if (tid < 64) { const f32x4 gv = ((const f32x4*)(tid < 32 ? pq : pk))[tid & 31]; *(LAS f32x4*)(gl + 16 * tid) = gv; } }
    u32x4 mkr[8], mvr[8], mqr[8];
    {
        u32x4 kr[6], vr[6];
        { const att::BU u0 = get_bu(A, vcu, 0); att::bu_load(u0, tid, kr, vr); }
#pragma unroll 1
        for (int idx = 0; idx < 4; ++idx) {
            const att::BU u = get_bu(A, vcu, idx);
            att::bu_store(lds, tid, kr, vr, u.first);
            bf16x8 qf[4]; att::bu_loadq(u, wid, lane, qf);
            __syncthreads();
            { const att::BU un = get_bu(A, vcu, idx + 1); att::bu_load(un, tid, kr, vr); }
            att::bu_compute(lds, u, qf, wid, lane);
            asm volatile("" ::: "memory");
            __syncthreads();
        }
        {
            const att::BU u = get_bu(A, vcu, 4);
            att::bu_store(lds, tid, kr, vr, u.first);
            bf16x8 qf[4]; att::bu_loadq(u, wid, lane, qf);
            __syncthreads();
            att::mem_load(km, km + 512, tid, mkr, mvr);
            { const int qi = 32 * wid + (lane & 31), h = lane >> 5;
#pragma unroll
              for (int d0 = 0; d0 < 8; ++d0) mqr[d0] = *(const u32x4*)(mq + (size_t)qi * 512 + 16 * d0 + 8 * h); }
            att::bu_compute(lds, u, qf, wid, lane);
            asm volatile("" ::: "memory");
            __syncthreads();
        }
    }
    {
        bf16_t* o = (bf16_t*)((unsigned char*)A.out + DO_OCAT) + mrow0 * KCAT + 768 + mhd * 128;
        att::mem_unit(lds, mqr, mkr, mvr, gl, o, KCAT, tid, wid, lane);
    }
}

__device__ __forceinline__ void p2b_merge(const Args& A, int vcu, int G, int tid) {
    const bf16_t* oag = (const bf16_t*)((unsigned char*)A.out + DO_OAG);
    bf16_t* ocat = (bf16_t*)((unsigned char*)A.out + DO_OCAT);
    const float* lse = (const float*)(A.ws + WS_LSE);
    for (int idx = vcu * 512 + tid; idx < T_ * 32; idx += G * 512) {
        const int t = idx >> 5, ch = idx & 31, hd = ch >> 3;
        const float l0 = lse[(size_t)t * 4 + hd], l1 = lse[(size_t)T_ * 4 + (size_t)t * 4 + hd], l2 = lse[(size_t)2 * T_ * 4 + (size_t)t * 4 + hd];
        const float mx = fmaxf(l0, fmaxf(l1, l2));
        float w0 = __builtin_amdgcn_exp2f(l0 - mx), w1 = __builtin_amdgcn_exp2f(l1 - mx), w2 = __builtin_amdgcn_exp2f(l2 - mx);
        const float inv = 1.0f / (w0 + w1 + w2); w0 *= inv; w1 *= inv; w2 *= inv;
        const u32x4 a = *(const u32x4*)(oag + (size_t)t * 256 + ch * 8), b = *(const u32x4*)(oag + (size_t)T_ * 256 + (size_t)t * 256 + ch * 8), c = *(const u32x4*)(oag + (size_t)2 * T_ * 256 + (size_t)t * 256 + ch * 8);
        u32x4 w;
#pragma unroll
        for (int e = 0; e < 4; ++e) w[e] = cvtpk(w0 * bflo(a[e]) + w1 * bflo(b[e]) + w2 * bflo(c[e]), w0 * bfhi(a[e]) + w1 * bfhi(b[e]) + w2 * bfhi(c[e]));
        *(u32x4*)(ocat + (size_t)t * KCAT + ch * 8) = w;
    }
}

struct P3aOrder : pg8::StaticOrder {
    const bf16_t* oag; bf16_t* ocat; const float* lse;
    __device__ __forceinline__ void a_ready(const pg8::Unit& u) const {
#pragma unroll 1
        for (int i0 = threadIdx.x; i0 < 256 * 32; i0 += 2 * 512) {
            u32x4 a[2], b[2], c[2]; float l0[2], l1[2], l2[2];
#pragma unroll
            for (int j = 0; j < 2; ++j) { const int idx = i0 + 512 * j, t = u.pm * 256 + (idx >> 5), ch = idx & 31, hd = ch >> 3;
                l0[j] = lse[(size_t)t * 4 + hd]; l1[j] = lse[(size_t)T_ * 4 + (size_t)t * 4 + hd]; l2[j] = lse[(size_t)2 * T_ * 4 + (size_t)t * 4 + hd];
                a[j] = *(const u32x4*)(oag + (size_t)t * 256 + ch * 8); b[j] = *(const u32x4*)(oag + (size_t)T_ * 256 + (size_t)t * 256 + ch * 8); c[j] = *(const u32x4*)(oag + (size_t)2 * T_ * 256 + (size_t)t * 256 + ch * 8); }
#pragma unroll
            for (int j = 0; j < 2; ++j) { const int idx = i0 + 512 * j, t = u.pm * 256 + (idx >> 5), ch = idx & 31;
                const float mx = fmaxf(l0[j], fmaxf(l1[j], l2[j]));
                float w0 = __builtin_amdgcn_exp2f(l0[j] - mx), w1 = __builtin_amdgcn_exp2f(l1[j] - mx), w2 = __builtin_amdgcn_exp2f(l2[j] - mx);
                const float inv = 1.0f / (w0 + w1 + w2); w0 *= inv; w1 *= inv; w2 *= inv;
                u32x4 w;
#pragma unroll
                for (int e = 0; e < 4; ++e) w[e] = cvtpk(w0 * bflo(a[j][e]) + w1 * bflo(b[j][e]) + w2 * bflo(c[j][e]), w0 * bfhi(a[j][e]) + w1 * bfhi(b[j][e]) + w2 * bfhi(c[j][e]));
                *(u32x4*)(ocat + (size_t)t * KCAT + ch * 8) = w; }
        }
        asm volatile("s_waitcnt vmcnt(0)" ::: "memory"); __builtin_amdgcn_s_barrier(); asm volatile("" ::: "memory");
    }
};

__device__ __forceinline__ float ub(unsigned w, int i) { return (float)((w >> (8 * i)) & 0xffu); }
struct Epi3a {
    static constexpr bool PERM = true;
    const unsigned char* G; bf16_t* MERGED;
    bool skip = false;
    __device__ __forceinline__ void khook(f32x4 (&acc)[2][2][4][2], const pg8::Unit& u, int t, int wr, int wc, int fr, int fq) const {
        if (t != 4 && t != 12) return;
        const int gsel = (t == 4) ? 0 : 1024;
#pragma unroll
        for (int ai = 0; ai < 2; ++ai) {
            u32x2 ga[4][2], gb[4][2];
#pragma unroll
            for (int m = 0; m < 4; ++m) { const unsigned char* gp = G + (size_t)(u.pm * 256 + ai * 128 + wr * 64 + m * 16 + fr) * 3072 + gsel + u.pn * 256 + wc * 64 + 8 * fq;
#pragma unroll
                for (int bj = 0; bj < 2; ++bj) { ga[m][bj] = *(const u32x2*)(gp + 32 * bj); gb[m][bj] = *(const u32x2*)(gp + 1024 + 32 * bj); } }
            asm volatile("" ::: "memory");
#pragma unroll
            for (int m = 0; m < 4; ++m)
#pragma unroll
                for (int bj = 0; bj < 2; ++bj)
#pragma unroll
                    for (int n = 0; n < 2; ++n)
#pragma unroll
                        for (int e = 0; e < 4; ++e) acc[ai][bj][m][n][e] *= ub(ga[m][bj][n], e) * __builtin_amdgcn_rcpf(ub(gb[m][bj][n], e));
        }
    }
    __device__ __forceinline__ void operator()(const f32x4 (&acc)[2][2][4][2], const pg8::Unit& u, int wr, int wc, int fr, int fq) const {
        const int col = u.pn * 256 + wc * 64 + 8 * fq;
        u32x2 g2[2][4][2];
#pragma unroll
        for (int ai = 0; ai < 2; ++ai)
#pragma unroll
            for (int m = 0; m < 4; ++m) { const size_t row = (size_t)(u.pm * 256 + ai * 128 + wr * 64 + m * 16 + fr);
#pragma unroll
                for (int bj = 0; bj < 2; ++bj) g2[ai][m][bj] = *(const u32x2*)(G + row * 3072 + 2048 + col + 32 * bj); }
        asm volatile("" ::: "memory");
        const float k = 1.0f / 255.0f;
#pragma unroll
        for (int ai = 0; ai < 2; ++ai)
#pragma unroll
            for (int m = 0; m < 4; ++m) { const size_t row = (size_t)(u.pm * 256 + ai * 128 + wr * 64 + m * 16 + fr);
#pragma unroll
                for (int bj = 0; bj < 2; ++bj) { const u32x2 g = g2[ai][m][bj]; const f32x4 v0 = acc[ai][bj][m][0] * k, v1 = acc[ai][bj][m][1] * k;
                    u32x4 w; w.x = cvtpk(v0[0] * ub(g.x, 0), v0[1] * ub(g.x, 1)); w.y = cvtpk(v0[2] * ub(g.x, 2), v0[3] * ub(g.x, 3)); w.z = cvtpk(v1[0] * ub(g.y, 0), v1[1] * ub(g.y, 1)); w.w = cvtpk(v1[2] * ub(g.y, 2), v1[3] * ub(g.y, 3));
                    *(u32x4*)(MERGED + row * 1024 + col + 32 * bj) = w; } }
    }
};

struct Epi3b {
    static constexpr bool PERM = true;
    const float* x; bf16_t* X1L; bf16_t* X1B; float* SSQ;
    bool skip = false;
    __device__ __forceinline__ void operator()(const f32x4 (&acc)[2][2][4][2], const pg8::Unit& u, int wr, int wc, int fr, int fq) const {
        const int col = u.pn * 256 + wc * 64 + 8 * fq;
#pragma unroll
        for (int ai = 0; ai < 2; ++ai) {
            f32x4 xv[4][2][2];
#pragma unroll
            for (int m = 0; m < 4; ++m) { const size_t row = (size_t)(u.pm * 256 + ai * 128 + wr * 64 + m * 16 + fr);
#pragma unroll
                for (int bj = 0; bj < 2; ++bj) { const size_t off = row * 1024 + col + 32 * bj; xv[m][bj][0] = *(const f32x4*)(x + off); xv[m][bj][1] = *(const f32x4*)(x + off + 4); } }
            asm volatile("" ::: "memory");
#pragma unroll
            for (int m = 0; m < 4; ++m) { const size_t row = (size_t)(u.pm * 256 + ai * 128 + wr * 64 + m * 16 + fr); float ss = 0.f;
#pragma unroll
                for (int bj = 0; bj < 2; ++bj) { const size_t off = row * 1024 + col + 32 * bj;
                    const f32x4 o0 = xv[m][bj][0] + acc[ai][bj][m][0], o1 = xv[m][bj][1] + acc[ai][bj][m][1];
                    ss += (o0[0] * o0[0] + o0[1] * o0[1]) + (o0[2] * o0[2] + o0[3] * o0[3]) + (o1[0] * o1[0] + o1[1] * o1[1]) + (o1[2] * o1[2] + o1[3] * o1[3]);
                    u32x4 w; w.x = cvtpk(o0[0], o0[1]); w.y = cvtpk(o0[2], o0[3]); w.z = cvtpk(o1[0], o1[1]); w.w = cvtpk(o1[2], o1[3]);
                    *(u32x4*)(X1B + off) = w; }
                ss += xor16(ss); ss = sum_halves(ss);
                if (fq == 0) SSQ[row * 16 + u.pn * 4 + wc] = ss; }
            asm volatile("" ::: "memory");
        }
    }
};

struct Epi4 {
    static constexpr bool PERM = true;
    const float* convw; const float* convb; bf16_t* ACT; float* UE; float* UF; LAS float* xch; LAS const float* rtab; LAS const float* ctab;
    bool skip = false;
    __device__ __forceinline__ void operator()(f32x4 (&acc)[2][2][4][2], const pg8::Unit& u, int wr, int wc, int fr, int fq) const {
        const int lane = fr + 16 * fq;
        const int rowbase = u.pm * 256 + 128 * wr + 8 * fr;
        const int jj = 32 * wc + 8 * fq;
        const bool bstart = (u.pm & 15) == 0;
        {
            LAS const float* tb = rtab + ((u.pm >> 2) & 1) * 256 + 128 * wr + 8 * fr;
            const f32x4 ra = *(LAS const f32x4*)tb, rb = *(LAS const f32x4*)(tb + 4);
#pragma unroll
            for (int i = 0; i < 8; ++i) { const float rs = (i < 4) ? ra[i & 3] : rb[i & 3];
#pragma unroll
                for (int bj = 0; bj < 2; ++bj)
#pragma unroll
                    for (int n = 0; n < 2; ++n) acc[i >> 2][bj][i & 3][n] *= rs; }
        }
#define U4(bj, n, i) acc[(i) >> 2][bj][(i) & 3][n]
        if (wr == 0 && fr == 0) {
#pragma unroll
            for (int i = 0; i < 2; ++i)
#pragma unroll
                for (int bj = 0; bj < 2; ++bj)
#pragma unroll
                    for (int n = 0; n < 2; ++n) *(f32x4*)(UF + (size_t)(u.pm * 2 + i) * 5632 + u.pn * 256 + 128 * bj + jj + 4 * n) = U4(bj, n, i);
        }
        if (wr == 1 && fr == 15) {
#pragma unroll
            for (int i = 0; i < 2; ++i)
#pragma unroll
                for (int bj = 0; bj < 2; ++bj)
#pragma unroll
                    for (int n = 0; n < 2; ++n) *(f32x4*)(UE + (size_t)(u.pm * 2 + i) * 5632 + u.pn * 256 + 128 * bj + jj + 4 * n) = U4(bj, n, 6 + i);
        }
        if (wr == 0 && fr == 15) {
#pragma unroll
            for (int i = 0; i < 2; ++i)
#pragma unroll
                for (int bj = 0; bj < 2; ++bj)
#pragma unroll
                    for (int n = 0; n < 2; ++n) *(LAS f32x4*)(xch + ((((wc * 2 + i) * 2 + bj) * 2 + n) * 4 + fq) * 4) = U4(bj, n, 6 + i);
        }
        asm volatile("s_waitcnt lgkmcnt(0)" ::: "memory"); __builtin_amdgcn_s_barrier(); asm volatile("" ::: "memory");
        const int src = (lane & 48) | ((fr - 1) & 15);
        const int cha = u.pn * 128 + jj;
#pragma unroll
        for (int n = 0; n < 2; ++n) {
            asm volatile("" ::: "memory"); __builtin_amdgcn_sched_barrier(0);
            f32x4 p6[2], p7[2], w0[2], w1[2], w2[2], cb[2];
#pragma unroll
            for (int bj = 0; bj < 2; ++bj) {
                f32x4 h6 = (f32x4){0.f, 0.f, 0.f, 0.f}, h7 = h6;
                if (wr == 1) { h6 = *(LAS const f32x4*)(xch + ((((wc * 2 + 0) * 2 + bj) * 2 + n) * 4 + fq) * 4); h7 = *(LAS const f32x4*)(xch + ((((wc * 2 + 1) * 2 + bj) * 2 + n) * 4 + fq) * 4); }
#pragma unroll
                for (int e = 0; e < 4; ++e) { const float a6 = __shfl(U4(bj, n, 6)[e], src), a7 = __shfl(U4(bj, n, 7)[e], src); p6[bj][e] = (fr == 0) ? h6[e] : a6; p7[bj][e] = (fr == 0) ? h7[e] : a7; }
                LAS const float* ct = ctab + u.par * 1024 + bj * 512 + jj + 4 * n;
                w0[bj] = *(LAS const f32x4*)ct; w1[bj] = *(LAS const f32x4*)(ct + 128); w2[bj] = *(LAS const f32x4*)(ct + 256); cb[bj] = *(LAS const f32x4*)(ct + 384);
            }
#pragma unroll
            for (int i = 0; i < 8; ++i) {
                f32x4 c[2];
#pragma unroll
                for (int bj = 0; bj < 2; ++bj) {
                    const f32x4 um1 = (i >= 1) ? U4(bj, n, i >= 1 ? i - 1 : 0) : p7[bj];
                    const f32x4 um2 = (i >= 2) ? U4(bj, n, i >= 2 ? i - 2 : 0) : ((i == 1) ? p7[bj] : p6[bj]);
                    c[bj] = cb[bj] + w2[bj] * U4(bj, n, i) + w1[bj] * um1 + w0[bj] * um2;
                }
                f32x4 a;
#pragma unroll
                for (int e = 0; e < 4; ++e) { const float z = c[0][e]; a[e] = z * __builtin_amdgcn_rcpf(1.0f + __builtin_amdgcn_exp2f(-z * LOG2E)) * c[1][e]; }
                u32x2 w; w.x = cvtpk(a[0], a[1]); w.y = cvtpk(a[2], a[3]);
                const bool skip = (wr == 0 && fr == 0 && i < 2 && !bstart);
                if (!skip) *(u32x2*)(ACT + (size_t)(rowbase + i) * DFF_ + cha + 4 * n) = w;
            }
        }
#undef U4
    }
};

struct P4Order : pg8::StaticOrder {
    const float* SSQ; LAS float* rtab; mutable int lastpm; const float* convw; const float* convb; LAS unsigned char* ctab;
    __device__ __forceinline__ void a_ready(const pg8::Unit& u) const {
        { int t = threadIdx.x; asm volatile("" : "+v"(t)); const int w = __builtin_amdgcn_readfirstlane(t >> 6);
          if (w < 4) { const int bj = t >> 7, tap = (t >> 5) & 3, c4 = t & 31; const float* src = (tap < 3 ? convw + tap * 5632 : convb) + bj * DFF_ + u.pn * 128 + 4 * c4;
              __builtin_amdgcn_global_load_lds((const unsigned*)src, (LAS unsigned*)(ctab + u.par * 4096 + w * 1024), 16, 0, 0); } }
        if (u.pm == lastpm) return;
        lastpm = u.pm;
        const int t = threadIdx.x;
        if (t < 256) {
            const float* sp = SSQ + (size_t)(u.pm * 256 + t) * 16;
            const f32x4 s0 = *(const f32x4*)sp, s1 = *(const f32x4*)(sp + 4), s2 = *(const f32x4*)(sp + 8), s3 = *(const f32x4*)(sp + 12);
            const float tot = ((s0[0] + s0[1]) + (s0[2] + s0[3])) + ((s1[0] + s1[1]) + (s1[2] + s1[3])) + ((s2[0] + s2[1]) + (s2[2] + s2[3])) + ((s3[0] + s3[1]) + (s3[2] + s3[3]));
            rtab[((u.pm >> 2) & 1) * 256 + t] = 1.0f / sqrtf(tot * (1.f / 1024.f) + EPS_);
        }
    }
};

struct Epi5 {
    static constexpr bool PERM = true;
    const bf16_t* X1B; const bf16_t* X1L; float* dst;
    bool skip = false;
    __device__ __forceinline__ void operator()(const f32x4 (&acc)[2][2][4][2], const pg8::Unit& u, int wr, int wc, int fr, int fq) const {
        const int col = u.pn * 256 + wc * 64 + 8 * fq;
#pragma unroll
        for (int ai = 0; ai < 2; ++ai) {
            u32x4 hv[4][2];
#pragma unroll
            for (int m = 0; m < 4; ++m) { const size_t row = (size_t)(u.pm * 256 + ai * 128 + wr * 64 + m * 16 + fr);
#pragma unroll
                for (int bj = 0; bj < 2; ++bj) { const size_t off = row * 1024 + col + 32 * bj; hv[m][bj] = *(const u32x4*)(X1B + off); } }
            asm volatile("" ::: "memory");
#pragma unroll
            for (int m = 0; m < 4; ++m) { const size_t row = (size_t)(u.pm * 256 + ai * 128 + wr * 64 + m * 16 + fr);
#pragma unroll
                for (int bj = 0; bj < 2; ++bj) { float* q = dst + row * 1024 + col + 32 * bj; const u32x4 h = hv[m][bj];
                    const f32x4 x0 = (f32x4){bflo(h.x), bfhi(h.x), bflo(h.y), bfhi(h.y)};
                    const f32x4 x1 = (f32x4){bflo(h.z), bfhi(h.z), bflo(h.w), bfhi(h.w)};
                    *(f32x4*)q = x0 + acc[ai][bj][m][0]; *(f32x4*)(q + 4) = x1 + acc[ai][bj][m][1]; } }
            asm volatile("" ::: "memory");
        }
    }
};
struct P5Order : pg8::StaticOrder {
    const float* UE; const float* UF; const float* convw; const float* convb; bf16_t* ACT;
    __device__ __forceinline__ void a_ready(const pg8::Unit& u) const {
        if ((u.pm & 15) != 0) {
            for (int ch = threadIdx.x; ch < DFF_; ch += 512) {
                const int pa = 256 * (ch >> 7) + (ch & 127), pg = pa + 128;
                const float* e = UE + (size_t)((u.pm - 1) * 2) * 5632; const float* f = UF + (size_t)(u.pm * 2) * 5632;
                float r[2];
#pragma unroll
                for (int i = 0; i < 2; ++i) {
                    float cc[2];
#pragma unroll
                    for (int s = 0; s < 2; ++s) { const int p = s ? pg : pa, cch = s * DFF_ + ch;
                        const float um2 = e[p], um1 = e[5632 + p], u0 = f[p], u1 = f[5632 + p];
                        const float w0 = convw[cch], w1 = convw[5632 + cch], w2 = convw[2 * 5632 + cch], b = convb[cch];
                        cc[s] = (i == 0) ? b + w0 * um2 + w1 * um1 + w2 * u0 : b + w0 * um1 + w1 * u0 + w2 * u1; }
                    r[i] = cc[0] * __builtin_amdgcn_rcpf(1.0f + __builtin_amdgcn_exp2f(-cc[0] * LOG2E)) * cc[1];
                }
                const unsigned w = cvtpk(r[0], r[1]);
                ACT[(size_t)(u.pm * 256) * DFF_ + ch] = (bf16_t)(w & 0xffffu); ACT[(size_t)(u.pm * 256 + 1) * DFF_ + ch] = (bf16_t)(w >> 16);
            }
        }
        asm volatile("s_waitcnt vmcnt(0)" ::: "memory"); __builtin_amdgcn_s_barrier(); asm volatile("" ::: "memory");
    }
};

__device__ __forceinline__ Args opaque_args() {
    Args a{};
#if defined(__HIP_DEVICE_COMPILE__)
    typedef const __attribute__((address_space(4))) Args* KArgsPtr;
    KArgsPtr p = (KArgsPtr)__builtin_amdgcn_kernarg_segment_ptr(); asm volatile("" : "+s"(p));
#pragma unroll
    for (int i = 0; i < 25; ++i) a.in[i] = p->in[i];
    a.out = p->out; a.ws = p->ws; a.ph_lo = p->ph_lo; a.ph_hi = p->ph_hi; a.li = p->li; a.pad = p->pad;
#endif
    return a;
}
__device__ __forceinline__ int opaque_tid() { int t = threadIdx.x; asm volatile("" : "+v"(t)); return t; }
__global__ void __launch_bounds__(NWAVES * 64, 2) fwd_kernel(Args args_by_value) {
    const Args args0 = opaque_args();
    extern __shared__ __attribute__((aligned(16))) unsigned char lds_raw[];
    LAS unsigned char* lds = (LAS unsigned char*)lds_raw;
    volatile LAS unsigned* MISC = (volatile LAS unsigned*)(lds + MISC_OFF);
    const int tid = threadIdx.x, lane = tid & 63, wave = __builtin_amdgcn_readfirstlane(tid >> 6);
    const int G = gridDim.x; const int bx = blockIdx.x; const int vcu = (G % 8 == 0) ? (bx % 8) * (G / 8) + bx / 8 : bx;
    unsigned char* ws = args0.ws;
    gu32* ctl = (gu32*)(ws + WS_CTL);
    for (int u = tid; u < (LDS_BYTES - LDSCTL_OFF) / 4; u += NWAVES * 64) ((LAS unsigned*)(lds + LDSCTL_OFF))[u] = 0u;
    __syncthreads();
    XcdBarrier bar; bar.bar = g_barrier_words + args0.li * XCD_BAR_WORDS; bar.nx = G < 8 ? (unsigned)G : 8u; bar.x = (unsigned)bx % bar.nx; bar.nloc = ((unsigned)G - bar.x + bar.nx - 1u) / bar.nx;
#ifdef PROBE_PH
    const unsigned long long tk0 = __builtin_amdgcn_s_memrealtime(); int nst = 0;
#define GRID_BAR() do { if (!MK_MULTI) xcd_barrier(bar); if (bx == 0 && tid == 0) { ((float*)(ws + WS_CTL + 768 * 1024))[nst] = (float)(__builtin_amdgcn_s_memrealtime() - tk0); } ++nst; } while (0)
#else
#define GRID_BAR() do { if (!MK_MULTI) xcd_barrier(bar); } while (0)
#endif
    const int lo = args0.ph_lo, hi = args0.ph_hi;
#ifndef PHASE_MASK
#define PHASE_MASK 0xff
#endif
#define IN(k) (((PHASE_MASK >> (k)) & 1) && lo <= (k) && (k) < hi)
#define BOTH(k) (IN(k) && IN((k) + 1))

    if (IN(0)) { const Args args = opaque_args(); const int t_ = opaque_tid(); p0_prologue(args, lds, vcu, G, __builtin_amdgcn_readfirstlane(t_ >> 6), t_ & 63); if (BOTH(0)) GRID_BAR(); }
#ifdef PROBE_BARS
    for (int xb = 0; xb < PROBE_BARS; ++xb) GRID_BAR();
#endif

    if (IN(1)) { const Args args = opaque_args();
        constexpr int NUB = 64 * 26 + 16;
        const unsigned* ropep = (const unsigned*)((unsigned char*)args.out + DO_ROPE);
        {
            pg8::Gemm g{(const bf16_t*)(ws + WS_A1I8), (const bf16_t*)((unsigned char*)args.out + DO_WI8), T_ + NB_ * MEM_, NCAT, 512 + args0.pad};
            TileOrder S; S.init(0x3FFFFFFu, 1, G, bx);
            Epi1 E{ws, ropep, args.in[I_AQ], args.in[I_AK], args.in[I_BQ], args.in[I_BK], args.in[I_BGATE], (const float*)(ws + WS_RSC), (const float*)(ws + WS_CMAX), lds};
            pg8::gemm_phase<Epi1, TileOrder, true, false, false, 2, true>(lds + RING_OFF, g, S, E);
            { const int nrem = NUB % G;
              const int t_ = opaque_tid(), w_ = __builtin_amdgcn_readfirstlane(t_ >> 6), l_ = t_ & 63;
              if (nrem == 0) p0_late_weights<0>(args, bx * NWAVES + w_, G * NWAVES, l_);
              else if (bx >= nrem) p0_late_weights<0>(args, (bx - nrem) * NWAVES + w_, (G - nrem) * NWAVES, l_); }
        }
        if (BOTH(1)) GRID_BAR();
    }

    if (IN(2)) { const Args args = opaque_args(); const int t_ = opaque_tid(); p2_attention(args, lds, vcu, t_, __builtin_amdgcn_readfirstlane(t_ >> 6), t_ & 63); if (BOTH(2)) GRID_BAR(); }


    if (IN(4)) { const Args args = opaque_args();
        pg8::Gemm g{(const bf16_t*)((unsigned char*)args.out + DO_OCAT), (const bf16_t*)(ws + WS_WO), T_, 1024, KCAT};
        P3aOrder S; S.init(T_, 1024, G, bx);
        S.oag = (const bf16_t*)((unsigned char*)args.out + DO_OAG); S.ocat = (bf16_t*)((unsigned char*)args.out + DO_OCAT); S.lse = (const float*)(ws + WS_LSE);
        Epi3a E{(const unsigned char*)(ws + WS_G), (bf16_t*)(ws + WS_MERGED)};
        pg8::gemm_phase<Epi3a, P3aOrder, false, false, true>(lds + RING_OFF, g, S, E);
        if (BOTH(4)) GRID_BAR();
    }

    if (IN(5)) { const Args args = opaque_args();
        pg8::Gemm g{(const bf16_t*)(ws + WS_MERGED), (const bf16_t*)(ws + WS_WOUT), T_, 1024, 1024};
        pg8::StaticOrder S; S.init(T_, 1024, G, bx);
        Epi3b E{args.in[I_X], (bf16_t*)(ws + WS_X1L), (bf16_t*)(ws + WS_X1B), (float*)(ws + WS_SSQ)};
        pg8::gemm_phase<Epi3b, pg8::StaticOrder, false, false, false>(lds + RING_OFF, g, S, E);
        if (BOTH(5)) GRID_BAR();
    }

    if (IN(6)) { const Args args = opaque_args();
        pg8::Gemm g{(const bf16_t*)(ws + WS_X1B), (const bf16_t*)(ws + WS_WUP), T_, 5632, 1024};
          P4Order S; S.init(T_, 5632, G, bx, 4); S.SSQ = (const float*)(ws + WS_SSQ); S.rtab = (LAS float*)(lds + XCH_OFF + 2048); S.lastpm = -1; S.convw = args.in[I_CONVW]; S.convb = args.in[I_CONVB]; S.ctab = lds + CTAB_OFF;
        Epi4 E{args.in[I_CONVW], args.in[I_CONVB], (bf16_t*)(ws + WS_ACT), (float*)(ws + WS_UE), (float*)(ws + WS_UF), (LAS float*)(lds + XCH_OFF), (LAS const float*)(lds + XCH_OFF + 2048), (LAS const float*)(lds + CTAB_OFF)};
#ifdef PROBE_NOEPI
        E.skip = (args0.li == 1);
#endif
        pg8::gemm_phase<Epi4, P4Order, true, true, false>(lds + RING_OFF, g, S, E);
        { const int nrem = (64 * 22) % G;
          const int t_ = opaque_tid(), w_ = __builtin_amdgcn_readfirstlane(t_ >> 6), l_ = t_ & 63;
          if (nrem == 0) p0_late_weights<1>(args, bx * NWAVES + w_, G * NWAVES, l_);
          else if (bx >= nrem) p0_late_weights<1>(args, (bx - nrem) * NWAVES + w_, (G - nrem) * NWAVES, l_); }
        if (BOTH(6)) GRID_BAR();
    }

    if (IN(7)) { const Args args = opaque_args();
        pg8::Gemm g{(const bf16_t*)(ws + WS_ACT), (const bf16_t*)(ws + WS_WDOWN), T_, 1024, DFF_};
        P5Order S; S.init(T_, 1024, G, bx);
        S.UE = (const float*)(ws + WS_UE); S.UF = (const float*)(ws + WS_UF); S.convw = args.in[I_CONVW]; S.convb = args.in[I_CONVB]; S.ACT = (bf16_t*)(ws + WS_ACT);
        Epi5 E{(const bf16_t*)(ws + WS_X1B), (const bf16_t*)(ws + WS_X1L), args.out};
        pg8::gemm_phase<Epi5, P5Order, false, false, false>(lds + RING_OFF, g, S, E);
    }
#ifdef PROBE_PH
    if (IN(7) && bx == 0 && tid == 0) { asm volatile("s_waitcnt vmcnt(0)" ::: "memory"); float* st = (float*)(ws + WS_CTL + 768 * 1024); st[nst] = (float)(__builtin_amdgcn_s_memrealtime() - tk0);
        args.out[5] = 1000.0f * (1000.0f * floorf(st[PROBE_PH] / 1000.0f + 0.5f)); }
#endif
#ifdef PROBE_TS
    if (IN(7) && bx == 0 && tid == 0) { asm volatile("s_waitcnt vmcnt(0)" ::: "memory"); const float* dbg = (const float*)(ws + WS_CTL + 512 * 1024); args.out[5] = 1000.0f * (400.0f * floorf(dbg[PROBE_TS - 1] / 400.0f + 0.5f)); }
#endif
#undef IN
#undef BOTH
#undef GRID_BAR
}

extern "C" void kernel_launch(void* const* d_in, const int* in_sizes, int n_in, void* d_out, int out_size, void* d_ws, size_t ws_size, hipStream_t stream) {
    static int grid = 0;
    if (grid == 0) {
        if (n_in != 25 || out_size != T_ * DM_ || ws_size < WS_END) { fprintf(stderr, "kernel_launch: unexpected shapes (n_in %d, out %d, ws %zu); nothing launched\n", n_in, out_size, ws_size); grid = -1; return; }
        int dev = 0, cus = 0, per_cu = 0;
        if (hipGetDevice(&dev) != hipSuccess || hipDeviceGetAttribute(&cus, hipDeviceAttributeMultiprocessorCount, dev) != hipSuccess) { grid = -1; return; }
        if (hipFuncSetAttribute((const void*)fwd_kernel, hipFuncAttributeMaxDynamicSharedMemorySize, LDS_BYTES) != hipSuccess) { fprintf(stderr, "kernel_launch: hipFuncSetAttribute failed\n"); grid = -1; return; }
        if (hipOccupancyMaxActiveBlocksPerMultiprocessor(&per_cu, (const void*)fwd_kernel, NWAVES * 64, LDS_BYTES) != hipSuccess || per_cu < 1) { fprintf(stderr, "kernel_launch: occupancy query says %d blocks per CU\n", per_cu); }
        (void)hipGetLastError();
        grid = cus;
        if (grid != 256) fprintf(stderr, "kernel_launch: %d CUs (the phase schedules expect 256)\n", grid);
    }
    if (grid < 0) return;
    Args a{};
    for (int i = 0; i < 25; ++i) a.in[i] = (const float*)d_in[i];
    a.out = (float*)d_out; a.ws = (unsigned char*)d_ws;
#if MK_MULTI
    for (int p = 0; p < NPHASES; ++p) { a.ph_lo = p; a.ph_hi = p + 1; a.li = p; hipLaunchKernelGGL(fwd_kernel, dim3(grid), dim3(NWAVES * 64), LDS_BYTES, stream, a); }
#elif defined(PROBE_PHASE)
    a.ph_lo = 0; a.ph_hi = PROBE_PHASE + 1; a.li = 0;
    hipLaunchKernelGGL(fwd_kernel, dim3(grid), dim3(NWAVES * 64), LDS_BYTES, stream, a);
    a.ph_lo = PROBE_PHASE; a.ph_hi = NPHASES; a.li = 1;
    hipLaunchKernelGGL(fwd_kernel, dim3(grid), dim3(NWAVES * 64), LDS_BYTES, stream, a);
#else
    a.ph_lo = 0; a.ph_hi = NPHASES; a.li = 0;
    hipLaunchKernelGGL(fwd_kernel, dim3(grid), dim3(NWAVES * 64), LDS_BYTES, stream, a);
#endif
}
```

```cpp
#include <hip/hip_runtime.h>
#include <cstdio>
#include <cstdint>

#ifndef MK_MULTI
#define MK_MULTI 0
#endif
#define LAS __attribute__((address_space(3)))
#define GAS __attribute__((address_space(1)))
typedef unsigned short bf16_t;
typedef short bf16x8 __attribute__((ext_vector_type(8)));
typedef short s16x4 __attribute__((ext_vector_type(4)));
typedef float f32x4 __attribute__((ext_vector_type(4)));
typedef float f32x16 __attribute__((ext_vector_type(16)));
typedef unsigned u32x4 __attribute__((ext_vector_type(4)));
typedef unsigned u32x2 __attribute__((ext_vector_type(2)));
typedef int v4i32 __attribute__((ext_vector_type(4)));
typedef int v8i32 __attribute__((ext_vector_type(8)));

constexpr int T_ = 16384, SEQ_ = 4096, NB_ = 4, DM_ = 1024, MEM_ = 256, DFF_ = 2816;
constexpr int NCAT = 7680;
constexpr int KCAT = 1280;
constexpr float EPS_ = 1e-6f;
constexpr float LOG2E = 1.4426950408889634f;
constexpr float QSCALE64 = 0.125f * LOG2E;
constexpr float QSCALE128 = 0.08838834764831845f * LOG2E;

__device__ __forceinline__ unsigned cvtpk(float lo, float hi) {
    typedef float f2 __attribute__((ext_vector_type(2))); typedef __bf16 b2 __attribute__((ext_vector_type(2)));
    f2 v = {lo, hi}; b2 b = __builtin_convertvector(v, b2); return __builtin_bit_cast(unsigned, b);
}
__device__ __forceinline__ float xor16(float v) { return __int_as_float(__builtin_amdgcn_ds_swizzle(__float_as_int(v), 0x401F)); }
__device__ __forceinline__ float sum_halves(float v) { const auto rr = __builtin_amdgcn_permlane32_swap(__float_as_uint(v), __float_as_uint(v), false, false); return __uint_as_float(rr[0]) + __uint_as_float(rr[1]); }
__device__ __forceinline__ float bflo(unsigned w) { return __uint_as_float(w << 16); }
__device__ __forceinline__ float bfhi(unsigned w) { return __uint_as_float(w & 0xffff0000u); }

namespace pg8 {
constexpr int BM = 256, BK = 64, HALF = 128, HTB = HALF * BK * 2, STAGE_BYTES = 8 * HTB, NXCD = 8, WGM = 8;
__host__ __device__ __forceinline__ int lds_byte(int r, int c) { const int st = (r >> 4) * 2 + (c >> 5), rr = r & 15, cc = c & 31, ob = rr * 64 + cc * 2; return st * 1024 + (ob ^ (((ob >> 9) & 1) << 5)); }
__host__ __device__ __forceinline__ void stage_rc(int b, int& R, int& C) { const int st = b / 1024, sb = b % 1024, swz = sb ^ (((sb >> 9) & 1) << 5); R = (st >> 1) * 16 + swz / 64; C = (st & 1) * 32 + (swz % 64) / 2; }
__host__ __device__ __forceinline__ int perm32(int rho) { const int n = rho >> 4, i = rho & 15; return 8 * (i >> 2) + 4 * n + (i & 3); }

struct Unit { int pm, pn, par; };
struct Gemm { const bf16_t* A; const bf16_t* Bt; int M, N, K; };

struct StaticOrder {
    int nM, nN, nwg, G, c, wgm;
    __host__ __device__ void init(int M, int N, int G_, int c_, int wgm_ = WGM) { nM = M / BM; nN = N / BM; nwg = nM * nN; G = G_; c = c_; wgm = wgm_; }
    __host__ __device__ bool next(int i, Unit& u) const {
        const long L = (long)i * G + c; if (L >= nwg) return false;
        int wgid = (int)L; { const int q = nwg / NXCD, r = nwg % NXCD, xcd = wgid % NXCD, off = wgid / NXCD; wgid = (xcd < r ? xcd * (q + 1) : r * (q + 1) + (xcd - r) * q) + off; }
        const int nig = wgm * nN, gid = wgid / nig, fm = gid * wgm, gsz = (nM - fm) < wgm ? (nM - fm) : wgm;
        u.pm = fm + ((wgid % nig) % gsz); u.pn = (wgid % nig) / gsz; return true;
    }
    __device__ __forceinline__ void a_ready(const Unit&) const {}
    __device__ __forceinline__ void done(const Unit&) const {}
};

template <class Epi, class Sched, bool ALIGN_EPI, bool PERMA, bool KHOOK, int QM = 0, bool PREF = false>
__device__ __forceinline__ void gemm_phase(LAS unsigned char* lds, const Gemm g, const Sched& S, const Epi& E) {
    constexpr bool FP8 = (QM == 1), I8 = (QM == 2);
    int tid_ = threadIdx.x; asm volatile("" : "+v"(tid_));
    const int tid = tid_, wid = __builtin_amdgcn_readfirstlane(tid >> 6), lane = tid & 63, wr = wid >> 2, wc = wid & 3, fr = lane & 15, fq = lane >> 4;
    const int K = g.K, nt = K / BK;
    unsigned voffA0, voffA1, voffB;
    { int R, C; stage_rc(tid * 16, R, C); const int Rb = (R & ~31) + perm32(R & 31);
        if (PERMA) { const int rw = R >> 6, rm = (R >> 4) & 3, rf = R & 15; voffA0 = (unsigned)((128 * rw + 8 * rf + rm) * K + C) * 2u; voffA1 = (unsigned)((128 * rw + 8 * rf + 4 + rm) * K + C) * 2u; }
        else { voffA0 = (unsigned)(R * K + C) * 2u; voffA1 = voffA0; }
        voffB = (unsigned)(Rb * K + C) * 2u; }
    const size_t pstep_voffA0 = (size_t)(PERMA ? 128 : 64) * K * 2, pstep_voffA1 = pstep_voffA0, pstep_voffB = (size_t)64 * K * 2;
    const size_t kstep = (size_t)(BK * 2);
    const size_t hstep = (size_t)HALF * K * 2;
    const size_t ahs = PERMA ? (size_t)0 : hstep;
    const size_t tstep = 2 * hstep;
    const unsigned ldsw = (unsigned)wid * 1024u;
    const int aoff = lds_byte(wr * 64 + fr, fq * 8), boff = lds_byte(wc * 32 + fr, fq * 8);
#define PG8_SA(b, h) (((b) * 2 + (h)) * HTB)
#define PG8_SB(b, h) ((4 + (b) * 2 + (h)) * HTB)
#define PG8_STAGE(bufoff, gbase, voff) do { _Pragma("unroll") for (int _i = 0; _i < 2; ++_i) { unsigned _v = (voff); asm volatile("" : "+v"(_v));     \
        __builtin_amdgcn_global_load_lds((const unsigned*)((const char*)(gbase) + _i * PG8_PSTEP(voff) + _v), (LAS unsigned*)(lds + (bufoff) + ldsw + _i * 8192), 16, 0, 0); } } while (0)
#define PG8_PSTEP(voff) pstep_##voff
#define PG8_LD8(p) __builtin_shufflevector(*(const LAS v4i32*)(p), *(const LAS v4i32*)((p) + 1024), 0, 1, 2, 3, 4, 5, 6, 7)
#define PG8_LDA(dst, b, h) do { if constexpr (false) { _Pragma("unroll") for (int m = 0; m < 4; ++m) dst##8[m] = PG8_LD8(lds + PG8_SA(b, h) + aoff + m * 2048); } \
        else { _Pragma("unroll") for (int m = 0; m < 4; ++m) _Pragma("unroll") for (int k = 0; k < 2; ++k) dst[m][k] = *(const LAS bf16x8*)(lds + PG8_SA(b, h) + aoff + m * 2048 + k * 1024); } } while (0)
#define PG8_LDB(dst, b, h) do { if constexpr (false) { _Pragma("unroll") for (int n = 0; n < 2; ++n) dst##8[n] = PG8_LD8(lds + PG8_SB(b, h) + boff + n * 2048); } \
        else { _Pragma("unroll") for (int n = 0; n < 2; ++n) _Pragma("unroll") for (int k = 0; k < 2; ++k) dst[n][k] = *(const LAS bf16x8*)(lds + PG8_SB(b, h) + boff + n * 2048 + k * 1024); } } while (0)
#define PG8_CAT(x) __builtin_shufflevector(__builtin_bit_cast(v4i32, (x)[0]), __builtin_bit_cast(v4i32, (x)[1]), 0, 1, 2, 3, 4, 5, 6, 7)
#define PG8_MMA(ai, bj, At, Bt) do { if constexpr (FP8) __builtin_amdgcn_sched_barrier(0); __builtin_amdgcn_s_setprio(1); _Pragma("unroll") for (int m = 0; m < 4; ++m) _Pragma("unroll") for (int n = 0; n < 2; ++n) { \
        if constexpr (FP8) acc[ai][bj][m][n] = __builtin_amdgcn_mfma_scale_f32_16x16x128_f8f6f4(PG8_CAT(Bt[n]), PG8_CAT(At[m]), acc[ai][bj][m][n], 0, 0, 0, 0, 0, 0); \
        else if constexpr (I8) { _Pragma("unroll") for (int k = 0; k < 2; ++k) acc[ai][bj][m][n] = __builtin_bit_cast(f32x4, __builtin_amdgcn_mfma_i32_16x16x64_i8(__builtin_bit_cast(v4i32, Bt[n][k]), __builtin_bit_cast(v4i32, At[m][k]), __builtin_bit_cast(v4i32, acc[ai][bj][m][n]), 0, 0, 0)); } \
        else { _Pragma("unroll") for (int k = 0; k < 2; ++k) acc[ai][bj][m][n] = __builtin_amdgcn_mfma_f32_16x16x32_bf16(Bt[n][k], At[m][k], acc[ai][bj][m][n], 0, 0, 0); } } if constexpr (FP8) __builtin_amdgcn_sched_barrier(0); __builtin_amdgcn_s_setprio(0); if constexpr (FP8) __builtin_amdgcn_sched_barrier(0); } while (0)
#define PG8_WAIT_V(n) asm volatile("s_waitcnt vmcnt(" #n ")" ::: "memory")
#define PG8_WAIT_L(n) asm volatile("s_waitcnt lgkmcnt(" #n ")" ::: "memory")
#define PG8_BAR __builtin_amdgcn_s_barrier()
#define PG8_SCHED __builtin_amdgcn_sched_barrier(0)
    Unit cur, nxt; int ui = 0;
    if (!S.next(0, cur)) return;
    cur.par = 0;
    f32x4 acc[2][2][4][2];
#pragma unroll
    for (int a = 0; a < 2; ++a)
#pragma unroll
        for (int b = 0; b < 2; ++b)
#pragma unroll
            for (int m = 0; m < 4; ++m)
#pragma unroll
                for (int n = 0; n < 2; ++n) acc[a][b][m][n] = (f32x4){0.f, 0.f, 0.f, 0.f};
    bf16x8 At[4][2], B0[2][2], B1[2][2];
    v8i32 At8[4], B08[2], B18[2];
    const char* cA = (const char*)g.A + (size_t)cur.pm * tstep; const char* cB = (const char*)g.Bt + (size_t)cur.pn * tstep;
    S.a_ready(cur);
    PG8_STAGE(PG8_SB(0, 0), cB, voffB); PG8_STAGE(PG8_SB(0, 1), cB + hstep, voffB); PG8_STAGE(PG8_SA(0, 0), cA, voffA0); PG8_STAGE(PG8_SA(0, 1), cA + ahs, voffA1);
    if (wr == 1) PG8_BAR;
    PG8_WAIT_V(2); PG8_BAR;
    PG8_STAGE(PG8_SB(1, 0), cB + kstep, voffB); PG8_STAGE(PG8_SA(1, 0), cA + kstep, voffA0); PG8_STAGE(PG8_SB(1, 1), cB + hstep + kstep, voffB);
    PG8_WAIT_V(6); PG8_BAR;
    for (;;) {
        const bool has_next = S.next(ui + 1, nxt); nxt.par = (ui + 1) & 1;
        const char* nA = has_next ? (const char*)g.A + (size_t)nxt.pm * tstep : cA; const char* nB = has_next ? (const char*)g.Bt + (size_t)nxt.pn * tstep : cB;
        for (int t = 0; t < nt; t += 2) {
            const bool last = (t == nt - 2);
            const char* a1 = cA + (size_t)(t + 1) * kstep;
            const char* a2 = last ? nA : cA + (size_t)(t + 2) * kstep; const char* b2 = last ? nB : cB + (size_t)(t + 2) * kstep;
            const char* a3 = a2 + kstep; const char* b3 = b2 + kstep;
            asm volatile("" : "+s"(a1), "+s"(a2), "+s"(b2), "+s"(a3), "+s"(b3));
            if (last && has_next) S.a_ready(nxt);
            if constexpr (KHOOK) { int l3_ = threadIdx.x; asm volatile("" : "+v"(l3_)); E.khook(acc, cur, t, wr, wc, l3_ & 15, (l3_ >> 4) & 3); }
            PG8_LDB(B0, 0, 0); PG8_LDB(B1, 0, 1); PG8_SCHED; PG8_LDA(At, 0, 0); PG8_STAGE(PG8_SA(1, 1), a1 + ahs, voffA1);
            PG8_WAIT_V(8); PG8_WAIT_L(0); PG8_BAR;
            if constexpr (PREF) { if (t == 0 && wr == 0) E.prefetch(cur, wid); }
            PG8_MMA(0, 0, At, B0); PG8_MMA(0, 1, At, B1); PG8_BAR; PG8_SCHED;
            PG8_LDA(At, 0, 1); PG8_STAGE(PG8_SB(0, 0), b2, voffB); PG8_STAGE(PG8_SB(0, 1), b2 + hstep, voffB); PG8_STAGE(PG8_SA(0, 0), a2, voffA0);
            PG8_WAIT_V(8); PG8_WAIT_L(0); PG8_BAR; PG8_MMA(1, 0, At, B0); PG8_MMA(1, 1, At, B1); PG8_BAR; PG8_SCHED;
            PG8_LDB(B0, 1, 0); PG8_LDB(B1, 1, 1); PG8_SCHED; PG8_LDA(At, 1, 0); PG8_STAGE(PG8_SA(0, 1), a2 + ahs, voffA1);
            PG8_WAIT_V(8); PG8_WAIT_L(0); PG8_BAR; PG8_MMA(0, 0, At, B0); PG8_MMA(0, 1, At, B1); PG8_BAR; PG8_SCHED;
            PG8_LDA(At, 1, 1); PG8_STAGE(PG8_SB(1, 0), b3, voffB); PG8_STAGE(PG8_SB(1, 1), b3 + hstep, voffB); PG8_STAGE(PG8_SA(1, 0), a3, voffA0);
            PG8_WAIT_V(8); PG8_WAIT_L(0); PG8_BAR; PG8_MMA(1, 0, At, B0); PG8_MMA(1, 1, At, B1); PG8_BAR; PG8_SCHED;
        }
        if constexpr (ALIGN_EPI) { if (wr == 0) PG8_BAR; }
        { int l2_ = threadIdx.x; asm volatile("" : "+v"(l2_)); const int fr2 = l2_ & 15, fq2 = (l2_ >> 4) & 3;
          if (!E.skip) E(acc, cur, wr, wc, fr2, fq2); } S.done(cur);
        if (!has_next) break;
#pragma unroll
        for (int a = 0; a < 2; ++a)
#pragma unroll
            for (int b = 0; b < 2; ++b)
#pragma unroll
                for (int m = 0; m < 4; ++m)
#pragma unroll
                    for (int n = 0; n < 2; ++n) acc[a][b][m][n] = (f32x4){0.f, 0.f, 0.f, 0.f};
        cur = nxt; cA = nA; cB = nB; ++ui;
        if constexpr (ALIGN_EPI) { if (wr == 1) PG8_BAR; }
    }
    PG8_WAIT_V(0);
    if constexpr (!ALIGN_EPI) { if (wr == 0) PG8_BAR; }
    PG8_BAR;
#undef PG8_SA
#undef PG8_SB
#undef PG8_STAGE
#undef PG8_PSTEP
#undef PG8_LDA
#undef PG8_LDB
#undef PG8_MMA
#undef PG8_CAT
#undef PG8_LD8
#undef PG8_WAIT_V
#undef PG8_WAIT_L
#undef PG8_BAR
#undef PG8_SCHED
}
}

constexpr size_t MiB = 1u << 20;
constexpr size_t WS_CTL = 0, CTL_ZERO_BYTES = 1 * MiB;
constexpr size_t WS_WO = 1 * MiB;
constexpr size_t WS_WOUT = 4 * MiB;
constexpr size_t WS_WUP = 6 * MiB;
constexpr size_t WS_WDOWN = 17 * MiB;
constexpr size_t WS_SSQ = 23 * MiB;
constexpr size_t WS_UE = 24 * MiB;
constexpr size_t WS_UF = 27 * MiB;
constexpr size_t WS_LSE = 30 * MiB;
constexpr size_t WS_MKV = 31 * MiB;
constexpr size_t WS_G = 34 * MiB;
constexpr size_t WS_A1I8 = 84 * MiB;
constexpr size_t WS_RSC = 23 * MiB;
constexpr size_t WS_CMAX = 23 * MiB + 128 * 1024;
constexpr size_t WS_ACT = 34 * MiB;
constexpr size_t WS_QA = 130 * MiB;
constexpr size_t WS_KA = 154 * MiB;
constexpr size_t WS_VA = 178 * MiB;
constexpr size_t WS_MERGED = 130 * MiB;
constexpr size_t WS_X1B = 162 * MiB;
constexpr size_t WS_X1L = 194 * MiB;
constexpr size_t WS_QB = 202 * MiB;
constexpr size_t WS_KVB = 218 * MiB;
constexpr size_t WS_MQ = 226 * MiB;
constexpr size_t WS_END = 242 * MiB;
constexpr size_t DO_WI8 = 34 * MiB;
constexpr size_t DO_ROPE = 49 * MiB;
constexpr size_t DO_OCAT = 0;
constexpr size_t DO_OAG = 40 * MiB;

constexpr int CW_TMO = 0, CW_BAR = 4096;

constexpr int RING_OFF = 0, RING_BYTES = 131072;
constexpr int XCH_OFF = RING_BYTES;
constexpr int LDSCTL_OFF = RING_BYTES + 4096, MISC_OFF = LDSCTL_OFF + 320;
constexpr int LDS_BYTES = 147456;
constexpr int P1T_ROPE = 131072, P1T_CS = 139264, P1T_BIAS = 140288, P1T_RSC = 141312, P1T_GAIN = 142336;
constexpr int CTAB_OFF = 139264;
constexpr int NWAVES = 8;
constexpr int NPHASES = 8;

typedef GAS unsigned gu32;
#define RLX_AGENT __ATOMIC_RELAXED, __HIP_MEMORY_SCOPE_AGENT
#define LDS_WAIT() asm volatile("s_waitcnt lgkmcnt(0)" ::: "memory")
#define VM_WAIT() asm volatile("s_waitcnt vmcnt(0)" ::: "memory")

#define XB_TMO      128
#define XB_XCNT(j)  (256  + 64 * (j))
#define XB_XSUB(j)  (1280 + 64 * (j))
#define XB_XGEN(j)  (2304 + 64 * (j))
#define XB_TOP      3328
#define XB_TOPGEN   3392
#define XCD_BAR_WORDS 3456
#define XB_SPIN_CAP (1u << 18)
__device__ __forceinline__ unsigned xb_ld(unsigned* p)              { return __hip_atomic_load(p, __ATOMIC_RELAXED, __HIP_MEMORY_SCOPE_AGENT); }
__device__ __forceinline__ unsigned xb_add(unsigned* p, unsigned v) { return __hip_atomic_fetch_add(p, v, __ATOMIC_RELAXED, __HIP_MEMORY_SCOPE_AGENT); }
__device__ __forceinline__ unsigned xb_xcc_id() { return (unsigned)__builtin_amdgcn_s_getreg((3 << 11) | 20) & 0xFu; }
#define XB_SPIN(cond, bar) do { unsigned _sp = 0; while (cond) { __builtin_amdgcn_s_sleep(1); \
    if ((++_sp & 255u) == 0u) { if (xb_ld(&(bar)[XB_TMO])) break; if (_sp > XB_SPIN_CAP) { atomicAdd(&(bar)[XB_TMO], 1u); break; } } } } while (0)
__device__ unsigned g_barrier_words[2 * XCD_BAR_WORDS];
struct XcdBarrier { unsigned* bar; unsigned x, nloc, nx; };
__device__ __forceinline__ void xcd_barrier(const XcdBarrier& b) {
    asm volatile("s_waitcnt vmcnt(0)" ::: "memory");
    __syncthreads();
    if (threadIdx.x == 0) {
        unsigned* bar = b.bar;
        __builtin_amdgcn_s_waitcnt(0);
        const unsigned nloc = b.nloc, nx = b.nx;
        const unsigned old = xb_add(&bar[XB_XSUB(b.x)], 1u);
        const unsigned gen = old / nloc;
        if (old + 1u == (gen + 1u) * nloc) {
            __builtin_amdgcn_fence(__ATOMIC_RELEASE, "agent");
            asm volatile("s_waitcnt vmcnt(0)" ::: "memory");
            const unsigned og = xb_add(&bar[XB_TOP], 1u);
            const unsigned tg = og / nx;
            if (og + 1u == (tg + 1u) * nx) xb_add(&bar[XB_TOPGEN], 1u);
            else XB_SPIN(xb_ld(&bar[XB_TOPGEN]) == tg, bar);
            __builtin_amdgcn_fence(__ATOMIC_ACQUIRE, "agent");
            xb_add(&bar[XB_XGEN(b.x)], 1u);
            asm volatile("s_waitcnt vmcnt(0)" ::: "memory");
        } else {
            XB_SPIN(xb_ld(&bar[XB_XGEN(b.x)]) == gen, bar);
            __builtin_amdgcn_fence(__ATOMIC_ACQUIRE, "agent");
            asm volatile("s_waitcnt vmcnt(0)" ::: "memory");
        }
    }
    __syncthreads();
}

struct Args {
    const float* in[25]; float* out; unsigned char* ws; int ph_lo, ph_hi, li, pad;
};
enum { I_X = 0, I_MEM, I_POS, I_ATTN_NORM, I_W_IN, I_AQ, I_AK, I_BQ, I_BK, I_SINK, I_MEM_NORM, I_W_MKV, I_MQN, I_MKN, I_WOA, I_WOB, I_WOM, I_WGATE, I_BGATE, I_WOUT, I_FFN_NORM, I_WUP, I_CONVW, I_CONVB, I_WDOWN };

__host__ __device__ __forceinline__ int map_uniform(int n) { const int c = n & 255; return (n & ~255) + 128 * ((c >> 5) & 1) + 32 * (c >> 6) + (c & 31); }
__host__ __device__ __forceinline__ int map_up(int n) { return n < DFF_ ? 256 * (n >> 7) + (n & 127) : 256 * ((n - DFF_) >> 7) + 128 + ((n - DFF_) & 127); }

__device__ __forceinline__ float wave_sum(float v) {
#pragma unroll
    for (int o = 1; o < 64; o <<= 1) v += __shfl_xor(v, o);
    return v;
}
template <int MAP>
__device__ __forceinline__ void p0_transpose_item(const float* W, int K, int N, bf16_t* WT, int noff, int pitch, int koff, const float* kscale, LAS float*  , int item, int lane) {
    const int nblk = N / 32, kb = item / nblk, nb = item % nblk, k0 = 64 * kb + 8 * (lane >> 3), n0 = 32 * nb;
    f32x4 v[8];
#pragma unroll
    for (int i = 0; i < 8; ++i) v[i] = *(const f32x4*)(W + (size_t)(k0 + i) * N + n0 + 4 * (lane & 7));
    if (kscale) { const f32x4 s0 = *(const f32x4*)(kscale + k0), s1 = *(const f32x4*)(kscale + k0 + 4);
#pragma unroll
        for (int i = 0; i < 8; ++i) v[i] = v[i] * (i < 4 ? s0[i & 3] : s1[i & 3]); }
    const int r0 = (MAP == 0 ? map_uniform(noff + n0) : map_up(noff + n0)) + 4 * (lane & 7);
#pragma unroll
    for (int e = 0; e < 4; ++e) { u32x4 o; o.x = cvtpk(v[0][e], v[1][e]); o.y = cvtpk(v[2][e], v[3][e]); o.z = cvtpk(v[4][e], v[5][e]); o.w = cvtpk(v[6][e], v[7][e]);
        *(GAS u32x4*)(WT + (size_t)(r0 + e) * pitch + koff + k0 + 0) = o; }
}
constexpr float I8MAGIC = 12582912.0f;
__device__ __forceinline__ unsigned pack_i8(float m0, float m1, float m2, float m3) {
    const unsigned p01 = __builtin_amdgcn_perm(__float_as_uint(m1), __float_as_uint(m0), 0x0c0c0400u);
    const unsigned p23 = __builtin_amdgcn_perm(__float_as_uint(m3), __float_as_uint(m2), 0x0c0c0400u);
    return p01 | (p23 << 16);
}
__device__ __forceinline__ float wave_max(float v) {
#pragma unroll
    for (int o = 1; o < 64; o <<= 1) v = fmaxf(v, __shfl_xor(v, o));
    return v;
}
__device__ __forceinline__ void p0_quant_weight_block(const float* W, int N, int nb, int coff, unsigned char* WT, float* cmax, LAS float* part, int wave, int lane) {
    const int n0 = 32 * nb;
    f32x4 v[2][8];
#pragma unroll
    for (int it = 0; it < 2; ++it) { const int k0 = 128 * wave + 64 * it + 8 * (lane >> 3);
#pragma unroll
        for (int i = 0; i < 8; ++i) v[it][i] = *(const f32x4*)(W + (size_t)(k0 + i) * N + n0 + 4 * (lane & 7)); }
    f32x4 mx = {0.f, 0.f, 0.f, 0.f};
#pragma unroll
    for (int it = 0; it < 2; ++it)
#pragma unroll
        for (int i = 0; i < 8; ++i)
#pragma unroll
            for (int e = 0; e < 4; ++e) mx[e] = fmaxf(mx[e], fabsf(v[it][i][e]));
#pragma unroll
    for (int o = 8; o < 64; o <<= 1)
#pragma unroll
        for (int e = 0; e < 4; ++e) mx[e] = fmaxf(mx[e], __shfl_xor(mx[e], o));
    if (lane < 8) *(LAS f32x4*)(part + wave * 32 + 4 * lane) = mx;
    __syncthreads();
    f32x4 cm = *(const LAS f32x4*)(part + 4 * (lane & 7));
#pragma unroll
    for (int w = 1; w < 8; ++w) { const f32x4 o = *(const LAS f32x4*)(part + w * 32 + 4 * (lane & 7));
#pragma unroll
        for (int e = 0; e < 4; ++e) cm[e] = fmaxf(cm[e], o[e]); }
    if (wave == 0 && lane < 8) *(f32x4*)(cmax + coff + n0 + 4 * lane) = cm;
    f32x4 inv;
#pragma unroll
    for (int e = 0; e < 4; ++e) inv[e] = cm[e] > 0.f ? 127.0f / cm[e] : 0.f;
    const int r0 = map_uniform(coff + n0) + 4 * (lane & 7);
#pragma unroll
    for (int it = 0; it < 2; ++it) { const int k0 = 128 * wave + 64 * it + 8 * (lane >> 3);
#pragma unroll
        for (int e = 0; e < 4; ++e) { u32x2 o;
            o.x = pack_i8(__builtin_fmaf(v[it][0][e], inv[e], I8MAGIC), __builtin_fmaf(v[it][1][e], inv[e], I8MAGIC), __builtin_fmaf(v[it][2][e], inv[e], I8MAGIC), __builtin_fmaf(v[it][3][e], inv[e], I8MAGIC));
            o.y = pack_i8(__builtin_fmaf(v[it][4][e], inv[e], I8MAGIC), __builtin_fmaf(v[it][5][e], inv[e], I8MAGIC), __builtin_fmaf(v[it][6][e], inv[e], I8MAGIC), __builtin_fmaf(v[it][7][e], inv[e], I8MAGIC));
            *(GAS u32x2*)(WT + (size_t)(r0 + e) * 1024 + k0) = o; } }
    __syncthreads();
}
template <int NR>
__device__ __forceinline__ void rms_rows_to_i8(const float* xrow, size_t rstride, const float* gain, unsigned char* orow, float* rsc, int lane) {
    const GAS f32x4* gr = (const GAS f32x4*)gain + lane;
    f32x4 v[NR][4]; float s[NR], mx[NR];
#pragma unroll
    for (int r = 0; r < NR; ++r) { const GAS f32x4* xr = (const GAS f32x4*)(xrow + r * rstride) + lane;
#pragma unroll
        for (int j = 0; j < 4; ++j) v[r][j] = xr[64 * j]; }
    f32x4 g[4];
#pragma unroll
    for (int j = 0; j < 4; ++j) g[j] = gr[64 * j];
#pragma unroll
    for (int r = 0; r < NR; ++r) { s[r] = 0.f;
#pragma unroll
        for (int j = 0; j < 4; ++j) s[r] += (v[r][j].x * v[r][j].x + v[r][j].y * v[r][j].y) + (v[r][j].z * v[r][j].z + v[r][j].w * v[r][j].w); }
#pragma unroll
    for (int r = 0; r < NR; ++r) { const float rstd = 1.0f / sqrtf(wave_sum(s[r]) * (1.f / 1024.f) + EPS_); mx[r] = 0.f;
#pragma unroll
        for (int j = 0; j < 4; ++j) { v[r][j] = v[r][j] * rstd * g[j];
            mx[r] = fmaxf(fmaxf(mx[r], fmaxf(fabsf(v[r][j].x), fabsf(v[r][j].y))), fmaxf(fabsf(v[r][j].z), fabsf(v[r][j].w))); } }
#pragma unroll
    for (int r = 0; r < NR; ++r) mx[r] = wave_max(mx[r]);
#pragma unroll
    for (int r = 0; r < NR; ++r) { const float inv = mx[r] > 0.f ? 127.0f / mx[r] : 0.f;
        GAS unsigned* o4 = (GAS unsigned*)(orow + r * rstride) + lane;
#pragma unroll
        for (int j = 0; j < 4; ++j) o4[64 * j] = pack_i8(__builtin_fmaf(v[r][j].x, inv, I8MAGIC), __builtin_fmaf(v[r][j].y, inv, I8MAGIC), __builtin_fmaf(v[r][j].z, inv, I8MAGIC), __builtin_fmaf(v[r][j].w, inv, I8MAGIC));
        if (lane == 0) rsc[r] = mx[r] * (1.0f / 127.0f); }
}
__device__ __forceinline__ void sincos_f(float ang, float& co, float& si) {
    const double x = (double)ang; const double n = __builtin_rint(x * 0.63661977236758134308);
    double r = __builtin_fma(-n, 1.5707963267948966192, x); r = __builtin_fma(-n, 6.123233995736766036e-17, r);
    const double r2 = r * r;
    double s = -1.0 / 6227020800.0; s = s * r2 + 1.0 / 39916800.0; s = s * r2 - 1.0 / 362880.0; s = s * r2 + 1.0 / 5040.0; s = s * r2 - 1.0 / 120.0; s = s * r2 + 1.0 / 6.0; s = r - r * r2 * s;
    double c = 1.0 / 479001600.0; c = c * r2 - 1.0 / 3628800.0; c = c * r2 + 1.0 / 40320.0; c = c * r2 - 1.0 / 720.0; c = c * r2 + 1.0 / 24.0; c = c * r2 - 0.5; c = c * r2 + 1.0;
    const int q = (int)((long long)n & 3);
    const double cs = (q == 0) ? c : (q == 1) ? -s : (q == 2) ? -c : s;
    const double sn = (q == 0) ? s : (q == 1) ? c : (q == 2) ? -s : -c;
    co = (float)cs; si = (float)sn;
}

struct Frame {
    LAS unsigned char* lds;
    int tid, lane, wave, vcu, G;
    const Args* a;
};

__device__ __forceinline__ void p0_prologue(const Args& A, LAS unsigned char* lds, int vcu, int G, int wave, int lane) {
    const int gw = vcu * NWAVES + wave, NGW = G * NWAVES;
    unsigned char* wi8 = (unsigned char*)A.out + DO_WI8;
    unsigned char* a1 = A.ws + WS_A1I8;
    float* rsc = (float*)(A.ws + WS_RSC); float* cmax = (float*)(A.ws + WS_CMAX);
    unsigned* rope = (unsigned*)((unsigned char*)A.out + DO_ROPE);
    constexpr int B_IN = 3584 / 32, B_GATE = 3072 / 32, B_MKV = 1024 / 32;
    for (int it = vcu; it < B_IN + B_GATE + B_MKV; it += G) {
        LAS float* part = (LAS float*)(lds + RING_OFF);
        if (it < B_IN) p0_quant_weight_block(A.in[I_W_IN], 3584, it, 0, wi8, cmax, part, wave, lane);
        else if (it < B_IN + B_GATE) p0_quant_weight_block(A.in[I_WGATE], 3072, it - B_IN, 3584, wi8, cmax, part, wave, lane);
        else p0_quant_weight_block(A.in[I_W_MKV], 1024, it - B_IN - B_GATE, 6656, wi8, cmax, part, wave, lane);
    }
    for (int m = 4 * gw; m < T_; m += 4 * NGW)
        rms_rows_to_i8<4>(A.in[I_X] + (size_t)m * DM_, DM_, A.in[I_ATTN_NORM], a1 + (size_t)m * DM_, rsc + m, lane);
    for (int m = NGW - 1 - gw; m < NB_ * MEM_; m += NGW)
        rms_rows_to_i8<1>(A.in[I_MEM] + (size_t)m * DM_, DM_, A.in[I_MEM_NORM], a1 + (size_t)(T_ + m) * DM_, rsc + T_ + m, lane);
    const int* pos = (const int*)A.in[I_POS];
    for (int idx = gw * 64 + lane; idx < T_ * 8; idx += NGW * 64) {
        const int t = idx >> 3, i = idx & 7;
        const float fr = (i == 0) ? 1.0f : (i == 1) ? 0.193922758102417f : (i == 2) ? 0.03760603442788124f : (i == 3) ? 0.007292666472494602f : (i == 4) ? 0.0014142136787995696f
                       : (i == 5) ? 0.00027424818836152554f : (i == 6) ? 5.318298644851893e-05f : 1.031338433676865e-05f;
        const float ang = (float)pos[t] * fr; float co, si; sincos_f(ang, co, si);
        rope[idx] = (unsigned)__builtin_bit_cast(unsigned short, (_Float16)co) | ((unsigned)__builtin_bit_cast(unsigned short, (_Float16)si) << 16);
    }
}

struct TItem { const float* W; bf16_t* WT; const float* kscale; int N, noff, pitch, koff, map, item; };
__device__ __forceinline__ void ti_load(const TItem& d, int lane, f32x4 (&v)[8], f32x4 (&sc)[2]) {
    const int nblk = d.N / 32, kb = d.item / nblk, nb = d.item % nblk, k0 = 64 * kb + 8 * (lane >> 3), n0 = 32 * nb;
#pragma unroll
    for (int i = 0; i < 8; ++i) v[i] = *(const f32x4*)(d.W + (size_t)(k0 + i) * d.N + n0 + 4 * (lane & 7));
    if (d.kscale) { sc[0] = *(const f32x4*)(d.kscale + k0); sc[1] = *(const f32x4*)(d.kscale + k0 + 4); }
}
__device__ __forceinline__ void ti_store(const TItem& d, int lane, f32x4 (&v)[8], const f32x4 (&sc)[2]) {
    const int nblk = d.N / 32, kb = d.item / nblk, nb = d.item % nblk, k0 = 64 * kb + 8 * (lane >> 3), n0 = 32 * nb;
    if (d.kscale) {
#pragma unroll
        for (int i = 0; i < 8; ++i) v[i] = v[i] * (i < 4 ? sc[0][i & 3] : sc[1][i & 3]); }
    const int r0 = (d.map == 0 ? map_uniform(d.noff + n0) : map_up(d.noff + n0)) + 4 * (lane & 7);
#pragma unroll
    for (int e = 0; e < 4; ++e) { u32x4 o; o.x = cvtpk(v[0][e], v[1][e]); o.y = cvtpk(v[2][e], v[3][e]); o.z = cvtpk(v[4][e], v[5][e]); o.w = cvtpk(v[6][e], v[7][e]);
        *(GAS u32x4*)(d.WT + (size_t)(r0 + e) * d.pitch + d.koff + k0) = o; }
}
template <int PART>
__device__ __forceinline__ bool late_item(const Args& A, int it, TItem& d) {
    constexpr int I_OA = (256 / 64) * (1024 / 32), I_OB = (512 / 64) * (1024 / 32), I_OM = I_OB, I_OUT = (1024 / 64) * (1024 / 32);
    constexpr int I_UP = (1024 / 64) * (5632 / 32), I_DOWN = (2816 / 64) * (1024 / 32);
    bf16_t* wo = (bf16_t*)(A.ws + WS_WO);
    if (PART == 1) { if (it >= I_DOWN) return false; d = TItem{A.in[I_WDOWN], (bf16_t*)(A.ws + WS_WDOWN), nullptr, 1024, 0, 2816, 0, 0, it}; return true; }
    int r = it;
    if (r < I_OA) { d = TItem{A.in[I_WOA], wo, nullptr, 1024, 0, KCAT, 0, 0, r}; return true; } r -= I_OA;
    if (r < I_OB) { d = TItem{A.in[I_WOB], wo, nullptr, 1024, 0, KCAT, 256, 0, r}; return true; } r -= I_OB;
    if (r < I_OM) { d = TItem{A.in[I_WOM], wo, nullptr, 1024, 0, KCAT, 768, 0, r}; return true; } r -= I_OM;
    if (r < I_OUT) { d = TItem{A.in[I_WOUT], (bf16_t*)(A.ws + WS_WOUT), nullptr, 1024, 0, 1024, 0, 0, r}; return true; } r -= I_OUT;
    if (r < I_UP) { d = TItem{A.in[I_WUP], (bf16_t*)(A.ws + WS_WUP), A.in[I_FFN_NORM], 5632, 0, 1024, 0, 1, r}; return true; }
    return false;
}
template <int PART>
__device__ __forceinline__ void p0_late_weights(const Args& A, int gw, int ngw, int lane) {
    constexpr int NB = 3;
    for (int it = gw; ; it += NB * ngw) {
        TItem d[NB]; bool ok[NB]; f32x4 v[NB][8], sc[NB][2];
#pragma unroll
        for (int b = 0; b < NB; ++b) { ok[b] = late_item<PART>(A, it + b * ngw, d[b]); if (ok[b]) ti_load(d[b], lane, v[b], sc[b]); }
        if (!ok[0]) break;
#pragma unroll
        for (int b = 0; b < NB; ++b) if (ok[b]) ti_store(d[b], lane, v[b], sc[b]);
    }
}

struct TileOrder {
    pg8::StaticOrder so; unsigned mask; int mkv;
    __device__ void init(unsigned mask_, int mkv_, int G, int c) { mask = mask_; mkv = mkv_; so.init(T_, 256 * __builtin_popcount(mask_), G, c, 4); }
    __device__ bool next(int i, pg8::Unit& u) const {
        if (so.next(i, u)) { const int k = u.pn; const unsigned long long tb = k < 12 ? 0xa48a2524e620c20ull : k < 24 ? 0xcaef6ace0e6e188ull : 0x22full; u.pn = (int)((tb >> (5 * (k % 12))) & 31ull); return true; }
        if (!mkv) return false;
        const long L = (long)i * so.G + so.c - so.nwg; if (L < 0 || L >= 16) return false;
        u.pm = 64 + (int)(L >> 2); u.pn = 26 + (int)(L & 3); return true;
    }
    __device__ __forceinline__ void a_ready(const pg8::Unit&) const {}
    __device__ __forceinline__ void done(const pg8::Unit&) const {}
};

__device__ __forceinline__ f32x4 cvt_i32(const f32x4& a) { const v4i32 i = __builtin_bit_cast(v4i32, a); return (f32x4){(float)i[0], (float)i[1], (float)i[2], (float)i[3]}; }

__device__ __forceinline__ float h2f_lo(unsigned w) { return (float)__builtin_bit_cast(_Float16, (unsigned short)(w & 0xffffu)); }
__device__ __forceinline__ float h2f_hi(unsigned w) { return (float)__builtin_bit_cast(_Float16, (unsigned short)(w >> 16)); }

struct EpiG {
    static constexpr bool PERM = true;
    unsigned char* G; LAS const unsigned char* lds;
    bool skip = false;
    __device__ __forceinline__ void operator()(const f32x4 (&acc)[2][2][4][2], const pg8::Unit& u, int wr, int wc, int fr, int fq) const {
        const int col0 = u.pn * 256, row0 = u.pm * 256;
        f32x4 bv[2][2], cs[2][2];
#pragma unroll
        for (int bj = 0; bj < 2; ++bj)
#pragma unroll
            for (int n = 0; n < 2; ++n) { const int j = wc * 64 + 32 * bj + 8 * fq + 4 * n; bv[bj][n] = *(LAS const f32x4*)(lds + P1T_BIAS + 4 * j) * (-LOG2E); cs[bj][n] = *(LAS const f32x4*)(lds + P1T_CS + 4 * j) * (-LOG2E / 127.0f); }
        float rsv[2][4];
#pragma unroll
        for (int ai = 0; ai < 2; ++ai)
#pragma unroll
            for (int m = 0; m < 4; ++m) rsv[ai][m] = *(LAS const float*)(lds + P1T_RSC + 4 * (ai * 128 + wr * 64 + m * 16 + fr));
#pragma unroll
        for (int ai = 0; ai < 2; ++ai)
#pragma unroll
            for (int m = 0; m < 4; ++m) { unsigned char* rowp = G + (size_t)(row0 + ai * 128 + wr * 64 + m * 16 + fr) * 3072 + col0 + wc * 64 + 8 * fq;
#pragma unroll
                for (int bj = 0; bj < 2; ++bj) { u32x2 w;
#pragma unroll
                    for (int n = 0; n < 2; ++n) { const f32x4 z = (cvt_i32(acc[ai][bj][m][n]) * rsv[ai][m]) * cs[bj][n] + bv[bj][n]; unsigned q[4];
#pragma unroll
                        for (int e = 0; e < 4; ++e) { const float g = __builtin_amdgcn_rcpf(1.0f + __builtin_amdgcn_exp2f(z[e])); const unsigned qi = (unsigned)(g * 255.0f + 0.5f); q[e] = qi < 1u ? 1u : qi; }
                        w[n] = q[0] | (q[1] << 8) | (q[2] << 16) | (q[3] << 24); }
                    *(u32x2*)(rowp + 32 * bj) = w; } }
    }
};

struct Epi1 {
    static constexpr bool PERM = true;
    unsigned char* ws; const unsigned* rope; const float *aq, *ak, *bq, *bk, *bgate; const float* rsc; const float* cmax; LAS unsigned char* lds;
    bool skip = false;
    __device__ __forceinline__ void prefetch(const pg8::Unit& u, int w) const {
        int lane = threadIdx.x; asm volatile("" : "+v"(lane)); lane &= 63;
        const int pn = u.pn, pm = u.pm;
        if (pm < 64 && pn < 12) {
#pragma unroll
            for (int j = 0; j < 2; ++j) { const int piece = 2 * w + j;
                __builtin_amdgcn_global_load_lds((const unsigned*)((const char*)rope + (size_t)pm * 8192 + piece * 1024 + lane * 16), (LAS unsigned*)(lds + P1T_ROPE + piece * 1024), 16, 0, 0); }
        }
        if (w == 0) __builtin_amdgcn_global_load_lds((const unsigned*)(cmax + pn * 256 + lane * 4), (LAS unsigned*)(lds + P1T_CS), 16, 0, 0);
        else if (w == 1) { if (pn >= 14 && pn < 26) __builtin_amdgcn_global_load_lds((const unsigned*)(bgate + (pn - 14) * 256 + lane * 4), (LAS unsigned*)(lds + P1T_BIAS), 16, 0, 0); }
        else if (w == 2) __builtin_amdgcn_global_load_lds((const unsigned*)(rsc + pm * 256 + lane * 4), (LAS unsigned*)(lds + P1T_RSC), 16, 0, 0);
        else if (pn < 12) { const int gi = pn / 3, ty = pn - 3 * gi;
            const float* gp = (pn >= 11) ? bk : (pn >= 9) ? bq : (ty == 0) ? aq + 64 * gi : ak + 64 * gi;
            if (lane < 16) __builtin_amdgcn_global_load_lds((const unsigned*)(gp + lane * 4), (LAS unsigned*)(lds + P1T_GAIN), 16, 0, 0); }
    }
    __device__ __forceinline__ void plain(const f32x4 (&acc)[2][2][4][2], bf16_t* dst, int ld, int col0, int row0, int wr, int wc, int fr, int fq) const {
        f32x4 cs[2][2];
#pragma unroll
        for (int bj = 0; bj < 2; ++bj)
#pragma unroll
            for (int n = 0; n < 2; ++n) cs[bj][n] = *(LAS const f32x4*)(lds + P1T_CS + 4 * (wc * 64 + 32 * bj + 8 * fq + 4 * n)) * (1.0f / 127.0f);
        float rsv[2][4];
#pragma unroll
        for (int ai = 0; ai < 2; ++ai)
#pragma unroll
            for (int m = 0; m < 4; ++m) rsv[ai][m] = *(LAS const float*)(lds + P1T_RSC + 4 * (ai * 128 + wr * 64 + m * 16 + fr));
#pragma unroll
        for (int ai = 0; ai < 2; ++ai)
#pragma unroll
            for (int m = 0; m < 4; ++m) { bf16_t* rowp = dst + (size_t)(row0 + ai * 128 + wr * 64 + m * 16 + fr) * ld + col0 + wc * 64 + 8 * fq;
#pragma unroll
                for (int bj = 0; bj < 2; ++bj) { const f32x4 v0 = cvt_i32(acc[ai][bj][m][0]) * rsv[ai][m] * cs[bj][0], v1 = cvt_i32(acc[ai][bj][m][1]) * rsv[ai][m] * cs[bj][1];
                    u32x4 w; w.x = cvtpk(v0[0], v0[1]); w.y = cvtpk(v0[2], v0[3]); w.z = cvtpk(v1[0], v1[1]); w.w = cvtpk(v1[2], v1[3]);
                    *(u32x4*)(rowp + 32 * bj) = w; } }
    }
    __device__ __forceinline__ void normed(const f32x4 (&acc)[2][2][4][2], bf16_t* dst, int ld, int col0, int row0, float scale, int wr, int wc, int fr, int fq) const {
        f32x4 g[2][2], cs[2][2];
#pragma unroll
        for (int bj = 0; bj < 2; ++bj)
#pragma unroll
            for (int n = 0; n < 2; ++n) { g[bj][n] = *(LAS const f32x4*)(lds + P1T_GAIN + 4 * (32 * bj + 8 * fq + 4 * n)) * scale; cs[bj][n] = *(LAS const f32x4*)(lds + P1T_CS + 4 * (wc * 64 + 32 * bj + 8 * fq + 4 * n)) * (1.0f / 127.0f); }
#pragma unroll
        for (int aim = 0; aim < 4; ++aim) {
            const int ai = aim >> 1;
            u32x4 rw[2][2]; float rsv[2];
#pragma unroll
            for (int mm = 0; mm < 2; ++mm) { const int tr = ai * 128 + wr * 64 + (2 * (aim & 1) + mm) * 16 + fr; rsv[mm] = *(LAS const float*)(lds + P1T_RSC + 4 * tr);
#pragma unroll
                for (int n = 0; n < 2; ++n) rw[mm][n] = *(LAS const u32x4*)(lds + P1T_ROPE + 32 * tr + 16 * n); }
#pragma unroll
            for (int mm = 0; mm < 2; ++mm) { const int m = 2 * (aim & 1) + mm;
                const int row = row0 + ai * 128 + wr * 64 + m * 16 + fr;
                f32x4 v[2][2];
                float ss = 0.f;
#pragma unroll
                for (int bj = 0; bj < 2; ++bj)
#pragma unroll
                    for (int n = 0; n < 2; ++n) { const f32x4 x = cvt_i32(acc[ai][bj][m][n]) * cs[bj][n]; v[bj][n] = x; ss += (x[0] * x[0] + x[1] * x[1]) + (x[2] * x[2] + x[3] * x[3]); }
                ss += xor16(ss); ss = sum_halves(ss);
                const float rq = rsv[mm];
                const float rs = rq / sqrtf(ss * (rq * rq * (1.f / 64.f)) + EPS_);
#pragma unroll
                for (int bj = 0; bj < 2; ++bj)
#pragma unroll
                    for (int n = 0; n < 2; ++n) v[bj][n] = v[bj][n] * rs * g[bj][n];
#pragma unroll
                for (int n = 0; n < 2; ++n) {
                    const u32x4 cw = rw[mm][n];
                    const f32x4 co = {h2f_lo(cw[0]), h2f_lo(cw[1]), h2f_lo(cw[2]), h2f_lo(cw[3])}, si = {h2f_hi(cw[0]), h2f_hi(cw[1]), h2f_hi(cw[2]), h2f_hi(cw[3])};
                    f32x4 pr;
#pragma unroll
                    for (int e = 0; e < 4; ++e) pr[e] = xor16(v[0][n][e]);
                    const f32x4 r0 = v[0][n] * co - pr * si, r1 = v[0][n] * co + pr * si;
                    v[0][n] = (fq == 0) ? r0 : (fq == 1) ? r1 : v[0][n];
                }
                bf16_t* rowp = dst + (size_t)row * ld + col0 + wc * 64 + 8 * fq;
#pragma unroll
                for (int bj = 0; bj < 2; ++bj) { u32x4 w; w.x = cvtpk(v[bj][0][0], v[bj][0][1]); w.y = cvtpk(v[bj][0][2], v[bj][0][3]); w.z = cvtpk(v[bj][1][0], v[bj][1][1]); w.w = cvtpk(v[bj][1][2], v[bj][1][3]);
                    *(u32x4*)(rowp + 32 * bj) = w; }
            }
        }
    }
    __device__ __forceinline__ void operator()(const f32x4 (&acc)[2][2][4][2], const pg8::Unit& u, int wr, int wc, int fr, int fq) const {
        const int pn = u.pn, row0 = u.pm * 256;
        if (pn >= 26) { plain(acc, (bf16_t*)(ws + WS_MKV), 1024, (pn - 26) * 256, row0 - T_, wr, wc, fr, fq); return; }
        if (pn >= 14) { EpiG eg{ws + WS_G, lds}; pg8::Unit ug{u.pm, pn - 14}; eg(acc, ug, wr, wc, fr, fq); return; }
        if (pn >= 12) { plain(acc, (bf16_t*)(ws + WS_MQ), 512, (pn - 12) * 256, row0, wr, wc, fr, fq); return; }
        if (pn == 11) {
            if (wc >= 2) plain(acc, (bf16_t*)(ws + WS_KVB), 256, 0, row0, wr, wc, fr, fq);
            else normed(acc, (bf16_t*)(ws + WS_KVB), 256, 0, row0, 1.0f, wr, wc, fr, fq);
            return;
        }
        if (pn >= 9) { normed(acc, (bf16_t*)(ws + WS_QB), 512, (pn - 9) * 256, row0, QSCALE64, wr, wc, fr, fq); return; }
        const int gi = pn / 3, ty = pn - 3 * gi;
        if (ty == 2) { plain(acc, (bf16_t*)(ws + WS_VA) + (size_t)gi * T_ * 256, 256, 0, row0, wr, wc, fr, fq); return; }
        if (ty == 0) normed(acc, (bf16_t*)(ws + WS_QA) + (size_t)gi * T_ * 256, 256, 0, row0, QSCALE64, wr, wc, fr, fq);
        else normed(acc, (bf16_t*)(ws + WS_KA) + (size_t)gi * T_ * 256, 256, 0, row0, 1.0f, wr, wc, fr, fq);
    }
};

namespace att {
typedef short v4i16_t __attribute__((ext_vector_type(4)));
__device__ __forceinline__ int crow(int r, int h) { return (r & 3) + 8 * (r >> 2) + 4 * h; }
__device__ __forceinline__ s16x4 vtr(LAS const unsigned char* p) { return __builtin_bit_cast(s16x4, __builtin_amdgcn_ds_read_tr16_b64_v4i16((LAS v4i16_t*)p)); }

constexpr int KROW64 = 144, VROW64 = 128, NKEYS_B = 384;
constexpr int LDS_K64 = 0, LDS_V64 = NKEYS_B * KROW64;
constexpr int LDS_K128 = 0, LDS_V128 = 65536;

constexpr float SM_THR = 20.0f;
template <int NT, int ND>
__device__ __forceinline__ void softmax_step(f32x16 (&s)[NT], float& mref, float& l, f32x16 (&o)[ND], bf16x8 (&pf)[NT][2]) {
    if (__any(mref != 0.f)) {
#pragma unroll
        for (int t = 0; t < NT; ++t)
#pragma unroll
            for (int r = 0; r < 16; ++r) s[t][r] -= mref;
    }
    float mx = s[0][0];
#pragma unroll
    for (int t = 0; t < NT; ++t)
#pragma unroll
        for (int r = 0; r < 16; ++r) mx = fmaxf(mx, s[t][r]);
    mx = fmaxf(mx, __shfl_xor(mx, 32));
    if (__any(mx > SM_THR)) {
        const float dl = fmaxf(mx, 0.f); mref += dl;
#pragma unroll
        for (int t = 0; t < NT; ++t)
#pragma unroll
            for (int r = 0; r < 16; ++r) s[t][r] -= dl;
        const float f = __builtin_amdgcn_exp2f(-dl); l *= f;
#pragma unroll
        for (int d = 0; d < ND; ++d)
#pragma unroll
            for (int r = 0; r < 16; ++r) o[d][r] *= f;
    }
    float ps0 = 0.f, ps1 = 0.f;
#pragma unroll
    for (int t = 0; t < NT; ++t)
#pragma unroll
        for (int r = 0; r < 16; r += 2) { s[t][r] = __builtin_amdgcn_exp2f(s[t][r]); s[t][r + 1] = __builtin_amdgcn_exp2f(s[t][r + 1]); ps0 += s[t][r]; ps1 += s[t][r + 1]; }
    l += ps0 + ps1;
#pragma unroll
    for (int t = 0; t < NT; ++t)
#pragma unroll
        for (int k = 0; k < 2; ++k) { u32x4 w; w.x = cvtpk(s[t][8 * k + 0], s[t][8 * k + 1]); w.y = cvtpk(s[t][8 * k + 2], s[t][8 * k + 3]); w.z = cvtpk(s[t][8 * k + 4], s[t][8 * k + 5]); w.w = cvtpk(s[t][8 * k + 6], s[t][8 * k + 7]);
            pf[t][k] = __builtin_bit_cast(bf16x8, w); }
}

struct BU { const bf16_t* q; const bf16_t* k; const bf16_t* v; bf16_t* o; float* lse; int qstride, kvstride, ostride, lsestride; float sink2; int W; int first; };
__device__ __forceinline__ void bu_load(const BU& u, int tid, u32x4 (&kr)[6], u32x4 (&vr)[6]) {
#pragma unroll
    for (int it = 0; it < 6; ++it) {
        const int c = tid + 512 * it, row = c >> 3, ch = c & 7;
        const bool valid = !(u.first && row < 128);
        const long off = (long)((valid ? row : 128) - 128) * (long)u.kvstride + ch * 8;
        kr[it] = *(const u32x4*)(u.k + off); vr[it] = *(const u32x4*)(u.v + off);
    }
}
__device__ __forceinline__ void bu_store(LAS unsigned char* lds, int tid, const u32x4 (&kr)[6], const u32x4 (&vr)[6], int first) {
#pragma unroll
    for (int it = 0; it < 6; ++it) {
        const int c = tid + 512 * it, row = c >> 3, ch = c & 7;
        const bool valid = !(first && row < 128);
        const u32x4 z = (u32x4){0u, 0u, 0u, 0u};
        *(LAS u32x4*)(lds + LDS_K64 + row * KROW64 + ch * 16) = valid ? kr[it] : z;
        *(LAS u32x4*)(lds + LDS_V64 + row * VROW64 + ((ch * 16) ^ (((row >> 1) & 1) << 6))) = valid ? vr[it] : z;
    }
}
__device__ __forceinline__ void bu_loadq(const BU& u, int wid, int lane, bf16x8 (&qf)[4]) {
    const int qi = 32 * wid + (lane & 31), h = lane >> 5;
#pragma unroll
    for (int d0 = 0; d0 < 4; ++d0) qf[d0] = *(const bf16x8*)(u.q + (size_t)qi * u.qstride + 16 * d0 + 8 * h);
}
template <int NT>
__device__ __forceinline__ void bu_step(LAS const unsigned char* kbase, LAS const unsigned char* vbase, int vsw, int kt0, int mask, int jlo, int jhi, int h, const bf16x8 (&qf)[4],
                                        float& mref, float& l, f32x16 (&o)[2]) {
    f32x16 s[NT];
#pragma unroll
    for (int d0 = 0; d0 < 4; ++d0)
#pragma unroll
        for (int t = 0; t < NT; ++t) { const bf16x8 kf = *(LAS const bf16x8*)(kbase + (kt0 + t) * 32 * KROW64 + d0 * 32); if (d0 == 0) { for (int r = 0; r < 16; ++r) s[t][r] = 0.f; } s[t] = __builtin_amdgcn_mfma_f32_32x32x16_bf16(kf, qf[d0], s[t], 0, 0, 0); }
    if (mask == 1) {
        const int L = jlo - 32 * kt0 - 4 * h;
#pragma unroll
        for (int r = 0; r < 16; ++r) { if (((r & 3) + 8 * (r >> 2)) < L) s[0][r] = -INFINITY; }
    } else if (mask == 2) {
        const int H = jhi - 32 * kt0 - 4 * h;
#pragma unroll
        for (int r = 0; r < 16; ++r) { if (((r & 3) + 8 * (r >> 2)) > H) s[0][r] = -INFINITY; }
    } else if (mask == 3) {
#pragma unroll
        for (int t = 0; t < NT; ++t) { const int L = jlo - 32 * (kt0 + t) - 4 * h; const unsigned span = (unsigned)(jhi - jlo);
#pragma unroll
            for (int r = 0; r < 16; ++r) { if ((unsigned)(((r & 3) + 8 * (r >> 2)) - L) > span) s[t][r] = -INFINITY; } }
    }
    bf16x8 pf[NT][2];
    softmax_step<NT, 2>(s, mref, l, o, pf);
#pragma unroll
    for (int t = 0; t < NT; ++t)
#pragma unroll
        for (int k = 0; k < 2; ++k)
#pragma unroll
            for (int d = 0; d < 2; ++d) {
                LAS const unsigned char* vp = vbase + ((kt0 + t) * 32 + 16 * k) * VROW64 + 64 * (d ^ vsw);
                const s16x4 lo = vtr(vp), hi = vtr(vp + 8 * VROW64);
                const bf16x8 vf = (bf16x8){lo[0], lo[1], lo[2], lo[3], hi[0], hi[1], hi[2], hi[3]};
                o[d] = __builtin_amdgcn_mfma_f32_32x32x16_bf16(vf, pf[t][k], o[d], 0, 0, 0);
            }
}
__device__ __forceinline__ void bu_compute(LAS unsigned char* lds, const BU& u, const bf16x8 (&qf)[4], int wid, int lane) {
    const int c = lane & 31, h = lane >> 5;
    const int qi = 32 * wid + c;
    float mref = 0.f, l = 0.f; f32x16 o[2];
#pragma unroll
    for (int r = 0; r < 16; ++r) { o[0][r] = 0.f; o[1][r] = 0.f; }
    int jlo = qi + 128 - u.W; if (u.first && jlo < 128) jlo = 128;
    const int jhi = qi + 128;
    const int qq = (lane & 15) >> 2;
    LAS const unsigned char* kbase = lds + LDS_K64 + c * KROW64 + 16 * h;
    LAS const unsigned char* vbase = lds + LDS_V64 + (4 * h + qq) * VROW64 + ((lane >> 4) & 1) * 32 + (lane & 3) * 8;
    const int vsw = (qq >> 1) & 1;
#pragma unroll 1
    for (int st = 0; st < 2; ++st) bu_step<2>(kbase, vbase, vsw, wid + 2 * st, u.first ? 3 : (st == 0 ? 1 : 0), jlo, jhi, h, qf, mref, l, o);
    bu_step<1>(kbase, vbase, vsw, wid + 4, u.first ? 3 : 2, jlo, jhi, h, qf, mref, l, o);
    float lt = l + __shfl_xor(l, 32);
    lt += __builtin_amdgcn_exp2f(u.sink2 - mref);
    const float inv = 1.0f / lt;
    bf16_t* orow = u.o + (size_t)qi * u.ostride;
#pragma unroll
    for (int d = 0; d < 2; ++d)
#pragma unroll
        for (int rg = 0; rg < 4; ++rg) { u32x2 w; w.x = cvtpk(o[d][4 * rg] * inv, o[d][4 * rg + 1] * inv); w.y = cvtpk(o[d][4 * rg + 2] * inv, o[d][4 * rg + 3] * inv);
            *(u32x2*)(orow + 32 * d + 8 * rg + 4 * h) = w; }
    if (u.lse && h == 0) u.lse[(size_t)qi * u.lsestride] = mref + __builtin_amdgcn_logf(lt);
}

__device__ __forceinline__ void mem_load(const bf16_t* kmem, const bf16_t* vmem, int tid, u32x4 (&kr)[8], u32x4 (&vr)[8]) {
#pragma unroll
    for (int it = 0; it < 8; ++it) { const int cc = tid + 512 * it, row = cc >> 4, ch = cc & 15;
        kr[it] = *(const u32x4*)(kmem + (size_t)row * 1024 + ch * 8); vr[it] = *(const u32x4*)(vmem + (size_t)row * 1024 + ch * 8); }
}
__device__ __forceinline__ void mem_unit(LAS unsigned char* lds, const u32x4 (&qraw)[8], const u32x4 (&kr)[8], const u32x4 (&vr)[8], LAS const unsigned char* gl, bf16_t* o0, size_t ostride, int tid, int wid, int lane) {
#pragma unroll
    for (int it = 0; it < 8; ++it) {
        const int cc = tid + 512 * it, row = cc >> 4, ch = cc & 15;
        *(LAS u32x4*)(lds + LDS_K128 + row * 256 + ((ch ^ (row & 15)) * 16)) = kr[it];
        *(LAS u32x4*)(lds + LDS_V128 + row * 256 + ((ch * 16) ^ ((row & 3) << 6))) = vr[it];
    }
    const int c = lane & 31, h = lane >> 5;
    const int qi = 32 * wid + c;
    bf16x8 qf[8];
    {
        u32x4 raw[8]; float ss = 0.f;
#pragma unroll
        for (int d0 = 0; d0 < 8; ++d0) { raw[d0] = qraw[d0];
#pragma unroll
            for (int e = 0; e < 4; ++e) { const float a = bflo(raw[d0][e]), b = bfhi(raw[d0][e]); ss += a * a + b * b; } }
        ss += __shfl_xor(ss, 32);
        const float rs = (1.0f / sqrtf(ss * (1.f / 128.f) + EPS_)) * QSCALE128;
#pragma unroll
        for (int d0 = 0; d0 < 8; ++d0) { const f32x4 g0 = *(LAS const f32x4*)(gl + 4 * (16 * d0 + 8 * h)), g1 = *(LAS const f32x4*)(gl + 4 * (16 * d0 + 8 * h + 4));
            u32x4 w; w.x = cvtpk(bflo(raw[d0].x) * rs * g0[0], bfhi(raw[d0].x) * rs * g0[1]); w.y = cvtpk(bflo(raw[d0].y) * rs * g0[2], bfhi(raw[d0].y) * rs * g0[3]);
            w.z = cvtpk(bflo(raw[d0].z) * rs * g1[0], bfhi(raw[d0].z) * rs * g1[1]); w.w = cvtpk(bflo(raw[d0].w) * rs * g1[2], bfhi(raw[d0].w) * rs * g1[3]);
            qf[d0] = __builtin_bit_cast(bf16x8, w); }
    }
    __syncthreads();
    {
        const int row = tid >> 1, hf = tid & 1; u32x4 raw[8]; float ss = 0.f;
#pragma unroll
        for (int i = 0; i < 8; ++i) { raw[i] = *(LAS const u32x4*)(lds + LDS_K128 + row * 256 + (((hf * 8 + i) ^ (row & 15)) * 16));
#pragma unroll
            for (int e = 0; e < 4; ++e) { const float a = bflo(raw[i][e]), b = bfhi(raw[i][e]); ss += a * a + b * b; } }
        ss += __shfl_xor(ss, 1);
        const float rs = 1.0f / sqrtf(ss * (1.f / 128.f) + EPS_);
#pragma unroll
        for (int i = 0; i < 8; ++i) { LAS const unsigned char* gp = gl + 512 + 4 * (64 * hf + 8 * i); const f32x4 g0 = *(LAS const f32x4*)gp, g1 = *(LAS const f32x4*)(gp + 16);
            u32x4 w; w.x = cvtpk(bflo(raw[i].x) * rs * g0[0], bfhi(raw[i].x) * rs * g0[1]); w.y = cvtpk(bflo(raw[i].y) * rs * g0[2], bfhi(raw[i].y) * rs * g0[3]);
            w.z = cvtpk(bflo(raw[i].z) * rs * g1[0], bfhi(raw[i].z) * rs * g1[1]); w.w = cvtpk(bflo(raw[i].w) * rs * g1[2], bfhi(raw[i].w) * rs * g1[3]);
            *(LAS u32x4*)(lds + LDS_K128 + row * 256 + (((hf * 8 + i) ^ (row & 15)) * 16)) = w; }
    }
    __syncthreads();
    float mref = 0.f, l = 0.f; f32x16 o[4];
#pragma unroll
    for (int r = 0; r < 16; ++r) {
#pragma unroll
        for (int d = 0; d < 4; ++d) o[d][r] = 0.f; }
    const int qq = (lane & 15) >> 2;
    LAS const unsigned char* vbase = lds + LDS_V128 + (4 * h + qq) * 256 + ((lane >> 4) & 1) * 32 + (lane & 3) * 8;
#pragma unroll 1
    for (int kt = 0; kt < 8; kt += 2) {
        f32x16 s[2];
#pragma unroll
        for (int d0 = 0; d0 < 8; ++d0)
#pragma unroll
            for (int t = 0; t < 2; ++t) { const int krow = (kt + t) * 32 + c;
                const bf16x8 kf = *(LAS const bf16x8*)(lds + LDS_K128 + krow * 256 + (((2 * d0 + h) ^ (krow & 15)) * 16)); if (d0 == 0) { for (int r = 0; r < 16; ++r) s[t][r] = 0.f; } s[t] = __builtin_amdgcn_mfma_f32_32x32x16_bf16(kf, qf[d0], s[t], 0, 0, 0); }
        bf16x8 pf[2][2];
        softmax_step<2, 4>(s, mref, l, o, pf);
#pragma unroll
        for (int t = 0; t < 2; ++t)
#pragma unroll
            for (int k = 0; k < 2; ++k)
#pragma unroll
                for (int d = 0; d < 4; ++d) {
                    LAS const unsigned char* vp = vbase + ((kt + t) * 32 + 16 * k) * 256 + 64 * (d ^ qq);
                    const s16x4 lo = vtr(vp), hi = vtr(vp + 8 * 256);
                    const bf16x8 vf = (bf16x8){lo[0], lo[1], lo[2], lo[3], hi[0], hi[1], hi[2], hi[3]};
                    o[d] = __builtin_amdgcn_mfma_f32_32x32x16_bf16(vf, pf[t][k], o[d], 0, 0, 0);
                }
    }
    const float inv = 1.0f / (l + __shfl_xor(l, 32));
    bf16_t* orow = o0 + (size_t)qi * ostride;
#pragma unroll
    for (int d = 0; d < 4; ++d)
#pragma unroll
        for (int rg = 0; rg < 4; ++rg) { u32x2 w; w.x = cvtpk(o[d][4 * rg] * inv, o[d][4 * rg + 1] * inv); w.y = cvtpk(o[d][4 * rg + 2] * inv, o[d][4 * rg + 3] * inv);
            *(u32x2*)(orow + 32 * d + 8 * rg + 4 * h) = w; }
    __syncthreads();
}
}

__device__ __forceinline__ att::BU get_bu(const Args& A, int vcu, int idx) {
    unsigned char* ws = A.ws; att::BU u;
    if (idx < 3) {
        const int gi = idx, b = vcu >> 6, hd = (vcu >> 4) & 3, i16 = vcu & 15;
        const int dl = (gi == 0) ? 1 : (gi == 1) ? 4 : 16;
        int r, qb; if (gi == 0) { r = 0; qb = i16; } else if (gi == 1) { r = i16 >> 2; qb = i16 & 3; } else { r = i16; qb = 0; }
        const int i0 = qb * 256;
        const size_t row0 = (size_t)b * SEQ_ + r + (size_t)dl * i0;
        const size_t base = (size_t)gi * T_ * 256 + row0 * 256 + hd * 64;
        u.q = (const bf16_t*)(ws + WS_QA) + base; u.k = (const bf16_t*)(ws + WS_KA) + base; u.v = (const bf16_t*)(ws + WS_VA) + base;
        u.o = (bf16_t*)((unsigned char*)A.out + DO_OAG) + base;
        u.lse = (float*)(ws + WS_LSE) + (size_t)gi * T_ * 4 + row0 * 4 + hd;
        u.qstride = dl * 256; u.kvstride = dl * 256; u.ostride = dl * 256; u.lsestride = dl * 4; u.sink2 = -INFINITY; u.W = 128; u.first = (i0 == 0);
    } else {
        const int uu = vcu + 256 * (idx - 3), b = uu >> 7, hq = (uu >> 4) & 7, qb = uu & 15, kvh = hq >> 2;
        const size_t row0 = (size_t)b * SEQ_ + (size_t)qb * 256;
        u.q = (const bf16_t*)(ws + WS_QB) + row0 * 512 + hq * 64;
        u.k = (const bf16_t*)(ws + WS_KVB) + row0 * 256 + kvh * 64; u.v = u.k + 128;
        u.o = (bf16_t*)((unsigned char*)A.out + DO_OCAT) + row0 * KCAT + 256 + hq * 64;
        u.lse = nullptr; u.qstride = 512; u.kvstride = 256; u.ostride = KCAT; u.lsestride = 0; u.sink2 = A.in[I_SINK][hq] * LOG2E; u.W = 127; u.first = (qb == 0);
    }
    return u;
}
__device__ __forceinline__ void p2_attention(const Args& A, LAS unsigned char* lds, int vcu, int tid, int wid, int lane) {
    unsigned char* ws = A.ws;
    const int mu = vcu, mb = mu >> 6, mhd = (mu >> 4) & 3, mqb = mu & 15;
    const bf16_t* km = (const bf16_t*)(ws + WS_MKV) + (size_t)mb * MEM_ * 1024 + mhd * 128;
    const size_t mrow0 = (size_t)mb * SEQ_ + (size_t)mqb * 256;
    const bf16_t* mq = (const bf16_t*)(ws + WS_MQ) + mrow0 * 512 + mhd * 128;
    LAS unsigned char* gl = lds + 131072;
    { const float* const pq = A.in[I_MQN]; const float* const pk = A.in[I_MKN];
      if (tid < 64) { const f32x4 gv = ((const f32x4*)(tid < 32 ? pq : pk))[tid & 31]; *(LAS f32x4*)(gl + 16 * tid) = gv; } }
    u32x4 mkr[8], mvr[8], mqr[8];
    {
        u32x4 kr[6], vr[6];
        { const att::BU u0 = get_bu(A, vcu, 0); att::bu_load(u0, tid, kr, vr); }
#pragma unroll 1
        for (int idx = 0; idx < 4; ++idx) {
            const att::BU u = get_bu(A, vcu, idx);
            att::bu_store(lds, tid, kr, vr, u.first);
            bf16x8 qf[4]; att::bu_loadq(u, wid, lane, qf);
            __syncthreads();
            { const att::BU un = get_bu(A, vcu, idx + 1); att::bu_load(un, tid, kr, vr); }
            att::bu_compute(lds, u, qf, wid, lane);
            asm volatile("" ::: "memory");
            __syncthreads();
        }
        {
            const att::BU u = get_bu(A, vcu, 4);
            att::bu_store(lds, tid, kr, vr, u.first);
            bf16x8 qf[4]; att::bu_loadq(u, wid, lane, qf);
            __syncthreads();
            att::mem_load(km, km + 512, tid, mkr, mvr);
            { const int qi = 32 * wid + (lane & 31), h = lane >> 5;
#pragma unroll
              for (int d0 = 0; d0 < 8; ++d0) mqr[d0] = *(const u32x4*)(mq + (size_t)qi * 512 + 16 * d0 + 8 * h); }
            att::bu_compute(lds, u, qf, wid, lane);
            asm volatile("" ::: "memory");
            __syncthreads();
        }
    }
    {
        bf16_t* o = (bf16_t*)((unsigned char*)A.out + DO_OCAT) + mrow0 * KCAT + 768 + mhd * 128;
        att::mem_unit(lds, mqr, mkr, mvr, gl, o, KCAT, tid, wid, lane);
    }
}

__device__ __forceinline__ void p2b_merge(const Args& A, int vcu, int G, int tid) {
    const bf16_t* oag = (const bf16_t*)((unsigned char*)A.out + DO_OAG);
    bf16_t* ocat = (bf16_t*)((unsigned char*)A.out + DO_OCAT);
    const float* lse = (const float*)(A.ws + WS_LSE);
    for (int idx = vcu * 512 + tid; idx < T_ * 32; idx += G * 512) {
        const int t = idx >> 5, ch = idx & 31, hd = ch >> 3;
        const float l0 = lse[(size_t)t * 4 + hd], l1 = lse[(size_t)T_ * 4 + (size_t)t * 4 + hd], l2 = lse[(size_t)2 * T_ * 4 + (size_t)t * 4 + hd];
        const float mx = fmaxf(l0, fmaxf(l1, l2));
        float w0 = __builtin_amdgcn_exp2f(l0 - mx), w1 = __builtin_amdgcn_exp2f(l1 - mx), w2 = __builtin_amdgcn_exp2f(l2 - mx);
        const float inv = 1.0f / (w0 + w1 + w2); w0 *= inv; w1 *= inv; w2 *= inv;
        const u32x4 a = *(const u32x4*)(oag + (size_t)t * 256 + ch * 8), b = *(const u32x4*)(oag + (size_t)T_ * 256 + (size_t)t * 256 + ch * 8), c = *(const u32x4*)(oag + (size_t)2 * T_ * 256 + (size_t)t * 256 + ch * 8);
        u32x4 w;
#pragma unroll
        for (int e = 0; e < 4; ++e) w[e] = cvtpk(w0 * bflo(a[e]) + w1 * bflo(b[e]) + w2 * bflo(c[e]), w0 * bfhi(a[e]) + w1 * bfhi(b[e]) + w2 * bfhi(c[e]));
        *(u32x4*)(ocat + (size_t)t * KCAT + ch * 8) = w;
    }
}

struct P3aOrder : pg8::StaticOrder {
    const bf16_t* oag; bf16_t* ocat; const float* lse;
    __device__ __forceinline__ void a_ready(const pg8::Unit& u) const {
#pragma unroll 1
        for (int i0 = threadIdx.x; i0 < 256 * 32; i0 += 2 * 512) {
            u32x4 a[2], b[2], c[2]; float l0[2], l1[2], l2[2];
#pragma unroll
            for (int j = 0; j < 2; ++j) { const int idx = i0 + 512 * j, t = u.pm * 256 + (idx >> 5), ch = idx & 31, hd = ch >> 3;
                l0[j] = lse[(size_t)t * 4 + hd]; l1[j] = lse[(size_t)T_ * 4 + (size_t)t * 4 + hd]; l2[j] = lse[(size_t)2 * T_ * 4 + (size_t)t * 4 + hd];
                a[j] = *(const u32x4*)(oag + (size_t)t * 256 + ch * 8); b[j] = *(const u32x4*)(oag + (size_t)T_ * 256 + (size_t)t * 256 + ch * 8); c[j] = *(const u32x4*)(oag + (size_t)2 * T_ * 256 + (size_t)t * 256 + ch * 8); }
#pragma unroll
            for (int j = 0; j < 2; ++j) { const int idx = i0 + 512 * j, t = u.pm * 256 + (idx >> 5), ch = idx & 31;
                const float mx = fmaxf(l0[j], fmaxf(l1[j], l2[j]));
                float w0 = __builtin_amdgcn_exp2f(l0[j] - mx), w1 = __builtin_amdgcn_exp2f(l1[j] - mx), w2 = __builtin_amdgcn_exp2f(l2[j] - mx);
                const float inv = 1.0f / (w0 + w1 + w2); w0 *= inv; w1 *= inv; w2 *= inv;
                u32x4 w;
#pragma unroll
                for (int e = 0; e < 4; ++e) w[e] = cvtpk(w0 * bflo(a[j][e]) + w1 * bflo(b[j][e]) + w2 * bflo(c[j][e]), w0 * bfhi(a[j][e]) + w1 * bfhi(b[j][e]) + w2 * bfhi(c[j][e]));
                *(u32x4*)(ocat + (size_t)t * KCAT + ch * 8) = w; }
        }
        asm volatile("s_waitcnt vmcnt(0)" ::: "memory"); __builtin_amdgcn_s_barrier(); asm volatile("" ::: "memory");
    }
};

__device__ __forceinline__ float ub(unsigned w, int i) { return (float)((w >> (8 * i)) & 0xffu); }
struct Epi3a {
    static constexpr bool PERM = true;
    const unsigned char* G; bf16_t* MERGED;
    bool skip = false;
    __device__ __forceinline__ void khook(f32x4 (&acc)[2][2][4][2], const pg8::Unit& u, int t, int wr, int wc, int fr, int fq) const {
        if (t != 4 && t != 12) return;
        const int gsel = (t == 4) ? 0 : 1024;
#pragma unroll
        for (int ai = 0; ai < 2; ++ai) {
            u32x2 ga[4][2], gb[4][2];
#pragma unroll
            for (int m = 0; m < 4; ++m) { const unsigned char* gp = G + (size_t)(u.pm * 256 + ai * 128 + wr * 64 + m * 16 + fr) * 3072 + gsel + u.pn * 256 + wc * 64 + 8 * fq;
#pragma unroll
                for (int bj = 0; bj < 2; ++bj) { ga[m][bj] = *(const u32x2*)(gp + 32 * bj); gb[m][bj] = *(const u32x2*)(gp + 1024 + 32 * bj); } }
            asm volatile("" ::: "memory");
#pragma unroll
            for (int m = 0; m < 4; ++m)
#pragma unroll
                for (int bj = 0; bj < 2; ++bj)
#pragma unroll
                    for (int n = 0; n < 2; ++n)
#pragma unroll
                        for (int e = 0; e < 4; ++e) acc[ai][bj][m][n][e] *= ub(ga[m][bj][n], e) * __builtin_amdgcn_rcpf(ub(gb[m][bj][n], e));
        }
    }
    __device__ __forceinline__ void operator()(const f32x4 (&acc)[2][2][4][2], const pg8::Unit& u, int wr, int wc, int fr, int fq) const {
        const int col = u.pn * 256 + wc * 64 + 8 * fq;
        u32x2 g2[2][4][2];
#pragma unroll
        for (int ai = 0; ai < 2; ++ai)
#pragma unroll
            for (int m = 0; m < 4; ++m) { const size_t row = (size_t)(u.pm * 256 + ai * 128 + wr * 64 + m * 16 + fr);
#pragma unroll
                for (int bj = 0; bj < 2; ++bj) g2[ai][m][bj] = *(const u32x2*)(G + row * 3072 + 2048 + col + 32 * bj); }
        asm volatile("" ::: "memory");
        const float k = 1.0f / 255.0f;
#pragma unroll
        for (int ai = 0; ai < 2; ++ai)
#pragma unroll
            for (int m = 0; m < 4; ++m) { const size_t row = (size_t)(u.pm * 256 + ai * 128 + wr * 64 + m * 16 + fr);
#pragma unroll
                for (int bj = 0; bj < 2; ++bj) { const u32x2 g = g2[ai][m][bj]; const f32x4 v0 = acc[ai][bj][m][0] * k, v1 = acc[ai][bj][m][1] * k;
                    u32x4 w; w.x = cvtpk(v0[0] * ub(g.x, 0), v0[1] * ub(g.x, 1)); w.y = cvtpk(v0[2] * ub(g.x, 2), v0[3] * ub(g.x, 3)); w.z = cvtpk(v1[0] * ub(g.y, 0), v1[1] * ub(g.y, 1)); w.w = cvtpk(v1[2] * ub(g.y, 2), v1[3] * ub(g.y, 3));
                    *(u32x4*)(MERGED + row * 1024 + col + 32 * bj) = w; } }
    }
};

struct Epi3b {
    static constexpr bool PERM = true;
    const float* x; bf16_t* X1L; bf16_t* X1B; float* SSQ;
    bool skip = false;
    __device__ __forceinline__ void operator()(const f32x4 (&acc)[2][2][4][2], const pg8::Unit& u, int wr, int wc, int fr, int fq) const {
        const int col = u.pn * 256 + wc * 64 + 8 * fq;
#pragma unroll
        for (int ai = 0; ai < 2; ++ai) {
            f32x4 xv[4][2][2];
#pragma unroll
            for (int m = 0; m < 4; ++m) { const size_t row = (size_t)(u.pm * 256 + ai * 128 + wr * 64 + m * 16 + fr);
#pragma unroll
                for (int bj = 0; bj < 2; ++bj) { const size_t off = row * 1024 + col + 32 * bj; xv[m][bj][0] = *(const f32x4*)(x + off); xv[m][bj][1] = *(const f32x4*)(x + off + 4); } }
            asm volatile("" ::: "memory");
#pragma unroll
            for (int m = 0; m < 4; ++m) { const size_t row = (size_t)(u.pm * 256 + ai * 128 + wr * 64 + m * 16 + fr); float ss = 0.f;
#pragma unroll
                for (int bj = 0; bj < 2; ++bj) { const size_t off = row * 1024 + col + 32 * bj;
                    const f32x4 o0 = xv[m][bj][0] + acc[ai][bj][m][0], o1 = xv[m][bj][1] + acc[ai][bj][m][1];
                    ss += (o0[0] * o0[0] + o0[1] * o0[1]) + (o0[2] * o0[2] + o0[3] * o0[3]) + (o1[0] * o1[0] + o1[1] * o1[1]) + (o1[2] * o1[2] + o1[3] * o1[3]);
                    u32x4 w; w.x = cvtpk(o0[0], o0[1]); w.y = cvtpk(o0[2], o0[3]); w.z = cvtpk(o1[0], o1[1]); w.w = cvtpk(o1[2], o1[3]);
                    *(u32x4*)(X1B + off) = w; }
                ss += xor16(ss); ss = sum_halves(ss);
                if (fq == 0) SSQ[row * 16 + u.pn * 4 + wc] = ss; }
            asm volatile("" ::: "memory");
        }
    }
};

struct Epi4 {
    static constexpr bool PERM = true;
    const float* convw; const float* convb; bf16_t* ACT; float* UE; float* UF; LAS float* xch; LAS const float* rtab; LAS const float* ctab;
    bool skip = false;
    __device__ __forceinline__ void operator()(f32x4 (&acc)[2][2][4][2], const pg8::Unit& u, int wr, int wc, int fr, int fq) const {
        const int lane = fr + 16 * fq;
        const int rowbase = u.pm * 256 + 128 * wr + 8 * fr;
        const int jj = 32 * wc + 8 * fq;
        const bool bstart = (u.pm & 15) == 0;
        {
            LAS const float* tb = rtab + ((u.pm >> 2) & 1) * 256 + 128 * wr + 8 * fr;
            const f32x4 ra = *(LAS const f32x4*)tb, rb = *(LAS const f32x4*)(tb + 4);
#pragma unroll
            for (int i = 0; i < 8; ++i) { const float rs = (i < 4) ? ra[i & 3] : rb[i & 3];
#pragma unroll
                for (int bj = 0; bj < 2; ++bj)
#pragma unroll
                    for (int n = 0; n < 2; ++n) acc[i >> 2][bj][i & 3][n] *= rs; }
        }
#define U4(bj, n, i) acc[(i) >> 2][bj][(i) & 3][n]
        if (wr == 0 && fr == 0) {
#pragma unroll
            for (int i = 0; i < 2; ++i)
#pragma unroll
                for (int bj = 0; bj < 2; ++bj)
#pragma unroll
                    for (int n = 0; n < 2; ++n) *(f32x4*)(UF + (size_t)(u.pm * 2 + i) * 5632 + u.pn * 256 + 128 * bj + jj + 4 * n) = U4(bj, n, i);
        }
        if (wr == 1 && fr == 15) {
#pragma unroll
            for (int i = 0; i < 2; ++i)
#pragma unroll
                for (int bj = 0; bj < 2; ++bj)
#pragma unroll
                    for (int n = 0; n < 2; ++n) *(f32x4*)(UE + (size_t)(u.pm * 2 + i) * 5632 + u.pn * 256 + 128 * bj + jj + 4 * n) = U4(bj, n, 6 + i);
        }
        if (wr == 0 && fr == 15) {
#pragma unroll
            for (int i = 0; i < 2; ++i)
#pragma unroll
                for (int bj = 0; bj < 2; ++bj)
#pragma unroll
                    for (int n = 0; n < 2; ++n) *(LAS f32x4*)(xch + ((((wc * 2 + i) * 2 + bj) * 2 + n) * 4 + fq) * 4) = U4(bj, n, 6 + i);
        }
        asm volatile("s_waitcnt lgkmcnt(0)" ::: "memory"); __builtin_amdgcn_s_barrier(); asm volatile("" ::: "memory");
        const int src = (lane & 48) | ((fr - 1) & 15);
        const int cha = u.pn * 128 + jj;
#pragma unroll
        for (int n = 0; n < 2; ++n) {
            asm volatile("" ::: "memory"); __builtin_amdgcn_sched_barrier(0);
            f32x4 p6[2], p7[2], w0[2], w1[2], w2[2], cb[2];
#pragma unroll
            for (int bj = 0; bj < 2; ++bj) {
                f32x4 h6 = (f32x4){0.f, 0.f, 0.f, 0.f}, h7 = h6;
                if (wr == 1) { h6 = *(LAS const f32x4*)(xch + ((((wc * 2 + 0) * 2 + bj) * 2 + n) * 4 + fq) * 4); h7 = *(LAS const f32x4*)(xch + ((((wc * 2 + 1) * 2 + bj) * 2 + n) * 4 + fq) * 4); }
#pragma unroll
                for (int e = 0; e < 4; ++e) { const float a6 = __shfl(U4(bj, n, 6)[e], src), a7 = __shfl(U4(bj, n, 7)[e], src); p6[bj][e] = (fr == 0) ? h6[e] : a6; p7[bj][e] = (fr == 0) ? h7[e] : a7; }
                LAS const float* ct = ctab + u.par * 1024 + bj * 512 + jj + 4 * n;
                w0[bj] = *(LAS const f32x4*)ct; w1[bj] = *(LAS const f32x4*)(ct + 128); w2[bj] = *(LAS const f32x4*)(ct + 256); cb[bj] = *(LAS const f32x4*)(ct + 384);
            }
#pragma unroll
            for (int i = 0; i < 8; ++i) {
                f32x4 c[2];
#pragma unroll
                for (int bj = 0; bj < 2; ++bj) {
                    const f32x4 um1 = (i >= 1) ? U4(bj, n, i >= 1 ? i - 1 : 0) : p7[bj];
                    const f32x4 um2 = (i >= 2) ? U4(bj, n, i >= 2 ? i - 2 : 0) : ((i == 1) ? p7[bj] : p6[bj]);
                    c[bj] = cb[bj] + w2[bj] * U4(bj, n, i) + w1[bj] * um1 + w0[bj] * um2;
                }
                f32x4 a;
#pragma unroll
                for (int e = 0; e < 4; ++e) { const float z = c[0][e]; a[e] = z * __builtin_amdgcn_rcpf(1.0f + __builtin_amdgcn_exp2f(-z * LOG2E)) * c[1][e]; }
                u32x2 w; w.x = cvtpk(a[0], a[1]); w.y = cvtpk(a[2], a[3]);
                const bool skip = (wr == 0 && fr == 0 && i < 2 && !bstart);
                if (!skip) *(u32x2*)(ACT + (size_t)(rowbase + i) * DFF_ + cha + 4 * n) = w;
            }
        }
#undef U4
    }
};

struct P4Order : pg8::StaticOrder {
    const float* SSQ; LAS float* rtab; mutable int lastpm; const float* convw; const float* convb; LAS unsigned char* ctab;
    __device__ __forceinline__ void a_ready(const pg8::Unit& u) const {
        { int t = threadIdx.x; asm volatile("" : "+v"(t)); const int w = __builtin_amdgcn_readfirstlane(t >> 6);
          if (w < 4) { const int bj = t >> 7, tap = (t >> 5) & 3, c4 = t & 31; const float* src = (tap < 3 ? convw + tap * 5632 : convb) + bj * DFF_ + u.pn * 128 + 4 * c4;
              __builtin_amdgcn_global_load_lds((const unsigned*)src, (LAS unsigned*)(ctab + u.par * 4096 + w * 1024), 16, 0, 0); } }
        if (u.pm == lastpm) return;
        lastpm = u.pm;
        const int t = threadIdx.x;
        if (t < 256) {
            const float* sp = SSQ + (size_t)(u.pm * 256 + t) * 16;
            const f32x4 s0 = *(const f32x4*)sp, s1 = *(const f32x4*)(sp + 4), s2 = *(const f32x4*)(sp + 8), s3 = *(const f32x4*)(sp + 12);
            const float tot = ((s0[0] + s0[1]) + (s0[2] + s0[3])) + ((s1[0] + s1[1]) + (s1[2] + s1[3])) + ((s2[0] + s2[1]) + (s2[2] + s2[3])) + ((s3[0] + s3[1]) + (s3[2] + s3[3]));
            rtab[((u.pm >> 2) & 1) * 256 + t] = 1.0f / sqrtf(tot * (1.f / 1024.f) + EPS_);
        }
    }
};

struct Epi5 {
    static constexpr bool PERM = true;
    const bf16_t* X1B; const bf16_t* X1L; float* dst;
    bool skip = false;
    __device__ __forceinline__ void operator()(const f32x4 (&acc)[2][2][4][2], const pg8::Unit& u, int wr, int wc, int fr, int fq) const {
        const int col = u.pn * 256 + wc * 64 + 8 * fq;
#pragma unroll
        for (int ai = 0; ai < 2; ++ai) {
            u32x4 hv[4][2];
#pragma unroll
            for (int m = 0; m < 4; ++m) { const size_t row = (size_t)(u.pm * 256 + ai * 128 + wr * 64 + m * 16 + fr);
#pragma unroll
                for (int bj = 0; bj < 2; ++bj) { const size_t off = row * 1024 + col + 32 * bj; hv[m][bj] = *(const u32x4*)(X1B + off); } }
            asm volatile("" ::: "memory");
#pragma unroll
            for (int m = 0; m < 4; ++m) { const size_t row = (size_t)(u.pm * 256 + ai * 128 + wr * 64 + m * 16 + fr);
#pragma unroll
                for (int bj = 0; bj < 2; ++bj) { float* q = dst + row * 1024 + col + 32 * bj; const u32x4 h = hv[m][bj];
                    const f32x4 x0 = (f32x4){bflo(h.x), bfhi(h.x), bflo(h.y), bfhi(h.y)};
                    const f32x4 x1 = (f32x4){bflo(h.z), bfhi(h.z), bflo(h.w), bfhi(h.w)};
                    *(f32x4*)q = x0 + acc[ai][bj][m][0]; *(f32x4*)(q + 4) = x1 + acc[ai][bj][m][1]; } }
            asm volatile("" ::: "memory");
        }
    }
};
struct P5Order : pg8::StaticOrder {
    const float* UE; const float* UF; const float* convw; const float* convb; bf16_t* ACT;
    __device__ __forceinline__ void a_ready(const pg8::Unit& u) const {
        if ((u.pm & 15) != 0) {
            for (int ch = threadIdx.x; ch < DFF_; ch += 512) {
                const int pa = 256 * (ch >> 7) + (ch & 127), pg = pa + 128;
                const float* e = UE + (size_t)((u.pm - 1) * 2) * 5632; const float* f = UF + (size_t)(u.pm * 2) * 5632;
                float r[2];
#pragma unroll
                for (int i = 0; i < 2; ++i) {
                    float cc[2];
#pragma unroll
                    for (int s = 0; s < 2; ++s) { const int p = s ? pg : pa, cch = s * DFF_ + ch;
                        const float um2 = e[p], um1 = e[5632 + p], u0 = f[p], u1 = f[5632 + p];
                        const float w0 = convw[cch], w1 = convw[5632 + cch], w2 = convw[2 * 5632 + cch], b = convb[cch];
                        cc[s] = (i == 0) ? b + w0 * um2 + w1 * um1 + w2 * u0 : b + w0 * um1 + w1 * u0 + w2 * u1; }
                    r[i] = cc[0] * __builtin_amdgcn_rcpf(1.0f + __builtin_amdgcn_exp2f(-cc[0] * LOG2E)) * cc[1];
                }
                const unsigned w = cvtpk(r[0], r[1]);
                ACT[(size_t)(u.pm * 256) * DFF_ + ch] = (bf16_t)(w & 0xffffu); ACT[(size_t)(u.pm * 256 + 1) * DFF_ + ch] = (bf16_t)(w >> 16);
            }
        }
        asm volatile("s_waitcnt vmcnt(0)" ::: "memory"); __builtin_amdgcn_s_barrier(); asm volatile("" ::: "memory");
    }
};

__device__ __forceinline__ Args opaque_args() {
    Args a{};
#if defined(__HIP_DEVICE_COMPILE__)
    typedef const __attribute__((address_space(4))) Args* KArgsPtr;
    KArgsPtr p = (KArgsPtr)__builtin_amdgcn_kernarg_segment_ptr(); asm volatile("" : "+s"(p));
#pragma unroll
    for (int i = 0; i < 25; ++i) a.in[i] = p->in[i];
    a.out = p->out; a.ws = p->ws; a.ph_lo = p->ph_lo; a.ph_hi = p->ph_hi; a.li = p->li; a.pad = p->pad;
#endif
    return a;
}
__device__ __forceinline__ int opaque_tid() { int t = threadIdx.x; asm volatile("" : "+v"(t)); return t; }
__global__ void __launch_bounds__(NWAVES * 64, 2) fwd_kernel(Args args_by_value) {
    const Args args0 = opaque_args();
    extern __shared__ __attribute__((aligned(16))) unsigned char lds_raw[];
    LAS unsigned char* lds = (LAS unsigned char*)lds_raw;
    volatile LAS unsigned* MISC = (volatile LAS unsigned*)(lds + MISC_OFF);
    const int tid = threadIdx.x, lane = tid & 63, wave = __builtin_amdgcn_readfirstlane(tid >> 6);
    const int G = gridDim.x; const int bx = blockIdx.x; const int vcu = (G % 8 == 0) ? (bx % 8) * (G / 8) + bx / 8 : bx;
    unsigned char* ws = args0.ws;
    gu32* ctl = (gu32*)(ws + WS_CTL);
    for (int u = tid; u < (LDS_BYTES - LDSCTL_OFF) / 4; u += NWAVES * 64) ((LAS unsigned*)(lds + LDSCTL_OFF))[u] = 0u;
    __syncthreads();
    XcdBarrier bar; bar.bar = g_barrier_words + args0.li * XCD_BAR_WORDS; bar.nx = G < 8 ? (unsigned)G : 8u; bar.x = (unsigned)bx % bar.nx; bar.nloc = ((unsigned)G - bar.x + bar.nx - 1u) / bar.nx;
#ifdef PROBE_PH
    const unsigned long long tk0 = __builtin_amdgcn_s_memrealtime(); int nst = 0;
#define GRID_BAR() do { if (!MK_MULTI) xcd_barrier(bar); if (bx == 0 && tid == 0) { ((float*)(ws + WS_CTL + 768 * 1024))[nst] = (float)(__builtin_amdgcn_s_memrealtime() - tk0); } ++nst; } while (0)
#else
#define GRID_BAR() do { if (!MK_MULTI) xcd_barrier(bar); } while (0)
#endif
    const int lo = args0.ph_lo, hi = args0.ph_hi;
#ifndef PHASE_MASK
#define PHASE_MASK 0xff
#endif
#define IN(k) (((PHASE_MASK >> (k)) & 1) && lo <= (k) && (k) < hi)
#define BOTH(k) (IN(k) && IN((k) + 1))

    if (IN(0)) { const Args args = opaque_args(); const int t_ = opaque_tid(); p0_prologue(args, lds, vcu, G, __builtin_amdgcn_readfirstlane(t_ >> 6), t_ & 63); if (BOTH(0)) GRID_BAR(); }
#ifdef PROBE_BARS
    for (int xb = 0; xb < PROBE_BARS; ++xb) GRID_BAR();
#endif

    if (IN(1)) { const Args args = opaque_args();
        constexpr int NUB = 64 * 26 + 16;
        const unsigned* ropep = (const unsigned*)((unsigned char*)args.out + DO_ROPE);
        {
            pg8::Gemm g{(const bf16_t*)(ws + WS_A1I8), (const bf16_t*)((unsigned char*)args.out + DO_WI8), T_ + NB_ * MEM_, NCAT, 512 + args0.pad};
            TileOrder S; S.init(0x3FFFFFFu, 1, G, bx);
            Epi1 E{ws, ropep, args.in[I_AQ], args.in[I_AK], args.in[I_BQ], args.in[I_BK], args.in[I_BGATE], (const float*)(ws + WS_RSC), (const float*)(ws + WS_CMAX), lds};
            pg8::gemm_phase<Epi1, TileOrder, true, false, false, 2, true>(lds + RING_OFF, g, S, E);
            { const int nrem = NUB % G;
              const int t_ = opaque_tid(), w_ = __builtin_amdgcn_readfirstlane(t_ >> 6), l_ = t_ & 63;
              if (nrem == 0) p0_late_weights<0>(args, bx * NWAVES + w_, G * NWAVES, l_);
              else if (bx >= nrem) p0_late_weights<0>(args, (bx - nrem) * NWAVES + w_, (G - nrem) * NWAVES, l_); }
        }
        if (BOTH(1)) GRID_BAR();
    }

    if (IN(2)) { const Args args = opaque_args(); const int t_ = opaque_tid(); p2_attention(args, lds, vcu, t_, __builtin_amdgcn_readfirstlane(t_ >> 6), t_ & 63); if (BOTH(2)) GRID_BAR(); }


    if (IN(4)) { const Args args = opaque_args();
        pg8::Gemm g{(const bf16_t*)((unsigned char*)args.out + DO_OCAT), (const bf16_t*)(ws + WS_WO), T_, 1024, KCAT};
        P3aOrder S; S.init(T_, 1024, G, bx);
        S.oag = (const bf16_t*)((unsigned char*)args.out + DO_OAG); S.ocat = (bf16_t*)((unsigned char*)args.out + DO_OCAT); S.lse = (const float*)(ws + WS_LSE);
        Epi3a E{(const unsigned char*)(ws + WS_G), (bf16_t*)(ws + WS_MERGED)};
        pg8::gemm_phase<Epi3a, P3aOrder, false, false, true>(lds + RING_OFF, g, S, E);
        if (BOTH(4)) GRID_BAR();
    }

    if (IN(5)) { const Args args = opaque_args();
        pg8::Gemm g{(const bf16_t*)(ws + WS_MERGED), (const bf16_t*)(ws + WS_WOUT), T_, 1024, 1024};
        pg8::StaticOrder S; S.init(T_, 1024, G, bx);
        Epi3b E{args.in[I_X], (bf16_t*)(ws + WS_X1L), (bf16_t*)(ws + WS_X1B), (float*)(ws + WS_SSQ)};
        pg8::gemm_phase<Epi3b, pg8::StaticOrder, false, false, false>(lds + RING_OFF, g, S, E);
        if (BOTH(5)) GRID_BAR();
    }

    if (IN(6)) { const Args args = opaque_args();
        pg8::Gemm g{(const bf16_t*)(ws + WS_X1B), (const bf16_t*)(ws + WS_WUP), T_, 5632, 1024};
          P4Order S; S.init(T_, 5632, G, bx, 4); S.SSQ = (const float*)(ws + WS_SSQ); S.rtab = (LAS float*)(lds + XCH_OFF + 2048); S.lastpm = -1; S.convw = args.in[I_CONVW]; S.convb = args.in[I_CONVB]; S.ctab = lds + CTAB_OFF;
        Epi4 E{args.in[I_CONVW], args.in[I_CONVB], (bf16_t*)(ws + WS_ACT), (float*)(ws + WS_UE), (float*)(ws + WS_UF), (LAS float*)(lds + XCH_OFF), (LAS const float*)(lds + XCH_OFF + 2048), (LAS const float*)(lds + CTAB_OFF)};
#ifdef PROBE_NOEPI
        E.skip = (args0.li == 1);
#endif
        pg8::gemm_phase<Epi4, P4Order, true, true, false>(lds + RING_OFF, g, S, E);
        { const int nrem = (64 * 22) % G;
          const int t_ = opaque_tid(), w_ = __builtin_amdgcn_readfirstlane(t_ >> 6), l_ = t_ & 63;
          if (nrem == 0) p0_late_weights<1>(args, bx * NWAVES + w_, G * NWAVES, l_);
          else if (bx >= nrem) p0_late_weights<1>(args, (bx - nrem) * NWAVES + w_, (G - nrem) * NWAVES, l_); }
        if (BOTH(6)) GRID_BAR();
    }

    if (IN(7)) { const Args args = opaque_args();
        pg8::Gemm g{(const bf16_t*)(ws + WS_ACT), (const bf16_t*)(ws + WS_WDOWN), T_, 1024, DFF_};
        P5Order S; S.init(T_, 1024, G, bx);
        S.UE = (const float*)(ws + WS_UE); S.UF = (const float*)(ws + WS_UF); S.convw = args.in[I_CONVW]; S.convb = args.in[I_CONVB]; S.ACT = (bf16_t*)(ws + WS_ACT);
        Epi5 E{(const bf16_t*)(ws + WS_X1B), (const bf16_t*)(ws + WS_X1L), args.out};
        pg8::gemm_phase<Epi5, P5Order, false, false, false>(lds + RING_OFF, g, S, E);
    }
#ifdef PROBE_PH
    if (IN(7) && bx == 0 && tid == 0) { asm volatile("s_waitcnt vmcnt(0)" ::: "memory"); float* st = (float*)(ws + WS_CTL + 768 * 1024); st[nst] = (float)(__builtin_amdgcn_s_memrealtime() - tk0);
        args.out[5] = 1000.0f * (1000.0f * floorf(st[PROBE_PH] / 1000.0f + 0.5f)); }
#endif
#ifdef PROBE_TS
    if (IN(7) && bx == 0 && tid == 0) { asm volatile("s_waitcnt vmcnt(0)" ::: "memory"); const float* dbg = (const float*)(ws + WS_CTL + 512 * 1024); args.out[5] = 1000.0f * (400.0f * floorf(dbg[PROBE_TS - 1] / 400.0f + 0.5f)); }
#endif
#undef IN
#undef BOTH
#undef GRID_BAR
}

extern "C" void kernel_launch(void* const* d_in, const int* in_sizes, int n_in, void* d_out, int out_size, void* d_ws, size_t ws_size, hipStream_t stream) {
    static int grid = 0;
    if (grid == 0) {
        if (n_in != 25 || out_size != T_ * DM_ || ws_size < WS_END) { fprintf(stderr, "kernel_launch: unexpected shapes (n_in %d, out %d, ws %zu); nothing launched\n", n_in, out_size, ws_size); grid = -1; return; }
        int dev = 0, cus = 0, per_cu = 0;
        if (hipGetDevice(&dev) != hipSuccess || hipDeviceGetAttribute(&cus, hipDeviceAttributeMultiprocessorCount, dev) != hipSuccess) { grid = -1; return; }
        if (hipFuncSetAttribute((const void*)fwd_kernel, hipFuncAttributeMaxDynamicSharedMemorySize, LDS_BYTES) != hipSuccess) { fprintf(stderr, "kernel_launch: hipFuncSetAttribute failed\n"); grid = -1; return; }
        if (hipOccupancyMaxActiveBlocksPerMultiprocessor(&per_cu, (const void*)fwd_kernel, NWAVES * 64, LDS_BYTES) != hipSuccess || per_cu < 1) { fprintf(stderr, "kernel_launch: occupancy query says %d blocks per CU\n", per_cu); }
        (void)hipGetLastError();
        grid = cus;
        if (grid != 256) fprintf(stderr, "kernel_launch: %d CUs (the phase schedules expect 256)\n", grid);
    }
    if (grid < 0) return;
    Args a{};
    for (int i = 0; i < 25; ++i) a.in[i] = (const float*)d_in[i];
    a.out = (float*)d_out; a.ws = (unsigned char*)d_ws;
#if MK_MULTI
    for (int p = 0; p < NPHASES; ++p) { a.ph_lo = p; a.ph_hi = p + 1; a.li = p; hipLaunchKernelGGL(fwd_kernel, dim3(grid), dim3(NWAVES * 64), LDS_BYTES, stream, a); }
#elif defined(PROBE_PHASE)
    a.ph_lo = 0; a.ph_hi = PROBE_PHASE + 1; a.li = 0;
    hipLaunchKernelGGL(fwd_kernel, dim3(grid), dim3(NWAVES * 64), LDS_BYTES, stream, a);
    a.ph_lo = PROBE_PHASE; a.ph_hi = NPHASES; a.li = 1;
    hipLaunchKernelGGL(fwd_kernel, dim3(grid), dim3(NWAVES * 64), LDS_BYTES, stream, a);
#else
    a.ph_lo = 0; a.ph_hi = NPHASES; a.li = 0;
    hipLaunchKernelGGL(fwd_kernel, dim3(grid), dim3(NWAVES * 64), LDS_BYTES, stream, a);
#endif
}
```
